# Optimizing an MI355X kernel written in HIP

```python
import math
import jax, jax.numpy as jnp
from jax import lax
import numpy as np

D_MODEL = 1024
BATCH = 16
SEQ = 2048
DEPTH = 2

CTX_LEN = 256
GRID_W = 64
MIX_WIDTH = D_MODEL
ATTN_HEADS = 4
ATTN_QK_DIM = 64
ATTN_V_DIM = 2 * ATTN_QK_DIM
Q_W = ATTN_HEADS * 2 * ATTN_QK_DIM
ATTN_WIDTH = ATTN_HEADS * ATTN_V_DIM
CONV_WIDTH = MIX_WIDTH - ATTN_WIDTH
CONV_GROUPS = 8
CONV_K = 3
K_OFF = Q_W
V_OFF = 2 * Q_W
B_OFF = V_OFF + ATTN_WIDTH
C_OFF = B_OFF + CONV_WIDTH
X_OFF = C_OFF + CONV_WIDTH
EVEN_IN = X_OFF + CONV_WIDTH
CHUNK = 128
CMLP_GROUPS = 4
CMLP_WIDTH = MIX_WIDTH
N_EXPERTS = 16
EXPERT_HIDDEN = D_MODEL
CAPACITY_FACTOR = 2
ROPE_THETA = 10000.0
NORM_EPS = 1e-6
Q_BLOCK = 128
N_EVEN = (DEPTH + 1) // 2
N_ODD = DEPTH // 2

kernel_name = "hybrid_diffattn_shortconv_chunkmlp_ecmoe_dit"


def _rms(x, g):
    xf = x.astype(jnp.float32)
    y = xf * lax.rsqrt(jnp.mean(xf * xf, axis=-1, keepdims=True) + NORM_EPS)
    return y.astype(x.dtype) * g


def _modulate(h, shift, scale):
    return h * (1 + scale) + shift


def _ctx_needed_after(l):
    return any(j % 2 == 0 for j in range(l + 1, DEPTH))


def _axial_rope_tables(n):
    rows = n // GRID_W
    row = jnp.repeat(jnp.arange(rows), GRID_W).astype(jnp.float32)
    col = jnp.tile(jnp.arange(GRID_W), rows).astype(jnp.float32)
    half = ATTN_QK_DIM // 2
    inv = 1.0 / (ROPE_THETA ** (jnp.arange(0, half, 2, dtype=jnp.float32) / half))
    ang_r = row[:, None] * inv
    ang_c = col[:, None] * inv
    ang = jnp.concatenate([ang_r, ang_r, ang_c, ang_c], axis=-1)
    return jnp.cos(ang), jnp.sin(ang)


def _apply_rope(x, cos, sin):
    quarter = ATTN_QK_DIM // 4
    xs = x.reshape(x.shape[:-1] + (2, 2, quarter))
    rot = jnp.stack([-xs[..., 1, :], xs[..., 0, :]], axis=-2).reshape(x.shape)
    cb = cos[None, :, None, None, :]
    sb = sin[None, :, None, None, :]
    return (x.astype(jnp.float32) * cb + rot.astype(jnp.float32) * sb).astype(x.dtype)


def _diff_attention(q, k, v, lam):
    bsz, n, heads, _, d = q.shape
    nb = n // Q_BLOCK
    qb = q.reshape(bsz, nb, Q_BLOCK, heads, 2, d).transpose(1, 0, 3, 4, 2, 5)
    kt = k.transpose(0, 2, 3, 1, 4)
    vt = v.transpose(0, 2, 1, 3)
    scale = d ** -0.5

    def one_block(q_blk):
        s = jnp.einsum('bhmqd,bhmkd->bhmqk', q_blk, kt).astype(jnp.float32) * scale
        p = jax.nn.softmax(s, axis=-1)
        a = p[:, :, 0] - lam * p[:, :, 1]
        return jnp.einsum('bhqk,bhkv->bhqv', a.astype(vt.dtype), vt)

    o = lax.map(one_block, qb)
    return o.transpose(1, 0, 3, 2, 4).reshape(bsz, n, heads, -1)


def _short_conv(u, w):
    n = u.shape[1]
    pad = CONV_K // 2
    up = jnp.pad(u, ((0, 0), (pad, pad), (0, 0)))
    return sum(up[:, i:i + n] * w[i] for i in range(CONV_K))


def _diff_heads(qp, kp, vp, lam, subln, lam_init, cos=None, sin=None, k_prefix=None, v_prefix=None):
    bsz, n, _ = qp.shape
    q = qp.reshape(bsz, n, ATTN_HEADS, 2, ATTN_QK_DIM)
    k = kp.reshape(bsz, kp.shape[1], ATTN_HEADS, 2, ATTN_QK_DIM)
    v = vp.reshape(bsz, vp.shape[1], ATTN_HEADS, ATTN_V_DIM)
    if cos is not None:
        q = _apply_rope(q, cos, sin)
        k = _apply_rope(k, cos, sin)
    if k_prefix is not None:
        k = jnp.concatenate([k_prefix, k], axis=1)
        v = jnp.concatenate([v_prefix, v], axis=1)
    o = _diff_attention(q, k, v, lam)
    o = _rms(o, subln) * (1.0 - lam_init)
    return o.reshape(bsz, n, ATTN_WIDTH)


def _even_mixer(h, hc, w_in, lam_p, subln, conv_w, cos, sin, lam_init, ctx_out):
    bsz, m = hc.shape[0], hc.shape[1]
    lam = (jnp.exp(jnp.sum(lam_p[0] * lam_p[1]).astype(jnp.float32))
           - jnp.exp(jnp.sum(lam_p[2] * lam_p[3]).astype(jnp.float32)) + lam_init)
    p = h @ w_in
    q, k, v, gb, gc, xs = jnp.split(p, [K_OFF, V_OFF, B_OFF, C_OFF, X_OFF], axis=-1)
    if ctx_out:
        pc = hc @ w_in
        qc, kc, vc, gbc, gcc, xsc = jnp.split(pc, [K_OFF, V_OFF, B_OFF, C_OFF, X_OFF], axis=-1)
    else:
        kvc = hc @ w_in[:, K_OFF:B_OFF]
        kc, vc = jnp.split(kvc, [V_OFF - K_OFF], axis=-1)
    kc_h = kc.reshape(bsz, m, ATTN_HEADS, 2, ATTN_QK_DIM)
    vc_h = vc.reshape(bsz, m, ATTN_HEADS, ATTN_V_DIM)
    attn = _diff_heads(q, k, v, lam, subln, lam_init, cos, sin, kc_h, vc_h)
    conv = gb * _short_conv(gc * xs, conv_w)
    mix = jnp.concatenate([attn, conv], axis=-1)
    mix_c = None
    if ctx_out:
        attn_c = _diff_heads(qc, kc, vc, lam, subln, lam_init)
        conv_c = gbc * _short_conv(gcc * xsc, conv_w)
        mix_c = jnp.concatenate([attn_c, conv_c], axis=-1)
    return mix, mix_c


def _chunk_mlp(h, w_in, v_norm, w_s, b_s):
    bsz, n, _ = h.shape
    p = jax.nn.gelu(h @ w_in, approximate=False)
    u, v = jnp.split(p, 2, axis=-1)
    v = _rms(v, v_norm)
    gw = CMLP_WIDTH // CMLP_GROUPS
    vc = v.reshape(bsz, n // CHUNK, CHUNK, CMLP_GROUPS, gw)
    s = jnp.einsum('gij,bcjgw->bcigw', w_s, vc) + b_s.T[None, None, :, :, None]
    return u * s.reshape(bsz, n, CMLP_WIDTH)


def _expert_choice_moe(h, w_r, w_gate, w_up, w_down):
    bsz, n, d = h.shape
    cap = CAPACITY_FACTOR * n // N_EXPERTS
    probs = jax.nn.softmax((h @ w_r).astype(jnp.float32), axis=-1)
    vals, idx = lax.top_k(jnp.swapaxes(probs, 1, 2), cap)
    xs = jax.vmap(lambda hb, ib: hb[ib])(h, idx)
    a = jnp.einsum('becd,edf->becf', xs, w_gate)
    b = jnp.einsum('becd,edf->becf', xs, w_up)
    y = jnp.einsum('becf,efd->becd', jax.nn.silu(a) * b, w_down) * vals[..., None].astype(h.dtype)
    return jax.vmap(lambda yb, ib: jnp.zeros((n, d), yb.dtype).at[ib.reshape(-1)].add(yb.reshape(-1, d)))(y, idx)


def setup_inputs(seed: int = 0) -> dict:
    key = jax.random.key(seed)
    ks = jax.random.split(key, 24)
    nrm = lambda k, shape, s: jax.random.normal(k, shape, jnp.float32) * s
    D = D_MODEL
    return {
        "x": nrm(ks[0], (BATCH, SEQ, D), 1.0),
        "c": nrm(ks[1], (BATCH, D), 1.0),
        "ctx": nrm(ks[2], (BATCH, CTX_LEN, D), 1.0),
        "c_ctx": nrm(ks[3], (D,), 1.0),
        "w_mod": nrm(ks[4], (DEPTH, D, 6 * D), 0.5 * D ** -0.5),
        "b_mod": nrm(ks[5], (DEPTH, 6 * D), 0.02),
        "norm1": 1.0 + nrm(ks[6], (DEPTH, D), 0.02),
        "norm2": 1.0 + nrm(ks[7], (DEPTH, D), 0.02),
        "even_w_in": nrm(ks[8], (N_EVEN, D, EVEN_IN), D ** -0.5),
        "even_lambda": nrm(ks[9], (N_EVEN, 4, ATTN_QK_DIM), 0.1),
        "even_subln": 1.0 + nrm(ks[10], (N_EVEN, ATTN_V_DIM), 0.02),
        "even_conv_w": nrm(ks[11], (N_EVEN, CONV_K, CONV_WIDTH), CONV_K ** -0.5),
        "odd_w_in": nrm(ks[12], (N_ODD, D, 2 * CMLP_WIDTH), D ** -0.5),
        "odd_v_norm": 1.0 + nrm(ks[13], (N_ODD, CMLP_WIDTH), 0.02),
        "odd_w_s": nrm(ks[14], (N_ODD, CMLP_GROUPS, CHUNK, CHUNK), CHUNK ** -0.5),
        "odd_b_s": 1.0 + nrm(ks[15], (N_ODD, CMLP_GROUPS, CHUNK), 0.01),
        "w_out": nrm(ks[16], (DEPTH, MIX_WIDTH, D), MIX_WIDTH ** -0.5),
        "w_router": nrm(ks[17], (DEPTH, D, N_EXPERTS), D ** -0.5),
        "w_gate": nrm(ks[18], (DEPTH, N_EXPERTS, D, EXPERT_HIDDEN), D ** -0.5),
        "w_up": nrm(ks[19], (DEPTH, N_EXPERTS, D, EXPERT_HIDDEN), D ** -0.5),
        "w_down": nrm(ks[20], (DEPTH, N_EXPERTS, EXPERT_HIDDEN, D), EXPERT_HIDDEN ** -0.5),
        "final_norm": 1.0 + nrm(ks[21], (D,), 0.02),
    }


def reference(x, c, ctx, c_ctx, w_mod, b_mod, norm1, norm2, even_w_in, even_lambda, even_subln,
              even_conv_w, odd_w_in, odd_v_norm, odd_w_s, odd_b_s, w_out, w_router, w_gate, w_up,
              w_down, final_norm):
    n_lat = x.shape[1]
    cos, sin = _axial_rope_tables(n_lat)
    xc = ctx
    sc_c = jax.nn.silu(c)
    sc_ctx = jax.nn.silu(c_ctx)
    for l in range(DEPTH):
        ctx_out = _ctx_needed_after(l)
        need_c = (l % 2 == 0) or ctx_out
        mod = sc_c @ w_mod[l] + b_mod[l]
        sh1, scl1, g1, sh2, scl2, g2 = jnp.split(mod[:, None, :], 6, axis=-1)
        h = _modulate(_rms(x, norm1[l]), sh1, scl1)
        if need_c:
            modc = sc_ctx @ w_mod[l] + b_mod[l]
            csh1, cscl1, cg1, csh2, cscl2, cg2 = jnp.split(modc, 6)
            hc = _modulate(_rms(xc, norm1[l]), csh1, cscl1)
        if l % 2 == 0:
            e = l // 2
            lam_init = 0.8 - 0.6 * math.exp(-0.3 * l)
            mix, mix_c = _even_mixer(h, hc, even_w_in[e], even_lambda[e], even_subln[e],
                                     even_conv_w[e], cos, sin, lam_init, ctx_out)
        else:
            o = l // 2
            mix = _chunk_mlp(h, odd_w_in[o], odd_v_norm[o], odd_w_s[o], odd_b_s[o])
            mix_c = _chunk_mlp(hc, odd_w_in[o], odd_v_norm[o], odd_w_s[o], odd_b_s[o]) if ctx_out else None
        x = x + g1 * (mix @ w_out[l])
        h2 = _modulate(_rms(x, norm2[l]), sh2, scl2)
        x = x + g2 * _expert_choice_moe(h2, w_router[l], w_gate[l], w_up[l], w_down[l])
        if ctx_out:
            xc = xc + cg1 * (mix_c @ w_out[l])
            hc2 = _modulate(_rms(xc, norm2[l]), csh2, cscl2)
            xc = xc + cg2 * _expert_choice_moe(hc2, w_router[l], w_gate[l], w_up[l], w_down[l])
    return _rms(x, final_norm)
```

```cpp
#define MK_PER_PHASE 0
#include <hip/hip_runtime.h>
#include <cstdio>
#include <cstdint>

#define GAS __attribute__((address_space(1)))
#define LAS __attribute__((address_space(3)))
typedef unsigned short bf16_t;
typedef short bf16x8 __attribute__((ext_vector_type(8)));
typedef short s16x4 __attribute__((ext_vector_type(4)));
typedef float f32x2 __attribute__((ext_vector_type(2)));
typedef float f32x4 __attribute__((ext_vector_type(4)));
typedef float f32x16 __attribute__((ext_vector_type(16)));
typedef unsigned u32x2 __attribute__((ext_vector_type(2)));
typedef unsigned u32x4 __attribute__((ext_vector_type(4)));

constexpr int DM = 1024, NB = 16, SEQ = 2048, CTX = 256, MROWS = NB * SEQ, CROWS = NB * CTX, SKV = CTX + SEQ;
constexpr int NE = 16, CAP = 256, MOE_ROWS = NB * NE * CAP;
constexpr float NORM_EPS = 1e-6f;
constexpr int MODW = 6 * DM;
constexpr int KSPLIT = 8;

__device__ __forceinline__ unsigned cvt_pk_bf16(float lo, float hi) { unsigned r; asm volatile("v_cvt_pk_bf16_f32 %0, %1, %2" : "=v"(r) : "v"(lo), "v"(hi)); return r; }
__device__ __forceinline__ float bf2f(unsigned short h) { return __uint_as_float(((unsigned)h) << 16); }
__device__ __forceinline__ float bflo(unsigned w) { return __uint_as_float(w << 16); }
__device__ __forceinline__ float bfhi(unsigned w) { return __uint_as_float(w & 0xffff0000u); }

namespace pg8 {
#define PG8_LAS __attribute__((address_space(3)))
constexpr int BM = 256, BK = 64, HALF = 128, HTB = HALF * BK * 2  , STAGE_BYTES = 8 * HTB, NXCD = 8, WGM = 8;

__host__ __device__ __forceinline__ int lds_byte(int r, int c) { const int st = (r >> 4) * 2 + (c >> 5), rr = r & 15, cc = c & 31, ob = rr * 64 + cc * 2; return st * 1024 + (ob ^ (((ob >> 9) & 1) << 5)); }
__host__ __device__ __forceinline__ void stage_rc(int b, int& R, int& C) { const int st = b / 1024, sb = b % 1024, swz = sb ^ (((sb >> 9) & 1) << 5); R = (st >> 1) * 16 + swz / 64; C = (st & 1) * 32 + (swz % 64) / 2; }
__host__ __device__ __forceinline__ int perm32(int rho) { const int n = rho >> 4, i = rho & 15; return 8 * (i >> 2) + 4 * n + (i & 3); }

struct Unit { int pm, pn, kind; const char* A; const char* B; };

__device__ __forceinline__ int xcd_remap(int wgid, int nwg) { const int q = nwg / NXCD, r = nwg % NXCD, xcd = wgid % NXCD, off = wgid / NXCD; return (xcd < r ? xcd * (q + 1) : r * (q + 1) + (xcd - r) * q) + off; }
__device__ __forceinline__ void grouped(int wgid, int nM, int nN, int& pm, int& pn) {
    const int nig = WGM * nN, gid = wgid / nig, fm = gid * WGM, gsz = (nM - fm) < WGM ? (nM - fm) : WGM;
    pm = fm + ((wgid % nig) % gsz); pn = (wgid % nig) / gsz;
}

__device__ __forceinline__ f32x2 gelu_pk(f32x2 v) {
    const f32x2 av = __builtin_elementwise_abs(v), d = av * 0.2316418882f + 1.0f;
    f32x2 t; t.x = __builtin_amdgcn_rcpf(d.x); t.y = __builtin_amdgcn_rcpf(d.y);
    f32x2 q = t * 0.5307027145f + (-0.7265760135f); q = q * t + 0.7107068705f; q = q * t + (-0.142248368f); q = q * t + 0.127414796f; q = q * t;
    const f32x2 s = (v * v) * (-0.72134752044f);
    f32x2 e; e.x = __builtin_amdgcn_exp2f(s.x); e.y = __builtin_amdgcn_exp2f(s.y);
    const f32x2 m = v * (q * e), r = v - m;
    f32x2 o; o.x = v.x < 0.f ? m.x : r.x; o.y = v.y < 0.f ? m.y : r.y; return o;
}

template <class Epi, class Sched, bool ALIGN_EPI = false, bool SP2 = false, bool GATHER = false>
__device__ __forceinline__ void gemm_phase(PG8_LAS unsigned char* lds, const int K, const Sched& S, const Epi& E, const int tid, const int* gidx = nullptr) {
    static_assert(SP2 || !GATHER, "row gather is wired into the SP2 loop only");
    const int wid = __builtin_amdgcn_readfirstlane(tid >> 6), lane = tid & 63, wr = wid >> 2, wc = wid & 3, fr = lane & 15, fq = lane >> 4;
    const int nt = K / BK;
    unsigned voffA[2], voffB[2];
#pragma unroll
    for (int i = 0; i < 2; ++i) { int R, C; stage_rc(tid * 16 + i * 8192, R, C); const int Rb = Epi::PERM ? ((R & ~31) + perm32(R & 31)) : R;
        voffA[i] = (unsigned)(R * K + C) * 2u; voffB[i] = (unsigned)(Rb * K + C) * 2u; }
    const size_t kstep = (size_t)(BK * 2);
    const size_t hstep = (size_t)HALF * K * 2;
    const unsigned ldsw = (unsigned)wid * 1024u;
    const int aoff = lds_byte(wr * 64 + fr, fq * 8), boff = lds_byte(wc * 32 + fr, fq * 8);
#define PG8_SA(b, h) (((b) * 2 + (h)) * HTB)
#define PG8_SB(b, h) ((4 + (b) * 2 + (h)) * HTB)
#define PG8_STAGE(bufoff, gbase, voff) do { _Pragma("unroll") for (int _i = 0; _i < 2; ++_i) \
        __builtin_amdgcn_global_load_lds((const unsigned*)((const char*)(gbase) + (voff)[_i]), (PG8_LAS unsigned*)(lds + (bufoff) + ldsw + _i * 8192), 16, 0, 0); } while (0)
#define PG8_GOFF(u, o0, o1) do { _Pragma("unroll") for (int _i = 0; _i < 2; ++_i) { int R_, C_; stage_rc(tid * 16 + _i * 8192, R_, C_); const int g0_ = gidx[(u).pm * 256 + R_], g1_ = gidx[(u).pm * 256 + 128 + R_]; \
        o0[_i] = (unsigned)(g0_ * K + C_) * 2u; o1[_i] = (unsigned)(g1_ * K + C_) * 2u; } } while (0)
#define PG8_STAGE_A(bufoff, gbase, half, nx) do { if constexpr (GATHER) { unsigned t_[2]; _Pragma("unroll") for (int _j = 0; _j < 2; ++_j) { int R_, C_; stage_rc(tid * 16 + _j * 8192, R_, C_); \
            const unsigned nv_ = (unsigned)(((half) ? ng1[_j] : ng0[_j]) * K + C_) * 2u; t_[_j] = (half) ? ((nx) ? nv_ : cva1[_j]) : ((nx) ? nv_ : cva0[_j]); } PG8_STAGE(bufoff, gbase, t_); } \
        else { PG8_STAGE(bufoff, (gbase) + ((half) ? hstep : 0), voffA); } } while (0)
#define PG8_LDA(dst, b, h) do { _Pragma("unroll") for (int m = 0; m < 4; ++m) _Pragma("unroll") for (int k = 0; k < 2; ++k) dst[m][k] = *(const PG8_LAS bf16x8*)(lds + PG8_SA(b, h) + aoff + m * 2048 + k * 1024); } while (0)
#define PG8_LDB(dst, b, h) do { _Pragma("unroll") for (int n = 0; n < 2; ++n) _Pragma("unroll") for (int k = 0; k < 2; ++k) dst[n][k] = *(const PG8_LAS bf16x8*)(lds + PG8_SB(b, h) + boff + n * 2048 + k * 1024); } while (0)
#define PG8_MMA(ai, bj, At, Bt) do { __builtin_amdgcn_s_setprio(1); _Pragma("unroll") for (int m = 0; m < 4; ++m) _Pragma("unroll") for (int n = 0; n < 2; ++n) _Pragma("unroll") for (int k = 0; k < 2; ++k) \
        acc[ai][bj][m][n] = __builtin_amdgcn_mfma_f32_16x16x32_bf16(Bt[n][k], At[m][k], acc[ai][bj][m][n], 0, 0, 0); __builtin_amdgcn_s_setprio(0); } while (0)
#define PG8_WAIT_V(n) asm volatile("s_waitcnt vmcnt(" #n ")" ::: "memory")
#define PG8_WAIT_L(n) asm volatile("s_waitcnt lgkmcnt(" #n ")" ::: "memory")
#define PG8_BAR __builtin_amdgcn_s_barrier()
#define PG8_SCHED __builtin_amdgcn_sched_barrier(0)
    Unit cur, nxt; int ui = 0;
    if (!S.next(0, cur)) return;
    f32x4 acc[2][2][4][2];
#pragma unroll
    for (int a = 0; a < 2; ++a)
#pragma unroll
        for (int b = 0; b < 2; ++b)
#pragma unroll
            for (int m = 0; m < 4; ++m)
#pragma unroll
                for (int n = 0; n < 2; ++n) acc[a][b][m][n] = (f32x4){0.f, 0.f, 0.f, 0.f};
    bf16x8 At[4][2], B0[2][2], B1[2][2];
    const char* cA = cur.A; const char* cB = cur.B;
    unsigned cva0[2] = {0u, 0u}, cva1[2] = {0u, 0u}; int ng0[2] = {0, 0}, ng1[2] = {0, 0};
    if constexpr (GATHER) PG8_GOFF(cur, cva0, cva1);
    if constexpr (SP2) {
        PG8_STAGE(PG8_SB(0, 0), cB, voffB); PG8_STAGE(PG8_SB(0, 1), cB + hstep, voffB); PG8_STAGE_A(PG8_SA(0, 0), cA, 0, false); PG8_STAGE_A(PG8_SA(0, 1), cA, 1, false);
        if (wr == 1) PG8_BAR;
        PG8_WAIT_V(2); PG8_BAR;
        PG8_STAGE(PG8_SB(1, 0), cB + kstep, voffB); PG8_STAGE_A(PG8_SA(1, 0), cA + kstep, 0, false); PG8_STAGE(PG8_SB(1, 1), cB + hstep + kstep, voffB);
        PG8_WAIT_V(6); PG8_BAR;
    } else {
        PG8_STAGE(PG8_SB(0, 0), cB, voffB); PG8_STAGE(PG8_SA(0, 0), cA, voffA); PG8_STAGE(PG8_SB(0, 1), cB + hstep, voffB); PG8_STAGE(PG8_SA(0, 1), cA + hstep, voffA);
        if (wr == 1) PG8_BAR;
        PG8_WAIT_V(4); PG8_BAR;
        PG8_STAGE(PG8_SB(1, 0), cB + kstep, voffB); PG8_STAGE(PG8_SA(1, 0), cA + kstep, voffA); PG8_STAGE(PG8_SB(1, 1), cB + hstep + kstep, voffB);
        PG8_WAIT_V(6); PG8_BAR;
    }
    for (;;) {
        const bool has_next = S.next(ui + 1, nxt);
        if constexpr (GATHER) { const Unit& gu = has_next ? nxt : cur; _Pragma("unroll") for (int _i = 0; _i < 2; ++_i) { int R_, C_; stage_rc(tid * 16 + _i * 8192, R_, C_); ng0[_i] = gidx[gu.pm * 256 + R_]; ng1[_i] = gidx[gu.pm * 256 + 128 + R_]; } }
        const char* nA = has_next ? nxt.A : cA; const char* nB = has_next ? nxt.B : cB;
        for (int t = 0; t < nt; t += 2) {
            const bool last = (t == nt - 2);
            const char* a1 = cA + (size_t)(t + 1) * kstep;
            const char* a2 = last ? nA : cA + (size_t)(t + 2) * kstep; const char* b2 = last ? nB : cB + (size_t)(t + 2) * kstep;
            const char* a3 = a2 + kstep; const char* b3 = b2 + kstep;
            if constexpr (SP2) {
            PG8_LDB(B0, 0, 0); PG8_LDB(B1, 0, 1); PG8_SCHED; PG8_LDA(At, 0, 0); PG8_STAGE_A(PG8_SA(1, 1), a1, 1, false);
            PG8_WAIT_V(8); PG8_WAIT_L(0); PG8_BAR; PG8_MMA(0, 0, At, B0); PG8_MMA(0, 1, At, B1); PG8_BAR; PG8_SCHED;
            PG8_LDA(At, 0, 1); PG8_STAGE(PG8_SB(0, 0), b2, voffB); PG8_STAGE(PG8_SB(0, 1), b2 + hstep, voffB); PG8_STAGE_A(PG8_SA(0, 0), a2, 0, last);
            PG8_WAIT_V(8); PG8_WAIT_L(0); PG8_BAR; PG8_MMA(1, 0, At, B0); PG8_MMA(1, 1, At, B1); PG8_BAR; PG8_SCHED;
            PG8_LDB(B0, 1, 0); PG8_LDB(B1, 1, 1); PG8_SCHED; PG8_LDA(At, 1, 0); PG8_STAGE_A(PG8_SA(0, 1), a2, 1, last);
            PG8_WAIT_V(8); PG8_WAIT_L(0); PG8_BAR; PG8_MMA(0, 0, At, B0); PG8_MMA(0, 1, At, B1); PG8_BAR; PG8_SCHED;
            PG8_LDA(At, 1, 1); PG8_STAGE(PG8_SB(1, 0), b3, voffB); PG8_STAGE(PG8_SB(1, 1), b3 + hstep, voffB); PG8_STAGE_A(PG8_SA(1, 0), a3, 0, last);
            PG8_WAIT_V(8); PG8_WAIT_L(0); PG8_BAR; PG8_MMA(1, 0, At, B0); PG8_MMA(1, 1, At, B1); PG8_BAR; PG8_SCHED;
            } else {
            PG8_LDB(B0, 0, 0); PG8_SCHED; PG8_LDA(At, 0, 0); PG8_STAGE(PG8_SA(1, 1), a1 + hstep, voffA);
            PG8_WAIT_L(8); PG8_BAR; PG8_WAIT_L(0); PG8_MMA(0, 0, At, B0); PG8_BAR; PG8_SCHED;
            PG8_LDB(B1, 0, 1); PG8_STAGE(PG8_SB(0, 0), b2, voffB);
            PG8_BAR; PG8_WAIT_L(0); PG8_MMA(0, 1, At, B1); PG8_BAR;
            PG8_LDA(At, 0, 1); PG8_STAGE(PG8_SA(0, 0), a2, voffA);
            PG8_BAR; PG8_WAIT_L(0); PG8_MMA(1, 0, At, B0); PG8_BAR; PG8_SCHED;
            PG8_STAGE(PG8_SB(0, 1), b2 + hstep, voffB);
            PG8_WAIT_V(6); PG8_BAR; PG8_MMA(1, 1, At, B1); PG8_BAR;
            PG8_LDB(B0, 1, 0); PG8_SCHED; PG8_LDA(At, 1, 0); PG8_STAGE(PG8_SA(0, 1), a2 + hstep, voffA);
            PG8_WAIT_L(8); PG8_BAR; PG8_WAIT_L(0); PG8_MMA(0, 0, At, B0); PG8_BAR; PG8_SCHED;
            PG8_LDB(B1, 1, 1); PG8_STAGE(PG8_SB(1, 0), b3, voffB);
            PG8_BAR; PG8_WAIT_L(0); PG8_MMA(0, 1, At, B1); PG8_BAR;
            PG8_LDA(At, 1, 1); PG8_STAGE(PG8_SA(1, 0), a3, voffA);
            PG8_BAR; PG8_WAIT_L(0); PG8_MMA(1, 0, At, B0); PG8_BAR; PG8_SCHED;
            PG8_STAGE(PG8_SB(1, 1), b3 + hstep, voffB);
            PG8_WAIT_V(6); PG8_BAR; PG8_MMA(1, 1, At, B1); PG8_BAR;
            }
        }
        if constexpr (ALIGN_EPI) { if (wr == 0) PG8_BAR; }
        E(acc, cur, wr, wc, fr, fq);
        if (!has_next) break;
#pragma unroll
        for (int a = 0; a < 2; ++a)
#pragma unroll
            for (int b = 0; b < 2; ++b)
#pragma unroll
                for (int m = 0; m < 4; ++m)
#pragma unroll
                    for (int n = 0; n < 2; ++n) acc[a][b][m][n] = (f32x4){0.f, 0.f, 0.f, 0.f};
        cur = nxt; cA = nA; cB = nB; ++ui;
        if constexpr (GATHER) { _Pragma("unroll") for (int _i = 0; _i < 2; ++_i) { int R_, C_; stage_rc(tid * 16 + _i * 8192, R_, C_); cva0[_i] = (unsigned)(ng0[_i] * K + C_) * 2u; cva1[_i] = (unsigned)(ng1[_i] * K + C_) * 2u; } }
        if constexpr (ALIGN_EPI) { if (wr == 1) PG8_BAR; }
    }
    PG8_WAIT_V(0);
    if constexpr (!ALIGN_EPI) { if (wr == 0) PG8_BAR; }
    PG8_BAR;
#undef PG8_SA
#undef PG8_SB
#undef PG8_STAGE
#undef PG8_GOFF
#undef PG8_STAGE_A
#undef PG8_LDA
#undef PG8_LDB
#undef PG8_MMA
#undef PG8_WAIT_V
#undef PG8_WAIT_L
#undef PG8_BAR
#undef PG8_SCHED
}

__device__ __forceinline__ void st4bf(bf16_t* p, f32x4 v) { u32x2 w; w.x = cvt_pk_bf16(v[0], v[1]); w.y = cvt_pk_bf16(v[2], v[3]); *(u32x2*)p = w; }
__device__ __forceinline__ void st8bf(bf16_t* p, f32x4 a, f32x4 b) { u32x4 w; w.x = cvt_pk_bf16(a[0], a[1]); w.y = cvt_pk_bf16(a[2], a[3]); w.z = cvt_pk_bf16(b[0], b[1]); w.w = cvt_pk_bf16(b[2], b[3]); *(u32x4*)p = w; }

struct EpiInProj {
    static constexpr bool PERM = false;
    bf16_t *Q, *Kb, *Vb, *GB, *Z; const float* rope;
    __device__ __forceinline__ void operator()(const f32x4 (&acc)[2][2][4][2], const Unit& u, int wr, int wc, int fr, int fq) const {
        const int lrow0 = wr * 64 + fr, lcol0 = wc * 32 + 4 * fq;
        if (u.kind == 0 && u.pn < 4) {
            const bool isq = u.pn < 2;
#pragma unroll
            for (int ai = 0; ai < 2; ++ai)
#pragma unroll
                for (int m = 0; m < 4; ++m) {
                    const int row = u.pm * 256 + ai * 128 + m * 16 + lrow0, npos = row & (SEQ - 1), b = row >> 11;
                    const int p = (wc & 1) ? (npos & 63) : (npos >> 6);
                    const f32x4 cs = *(const f32x4*)(rope + p * 32 + 4 * fq), sn = *(const f32x4*)(rope + p * 32 + 16 + 4 * fq);
                    bf16_t* dst = isq ? Q + (size_t)row * 512 + (u.pn & 1) * 256 + lcol0 : Kb + (((size_t)b * 4 + (u.pn & 1) * 2) * SKV + CTX + npos) * 128 + lcol0;
                    const size_t hstride = isq ? 128 : (size_t)SKV * 128;
#pragma unroll
                    for (int bj = 0; bj < 2; ++bj) {
                        const f32x4 lo = acc[ai][bj][m][0], hi = acc[ai][bj][m][1];
                        st4bf(dst + bj * hstride, lo * cs - hi * sn); st4bf(dst + bj * hstride + 16, hi * cs + lo * sn);
                    }
                }
        } else if (u.kind == 0 && u.pn >= 8) {
#pragma unroll
            for (int ai = 0; ai < 2; ++ai)
#pragma unroll
                for (int m = 0; m < 4; ++m) {
                    const int row = u.pm * 256 + ai * 128 + m * 16 + lrow0;
                    bf16_t* dst = Z + (size_t)row * 512 + (u.pn - 8) * 128 + lcol0;
#pragma unroll
                    for (int n = 0; n < 2; ++n) st4bf(dst + n * 16, acc[ai][0][m][n] * acc[ai][1][m][n]);
                }
        } else {
#pragma unroll
            for (int ai = 0; ai < 2; ++ai)
#pragma unroll
                for (int m = 0; m < 4; ++m) {
                    const int row = u.pm * 256 + ai * 128 + m * 16 + lrow0;
                    bf16_t* dst; size_t hstride = (size_t)SKV * 128;
                    if (u.kind == 0) { const int npos = row & (SEQ - 1), b = row >> 11;
                        if (u.pn < 6) dst = Vb + (((size_t)b * 4 + (u.pn & 1) * 2) * SKV + CTX + npos) * 128; else { dst = GB + (size_t)row * 512 + (u.pn - 6) * 256; hstride = 128; } }
                    else { const int b = row >> 8, mpos = row & 255;
                        dst = ((u.pn < 2) ? Kb : Vb) + (((size_t)b * 4 + (u.pn & 1) * 2) * SKV + mpos) * 128; }
                    dst += lcol0;
#pragma unroll
                    for (int bj = 0; bj < 2; ++bj)
#pragma unroll
                        for (int n = 0; n < 2; ++n) st4bf(dst + bj * hstride + n * 16, acc[ai][bj][m][n]);
                }
        }
    }
};

struct EpiOutProj {
    static constexpr bool PERM = false;
    const float* base; float* out; const float* g; float* ssq;
    __device__ __forceinline__ void operator()(const f32x4 (&acc)[2][2][4][2], const Unit& u, int wr, int wc, int fr, int fq) const {
        const int lrow0 = wr * 64 + fr, col0 = u.pn * 256 + wc * 32 + 4 * fq, b = u.pm >> 3;
        f32x4 gv[2][2];
#pragma unroll
        for (int bj = 0; bj < 2; ++bj)
#pragma unroll
            for (int n = 0; n < 2; ++n) gv[bj][n] = *(const f32x4*)(g + (size_t)b * MODW + col0 + bj * 128 + n * 16);
#pragma unroll
        for (int ai = 0; ai < 2; ++ai)
#pragma unroll
            for (int m = 0; m < 4; ++m) {
                const int row = u.pm * 256 + ai * 128 + m * 16 + lrow0; const size_t off = (size_t)row * DM + col0; float s = 0.f;
#pragma unroll
                for (int bj = 0; bj < 2; ++bj)
#pragma unroll
                    for (int n = 0; n < 2; ++n) { const f32x4 bs = *(const f32x4*)(base + off + bj * 128 + n * 16); const f32x4 o = bs + gv[bj][n] * acc[ai][bj][m][n];
                        *(f32x4*)(out + off + bj * 128 + n * 16) = o; s += (o[0] * o[0] + o[1] * o[1]) + (o[2] * o[2] + o[3] * o[3]); }
                s += __shfl_xor(s, 16); s += __shfl_xor(s, 32);
                if (fq == 0) ssq[(size_t)row * 16 + u.pn * 4 + wc] = s;
                if (m & 1) asm volatile("" ::: "memory");
            }
    }
};

struct EpiGateUp {
    static constexpr bool PERM = true;
    bf16_t* ACT;
    __device__ __forceinline__ void operator()(const f32x4 (&acc)[2][2][4][2], const Unit& u, int wr, int wc, int fr, int fq) const {
        const int lrow0 = wr * 64 + fr, col0 = u.pn * 128 + wc * 32 + 8 * fq;
#pragma unroll
        for (int ai = 0; ai < 2; ++ai)
#pragma unroll
            for (int m = 0; m < 4; ++m) {
                const int row = u.pm * 256 + ai * 128 + m * 16 + lrow0; f32x4 r[2];
#pragma unroll
                for (int n = 0; n < 2; ++n) { const f32x4 gt = acc[ai][0][m][n], up = acc[ai][1][m][n];
#pragma unroll
                    for (int i = 0; i < 4; ++i) { const float e = __builtin_amdgcn_exp2f(gt[i] * -1.4426950408889634f); r[n][i] = gt[i] * __builtin_amdgcn_rcpf(1.0f + e) * up[i]; } }
                st8bf(ACT + (size_t)row * DM + col0, r[0], r[1]);
            }
    }
};

struct EpiDown {
    static constexpr bool PERM = true;
    bf16_t* Y; const float* vals;
    __device__ __forceinline__ void operator()(const f32x4 (&acc)[2][2][4][2], const Unit& u, int wr, int wc, int fr, int fq) const {
        const int lrow0 = wr * 64 + fr, col0 = u.pn * 256 + wc * 32 + 8 * fq;
#pragma unroll
        for (int ai = 0; ai < 2; ++ai)
#pragma unroll
            for (int m = 0; m < 4; ++m) {
                const int row = u.pm * 256 + ai * 128 + m * 16 + lrow0; const float v = vals[row];
#pragma unroll
                for (int bj = 0; bj < 2; ++bj) st8bf(Y + (size_t)row * DM + col0 + bj * 128, acc[ai][bj][m][0] * v, acc[ai][bj][m][1] * v);
            }
    }
};

struct EpiOddIn {
    static constexpr bool PERM = true;
    bf16_t* U; bf16_t* VV; float* ssqv;
    __device__ __forceinline__ void operator()(const f32x4 (&acc)[2][2][4][2], const Unit& u, int wr, int wc, int fr, int fq) const {
        const int lrow0 = wr * 64 + fr; const bool isv = u.pn >= 4; const int pnl = u.pn & 3, col0 = pnl * 256 + wc * 32 + 8 * fq;
        bf16_t* dstb = isv ? VV : U;
#pragma unroll
        for (int ai = 0; ai < 2; ++ai)
#pragma unroll
            for (int m = 0; m < 4; ++m) {
                const int row = u.pm * 256 + ai * 128 + m * 16 + lrow0; float s = 0.f;
#pragma unroll
                for (int bj = 0; bj < 2; ++bj) { const f32x4 v0 = acc[ai][bj][m][0], v1 = acc[ai][bj][m][1];
                    const f32x2 a = gelu_pk((f32x2){v0[0], v0[1]}), b = gelu_pk((f32x2){v0[2], v0[3]}), c = gelu_pk((f32x2){v1[0], v1[1]}), d = gelu_pk((f32x2){v1[2], v1[3]});
                    s += (a.x * a.x + a.y * a.y) + (b.x * b.x + b.y * b.y) + (c.x * c.x + c.y * c.y) + (d.x * d.x + d.y * d.y);
                    st8bf(dstb + (size_t)row * DM + col0 + bj * 128, (f32x4){a.x, a.y, b.x, b.y}, (f32x4){c.x, c.y, d.x, d.y}); }
                if (isv) { s += __shfl_xor(s, 16); s += __shfl_xor(s, 32); if (fq == 0) ssqv[(size_t)row * 16 + pnl * 4 + wc] = s; }
            }
    }
};

constexpr size_t TSTEP = (size_t)256 * DM * 2;
struct SchedSimple {
    const char* A; const char* B; int nM, nN, G, c;
    __device__ __forceinline__ bool next(int i, Unit& u) const {
        const int nwg = nM * nN; const long L = (long)i * G + c; if (L >= nwg) return false;
        const int w = xcd_remap((int)L, nwg); grouped(w, nM, nN, u.pm, u.pn); u.kind = 0; u.A = A + (size_t)u.pm * TSTEP; u.B = B + (size_t)u.pn * TSTEP; return true;
    }
};
struct SchedInProj {
    const char* A; const char* Ac; const char* B; int G, c;
    __device__ __forceinline__ bool next(int i, Unit& u) const {
        constexpr int n0 = 128 * 12, nwg = n0 + 64; const long L = (long)i * G + c; if (L >= nwg) return false;
        const int w = xcd_remap((int)L, nwg);
        if (w < n0) { grouped(w, 128, 12, u.pm, u.pn); u.kind = 0; u.A = A + (size_t)u.pm * TSTEP; u.B = B + (size_t)u.pn * TSTEP; }
        else { const int x = w - n0; u.pm = x >> 2; u.pn = x & 3; u.kind = 1; u.A = Ac + (size_t)u.pm * TSTEP; u.B = B + (size_t)(2 + u.pn) * TSTEP; }
        return true;
    }
};
struct SchedMoe {
    const char* A; const char* B; int nN, G, c;
    __device__ __forceinline__ bool next(int i, Unit& u) const {
        const int nwg = 256 * nN; const long L = (long)i * G + c; if (L >= nwg) return false;
        const int w = xcd_remap((int)L, nwg); grouped(w, 256, nN, u.pm, u.pn); u.kind = 0; u.A = A + (size_t)u.pm * TSTEP; u.B = B + (size_t)((u.pm >> 4) * nN + u.pn) * TSTEP; return true;
    }
};
struct SchedMoeGather {
    const char* A; const char* B; int G, c;
    __device__ __forceinline__ bool next(int i, Unit& u) const {
        constexpr int nN = 8, nwg = 256 * nN; const long L = (long)i * G + c; if (L >= nwg) return false;
        const int w = xcd_remap((int)L, nwg); grouped(w, 256, nN, u.pm, u.pn); u.kind = 0; u.A = A + (size_t)(u.pm & 15) * SEQ * DM * 2; u.B = B + (size_t)((u.pm >> 4) * nN + u.pn) * TSTEP; return true;
    }
};
}

namespace att {
constexpr int NW = 8, QBLK = 32, KVBLK = 64, LDQ = 512, LDK = 128;
constexpr float SCALE = 0.125f, THR = 8.f;
constexpr int SHM_V = KVBLK * 128 * 2, SHM_K = KVBLK * 128 * 2, SHM_ATTN = 3 * (SHM_V + SHM_K) + NW * 64 * 4;
#define KSWZ(row, colB) ((row) * 256 + ((colB) ^ (((row) & 7) << 4)))
#define SBAR() __builtin_amdgcn_sched_barrier(0)
__device__ __forceinline__ int crow(int r, int hi) { return (r & 3) + 8 * (r >> 2) + 4 * hi; }
__device__ __forceinline__ unsigned cvtpk(float lo, float hi) { unsigned r; asm volatile("v_cvt_pk_bf16_f32 %0, %1, %2" : "=v"(r) : "v"(lo), "v"(hi)); return r; }

__device__ __forceinline__ void partialSM(f32x16& p0, f32x16& p1, float& m_reg, float& mn, float& alpha) {
  constexpr float C = SCALE * 1.4426950408889634f;
  float pmax = p0[0]; for (int r = 1; r < 16; ++r) pmax = fmaxf(pmax, p0[r]); for (int r = 0; r < 16; ++r) pmax = fmaxf(pmax, p1[r]);
  { auto rr = __builtin_amdgcn_permlane32_swap(__float_as_uint(pmax), __float_as_uint(pmax), false, false);
    pmax = fmaxf(__uint_as_float(rr[0]), __uint_as_float(rr[1])); }
  if (__builtin_expect(__all(pmax - m_reg <= THR / SCALE), 1)) { mn = m_reg; alpha = 1.f; }
  else { mn = fmaxf(m_reg, pmax); alpha = __builtin_amdgcn_exp2f((m_reg - mn) * C); m_reg = mn; }
  float mnC = -mn * C;
  for (int r = 0; r < 16; ++r) p0[r] = fmaf(p0[r], C, mnC); for (int r = 0; r < 16; ++r) p1[r] = fmaf(p1[r], C, mnC);
  for (int r = 0; r < 16; ++r) p0[r] = __builtin_amdgcn_exp2f(p0[r]);
}
__device__ __forceinline__ void finishSM(f32x16& p0, f32x16& p1, float alpha, float& l_reg, bf16x8& pa0, bf16x8& pa1, bf16x8& pa2, bf16x8& pa3) {
  for (int r = 0; r < 16; ++r) p1[r] = __builtin_amdgcn_exp2f(p1[r]);
  float ps = 0; for (int r = 0; r < 16; ++r) ps += p0[r]; for (int r = 0; r < 16; ++r) ps += p1[r];
  { auto rr = __builtin_amdgcn_permlane32_swap(__float_as_uint(ps), __float_as_uint(ps), false, false);
    ps = __uint_as_float(rr[0]) + __uint_as_float(rr[1]); }
  l_reg = l_reg * alpha + ps;
#define PK4(P, BASE, OUT) do { unsigned a0 = cvtpk(P[BASE + 0], P[BASE + 1]), a1 = cvtpk(P[BASE + 2], P[BASE + 3]);   \
    unsigned b0 = cvtpk(P[BASE + 4], P[BASE + 5]), b1 = cvtpk(P[BASE + 6], P[BASE + 7]);                              \
    auto r0 = __builtin_amdgcn_permlane32_swap(a0, b0, false, false); auto r1 = __builtin_amdgcn_permlane32_swap(a1, b1, false, false); \
    u32x4 w = {r0[0], r1[0], r0[1], r1[1]}; OUT = *reinterpret_cast<bf16x8*>(&w); } while (0)
  PK4(p0, 0, pa0); PK4(p0, 8, pa1); PK4(p1, 0, pa2); PK4(p1, 8, pa3);
#undef PK4
}
__device__ __forceinline__ void qkt(f32x16& p0, f32x16& p1, const LAS unsigned char* Ks, const bf16x8* qr, int r32, int hi, int map) {
  p0 = f32x16{}; p1 = f32x16{};
#pragma unroll
  for (int d0 = 0; d0 < 4; ++d0) { const int cb = ((map * 4 + d0) * 16 + hi * 8) * 2;
    bf16x8 b0 = *(const LAS bf16x8*)(Ks + KSWZ(r32, cb));
    bf16x8 b1 = *(const LAS bf16x8*)(Ks + KSWZ(32 + r32, cb));
    p0 = __builtin_amdgcn_mfma_f32_32x32x16_bf16(b0, qr[d0], p0, 0, 0, 0);
    p1 = __builtin_amdgcn_mfma_f32_32x32x16_bf16(b1, qr[d0], p1, 0, 0, 0); }
}
__device__ __forceinline__ int v_st(int k, int c) { const int kk = (k & ~0xC) | ((k & 4) << 1) | ((k & 8) >> 1); return ((kk >> 3) * 4 + (c >> 5)) * 512 + ((kk & 7) * 32 + (c & 31)) * 2; }
__device__ __forceinline__ int v_rd_base(int lane) { return ((lane & 3) << 3) | (((lane >> 2) & 3) << 6) | (((lane >> 4) & 1) << 5) | (((lane >> 5) & 1) << 8); }
constexpr int v_rd_off(int d0, int ks, int half) { return d0 * 512 + ks * 4096 + half * 2048; }
template <int OFF> __device__ __forceinline__ s16x4 tr_read(int vb) {
  s16x4 r; asm volatile("ds_read_b64_tr_b16 %0, %1 offset:%2" : "=&v"(r) : "v"(vb), "i"(OFF) : "memory"); return r;
}
template <int D0> __device__ __forceinline__ void pv_one(f32x16& od, int vb, bf16x8 pa0, bf16x8 pa1, bf16x8 pa2, bf16x8 pa3) {
  const s16x4 l0 = tr_read<v_rd_off(D0, 0, 0)>(vb), h0 = tr_read<v_rd_off(D0, 0, 1)>(vb), l1 = tr_read<v_rd_off(D0, 1, 0)>(vb), h1 = tr_read<v_rd_off(D0, 1, 1)>(vb);
  const s16x4 l2 = tr_read<v_rd_off(D0, 2, 0)>(vb), h2 = tr_read<v_rd_off(D0, 2, 1)>(vb), l3 = tr_read<v_rd_off(D0, 3, 0)>(vb), h3 = tr_read<v_rd_off(D0, 3, 1)>(vb);
  asm volatile("s_waitcnt lgkmcnt(0)" ::: "memory"); SBAR();
#define PK(L, H) (bf16x8){L[0], L[1], L[2], L[3], H[0], H[1], H[2], H[3]}
  od = __builtin_amdgcn_mfma_f32_32x32x16_bf16(pa0, PK(l0, h0), od, 0, 0, 0);
  od = __builtin_amdgcn_mfma_f32_32x32x16_bf16(pa1, PK(l1, h1), od, 0, 0, 0);
  od = __builtin_amdgcn_mfma_f32_32x32x16_bf16(pa2, PK(l2, h2), od, 0, 0, 0);
  od = __builtin_amdgcn_mfma_f32_32x32x16_bf16(pa3, PK(l3, h3), od, 0, 0, 0);
#undef PK
}
__device__ __forceinline__ void pv_d0(f32x16* o, int vb, bf16x8 pa0, bf16x8 pa1, bf16x8 pa2, bf16x8 pa3) {
  pv_one<0>(o[0], vb, pa0, pa1, pa2, pa3); pv_one<1>(o[1], vb, pa0, pa1, pa2, pa3); pv_one<2>(o[2], vb, pa0, pa1, pa2, pa3); pv_one<3>(o[3], vb, pa0, pa1, pa2, pa3);
}

template <int OFF> __device__ __forceinline__ bf16x8 lds_read128(int addr) {
  bf16x8 r; asm volatile("ds_read_b128 %0, %1 offset:%2" : "=&v"(r) : "v"(addr), "i"(OFF) : "memory"); return r;
}
#define LGKM_WAIT(N) asm volatile("s_waitcnt lgkmcnt(" #N ")" ::: "memory")
#define VTR8(D0, L0, H0, L1, H1, L2, H2, L3, H3, vb) do { L0 = tr_read<v_rd_off(D0, 0, 0)>(vb); H0 = tr_read<v_rd_off(D0, 0, 1)>(vb); L1 = tr_read<v_rd_off(D0, 1, 0)>(vb); H1 = tr_read<v_rd_off(D0, 1, 1)>(vb); \
    L2 = tr_read<v_rd_off(D0, 2, 0)>(vb); H2 = tr_read<v_rd_off(D0, 2, 1)>(vb); L3 = tr_read<v_rd_off(D0, 3, 0)>(vb); H3 = tr_read<v_rd_off(D0, 3, 1)>(vb); } while (0)
#define VPK(L, H) (bf16x8){L[0], L[1], L[2], L[3], H[0], H[1], H[2], H[3]}
#define PV4(OD, L0, H0, L1, H1, L2, H2, L3, H3) do { OD = __builtin_amdgcn_mfma_f32_32x32x16_bf16(pa0, VPK(L0, H0), OD, 0, 0, 0); OD = __builtin_amdgcn_mfma_f32_32x32x16_bf16(pa1, VPK(L1, H1), OD, 0, 0, 0); \
    OD = __builtin_amdgcn_mfma_f32_32x32x16_bf16(pa2, VPK(L2, H2), OD, 0, 0, 0); OD = __builtin_amdgcn_mfma_f32_32x32x16_bf16(pa3, VPK(L3, H3), OD, 0, 0, 0); } while (0)
template <bool DO_QK, bool DO_PV>
__device__ __forceinline__ void m_phase(f32x16& p0, f32x16& p1, f32x16 (&o)[4], const bf16x8 (&qr)[4], const int (&kaddr)[4], int kb, int vb, bf16x8 pa0, bf16x8 pa1, bf16x8 pa2, bf16x8 pa3) {
  bf16x8 kf[8]; s16x4 a0, a1, a2, a3, a4, a5, a6, a7, b0, b1, b2, b3, b4, b5, b6, b7;
  SBAR();
  if constexpr (DO_QK) {
#pragma unroll
    for (int d0 = 0; d0 < 4; ++d0) { kf[2 * d0] = lds_read128<0>(kaddr[d0] + kb); kf[2 * d0 + 1] = lds_read128<8192>(kaddr[d0] + kb); }
  }
  if constexpr (DO_PV) VTR8(0, a0, a1, a2, a3, a4, a5, a6, a7, vb);
  if constexpr (DO_QK) {
    if constexpr (DO_PV) LGKM_WAIT(8); else LGKM_WAIT(0);
    SBAR();
    p0 = __builtin_amdgcn_mfma_f32_32x32x16_bf16(kf[0], qr[0], f32x16{}, 0, 0, 0); p1 = __builtin_amdgcn_mfma_f32_32x32x16_bf16(kf[1], qr[0], f32x16{}, 0, 0, 0);
#pragma unroll
    for (int d0 = 1; d0 < 4; ++d0) { p0 = __builtin_amdgcn_mfma_f32_32x32x16_bf16(kf[2 * d0], qr[d0], p0, 0, 0, 0); p1 = __builtin_amdgcn_mfma_f32_32x32x16_bf16(kf[2 * d0 + 1], qr[d0], p1, 0, 0, 0); }
    SBAR();
  }
  if constexpr (DO_PV) {
    VTR8(1, b0, b1, b2, b3, b4, b5, b6, b7, vb); LGKM_WAIT(8); SBAR(); PV4(o[0], a0, a1, a2, a3, a4, a5, a6, a7); SBAR();
    VTR8(2, a0, a1, a2, a3, a4, a5, a6, a7, vb); LGKM_WAIT(8); SBAR(); PV4(o[1], b0, b1, b2, b3, b4, b5, b6, b7); SBAR();
    VTR8(3, b0, b1, b2, b3, b4, b5, b6, b7, vb); LGKM_WAIT(8); SBAR(); PV4(o[2], a0, a1, a2, a3, a4, a5, a6, a7); SBAR();
    LGKM_WAIT(0); SBAR(); PV4(o[3], b0, b1, b2, b3, b4, b5, b6, b7); SBAR();
  }
}

__device__ __forceinline__ void softmax_tile(f32x16& p0, f32x16& p1, float& m_reg, float& l_reg, f32x16 (&o)[4], LAS float* al_l, int r32, int hi,
                                             bf16x8& pa0, bf16x8& pa1, bf16x8& pa2, bf16x8& pa3) {
  constexpr float C = SCALE * 1.4426950408889634f;
  float pmax = fmaxf(p0[0], p1[0]);
#pragma unroll
  for (int r = 1; r < 16; ++r) pmax = fmaxf(fmaxf(pmax, p0[r]), p1[r]);
  { auto rr = __builtin_amdgcn_permlane32_swap(__float_as_uint(pmax), __float_as_uint(pmax), false, false);
    pmax = fmaxf(__uint_as_float(rr[0]), __uint_as_float(rr[1])); }
  float alpha = 1.f;
  if (!__builtin_expect(__all(pmax - m_reg <= THR / SCALE), 1)) { const float mn = fmaxf(m_reg, pmax); alpha = __builtin_amdgcn_exp2f((m_reg - mn) * C); m_reg = mn; }
  const float mnC = -m_reg * C;
#pragma unroll
  for (int r = 0; r < 16; ++r) { p0[r] = __builtin_amdgcn_exp2f(fmaf(p0[r], C, mnC)); p1[r] = __builtin_amdgcn_exp2f(fmaf(p1[r], C, mnC)); }
  float ps = 0.f;
#pragma unroll
  for (int r = 0; r < 16; ++r) ps += p0[r] + p1[r];
  { auto rr = __builtin_amdgcn_permlane32_swap(__float_as_uint(ps), __float_as_uint(ps), false, false);
    ps = __uint_as_float(rr[0]) + __uint_as_float(rr[1]); }
  l_reg = l_reg * alpha + ps;
  if (__any(alpha < 1.f)) { if (hi == 0) al_l[r32] = alpha; asm volatile("s_waitcnt lgkmcnt(0)" ::: "memory");
#pragma unroll
    for (int d = 0; d < 4; ++d)
#pragma unroll
      for (int r = 0; r < 16; ++r) o[d][r] *= al_l[crow(r, hi)]; }
#define PK4(P, BASE, OUT) do { unsigned a0 = cvtpk(P[BASE + 0], P[BASE + 1]), a1 = cvtpk(P[BASE + 2], P[BASE + 3]);   \
    unsigned b0 = cvtpk(P[BASE + 4], P[BASE + 5]), b1 = cvtpk(P[BASE + 6], P[BASE + 7]);                              \
    auto r0 = __builtin_amdgcn_permlane32_swap(a0, b0, false, false); auto r1 = __builtin_amdgcn_permlane32_swap(a1, b1, false, false); \
    u32x4 w = {r0[0], r1[0], r0[1], r1[1]}; OUT = *reinterpret_cast<bf16x8*>(&w); } while (0)
  PK4(p0, 0, pa0); PK4(p0, 8, pa1); PK4(p1, 0, pa2); PK4(p1, 8, pa3);
#undef PK4
}

__device__ __forceinline__ void attn_unit(const bf16_t* Qb, const bf16_t* Kh, const bf16_t* Vh, bf16_t* Ob, float lam, const float* subln, LAS unsigned char* lds) {
  int tid = threadIdx.x; asm volatile("" : "+v"(tid));
  const int wid = tid >> 6, lane = tid & 63, r32 = lane & 31, hi = lane >> 5, map = wid >> 2, qw = wid & 3;
  const bool lead = __builtin_amdgcn_readfirstlane(wid) < 4;
  constexpr int SLOT = SHM_K + SHM_V;
  LAS float* ws = (LAS float*)(lds + 3 * SLOT) + wid * 64; LAS float* li_l = ws; LAS float* al_l = ws + 32;
  float m_reg = -1e30f, l_reg = 0; f32x16 o[4] = {}; bf16x8 qr[4];
  const bf16_t* Qw = Qb + (long)(qw * QBLK + r32) * LDQ + map * 64 + hi * 8;
#pragma unroll
  for (int d0 = 0; d0 < 4; ++d0) qr[d0] = *(const bf16x8*)(Qw + d0 * 16);
  const int sr = tid >> 4, sc = (tid & 15) * 8, vst0 = v_st(sr, sc), vst1 = v_st(32 + sr, sc), kst0 = KSWZ(sr, sc * 2), kst1 = KSWZ(32 + sr, sc * 2);
  const int vrb = (int)(uintptr_t)lds + SHM_K + v_rd_base(lane);
  int kaddr[4];
#pragma unroll
  for (int d0 = 0; d0 < 4; ++d0) kaddr[d0] = (int)(uintptr_t)lds + r32 * 256 + map * 128 + ((hi * 16 + d0 * 32) ^ ((r32 & 7) << 4));
  bf16x8 vs0, vs1, ks0, ks1;
#define SLOAD(k0) do { vs0 = *(const bf16x8*)(&Vh[(long)((k0) + sr) * LDK + sc]); vs1 = *(const bf16x8*)(&Vh[(long)((k0) + 32 + sr) * LDK + sc]); \
    ks0 = *(const bf16x8*)(&Kh[(long)((k0) + sr) * LDK + sc]); ks1 = *(const bf16x8*)(&Kh[(long)((k0) + 32 + sr) * LDK + sc]); } while (0)
#define SWRITE(slot) do { LAS unsigned char* sb_ = lds + (slot) * SLOT; *(LAS bf16x8*)(sb_ + SHM_K + vst0) = vs0; *(LAS bf16x8*)(sb_ + SHM_K + vst1) = vs1; \
    *(LAS bf16x8*)(sb_ + kst0) = ks0; *(LAS bf16x8*)(sb_ + kst1) = ks1; } while (0)
  constexpr int NT = SKV / KVBLK;
  f32x16 p0, p1; bf16x8 pa0, pa1, pa2, pa3;
  SLOAD(0); SWRITE(0); SLOAD(KVBLK); SWRITE(1); SLOAD(2 * KVBLK);
  __syncthreads();
  if (!lead) __syncthreads();
  pa0 = pa1 = pa2 = pa3 = bf16x8{};
  m_phase<true, false>(p0, p1, o, qr, kaddr, 0, vrb, pa0, pa1, pa2, pa3);
  __syncthreads();
  int s_cur = 0, s_nxt = 1, s_nn = 2;
  for (int t = 0; t < NT; ++t) {
    softmax_tile(p0, p1, m_reg, l_reg, o, al_l, r32, hi, pa0, pa1, pa2, pa3);
    if (lead) { if (t >= 1 && t + 1 < NT) { SWRITE(s_nxt); if (t + 2 < NT) SLOAD((t + 2) * KVBLK); } }
    else      { if (t + 2 < NT) { SWRITE(s_nn); if (t + 3 < NT) SLOAD((t + 3) * KVBLK); } }
    __syncthreads();
    if (t + 1 < NT) m_phase<true, true>(p0, p1, o, qr, kaddr, s_nxt * SLOT, vrb + s_cur * SLOT, pa0, pa1, pa2, pa3);
    else m_phase<false, true>(p0, p1, o, qr, kaddr, 0, vrb + s_cur * SLOT, pa0, pa1, pa2, pa3);
    __syncthreads();
    { const int x = s_cur; s_cur = s_nxt; s_nxt = s_nn; s_nn = x; }
  }
  if (lead) __syncthreads();
  if (hi == 0) li_l[r32] = l_reg; asm volatile("s_waitcnt lgkmcnt(0)" ::: "memory");
  float rli[16];
#pragma unroll
  for (int r = 0; r < 16; ++r) rli[r] = __builtin_amdgcn_rcpf(li_l[crow(r, hi)]);
  __syncthreads();
  LAS float* X = (LAS float*)lds + qw * 4096 + lane;
  if (map == 1) {
#pragma unroll
    for (int d0 = 0; d0 < 4; ++d0)
#pragma unroll
      for (int r = 0; r < 16; ++r) X[(d0 * 16 + r) * 64] = o[d0][r] * rli[r];
  }
  __syncthreads();
  if (map == 0) {
    float ss[16];
#pragma unroll
    for (int r = 0; r < 16; ++r) ss[r] = 0.f;
#pragma unroll
    for (int d0 = 0; d0 < 4; ++d0)
#pragma unroll
      for (int r = 0; r < 16; ++r) { const float d = o[d0][r] * rli[r] - lam * X[(d0 * 16 + r) * 64]; o[d0][r] = d; ss[r] += d * d; }
#pragma unroll
    for (int r = 0; r < 16; ++r) { float s = ss[r]; s += __shfl_xor(s, 1); s += __shfl_xor(s, 2); s += __shfl_xor(s, 4); s += __shfl_xor(s, 8); s += __shfl_xor(s, 16);
      ss[r] = __builtin_amdgcn_rsqf(s * (1.0f / 128.0f) + NORM_EPS) * 0.8f; }
#pragma unroll
    for (int d0 = 0; d0 < 4; ++d0) { const float g = subln[32 * d0 + r32];
#pragma unroll
      for (int r = 0; r < 16; ++r) { const float v = o[d0][r] * ss[r] * g; Ob[(long)(qw * QBLK + crow(r, hi)) * 1024 + 32 * d0 + r32] = (bf16_t)(cvtpk(v, v) & 0xffffu); } }
  }
  __syncthreads();
#undef SLOAD
#undef SWRITE
}
}

constexpr int NWAVES = 8;
#ifndef MK_PER_PHASE
#define MK_PER_PHASE 0
#endif
constexpr int N_PHASES = 18;
#ifndef REPMASK
#define REPMASK 0
#endif
#ifndef SUBREP
#define SUBREP 0
#endif
#ifndef PHMASK
#define PHMASK 0xfff
#endif

constexpr size_t MiB = 1u << 20;
constexpr size_t WS_CTL = 0, CTL_ZERO_BYTES = 1 * MiB;
constexpr size_t WS_MOD = 8 * MiB;
constexpr size_t WS_PROBS = 9 * MiB;
constexpr size_t WS_SLOT = 11 * MiB;
constexpr size_t WS_VALS = 13 * MiB;
constexpr size_t WS_SSQ = 14 * MiB;
constexpr size_t WS_IDX = 13 * MiB + 512 * 1024;
constexpr size_t WS_WIN0 = 16 * MiB;
constexpr size_t WS_WIN1 = 22 * MiB;
constexpr size_t WS_WOUT = 26 * MiB;
constexpr size_t WS_WGU = 30 * MiB;
constexpr size_t WS_WD = 158 * MiB;
constexpr size_t WS_H = 222 * MiB;
constexpr size_t WS_HC = 286 * MiB;
constexpr size_t WS_R = 294 * MiB;
constexpr size_t WS_Q = WS_R, WS_K = WS_R + 32 * MiB, WS_V = WS_R + 68 * MiB, WS_GB = WS_R + 104 * MiB, WS_Z = WS_R + 136 * MiB, WS_MIX = WS_R + 168 * MiB;
constexpr size_t WS_XG = WS_R, WS_ACT = WS_R + 128 * MiB, WS_Y = WS_R;
constexpr size_t WS_U = WS_R, WS_VV = WS_R + 64 * MiB, WS_MIX1 = WS_R + 128 * MiB;
constexpr size_t WS_END = WS_R + 256 * MiB;
constexpr int CW_BAR = 4096;

constexpr int RING_BYTES = 131072, LDSCTL_OFF = RING_BYTES, MISC_OFF = LDSCTL_OFF + 320, LDS_BYTES = 147456;

typedef GAS unsigned gu32;
#define RLX_AGENT __ATOMIC_RELAXED, __HIP_MEMORY_SCOPE_AGENT
#define LDS_WAIT() asm volatile("s_waitcnt lgkmcnt(0)" ::: "memory")
#define VM_WAIT() asm volatile("s_waitcnt vmcnt(0)" ::: "memory")

#define XB_TMO      128
#define XB_XCNT(j)  (256  + 64 * (j))
#define XB_XSUB(j)  (1280 + 64 * (j))
#define XB_XGEN(j)  (2304 + 64 * (j))
#define XB_TOP      3328
#define XB_TOPGEN   3392
#define XCD_BAR_WORDS 3456
#define XB_SPIN_CAP (1u << 20)
__device__ __forceinline__ unsigned xb_ld(unsigned* p)              { return __hip_atomic_load(p, __ATOMIC_RELAXED, __HIP_MEMORY_SCOPE_AGENT); }
__device__ __forceinline__ unsigned xb_add(unsigned* p, unsigned v) { return __hip_atomic_fetch_add(p, v, __ATOMIC_RELAXED, __HIP_MEMORY_SCOPE_AGENT); }
__device__ __forceinline__ unsigned xb_xcc_id() { return (unsigned)__builtin_amdgcn_s_getreg((3 << 11) | 20) & 0xFu; }
#define XB_SPIN(cond, bar) do { unsigned _sp = 0; while (cond) { __builtin_amdgcn_s_sleep(1); \
    if ((++_sp & 255u) == 0u) { if (xb_ld(&(bar)[XB_TMO])) break; if (_sp > XB_SPIN_CAP) { atomicAdd(&(bar)[XB_TMO], 1u); break; } } } } while (0)
struct XcdBarrier { unsigned* bar; unsigned x; volatile LAS unsigned* st; };
__device__ __forceinline__ XcdBarrier xcd_barrier_post(unsigned* bar, volatile LAS unsigned* st) {
    XcdBarrier b; b.bar = bar; b.x = xb_xcc_id(); b.st = st;
    if (threadIdx.x == 0) (void)xb_add(&bar[XB_XCNT(b.x)], 1u);
    return b;
}
__device__ __forceinline__ void xcd_barrier_complete(unsigned* bar, unsigned x, unsigned& nloc, unsigned& nx) {
    const unsigned G = gridDim.x * gridDim.y * gridDim.z;
    unsigned sum, cnt, mine, sp = 0u;
    for (;;) {
        sum = 0u; cnt = 0u; mine = 0u;
#pragma unroll
        for (unsigned j = 0; j < 16; ++j) { const unsigned c = xb_ld(&bar[XB_XCNT(j)]); sum += c; cnt += (c > 0u) ? 1u : 0u; mine = (j == x) ? c : mine; }
        if (sum == G) break;
        __builtin_amdgcn_s_sleep(1);
        if ((++sp & 255u) == 0u) { if (xb_ld(&bar[XB_TMO])) break; if (sp > XB_SPIN_CAP) { atomicAdd(&bar[XB_TMO], 1u); break; } }
    }
    nloc = mine > 0u ? mine : 1u; nx = cnt > 0u ? cnt : 1u;
}
__device__ __forceinline__ void xcd_barrier(const XcdBarrier& b) {
    asm volatile("s_waitcnt vmcnt(0)" ::: "memory");
    __syncthreads();
    if (threadIdx.x == 0) {
        unsigned* bar = b.bar;
        __builtin_amdgcn_s_waitcnt(0);
        unsigned nloc = b.st[0], nx = b.st[1];
        if (nloc == 0u) { xcd_barrier_complete(bar, b.x, nloc, nx); b.st[0] = nloc; b.st[1] = nx; }
        const unsigned old = xb_add(&bar[XB_XSUB(b.x)], 1u);
        const unsigned gen = old / nloc;
        if (old + 1u == (gen + 1u) * nloc) {
            __builtin_amdgcn_fence(__ATOMIC_RELEASE, "agent");
            asm volatile("s_waitcnt vmcnt(0)" ::: "memory");
            const unsigned og = xb_add(&bar[XB_TOP], 1u);
            const unsigned tg = og / nx;
            if (og + 1u == (tg + 1u) * nx) xb_add(&bar[XB_TOPGEN], 1u);
            else XB_SPIN(xb_ld(&bar[XB_TOPGEN]) == tg, bar);
            __builtin_amdgcn_fence(__ATOMIC_ACQUIRE, "agent");
            xb_add(&bar[XB_XGEN(b.x)], 1u);
            asm volatile("s_waitcnt vmcnt(0)" ::: "memory");
        } else {
            XB_SPIN(xb_ld(&bar[XB_XGEN(b.x)]) == gen, bar);
            __builtin_amdgcn_fence(__ATOMIC_ACQUIRE, "agent");
            asm volatile("s_waitcnt vmcnt(0)" ::: "memory");
        }
    }
    __syncthreads();
}

__device__ const float ROPE_TAB[64 * 32] = {
1.000000000e+00f, 1.000000000e+00f, 1.000000000e+00f, 1.000000000e+00f, 1.000000000e+00f, 1.000000000e+00f, 1.000000000e+00f, 1.000000000e+00f, 1.000000000e+00f, 1.000000000e+00f, 1.000000000e+00f, 1.000000000e+00f, 1.000000000e+00f, 1.000000000e+00f, 1.000000000e+00f, 1.000000000e+00f, 0.000000000e+00f, 0.000000000e+00f, 0.000000000e+00f, 0.000000000e+00f, 0.000000000e+00f, 0.000000000e+00f, 0.000000000e+00f, 0.000000000e+00f, 0.000000000e+00f, 0.000000000e+00f, 0.000000000e+00f, 0.000000000e+00f, 0.000000000e+00f, 0.000000000e+00f, 0.000000000e+00f, 0.000000000e+00f,
5.403023059e-01f, 8.460091103e-01f, 9.504152803e-01f, 9.842302345e-01f, 9.950041653e-01f, 9.984192778e-01f, 9.995000417e-01f, 9.998418903e-01f, 9.999500004e-01f, 9.999841887e-01f, 9.999950000e-01f, 9.999984189e-01f, 9.999995000e-01f, 9.999998419e-01f, 9.999999500e-01f, 9.999999842e-01f, 8.414709848e-01f, 5.331684399e-01f, 3.109835929e-01f, 1.768921862e-01f, 9.983341665e-02f, 5.620449921e-02f, 3.161750640e-02f, 1.778185688e-02f, 9.999833334e-03f, 5.623383614e-03f, 3.162272390e-03f, 1.778278473e-03f, 9.999998333e-04f, 5.623412956e-04f, 3.162277607e-04f, 1.778279401e-04f,
-4.161468365e-01f, 4.314628294e-01f, 8.065784099e-01f, 9.374183089e-01f, 9.800665778e-01f, 9.936821085e-01f, 9.980006666e-01f, 9.993676111e-01f, 9.998000067e-01f, 9.999367551e-01f, 9.999800001e-01f, 9.999936755e-01f, 9.999980000e-01f, 9.999993675e-01f, 9.999998000e-01f, 9.999999368e-01f, 9.092974268e-01f, 9.021307150e-01f, 5.911271172e-01f, 3.482052759e-01f, 1.986693308e-01f, 1.122313110e-01f, 6.320339793e-02f, 3.555809079e-02f, 1.999866669e-02f, 1.124658940e-02f, 6.324513157e-03f, 3.556551322e-03f, 1.999998667e-03f, 1.124682413e-03f, 6.324554899e-04f, 3.556558745e-04f,
-9.899924966e-01f, -1.159661415e-01f, 5.827536107e-01f, 8.610406494e-01f, 9.553364891e-01f, 9.858034685e-01f, 9.955033740e-01f, 9.985773125e-01f, 9.995500337e-01f, 9.998577009e-01f, 9.999550003e-01f, 9.999857698e-01f, 9.999955000e-01f, 9.999985770e-01f, 9.999995500e-01f, 9.999998577e-01f, 1.411200081e-01f, 9.932531671e-01f, 8.126488966e-01f, 5.085361344e-01f, 2.955202067e-01f, 1.679033098e-01f, 9.472609133e-02f, 5.332308054e-02f, 2.999550020e-02f, 1.686943954e-02f, 9.486690679e-03f, 5.334812925e-03f, 2.999995500e-03f, 1.687023175e-03f, 9.486831557e-04f, 5.334837977e-04f,
-6.536436209e-01f, -6.276796538e-01f, 3.011374626e-01f, 7.575061717e-01f, 9.210609940e-01f, 9.748082656e-01f, 9.920106610e-01f, 9.974712444e-01f, 9.992001067e-01f, 9.997470285e-01f, 9.999200011e-01f, 9.999747019e-01f, 9.999920000e-01f, 9.999974702e-01f, 9.999992000e-01f, 9.999997470e-01f, -7.568024953e-01f, 7.784717415e-01f, 9.535807405e-01f, 6.528280017e-01f, 3.894183423e-01f, 2.230444916e-01f, 1.261540665e-01f, 7.107120850e-02f, 3.998933419e-02f, 2.249175622e-02f, 1.264877333e-02f, 7.113057657e-03f, 3.999989333e-03f, 2.249363404e-03f, 1.264910727e-03f, 7.113117040e-04f,
2.836621855e-01f, -9.460792693e-01f, -1.034231891e-02f, 6.300803045e-01f, 8.775825619e-01f, 9.607312606e-01f, 9.875260200e-01f, 9.960497564e-01f, 9.987502604e-01f, 9.996047413e-01f, 9.998750026e-01f, 9.999604718e-01f, 9.999875000e-01f, 9.999960472e-01f, 9.999987500e-01f, 9.999996047e-01f, -9.589242747e-01f, 3.239352036e-01f, 9.999465168e-01f, 7.765299800e-01f, 4.794255386e-01f, 2.774805306e-01f, 1.574558982e-01f, 8.879686236e-02f, 4.997916927e-02f, 2.811336166e-02f, 1.581072950e-02f, 8.891279896e-03f, 4.999979167e-03f, 2.811702921e-03f, 1.581138171e-03f, 8.891395879e-04f,
9.601702867e-01f, -9.731037080e-01f, -3.207964584e-01f, 4.827820000e-01f, 8.253356149e-01f, 9.436169571e-01f, 9.820539352e-01f, 9.943132982e-01f, 9.982005399e-01f, 9.994308440e-01f, 9.998200054e-01f, 9.999430795e-01f, 9.999820001e-01f, 9.999943079e-01f, 9.999982000e-01f, 9.999994308e-01f, -2.794154982e-01f, -2.303674747e-01f, 9.471481575e-01f, 8.757405669e-01f, 5.646424734e-01f, 3.310393303e-01f, 1.886002871e-01f, 1.064944369e-01f, 5.996400648e-02f, 3.373407807e-02f, 1.897252756e-02f, 1.066947402e-02f, 5.999964000e-03f, 3.374041549e-03f, 1.897365458e-03f, 1.066967444e-03f,
7.539022543e-01f, -7.004299352e-01f, -5.994373930e-01f, 3.202569776e-01f, 7.648421873e-01f, 9.235194611e-01f, 9.755998784e-01f, 9.922624187e-01f, 9.975510003e-01f, 9.992253420e-01f, 9.997550100e-01f, 9.999225252e-01f, 9.999755001e-01f, 9.999922524e-01f, 9.999975500e-01f, 9.999992252e-01f, 6.569865987e-01f, -7.137211682e-01f, 8.004216463e-01f, 9.473307069e-01f, 6.442176872e-01f, 3.835515676e-01f, 2.195560914e-01f, 1.241583359e-01f, 6.994284734e-02f, 3.935372772e-02f, 2.213413590e-02f, 1.244763440e-02f, 6.999942833e-03f, 3.936379111e-03f, 2.213592554e-03f, 1.244795266e-03f,
-1.455000338e-01f, -2.120365045e-01f, -8.186324573e-01f, 1.476312003e-01f, 6.967067093e-01f, 9.005023096e-01f, 9.681703030e-01f, 9.898977666e-01f, 9.968017063e-01f, 9.989882418e-01f, 9.996800171e-01f, 9.998988088e-01f, 9.999680002e-01f, 9.999898807e-01f, 9.999968000e-01f, 9.999989881e-01f, 9.893582466e-01f, -9.772617463e-01f, 5.743177691e-01f, 9.890424807e-01f, 7.173560909e-01f, 4.348512280e-01f, 2.502923579e-01f, 1.417829736e-01f, 7.991469397e-02f, 4.497213290e-02f, 2.529552289e-02f, 1.422575542e-02f, 7.999914667e-03f, 4.498715427e-03f, 2.529819430e-03f, 1.422623048e-03f,
-9.111302619e-01f, 3.416603061e-01f, -9.566441996e-01f, -2.965079584e-02f, 6.216099683e-01f, 8.746382701e-01f, 9.597726380e-01f, 9.872200896e-01f, 9.959527330e-01f, 9.987195509e-01f, 9.995950273e-01f, 9.998719305e-01f, 9.999595003e-01f, 9.999871928e-01f, 9.999959500e-01f, 9.999987193e-01f, 4.121184852e-01f, -9.398235128e-01f, 2.912591207e-01f, 9.995603185e-01f, 7.833269096e-01f, 4.847761303e-01f, 2.807783529e-01f, 1.593627767e-01f, 8.987854920e-02f, 5.058911594e-02f, 2.845665693e-02f, 1.600383145e-02f, 8.999878500e-03f, 5.061050321e-03f, 2.846046052e-03f, 1.600450786e-03f,
-8.390715291e-01f, 7.901319677e-01f, -9.997860729e-01f, -2.059976198e-01f, 5.403023059e-01f, 8.460091103e-01f, 9.504152803e-01f, 9.842302345e-01f, 9.950041653e-01f, 9.984192778e-01f, 9.995000417e-01f, 9.998418903e-01f, 9.999500004e-01f, 9.999841887e-01f, 9.999950000e-01f, 9.999984189e-01f, -5.440211109e-01f, -6.129367615e-01f, -2.068353153e-02f, 9.785524925e-01f, 8.414709848e-01f, 5.331684399e-01f, 3.109835929e-01f, 1.768921862e-01f, 9.983341665e-02f, 5.620449921e-02f, 3.161750640e-02f, 1.778185688e-02f, 9.999833334e-03f, 5.623383614e-03f, 3.162272390e-03f, 1.778278473e-03f,
4.425697988e-03f, 9.952573799e-01f, -9.437797217e-01f, -3.758473754e-01f, 4.535961214e-01f, 8.147053397e-01f, 9.401075865e-01f, 9.809291466e-01f, 9.939560980e-01f, 9.980874320e-01f, 9.993950610e-01f, 9.998086883e-01f, 9.999395006e-01f, 9.999808683e-01f, 9.999939500e-01f, 9.999980868e-01f, -9.999902066e-01f, -9.727665569e-02f, -3.305750095e-01f, 9.266815798e-01f, 8.912073601e-01f, 5.798751671e-01f, 3.408778753e-01f, 1.943656590e-01f, 1.097783008e-01f, 6.181810515e-02f, 3.477803970e-02f, 1.955982607e-02f, 1.099977817e-02f, 6.185715129e-03f, 3.478498411e-03f, 1.956106104e-03f,
8.438539587e-01f, 8.938616532e-01f, -7.941792645e-01f, -5.338430810e-01f, 3.623577545e-01f, 7.808259235e-01f, 9.288598634e-01f, 9.773178698e-01f, 9.928086359e-01f, 9.977240240e-01f, 9.992800864e-01f, 9.997723246e-01f, 9.999280009e-01f, 9.999772317e-01f, 9.999928000e-01f, 9.999977232e-01f, -5.365729180e-01f, 4.483428876e-01f, -6.076835491e-01f, 8.455835647e-01f, 9.320390860e-01f, 6.247486512e-01f, 3.704313082e-01f, 2.117776696e-01f, 1.197122073e-01f, 6.742975624e-02f, 3.793822522e-02f, 2.133773341e-02f, 1.199971200e-02f, 6.748044688e-03f, 3.794724085e-03f, 2.133933673e-03f,
9.074467815e-01f, 5.171728240e-01f, -5.658204948e-01f, -6.750016262e-01f, 2.674988286e-01f, 7.444779696e-01f, 9.166833580e-01f, 9.733975461e-01f, 9.915618937e-01f, 9.973290652e-01f, 9.991551190e-01f, 9.997327994e-01f, 9.999155012e-01f, 9.999732789e-01f, 9.999915500e-01f, 9.999973279e-01f, 4.201670368e-01f, 8.558809906e-01f, -8.245284517e-01f, 7.378162404e-01f, 9.635581854e-01f, 6.676470271e-01f, 3.996143406e-01f, 2.291227120e-01f, 1.296341426e-01f, 7.303927501e-02f, 4.109803135e-02f, 2.311557328e-02f, 1.299963384e-02f, 7.310372113e-03f, 4.110949379e-03f, 2.311761174e-03f,
1.367372182e-01f, -1.879581181e-02f, -2.813496238e-01f, -7.948709366e-01f, 1.699671429e-01f, 7.057763899e-01f, 9.035902455e-01f, 9.691694153e-01f, 9.902159962e-01f, 9.969025682e-01f, 9.990201601e-01f, 9.996901128e-01f, 9.999020016e-01f, 9.999690098e-01f, 9.999902000e-01f, 9.999969010e-01f, 9.906073557e-01f, 9.998233431e-01f, -9.596053299e-01f, 6.067785379e-01f, 9.854497300e-01f, 7.084346741e-01f, 4.283977921e-01f, 2.463953013e-01f, 1.395431146e-01f, 7.864648408e-02f, 4.425742651e-02f, 2.489334005e-02f, 1.399954267e-02f, 7.872697226e-03f, 4.427174262e-03f, 2.489588602e-03f,
-7.596879129e-01f, -5.489756801e-01f, 3.102253171e-02f, -8.896703905e-01f, 7.073720167e-02f, 6.648435374e-01f, 8.895936181e-01f, 9.646348142e-01f, 9.887710779e-01f, 9.964445465e-01f, 9.988752109e-01f, 9.996442649e-01f, 9.998875021e-01f, 9.999644246e-01f, 9.999887500e-01f, 9.999964424e-01f, 6.502878402e-01f, 8.358383233e-01f, -9.995186854e-01f, 4.566033249e-01f, 9.974949866e-01f, 7.469826442e-01f, 4.567528814e-01f, 2.635899757e-01f, 1.494381325e-01f, 8.425120614e-02f, 4.741637909e-02f, 2.667102809e-02f, 1.499943751e-02f, 8.435019850e-03f, 4.743398702e-03f, 2.667415952e-03f,
-9.576594803e-01f, -9.100810415e-01f, 3.403182001e-01f, -9.564100574e-01f, -2.919952230e-02f, 6.218088190e-01f, 8.747074712e-01f, 9.597951768e-01f, 9.872272834e-01f, 9.959550145e-01f, 9.987202730e-01f, 9.995952558e-01f, 9.998720027e-01f, 9.999595231e-01f, 9.999872000e-01f, 9.999959523e-01f, -2.879033167e-01f, 4.144303293e-01f, -9.403103332e-01f, 2.920270571e-01f, 9.995736030e-01f, 7.831690702e-01f, 4.846512559e-01f, 2.807012978e-01f, 1.593182066e-01f, 8.985326395e-02f, 5.057485751e-02f, 2.844863180e-02f, 1.599931734e-02f, 8.997339806e-03f, 5.059622668e-03f, 2.845243217e-03f,
-2.751633381e-01f, -9.908980244e-01f, 6.158647034e-01f, -9.929849996e-01f, -1.288444943e-01f, 5.768082866e-01f, 8.589466897e-01f, 9.546520336e-01f, 9.855847669e-01f, 9.954339878e-01f, 9.985553480e-01f, 9.995430857e-01f, 9.998555035e-01f, 9.999543054e-01f, 9.999855500e-01f, 9.999954305e-01f, -9.613974919e-01f, -1.346146549e-01f, -7.878519322e-01f, 1.182403929e-01f, 9.916648105e-01f, 8.168795508e-01f, 5.120650195e-01f, 2.977238566e-01f, 1.691823491e-01f, 9.545248036e-02f, 5.373283018e-02f, 3.022614554e-02f, 1.699918118e-02f, 9.559656917e-03f, 5.375846129e-03f, 3.023070392e-03f,
6.603167082e-01f, -7.665364704e-01f, 8.303362493e-01f, -9.982416606e-01f, -2.272020947e-01f, 5.299842069e-01f, 8.423270331e-01f, 9.492070108e-01f, 9.838436928e-01f, 9.948814827e-01f, 9.983804374e-01f, 9.994877548e-01f, 9.998380044e-01f, 9.999487715e-01f, 9.999838000e-01f, 9.999948771e-01f, -7.509872468e-01f, -6.422007782e-01f, -5.572626967e-01f, -5.927551787e-02f, 9.738476309e-01f, 8.480075120e-01f, 5.389667608e-01f, 3.146522694e-01f, 1.790295734e-01f, 1.010486783e-01f, 5.689026552e-02f, 3.200356370e-02f, 1.799902802e-02f, 1.012197101e-02f, 5.692069051e-03f, 3.200897472e-03f,
9.887046182e-01f, -3.060956503e-01f, 9.624638147e-01f, -9.720142477e-01f, -3.232895669e-01f, 4.814846115e-01f, 8.248651197e-01f, 9.434618303e-01f, 9.820042351e-01f, 9.942975168e-01f, 9.981955429e-01f, 9.994292632e-01f, 9.998195054e-01f, 9.999429214e-01f, 9.999819501e-01f, 9.999942921e-01f, 1.498772097e-01f, -9.520007631e-01f, -2.714100320e-01f, -2.349219066e-01f, 9.463000877e-01f, 8.764545447e-01f, 5.653295802e-01f, 3.314811830e-01f, 1.888588950e-01f, 1.066416808e-01f, 6.004713196e-02f, 3.378088066e-02f, 1.899885685e-02f, 1.068428189e-02f, 6.008291404e-03f, 3.378724451e-03f,
4.080820618e-01f, 2.486170528e-01f, 9.991443830e-01f, -9.151299613e-01f, -4.161468365e-01f, 4.314628294e-01f, 8.065784099e-01f, 9.374183089e-01f, 9.800665778e-01f, 9.936821085e-01f, 9.980006666e-01f, 9.993676111e-01f, 9.998000067e-01f, 9.999367551e-01f, 9.999800001e-01f, 9.999936755e-01f, 9.129452507e-01f, -9.686018589e-01f, 4.135821352e-02f, -4.031589686e-01f, 9.092974268e-01f, 9.021307150e-01f, 5.911271172e-01f, 3.482052759e-01f, 1.986693308e-01f, 1.122313110e-01f, 6.320339793e-02f, 3.555809079e-02f, 1.999866669e-02f, 1.124658940e-02f, 6.324513157e-03f, 3.556551322e-03f,
-5.477292602e-01f, 7.267602337e-01f, 9.367403630e-01f, -8.293829050e-01f, -5.048461046e-01f, 3.800770014e-01f, 7.874851889e-01f, 9.310783576e-01f, 9.780309147e-01f, 9.930352774e-01f, 9.977958102e-01f, 9.993027988e-01f, 9.997795081e-01f, 9.999302726e-01f, 9.999779501e-01f, 9.999930272e-01f, 8.366556385e-01f, -6.868912307e-01f, 3.500249882e-01f, -5.586805857e-01f, 8.632093666e-01f, 9.249548492e-01f, 6.163335763e-01f, 3.648192595e-01f, 2.084598998e-01f, 1.178173922e-01f, 6.635903187e-02f, 3.733518848e-02f, 2.099845653e-02f, 1.180889335e-02f, 6.640734277e-03f, 3.734378081e-03f,
-9.999608264e-01f, 9.810745045e-01f, 7.814403262e-01f, -7.174775009e-01f, -5.885011173e-01f, 3.274895812e-01f, 7.676045483e-01f, 9.244439812e-01f, 9.758974493e-01f, 9.923570438e-01f, 9.975809759e-01f, 9.992348264e-01f, 9.997580098e-01f, 9.999234739e-01f, 9.999758001e-01f, 9.999923473e-01f, -8.851309290e-03f, -1.936306189e-01f, 6.239799809e-01f, -6.965816792e-01f, 8.084964038e-01f, 9.448547900e-01f, 6.409237532e-01f, 3.813178801e-01f, 2.182296231e-01f, 1.233997476e-01f, 6.951400222e-02f, 3.911216810e-02f, 2.199822538e-02f, 1.237119357e-02f, 6.956954733e-03f, 3.912204722e-03f,
-5.328330203e-01f, 9.332357037e-01f, 5.486452902e-01f, -5.829431928e-01f, -6.662760213e-01f, 2.738668208e-01f, 7.469563671e-01f, 9.175172776e-01f, 9.736663950e-01f, 9.916474291e-01f, 9.973561658e-01f, 9.991636942e-01f, 9.997355117e-01f, 9.999163589e-01f, 9.999735501e-01f, 9.999916358e-01f, -8.462204042e-01f, 3.592646954e-01f, 8.360552287e-01f, -8.125129131e-01f, 7.457052122e-01f, 9.617676250e-01f, 6.648730598e-01f, 3.976959206e-01f, 2.279775235e-01f, 1.289782009e-01f, 7.266827742e-02f, 4.088902404e-02f, 2.299797222e-02f, 1.293348988e-02f, 7.273174493e-03f, 4.090031240e-03f,
4.241790073e-01f, 5.979773102e-01f, 2.614414084e-01f, -4.300231298e-01f, -7.373937155e-01f, 2.193782457e-01f, 7.255612918e-01f, 9.103004373e-01f, 9.713379749e-01f, 9.909064559e-01f, 9.971213821e-01f, 9.990894023e-01f, 9.997120138e-01f, 9.999089278e-01f, 9.999712001e-01f, 9.999908927e-01f, -9.055783620e-01f, 8.015130295e-01f, 9.652193481e-01f, -9.028178708e-01f, 6.754631806e-01f, 9.756398851e-01f, 6.881575487e-01f, 4.139482019e-01f, 2.377026264e-01f, 1.345525755e-01f, 7.582182595e-02f, 4.266575068e-02f, 2.399769607e-02f, 1.349578209e-02f, 7.589393526e-03f, 4.267857628e-03f,
9.912028119e-01f, 7.855280068e-02f, -5.168947139e-02f, -2.635403389e-01f, -8.011436155e-01f, 1.641961185e-01f, 7.034407157e-01f, 9.027957423e-01f, 9.689124217e-01f, 9.901341476e-01f, 9.968766273e-01f, 9.990119510e-01f, 9.996875163e-01f, 9.999011805e-01f, 9.999687502e-01f, 9.999901179e-01f, -1.323517501e-01f, 9.969099546e-01f, 9.986632058e-01f, -9.646483762e-01f, 5.984721441e-01f, 9.864277139e-01f, 7.107539373e-01f, 4.300695848e-01f, 2.474039593e-01f, 1.401226951e-01f, 7.897461625e-02f, 4.444234239e-02f, 2.499739591e-02f, 1.405807004e-02f, 7.905611800e-03f, 4.445683881e-03f,
6.469193223e-01f, -4.650645402e-01f, -3.596943353e-01f, -8.874560929e-02f, -8.568887534e-01f, 1.084948944e-01f, 6.806167575e-01f, 8.950055657e-01f, 9.663899781e-01f, 9.893305286e-01f, 9.966219036e-01f, 9.989313405e-01f, 9.996620190e-01f, 9.998931169e-01f, 9.999662002e-01f, 9.999893115e-01f, 7.625584505e-01f, 8.852767779e-01f, 9.330701931e-01f, -9.960543242e-01f, 5.155013718e-01f, 9.940970063e-01f, 7.326396313e-01f, 4.460549713e-01f, 2.570805519e-01f, 1.456883837e-01f, 8.212661682e-02f, 4.621879357e-02f, 2.599707077e-02f, 1.462035354e-02f, 8.221829283e-03f, 4.623509993e-03f,
-2.921388087e-01f, -8.654504764e-01f, -6.320285135e-01f, 8.884811520e-02f, -9.040721420e-01f, 5.245066969e-02f, 6.571122393e-01f, 8.869323709e-01f, 9.637708964e-01f, 9.884956243e-01f, 9.963572138e-01f, 9.988475712e-01f, 9.996355221e-01f, 9.998847372e-01f, 9.999635502e-01f, 9.999884735e-01f, 9.563759284e-01f, 5.009944839e-01f, 7.749451323e-01f, -9.960451859e-01f, 4.273798802e-01f, 9.986235163e-01f, 7.537927467e-01f, 4.618993065e-01f, 2.667314367e-01f, 1.512494653e-01f, 8.527779611e-02f, 4.799509859e-02f, 2.699671962e-02f, 1.518263242e-02f, 8.538045944e-03f, 4.801335960e-03f,
-9.626058663e-01f, -9.992934349e-01f, -8.416847784e-01f, 2.636396118e-01f, -9.422223407e-01f, -3.759374883e-03f, 6.329506635e-01f, 8.785787110e-01f, 9.610554383e-01f, 9.876294611e-01f, 9.960825604e-01f, 9.987606432e-01f, 9.996080256e-01f, 9.998760413e-01f, 9.999608003e-01f, 9.999876039e-01f, 2.709057883e-01f, -3.758498280e-02f, 5.399691971e-01f, -9.646212496e-01f, 3.349881502e-01f, 9.999929335e-01f, 7.741921322e-01f, 4.775975802e-01f, 2.763556486e-01f, 1.568057639e-01f, 8.842812263e-02f, 4.977125184e-02f, 2.799634148e-02f, 1.574490650e-02f, 8.854261752e-03f, 4.979161774e-03f,
-7.480575297e-01f, -8.253722231e-01f, -9.678716355e-01f, 4.301160387e-01f, -9.709581651e-01f, -5.995753440e-02f, 6.081561899e-01f, 8.699472273e-01f, 9.582438755e-01f, 9.867320664e-01f, 9.957979462e-01f, 9.986705569e-01f, 9.995795295e-01f, 9.998670292e-01f, 9.999579503e-01f, 9.999867027e-01f, -6.636338842e-01f, -5.645889596e-01f, 2.514448194e-01f, -9.027736113e-01f, 2.392493292e-01f, 9.982009287e-01f, 7.938173900e-01f, 4.931448283e-01f, 2.859522251e-01f, 1.623571039e-01f, 9.157756487e-02f, 5.154724769e-02f, 2.899593534e-02f, 1.630717560e-02f, 9.170476674e-03f, 5.156987431e-03f,
1.542514499e-01f, -3.972514054e-01f, -9.980752051e-01f, 5.830268074e-01f, -9.899924966e-01f, -1.159661415e-01f, 5.827536107e-01f, 8.610406494e-01f, 9.553364891e-01f, 9.858034685e-01f, 9.955033740e-01f, 9.985773125e-01f, 9.995500337e-01f, 9.998577009e-01f, 9.999550003e-01f, 9.999857698e-01f, -9.880316241e-01f, -9.177098239e-01f, -6.201520023e-02f, -8.124529167e-01f, 1.411200081e-01f, 9.932531671e-01f, 8.126488966e-01f, 5.085361344e-01f, 2.955202067e-01f, 1.679033098e-01f, 9.472609133e-02f, 5.332308054e-02f, 2.999550020e-02f, 1.686943954e-02f, 9.486690679e-03f, 5.334812925e-03f,
9.147423578e-01f, 1.532156071e-01f, -9.293002159e-01f, 7.175491840e-01f, -9.991351503e-01f, -1.716081281e-01f, 5.567683265e-01f, 8.518617938e-01f, 9.523335699e-01f, 9.848436969e-01f, 9.951988468e-01f, 9.984809103e-01f, 9.995195385e-01f, 9.998480564e-01f, 9.999519504e-01f, 9.999848053e-01f, -4.040376453e-01f, -9.881927837e-01f, -3.693252072e-01f, -6.965078381e-01f, 4.158066243e-02f, 9.851652909e-01f, 8.306678221e-01f, 5.237666315e-01f, 3.050586364e-01f, 1.734442061e-01f, 9.787367054e-02f, 5.509874477e-02f, 3.099503507e-02f, 1.743169815e-02f, 9.802903735e-03f, 5.512638250e-03f,
8.342233605e-01f, 6.564950042e-01f, -7.683670453e-01f, 8.294403958e-01f, -9.982947758e-01f, -2.267075851e-01f, 5.302263203e-01f, 8.424135629e-01f, 9.492354181e-01f, 9.838527819e-01f, 9.948843676e-01f, 9.983813507e-01f, 9.994880437e-01f, 9.998380958e-01f, 9.999488004e-01f, 9.999838092e-01f, 5.514266812e-01f, -7.543303715e-01f, -6.400094403e-01f, -5.585952289e-01f, -5.837414343e-02f, 9.739628693e-01f, 8.478561489e-01f, 5.388315034e-01f, 3.145665606e-01f, 1.789796176e-01f, 1.010202710e-01f, 5.687423476e-02f, 3.199453895e-02f, 1.799395124e-02f, 1.011911581e-02f, 5.690463401e-03f,
-1.327674722e-02f, 9.575859018e-01f, -5.312353455e-01f, 9.151714465e-01f, -9.874797699e-01f, -2.810903188e-01f, 5.031541321e-01f, 8.326989444e-01f, 9.460423435e-01f, 9.828307548e-01f, 9.945599395e-01f, 9.982786339e-01f, 9.994555494e-01f, 9.998278189e-01f, 9.999455505e-01f, 9.999827814e-01f, 9.999118601e-01f, -2.881479492e-01f, -8.472242960e-01f, -4.030647882e-01f, -1.577456941e-01f, 9.596813183e-01f, 8.641966902e-01f, 5.537259863e-01f, 3.240430284e-01f, 1.845093693e-01f, 1.041658613e-01f, 5.864954490e-02f, 3.299401083e-02f, 1.855619865e-02f, 1.043532687e-02f, 5.868288372e-03f,
-8.485702748e-01f, 9.637577894e-01f, -2.414213342e-01f, 9.720384190e-01f, -9.667981926e-01f, -3.345844009e-01f, 4.755788316e-01f, 8.227210104e-01f, 9.427546655e-01f, 9.817776480e-01f, 9.942255659e-01f, 9.981727603e-01f, 9.994220557e-01f, 9.998172259e-01f, 9.999422006e-01f, 9.999817221e-01f, 5.290826861e-01f, 2.667787912e-01f, -9.704203931e-01f, -2.348218730e-01f, -2.555411020e-01f, 9.423657881e-01f, 8.796731069e-01f, 5.684453703e-01f, 3.334870921e-01f, 1.900332863e-01f, 1.073104099e-01f, 6.042466957e-02f, 3.399344971e-02f, 1.911844019e-02f, 1.075153690e-02f, 6.046113157e-03f,
-9.036922051e-01f, 6.731098380e-01f, 7.233429552e-02f, 9.982477555e-01f, -9.364566873e-01f, -3.870207132e-01f, 4.475279919e-01f, 8.124829160e-01f, 9.393727128e-01f, 9.806934947e-01f, 9.938812501e-01f, 9.980637301e-01f, 9.993875625e-01f, 9.998063167e-01f, 9.999387506e-01f, 9.999806311e-01f, -4.281826695e-01f, 7.395425248e-01f, -9.973804438e-01f, -5.917278607e-02f, -3.507832277e-01f, 9.220710209e-01f, 8.942699237e-01f, 5.829850008e-01f, 3.428978075e-01f, 1.955511940e-01f, 1.104538854e-01f, 6.219960316e-02f, 3.499285460e-02f, 1.968067568e-02f, 1.106774584e-02f, 6.223937751e-03f,
-1.279636896e-01f, 1.751563210e-01f, 3.789165737e-01f, 9.929728260e-01f, -8.967584163e-01f, -4.382334809e-01f, 4.190296615e-01f, 8.019878987e-01f, 9.358968237e-01f, 9.795783292e-01f, 9.935269954e-01f, 9.979515438e-01f, 9.993520700e-01f, 9.997950914e-01f, 9.999352007e-01f, 9.999795085e-01f, -9.917788534e-01f, 9.845406356e-01f, -9.254308349e-01f, 1.183425828e-01f, -4.425204433e-01f, 8.988611774e-01f, 9.079725452e-01f, 5.973402802e-01f, 3.522742333e-01f, 2.010629178e-01f, 1.135962563e-01f, 6.397434006e-02f, 3.599222450e-02f, 2.024290495e-02f, 1.138395368e-02f, 6.401762149e-03f,
7.654140519e-01f, -3.767421515e-01f, 6.479219076e-01f, 9.563799991e-01f, -8.481000317e-01f, -4.880607978e-01f, 3.901123364e-01f, 7.912392773e-01f, 9.323273456e-01f, 9.784321869e-01f, 9.931628054e-01f, 9.978362017e-01f, 9.993155781e-01f, 9.997835499e-01f, 9.999315508e-01f, 9.999783543e-01f, -6.435381334e-01f, 9.263181696e-01f, -7.617067688e-01f, 2.921254821e-01f, -5.298361409e-01f, 8.728096342e-01f, 9.207672697e-01f, 6.115066689e-01f, 3.616154320e-01f, 2.065682834e-01f, 1.167374914e-01f, 6.574887465e-02f, 3.699155841e-02f, 2.080512781e-02f, 1.170016038e-02f, 6.579586343e-03f,
9.550736440e-01f, -8.126109057e-01f, 8.526731891e-01f, 8.896233956e-01f, -7.909677119e-01f, -5.363451377e-01f, 3.608049314e-01f, 7.802404506e-01f, 9.286646356e-01f, 9.772551038e-01f, 9.927886839e-01f, 9.977177042e-01f, 9.992780869e-01f, 9.997716922e-01f, 9.999278009e-01f, 9.999771684e-01f, 2.963685787e-01f, 5.828065854e-01f, -5.224446694e-01f, 4.566948806e-01f, -6.118578909e-01f, 8.439987519e-01f, 9.326413038e-01f, 6.254796874e-01f, 3.709204694e-01f, 2.120671168e-01f, 1.198775590e-01f, 6.752320133e-02f, 3.799085533e-02f, 2.136734410e-02f, 1.201636591e-02f, 6.757410330e-03f,
2.666429324e-01f, -9.982103072e-01f, 9.728653484e-01f, 7.948084874e-01f, -7.259323042e-01f, -5.829338522e-01f, 3.311367516e-01f, 7.689948967e-01f, 9.249090599e-01f, 9.760471174e-01f, 9.924046345e-01f, 9.975960516e-01f, 9.992395964e-01f, 9.997595184e-01f, 9.999239510e-01f, 9.999759510e-01f, 9.637953863e-01f, 5.980119189e-02f, -2.313720250e-01f, 6.068603368e-01f, -6.877661592e-01f, 8.125196145e-01f, 9.435827742e-01f, 6.392549170e-01f, 3.801884151e-01f, 2.175592441e-01f, 1.230164278e-01f, 6.929731449e-02f, 3.899011425e-02f, 2.192955363e-02f, 1.233257024e-02f, 6.935234103e-03f,
-6.669380617e-01f, -8.763791221e-01f, 9.965789963e-01f, 6.749256921e-01f, -6.536436209e-01f, -6.276796538e-01f, 3.011374626e-01f, 7.575061717e-01f, 9.210609940e-01f, 9.748082656e-01f, 9.920106610e-01f, 9.974712444e-01f, 9.992001067e-01f, 9.997470285e-01f, 9.999200011e-01f, 9.999747019e-01f, 7.451131605e-01f, -4.816218791e-01f, 8.264565347e-02f, 7.378857026e-01f, -7.568024953e-01f, 7.784717415e-01f, 9.535807405e-01f, 6.528280017e-01f, 3.894183423e-01f, 2.230444916e-01f, 1.261540665e-01f, 7.107120850e-02f, 3.998933419e-02f, 2.249175622e-02f, 1.264877333e-02f, 7.113057657e-03f,
-9.873392775e-01f, -4.846391354e-01f, 9.214624639e-01f, 5.337560571e-01f, -5.748239465e-01f, -6.704410810e-01f, 2.708370612e-01f, 7.457779085e-01f, 9.171208228e-01f, 9.735385879e-01f, 9.916067674e-01f, 9.973432828e-01f, 9.991596177e-01f, 9.997342223e-01f, 9.999159512e-01f, 9.999734212e-01f, -1.586226688e-01f, -8.747141867e-01f, 3.884674088e-01f, 8.456384993e-01f, -8.182771111e-01f, 7.419627733e-01f, 9.626252055e-01f, 6.661946496e-01f, 3.986093280e-01f, 2.285226858e-01f, 1.292904437e-01f, 7.284487777e-02f, 4.098851413e-02f, 2.305395171e-02f, 1.296497516e-02f, 7.290880986e-03f,
-3.999853150e-01f, 5.636087450e-02f, 7.549650153e-01f, 3.757520063e-01f, -4.902608213e-01f, -7.110829460e-01f, 2.402658454e-01f, 7.338138159e-01f, 9.130889403e-01f, 9.722381242e-01f, 9.911929578e-01f, 9.972121674e-01f, 9.991181296e-01f, 9.997211001e-01f, 9.999118013e-01f, 9.999721088e-01f, -9.165215479e-01f, -9.984104626e-01f, 6.557650689e-01f, 9.267202543e-01f, -8.715757724e-01f, 7.031081310e-01f, 9.707071255e-01f, 6.793506338e-01f, 4.077604531e-01f, 2.339936535e-01f, 1.324255279e-01f, 7.461831668e-02f, 4.198765309e-02f, 2.361613990e-02f, 1.328117570e-02f, 7.468704084e-03f,
5.551133015e-01f, 5.800027620e-01f, 5.135981094e-01f, 2.058969135e-01f, -4.007991721e-01f, -7.494767618e-01f, 2.094543837e-01f, 7.216176770e-01f, 9.089657497e-01f, 9.709069157e-01f, 9.907692362e-01f, 9.970778985e-01f, 9.990756424e-01f, 9.997076617e-01f, 9.999075514e-01f, 9.999707649e-01f, -8.317747426e-01f, -8.146145076e-01f, 8.580308748e-01f, 9.785736871e-01f, -9.161659367e-01f, 6.620306515e-01f, 9.778184193e-01f, 6.922917941e-01f, 4.168708024e-01f, 2.394572216e-01f, 1.355592879e-01f, 7.639151963e-02f, 4.298675006e-02f, 2.417832062e-02f, 1.359737490e-02f, 7.646526947e-03f,
9.998433086e-01f, 9.250143668e-01f, 2.212979668e-01f, 2.954792850e-02f, -3.073328700e-01f, -7.855011484e-01f, 1.784334851e-01f, 7.091933487e-01f, 9.047516632e-01f, 9.695450046e-01f, 9.903356070e-01f, 9.969404766e-01f, 9.990321562e-01f, 9.996939071e-01f, 9.999032016e-01f, 9.999693893e-01f, 1.770192511e-02f, -3.799321270e-01f, 9.752062397e-01f, 9.995633646e-01f, -9.516020739e-01f, 6.188601989e-01f, 9.839519762e-01f, 7.050140383e-01f, 4.259394651e-01f, 2.449132175e-01f, 1.386916923e-01f, 7.816448100e-02f, 4.398580404e-02f, 2.474049370e-02f, 1.391357275e-02f, 7.824349567e-03f,
5.253219888e-01f, 9.851384009e-01f, -9.294817111e-02f, -1.477329843e-01f, -2.107957994e-01f, -8.190422169e-01f, 1.472341679e-01f, 6.965447596e-01f, 9.004471024e-01f, 9.681524338e-01f, 9.898920744e-01f, 9.967999021e-01f, 9.989876708e-01f, 9.996798365e-01f, 9.998987517e-01f, 9.999679821e-01f, 8.509035245e-01f, 1.717624261e-01f, 9.956709484e-01f, 9.890272824e-01f, -9.775301177e-01f, 5.737332542e-01f, 9.891016630e-01f, 7.175133434e-01f, 4.349655341e-01f, 2.503614686e-01f, 1.418227098e-01f, 7.993719520e-02f, 4.498481404e-02f, 2.530265896e-02f, 1.422976920e-02f, 8.002171940e-03f,
-4.321779449e-01f, 7.418577573e-01f, -3.979766910e-01f, -3.203544680e-01f, -1.121525269e-01f, -8.499939289e-01f, 1.158876288e-01f, 6.836759095e-01f, 8.960524975e-01f, 9.667292474e-01f, 9.894386429e-01f, 9.966561754e-01f, 9.989421865e-01f, 9.996654497e-01f, 9.998942019e-01f, 9.999665433e-01f, 9.017883476e-01f, 6.705572816e-01f, 9.173955273e-01f, 9.472977435e-01f, -9.936910036e-01f, 5.267924836e-01f, 9.932623307e-01f, 7.297857568e-01f, 4.439481070e-01f, 2.558018026e-01f, 1.449523091e-01f, 8.170965662e-02f, 4.598377905e-02f, 2.586481621e-02f, 1.454596424e-02f, 8.179994060e-03f,
-9.923354692e-01f, 2.700984415e-01f, -6.635380855e-01f, -4.828721220e-01f, -1.238866346e-02f, -8.782584324e-01f, 8.442521171e-02f, 6.705908678e-01f, 8.915682882e-01f, 9.652754904e-01f, 9.889753170e-01f, 9.965092971e-01f, 9.988957033e-01f, 9.996507468e-01f, 9.998895520e-01f, 9.999650728e-01f, 1.235731227e-01f, 9.628327123e-01f, 7.481425059e-01f, 8.756908780e-01f, -9.999232576e-01f, 4.781862879e-01f, 9.964298187e-01f, 7.418273977e-01f, 4.528862854e-01f, 2.612340474e-01f, 1.480804588e-01f, 8.348185965e-02f, 4.698269808e-02f, 2.642696529e-02f, 1.486215781e-02f, 8.357815921e-03f,
-6.401443395e-01f, -2.848462729e-01f, -8.632967800e-01f, -6.301602158e-01f, 8.749898344e-02f, -9.037463706e-01f, 5.287837645e-02f, 6.572937723e-01f, 8.869949228e-01f, 9.637912089e-01f, 9.885021014e-01f, 9.963592674e-01f, 9.988482212e-01f, 9.996357277e-01f, 9.998848022e-01f, 9.999635708e-01f, -7.682546613e-01f, 9.585732110e-01f, 5.046966116e-01f, 7.764651328e-01f, -9.961646088e-01f, 4.280683329e-01f, 9.986009600e-01f, 7.536344584e-01f, 4.617791755e-01f, 2.666580314e-01f, 1.512071278e-01f, 8.525379868e-02f, 4.798157012e-02f, 2.698910600e-02f, 1.517834990e-02f, 8.535637518e-03f,
3.005925437e-01f, -7.520635254e-01f, -9.774428167e-01f, -7.575733518e-01f, 1.865123694e-01f, -9.263771649e-01f, 2.127866722e-02f, 6.437888276e-01f, 8.823328586e-01f, 9.622764496e-01f, 9.880190008e-01f, 9.962060871e-01f, 9.987997402e-01f, 9.996203926e-01f, 9.998799524e-01f, 9.999620371e-01f, -9.537526528e-01f, 6.590906264e-01f, 2.112002371e-01f, 6.527500415e-01f, -9.824526126e-01f, 3.765970636e-01f, 9.997735835e-01f, 7.652032053e-01f, 4.706258882e-01f, 2.720735828e-01f, 1.543322846e-01f, 8.702546812e-02f, 4.898039419e-02f, 2.755123819e-02f, 1.549454048e-02f, 8.713458845e-03f,
9.649660285e-01f, -9.876589150e-01f, -9.946563971e-01f, -8.610929796e-01f, 2.836621855e-01f, -9.460792693e-01f, -1.034231891e-02f, 6.300803045e-01f, 8.775825619e-01f, 9.607312606e-01f, 9.875260200e-01f, 9.960497564e-01f, 9.987502604e-01f, 9.996047413e-01f, 9.998750026e-01f, 9.999604718e-01f, -2.623748537e-01f, 1.566201379e-01f, -1.032407464e-01f, 5.084475199e-01f, -9.589242747e-01f, 3.239352036e-01f, 9.999465168e-01f, 7.765299800e-01f, 4.794255386e-01f, 2.774805306e-01f, 1.574558982e-01f, 8.879686236e-02f, 4.997916927e-02f, 2.811336166e-02f, 1.581072950e-02f, 8.891279896e-03f,
7.421541968e-01f, -9.190733545e-01f, -9.132304601e-01f, -9.374541386e-01f, 3.779777427e-01f, -9.627903967e-01f, -4.195296357e-02f, 6.161725377e-01f, 8.727445076e-01f, 9.591556907e-01f, 9.870231639e-01f, 9.958902760e-01f, 9.986997819e-01f, 9.995887740e-01f, 9.998699528e-01f, 9.999588749e-01f, 6.702291758e-01f, -3.940864994e-01f, -4.074434030e-01f, 3.481088020e-01f, -9.258146823e-01f, 2.702492405e-01f, 9.991195869e-01f, 7.876112009e-01f, 4.881772469e-01f, 2.828787037e-01f, 1.605779372e-01f, 9.056797580e-02f, 5.097789438e-02f, 2.867547624e-02f, 1.612691694e-02f, 9.069100666e-03f,
-1.629907808e-01f, -5.674299469e-01f, -7.412399703e-01f, -9.842484337e-01f, 4.685166713e-01f, -9.764577158e-01f, -7.352165877e-02f, 6.020699252e-01f, 8.678191797e-01f, 9.575497897e-01f, 9.865104376e-01f, 9.957276462e-01f, 9.986483046e-01f, 9.995724905e-01f, 9.998648030e-01f, 9.999572463e-01f, 9.866275920e-01f, -8.234216753e-01f, -6.712401257e-01f, 1.767908958e-01f, -8.834546557e-01f, 2.157088994e-01f, 9.972936206e-01f, 7.984433638e-01f, 4.968801378e-01f, 2.882679314e-01f, 1.636983704e-01f, 9.233880284e-02f, 5.197656850e-02f, 2.923758175e-02f, 1.644310277e-02f, 9.246921150e-03f,
-9.182827862e-01f, -4.102845452e-02f, -4.957411282e-01f, -9.999999947e-01f, 5.543743362e-01f, -9.870380181e-01f, -1.050168384e-01f, 5.877769265e-01f, 8.628070705e-01f, 9.559136084e-01f, 9.859878462e-01f, 9.955618678e-01f, 9.985958287e-01f, 9.995558910e-01f, 9.998595533e-01f, 9.999555861e-01f, 3.959251502e-01f, -9.991579785e-01f, -8.684703414e-01f, -1.029124367e-04f, -8.322674422e-01f, 1.604866066e-01f, 9.944704438e-01f, 8.090230434e-01f, 5.055333412e-01f, 2.936480433e-01f, 1.668171666e-01f, 9.410933788e-02f, 5.297519065e-02f, 2.979967802e-02f, 1.675928696e-02f, 9.424741341e-03f,
-8.293098329e-01f, 4.980090543e-01f, -2.010799162e-01f, -9.842120249e-01f, 6.346928759e-01f, -9.944978545e-01f, -1.364070100e-01f, 5.732980613e-01f, 8.577086814e-01f, 9.542471985e-01f, 9.854553950e-01f, 9.953929410e-01f, 9.985423543e-01f, 9.995389753e-01f, 9.998542035e-01f, 9.999538943e-01f, -5.587890489e-01f, -8.671718295e-01f, -9.795748401e-01f, -1.769934748e-01f, -7.727644876e-01f, 1.047569444e-01f, 9.906528795e-01f, 8.193468942e-01f, 5.141359917e-01f, 2.990188692e-01f, 1.699342947e-01f, 9.587957531e-02f, 5.397375983e-02f, 3.036176486e-02f, 1.707546947e-02f, 9.602561234e-03f,
2.212675626e-02f, 8.836688484e-01f, 1.135222784e-01f, -9.373824693e-01f, 7.086697743e-01f, -9.988136413e-01f, -1.676607860e-01f, 5.586379081e-01f, 8.525245221e-01f, 9.525506128e-01f, 9.849130892e-01f, 9.952208666e-01f, 9.984878812e-01f, 9.995217436e-01f, 9.998487538e-01f, 9.999521709e-01f, -9.997551734e-01f, -4.681125574e-01f, -9.935354510e-01f, -3.483017460e-01f, -7.055403256e-01f, 4.869609889e-02f, 9.858447448e-01f, 8.294116515e-01f, 5.226872289e-01f, 3.043802394e-01f, 1.730497234e-01f, 9.764950955e-02f, 5.497227503e-02f, 3.092384210e-02f, 1.739165027e-02f, 9.780380823e-03f,
8.532201077e-01f, 9.971747381e-01f, 4.168665323e-01f, -8.609883102e-01f, 7.755658785e-01f, -9.999717342e-01f, -1.987469151e-01f, 5.438011027e-01f, 8.472551110e-01f, 9.508239048e-01f, 9.843609343e-01f, 9.950456450e-01f, 9.984324097e-01f, 9.995041958e-01f, 9.998432041e-01f, 9.999504159e-01f, -5.215510021e-01f, 7.511685313e-02f, -9.089677080e-01f, -5.086247435e-01f, -6.312666379e-01f, -7.518696635e-03f, 9.800508475e-01f, 8.392141328e-01f, 5.311861979e-01f, 3.097319842e-01f, 1.761634216e-01f, 9.941913500e-02f, 5.597073526e-02f, 3.148590956e-02f, 1.770782933e-02f, 9.958200103e-03f,
8.998668270e-01f, 8.035689776e-01f, 6.788703658e-01f, -7.574389836e-01f, 8.347127848e-01f, -9.979684721e-01f, -2.296343139e-01f, 5.287923369e-01f, 8.419009752e-01f, 9.490671292e-01f, 9.837989357e-01f, 9.948672768e-01f, 9.983759398e-01f, 9.994863320e-01f, 9.998375544e-01f, 9.999486292e-01f, 4.361647552e-01f, 5.952116415e-01f, -7.342581470e-01f, -6.529059551e-01f, -5.506855426e-01f, -6.370972221e-02f, 9.732769811e-01f, 8.487512383e-01f, 5.396320487e-01f, 3.150739345e-01f, 1.792753582e-01f, 1.011884461e-01f, 5.696913951e-02f, 3.204796707e-02f, 1.802400663e-02f, 1.013601907e-02f,
1.191801354e-01f, 3.624786135e-01f, 8.735510056e-01f, -6.300003866e-01f, 8.855195169e-01f, -9.928101881e-01f, -2.602920974e-01f, 5.136163566e-01f, 8.364626499e-01f, 9.472803416e-01f, 9.832270992e-01f, 9.946857625e-01f, 9.983184715e-01f, 9.994681520e-01f, 9.998318047e-01f, 9.999468110e-01f, 9.928726481e-01f, 9.319920894e-01f, -4.867326171e-01f, -7.765948190e-01f, -4.646021794e-01f, -1.196993330e-01f, 9.655299188e-01f, 8.580199521e-01f, 5.480239368e-01f, 3.204059213e-01f, 1.823855020e-01f, 1.029574371e-01f, 5.796748680e-02f, 3.261001444e-02f, 1.834018212e-02f, 1.031383771e-02f,
-7.710802230e-01f, -1.902485591e-01f, 9.816020819e-01f, -4.826918728e-01f, 9.274784307e-01f, -9.845131900e-01f, -2.906896106e-01f, 4.982779609e-01f, 8.309406791e-01f, 9.454635984e-01f, 9.826454305e-01f, 9.945011028e-01f, 9.982600048e-01f, 9.994496561e-01f, 9.998259550e-01f, 9.999449611e-01f, 6.367380071e-01f, 9.817359552e-01f, -1.909380864e-01f, -8.757902465e-01f, -3.738766648e-01f, -1.753105211e-01f, 9.568174070e-01f, 8.670173434e-01f, 5.563610229e-01f, 3.257277760e-01f, 1.854938220e-01f, 1.047261026e-01f, 5.896577612e-02f, 3.317205150e-02f, 1.865635577e-02f, 1.049165603e-02f,
-9.524129804e-01f, -6.843826418e-01f, 9.923082299e-01f, -3.201594838e-01f, 9.601702867e-01f, -9.731037080e-01f, -3.207964584e-01f, 4.827820000e-01f, 8.253356149e-01f, 9.436169571e-01f, 9.820539352e-01f, 9.943132982e-01f, 9.982005399e-01f, 9.994308440e-01f, 9.998200054e-01f, 9.999430795e-01f, -3.048106211e-01f, 7.291230346e-01f, 1.237916674e-01f, -9.473636604e-01f, -2.794154982e-01f, -2.303674747e-01f, 9.471481575e-01f, 8.757405669e-01f, 5.646424734e-01f, 3.310393303e-01f, 1.886002871e-01f, 1.064944369e-01f, 5.996400648e-02f, 3.373407807e-02f, 1.897252756e-02f, 1.066947402e-02f,
-2.581016359e-01f, -9.677393408e-01f, 9.046077269e-01f, -1.475294147e-01f, 9.832684384e-01f, -9.586178129e-01f, -3.505825365e-01f, 4.671333740e-01f, 8.196480178e-01f, 9.417404761e-01f, 9.814526195e-01f, 9.941223493e-01f, 9.981400768e-01f, 9.994117159e-01f, 9.998139558e-01f, 9.999411664e-01f, -9.661177700e-01f, 2.519535043e-01f, 4.262450708e-01f, -9.890576686e-01f, -1.821625043e-01f, -2.846961343e-01f, 9.365318388e-01f, 8.841868642e-01f, 5.728674601e-01f, 3.363404163e-01f, 1.917048661e-01f, 1.082624345e-01f, 6.096217687e-02f, 3.429609397e-02f, 1.928869745e-02f, 1.084729167e-02f,
6.735071623e-01f, -9.530499555e-01f, 7.271977827e-01f, 2.975366287e-02f, 9.965420970e-01f, -9.411013007e-01f, -3.800180612e-01f, 4.513370314e-01f, 8.138784567e-01f, 9.398342148e-01f, 9.808414892e-01f, 9.939282566e-01f, 9.980786156e-01f, 9.993922718e-01f, 9.998078062e-01f, 9.999392216e-01f, -7.391806966e-01f, -3.028131145e-01f, 6.864279895e-01f, -9.995572618e-01f, -8.308940282e-02f, -3.381247429e-01f, 9.249790663e-01f, 8.923535645e-01f, 5.810351605e-01f, 3.416308663e-01f, 1.948075281e-01f, 1.100300897e-01f, 6.196028630e-02f, 3.485809903e-02f, 1.960486542e-02f, 1.102510897e-02f,
9.858965816e-01f, -6.448385490e-01f, 4.776720420e-01f, 2.060983239e-01f, 9.998586364e-01f, -9.206095492e-01f, -4.090735996e-01f, 4.353979673e-01f, 8.080275083e-01f, 9.378982333e-01f, 9.802205506e-01f, 9.937310210e-01f, 9.980161563e-01f, 9.993725116e-01f, 9.998015566e-01f, 9.999372453e-01f, 1.673557003e-01f, -7.643188115e-01f, 8.785382293e-01f, -9.785312876e-01f, 1.681390048e-02f, -3.904843889e-01f, 9.125013918e-01f, 9.002380852e-01f, 5.891447579e-01f, 3.469105129e-01f, 1.979082420e-01f, 1.117973969e-01f, 6.295833377e-02f, 3.542009306e-02f, 1.992103142e-02f, 1.120292593e-02f
};

struct Args { const float* in[22]; float* out; unsigned char* ws; int ph_lo, ph_hi; };
struct Frame { LAS unsigned char* lds; int tid, lane, wave, vcu, G, bx; };
#define CAS __attribute__((address_space(4)))
typedef CAS const char* kptr_t;
__device__ __forceinline__ kptr_t kargp() { kptr_t kp = (kptr_t)__builtin_amdgcn_kernarg_segment_ptr(); asm volatile("" : "+s"(kp)); return kp; }
typedef const float* cfp_t; typedef float* fp_t; typedef unsigned char* ucp_t;
__device__ __forceinline__ const float* arg_in(int i) { return *(CAS const cfp_t*)(kargp() + 8 * i); }
__device__ __forceinline__ float* arg_out() { return *(CAS const fp_t*)(kargp() + 176); }
__device__ __forceinline__ unsigned char* arg_ws() { return *(CAS const ucp_t*)(kargp() + 184); }
__device__ __forceinline__ float wave_sum(float v) {
#pragma unroll
    for (int o = 1; o < 64; o <<= 1) v += __shfl_xor(v, o);
    return v;
}
__device__ __forceinline__ float silu_f(float v) { return v * __builtin_amdgcn_rcpf(1.0f + __builtin_amdgcn_exp2f(v * -1.4426950408889634f)); }

constexpr int TP_PITCH = 144;
constexpr int N_TILES = 768 + 512 + 512 + 96 * 256;
struct TileDesc { const float* src; bf16_t* dst; int N, k0, n0, drow0; };
__device__ __forceinline__ TileDesc p0_decode(int t) {
    TileDesc d; int it, kind = 0;
    if (t < 768) { d.src = arg_in(8); d.dst = (bf16_t*)(arg_ws() + WS_WIN0); d.N = 3072; it = t; kind = 1; }
    else if (t < 1280) { d.src = arg_in(12); d.dst = (bf16_t*)(arg_ws() + WS_WIN1); d.N = 2048; it = t - 768; }
    else if (t < 1792) { const int x = t - 1280, l = x >> 8; d.src = arg_in(16) + (size_t)l * DM * DM; d.dst = (bf16_t*)(arg_ws() + WS_WOUT) + (size_t)l * DM * DM; d.N = 1024; it = x & 255; }
    else { const int x = t - 1792, mat = x >> 8, which = mat >> 5, le = mat & 31; it = x & 255; d.N = 1024;
        d.src = arg_in(18 + which) + (size_t)le * DM * DM;
        if (which == 2) d.dst = (bf16_t*)(arg_ws() + WS_WD) + (size_t)le * DM * DM; else { d.dst = (bf16_t*)(arg_ws() + WS_WGU) + (size_t)le * 2048 * DM; kind = 2 + which; } }
    const int nb = d.N >> 6, kb = it / nb, nblk = it - kb * nb; d.k0 = kb * 64; d.n0 = nblk * 64;
    int drow0 = d.n0;
    if (kind == 1) { if (d.n0 >= 2560) { const int c = d.n0 - 2560; drow0 = 2048 + (c >> 7) * 256 + 128 + (c & 127); } else if (d.n0 >= 2048) { const int c = d.n0 - 2048; drow0 = 2048 + (c >> 7) * 256 + (c & 127); } }
    else if (kind == 2) drow0 = (d.n0 >> 7) * 256 + (d.n0 & 127);
    else if (kind == 3) drow0 = (d.n0 >> 7) * 256 + 128 + (d.n0 & 127);
    d.drow0 = drow0; return d;
}
__device__ __forceinline__ void p0_tile_load(int t, int lane, f32x4 (&v)[16]) {
    const TileDesc d = p0_decode(t); const int nq = lane >> 2, kq = lane & 3;
    const float* s = d.src + (size_t)(d.k0 + 16 * kq) * d.N + d.n0 + 4 * nq;
#pragma unroll
    for (int i = 0; i < 16; ++i) v[i] = *(const f32x4*)(s + (size_t)i * d.N);
}
__device__ __forceinline__ void p0_tile_store(int t, int lane, const f32x4 (&v)[16], LAS unsigned char* T) {
    const TileDesc d = p0_decode(t); const int nq = lane >> 2, kq = lane & 3;
#pragma unroll
    for (int j = 0; j < 4; ++j) { u32x4 w0, w1;
        w0.x = cvt_pk_bf16(v[0][j], v[1][j]); w0.y = cvt_pk_bf16(v[2][j], v[3][j]); w0.z = cvt_pk_bf16(v[4][j], v[5][j]); w0.w = cvt_pk_bf16(v[6][j], v[7][j]);
        w1.x = cvt_pk_bf16(v[8][j], v[9][j]); w1.y = cvt_pk_bf16(v[10][j], v[11][j]); w1.z = cvt_pk_bf16(v[12][j], v[13][j]); w1.w = cvt_pk_bf16(v[14][j], v[15][j]);
        LAS unsigned char* p = T + (4 * nq + j) * TP_PITCH + 32 * kq; *(LAS u32x4*)p = w0; *(LAS u32x4*)(p + 16) = w1; }
    LDS_WAIT(); asm volatile("" ::: "memory");
    bf16_t* dp = d.dst + (size_t)(d.drow0 + (lane >> 3)) * DM + d.k0 + 8 * (lane & 7);
#pragma unroll
    for (int r = 0; r < 8; ++r) { const u32x4 w = *(const LAS u32x4*)(T + (8 * r + (lane >> 3)) * TP_PITCH + 16 * (lane & 7)); *(u32x4*)(dp + (size_t)(8 * r) * DM) = w; }
    LDS_WAIT(); asm volatile("" ::: "memory");
}
__device__ __forceinline__ void p0_mod_block(Frame& F, int l, int cc) {
    LAS float* sl = (LAS float*)F.lds;
    for (int idx = F.tid; idx < 17 * DM; idx += 512) { const int bb = idx >> 10, k = idx & 1023; const float v = (bb < 16) ? arg_in(1)[bb * DM + k] : arg_in(3)[k]; sl[k * 20 + bb] = silu_f(v); }
    __syncthreads();
    const int ksub = F.lane >> 3, cq = F.lane & 7, j0 = cc * 256 + F.wave * 32 + 4 * cq;
    f32x4 acc[17];
#pragma unroll
    for (int bb = 0; bb < 17; ++bb) acc[bb] = (f32x4){0.f, 0.f, 0.f, 0.f};
    const float* wl = arg_in(4) + (size_t)l * DM * MODW; const unsigned loff = (unsigned)(ksub * MODW + j0);
#define MOD_LOAD(W, i0) do { _Pragma("unroll") for (int q = 0; q < 8; ++q) W[q] = *(const f32x4*)(wl + (size_t)(8 * ((i0) + q)) * MODW + loff); } while (0)
#define MOD_FMA(W, i0) do { _Pragma("unroll") for (int q = 0; q < 8; ++q) { const int k = 8 * ((i0) + q) + ksub; const f32x4 w = W[q]; \
        const f32x4 s0 = *(const LAS f32x4*)(sl + k * 20), s1 = *(const LAS f32x4*)(sl + k * 20 + 4), s2 = *(const LAS f32x4*)(sl + k * 20 + 8), s3 = *(const LAS f32x4*)(sl + k * 20 + 12); const float s4 = sl[k * 20 + 16]; \
        _Pragma("unroll") for (int z = 0; z < 4; ++z) { acc[z] += s0[z] * w; acc[4 + z] += s1[z] * w; acc[8 + z] += s2[z] * w; acc[12 + z] += s3[z] * w; } \
        acc[16] += s4 * w; __builtin_amdgcn_sched_barrier(0); } } while (0)
    { f32x4 wA[8], wB[8];
      MOD_LOAD(wA, 0);
      for (int i0 = 0; i0 < 128; i0 += 16) {
          MOD_LOAD(wB, i0 + 8); asm volatile("" ::: "memory");
          MOD_FMA(wA, i0);
          { const int nx = i0 + 16 < 128 ? i0 + 16 : 0; MOD_LOAD(wA, nx); } asm volatile("" ::: "memory");
          MOD_FMA(wB, i0 + 8);
      } }
#undef MOD_LOAD
#undef MOD_FMA
#pragma unroll
    for (int bb = 0; bb < 17; ++bb)
#pragma unroll
        for (int q = 0; q < 4; ++q) { float x = acc[bb][q]; x += __shfl_xor(x, 8); x += __shfl_xor(x, 16); x += __shfl_xor(x, 32); acc[bb][q] = x; }
    if (ksub == 0) { float* mod = (float*)(arg_ws() + WS_MOD) + (size_t)l * 17 * MODW + j0; const f32x4 bv = *(const f32x4*)(arg_in(5) + l * MODW + j0);
#pragma unroll
        for (int bb = 0; bb < 17; ++bb) *(f32x4*)(mod + (size_t)bb * MODW) = acc[bb] + bv; }
    __syncthreads();
}
__device__ __forceinline__ void p0_prologue(Frame& F) {
    const bool is_mod = (F.vcu % 5 == 0) && (F.vcu < 240);
    if (is_mod) { const int m = F.vcu / 5; p0_mod_block(F, m / 24, m % 24); }
    const int nm = (F.vcu + 4) / 5 < 48 ? (F.vcu + 4) / 5 : 48; const int start = F.vcu * 108 - 26 * nm; int end = start + (is_mod ? 82 : 108); if (end > N_TILES) end = N_TILES;
    LAS unsigned char* T = F.lds + F.wave * (64 * TP_PITCH);
    f32x4 vA[16], vB[16];
    int t = start + F.wave;
    if (t < end) p0_tile_load(t, F.lane, vA);
    while (t < end) {
        int t2 = t + NWAVES; if (t2 < end) p0_tile_load(t2, F.lane, vB);
        p0_tile_store(t, F.lane, vA, T);
        t = t2; if (t >= end) break;
        t2 = t + NWAVES; if (t2 < end) p0_tile_load(t2, F.lane, vA);
        p0_tile_store(t, F.lane, vB, T);
        t = t2;
    }
}

__device__ __forceinline__ void st_row_bf16(bf16_t* orow, int lane, const f32x4 (&v)[4]) {
#pragma unroll
    for (int j = 0; j < 4; ++j) { u32x2 w; w.x = cvt_pk_bf16(v[j][0], v[j][1]); w.y = cvt_pk_bf16(v[j][2], v[j][3]); *(u32x2*)(orow + 4 * lane + 256 * j) = w; }
}
template <int NR> __device__ __forceinline__ void norm_rows(const float* const (&xr)[NR], bf16_t* const (&orow)[NR], int lane, const f32x4 (&A)[4], const f32x4 (&Bv)[4]) {
    f32x4 v[NR][4];
#pragma unroll
    for (int r = 0; r < NR; ++r)
#pragma unroll
        for (int j = 0; j < 4; ++j) v[r][j] = *(const f32x4*)(xr[r] + 4 * lane + 256 * j);
#pragma unroll
    for (int r = 0; r < NR; ++r) { float ss = 0.f;
#pragma unroll
        for (int j = 0; j < 4; ++j) ss += (v[r][j][0] * v[r][j][0] + v[r][j][1] * v[r][j][1]) + (v[r][j][2] * v[r][j][2] + v[r][j][3] * v[r][j][3]);
        const float rstd = __builtin_amdgcn_rsqf(wave_sum(ss) * (1.0f / DM) + NORM_EPS);
#pragma unroll
        for (int j = 0; j < 4; ++j) v[r][j] = v[r][j] * rstd * A[j] + Bv[j];
        st_row_bf16(orow[r], lane, v[r]); }
}
__device__ __forceinline__ void p1_norm_in(Frame& F) {
    const int b = F.vcu >> 4; const float* mod = (const float*)(arg_ws() + WS_MOD) + (size_t)b * MODW; const float* n1 = arg_in(6);
    f32x4 A[4], Bv[4];
#pragma unroll
    for (int j = 0; j < 4; ++j) { const int c = 4 * F.lane + 256 * j; A[j] = *(const f32x4*)(n1 + c) * (1.0f + *(const f32x4*)(mod + 1024 + c)); Bv[j] = *(const f32x4*)(mod + c); }
    bf16_t* H = (bf16_t*)(arg_ws() + WS_H); const float* X = arg_in(0);
    for (int i = 0; i < 16; i += 4) { const int row = F.vcu * 128 + F.wave + 8 * i;
        const float* const xr[4] = {X + (size_t)row * DM, X + (size_t)(row + 8) * DM, X + (size_t)(row + 16) * DM, X + (size_t)(row + 24) * DM};
        bf16_t* const orow[4] = {H + (size_t)row * DM, H + (size_t)(row + 8) * DM, H + (size_t)(row + 16) * DM, H + (size_t)(row + 24) * DM};
        norm_rows<4>(xr, orow, F.lane, A, Bv); }
    const float* modc = (const float*)(arg_ws() + WS_MOD) + (size_t)16 * MODW;
#pragma unroll
    for (int j = 0; j < 4; ++j) { const int c = 4 * F.lane + 256 * j; A[j] = *(const f32x4*)(n1 + c) * (1.0f + *(const f32x4*)(modc + 1024 + c)); Bv[j] = *(const f32x4*)(modc + c); }
    bf16_t* HC = (bf16_t*)(arg_ws() + WS_HC); const float* XC = arg_in(2);
    { const int row = F.vcu * 16 + F.wave;
        const float* const xr[2] = {XC + (size_t)row * DM, XC + (size_t)(row + 8) * DM};
        bf16_t* const orow[2] = {HC + (size_t)row * DM, HC + (size_t)(row + 8) * DM};
        norm_rows<2>(xr, orow, F.lane, A, Bv); }
}

#ifndef RNR
#define RNR 2
#endif
__device__ __forceinline__ void router_finish(const float (&lg)[16], int lane, float* prow) {
    float a8[8], a4[4], a2[2], a1;
    { const bool up = (lane & 32) != 0;
#pragma unroll
      for (int q = 0; q < 8; ++q) { const float keep = up ? lg[q + 8] : lg[q], send = up ? lg[q] : lg[q + 8]; a8[q] = keep + __shfl_xor(send, 32); } }
    { const bool up = (lane & 16) != 0;
#pragma unroll
      for (int q = 0; q < 4; ++q) { const float keep = up ? a8[q + 4] : a8[q], send = up ? a8[q] : a8[q + 4]; a4[q] = keep + __shfl_xor(send, 16); } }
    { const bool up = (lane & 8) != 0;
#pragma unroll
      for (int q = 0; q < 2; ++q) { const float keep = up ? a4[q + 2] : a4[q], send = up ? a4[q] : a4[q + 2]; a2[q] = keep + __shfl_xor(send, 8); } }
    { const bool up = (lane & 4) != 0; const float keep = up ? a2[1] : a2[0], send = up ? a2[0] : a2[1]; a1 = keep + __shfl_xor(send, 4); }
    a1 += __shfl_xor(a1, 2); a1 += __shfl_xor(a1, 1);
    float mx = a1; mx = fmaxf(mx, __shfl_xor(mx, 4)); mx = fmaxf(mx, __shfl_xor(mx, 8)); mx = fmaxf(mx, __shfl_xor(mx, 16)); mx = fmaxf(mx, __shfl_xor(mx, 32));
    const float pe = __builtin_amdgcn_exp2f((a1 - mx) * 1.4426950408889634f);
    float sm = pe; sm += __shfl_xor(sm, 4); sm += __shfl_xor(sm, 8); sm += __shfl_xor(sm, 16); sm += __shfl_xor(sm, 32);
    const int e = ((lane >> 5) & 1) * 8 + ((lane >> 4) & 1) * 4 + ((lane >> 3) & 1) * 2 + ((lane >> 2) & 1);
    if ((lane & 3) == 0) prow[e] = pe / sm;
}
__device__ __forceinline__ void p_router(Frame& F, int l) {
    LAS float* wr = (LAS float*)F.lds;
    const float* wsrc = arg_in(17) + (size_t)l * DM * NE;
    for (int idx = F.tid; idx < DM * NE; idx += 512) wr[(idx & 15) * DM + (idx >> 4)] = wsrc[idx];
    __syncthreads();
    const int b = F.vcu >> 4; const float* mod = (const float*)(arg_ws() + WS_MOD) + ((size_t)l * 17 + b) * MODW; const float* n2 = arg_in(7) + l * DM;
    f32x4 A[4], Bv[4];
#pragma unroll
    for (int j = 0; j < 4; ++j) { const int c = 4 * F.lane + 256 * j; A[j] = *(const f32x4*)(n2 + c) * (1.0f + *(const f32x4*)(mod + 4096 + c)); Bv[j] = *(const f32x4*)(mod + 3072 + c); }
    bf16_t* H = (bf16_t*)(arg_ws() + WS_H); const float* ssq = (const float*)(arg_ws() + WS_SSQ); float* probs = (float*)(arg_ws() + WS_PROBS); const float* X = arg_out();
    const int lane = F.lane;
    f32x4 vn[4]; float sqn;
    { const int row = F.vcu * 128 + F.wave; const float* xr = X + (size_t)row * DM + 4 * lane;
#pragma unroll
      for (int j = 0; j < 4; ++j) vn[j] = *(const f32x4*)(xr + 256 * j);
      sqn = lane < 16 ? ssq[(size_t)row * 16 + lane] : 0.f; }
    for (int i = 0; i < 16; ++i) { const int row = F.vcu * 128 + F.wave + 8 * i;
        f32x4 v[4]; const float sq = sqn;
#pragma unroll
        for (int j = 0; j < 4; ++j) v[j] = vn[j];
        { const int rn = row + (i < 15 ? 8 : 0); const float* xr = X + (size_t)rn * DM + 4 * lane;
#pragma unroll
          for (int j = 0; j < 4; ++j) vn[j] = *(const f32x4*)(xr + 256 * j);
          sqn = lane < 16 ? ssq[(size_t)rn * 16 + lane] : 0.f; }
        const float rstd = __builtin_amdgcn_rsqf(wave_sum(sq) * (1.0f / DM) + NORM_EPS);
#pragma unroll
        for (int j = 0; j < 4; ++j) v[j] = v[j] * rstd * A[j] + Bv[j];
        st_row_bf16(H + (size_t)row * DM, lane, v);
        float lg[16];
#pragma unroll
        for (int e = 0; e < 16; ++e) { float s = 0.f;
#pragma unroll
            for (int j = 0; j < 4; ++j) { const f32x4 w = *(const LAS f32x4*)(wr + e * DM + 4 * lane + 256 * j); s += (v[j][0] * w[0] + v[j][1] * w[1]) + (v[j][2] * w[2] + v[j][3] * w[3]); }
            lg[e] = s; }
        router_finish(lg, lane, probs + (size_t)row * 16);
    }
}

__device__ __forceinline__ void p_topk(Frame& F) {
    const int e = F.vcu >> 4, b = F.vcu & 15;
    LAS unsigned long long* keys = (LAS unsigned long long*)F.lds;
    LAS int* slot = (LAS int*)(F.lds + 16384);
    LAS int* idxs = (LAS int*)(F.lds + 24576);
    const float* probs = (const float*)(arg_ws() + WS_PROBS);
    for (int t = F.tid; t < SEQ; t += 512) { const float p = probs[((size_t)b * SEQ + t) * 16 + e]; keys[t] = ((unsigned long long)(~__float_as_uint(p)) << 32) | (unsigned)t; slot[t] = -1; }
    __syncthreads();
    for (int k = 2; k <= SEQ; k <<= 1)
        for (int j = k >> 1; j > 0; j >>= 1) {
            for (int t = F.tid; t < SEQ / 2; t += 512) { const int i = ((t & ~(j - 1)) << 1) | (t & (j - 1)), ixj = i | j; const bool up = (i & k) == 0;
                const unsigned long long a = keys[i], c = keys[ixj]; if ((a > c) == up) { keys[i] = c; keys[ixj] = a; } }
            __syncthreads();
        }
    float* vals = (float*)(arg_ws() + WS_VALS);
    if (F.tid < CAP) { const unsigned long long key = keys[F.tid]; const int t = (int)(unsigned)(key & 0xffffffffull); idxs[F.tid] = t; slot[t] = F.tid; ((int*)(arg_ws() + WS_IDX))[(size_t)F.vcu * CAP + F.tid] = t; vals[(size_t)F.vcu * CAP + F.tid] = __uint_as_float(~(unsigned)(key >> 32)); }
    __syncthreads();
    int* slotg = (int*)(arg_ws() + WS_SLOT);
    for (int t = F.tid; t < SEQ; t += 512) slotg[((size_t)b * SEQ + t) * 16 + e] = slot[t];
}

__device__ __forceinline__ void p_combine(Frame& F, int l, bool fin) {
    const int b = F.vcu >> 4, lane = F.lane; const float* mod = (const float*)(arg_ws() + WS_MOD) + ((size_t)l * 17 + b) * MODW;
    f32x4 G2[4], A[4], Bv[4];
#pragma unroll
    for (int j = 0; j < 4; ++j) { const int c = 4 * lane + 256 * j; G2[j] = *(const f32x4*)(mod + 5120 + c);
        if (fin) { A[j] = *(const f32x4*)(arg_in(21) + c); Bv[j] = (f32x4){0.f, 0.f, 0.f, 0.f}; }
        else { const float* mod1 = (const float*)(arg_ws() + WS_MOD) + ((size_t)(l + 1) * 17 + b) * MODW; A[j] = *(const f32x4*)(arg_in(6) + (l + 1) * DM + c) * (1.0f + *(const f32x4*)(mod1 + 1024 + c)); Bv[j] = *(const f32x4*)(mod1 + c); } }
    const int* slotg = (const int*)(arg_ws() + WS_SLOT); const bf16_t* Y = (const bf16_t*)(arg_ws() + WS_Y); bf16_t* H = (bf16_t*)(arg_ws() + WS_H);
    for (int i = 0; i < 16; ++i) { const int row = F.vcu * 128 + F.wave + 8 * i; float* xr = arg_out() + (size_t)row * DM + 4 * lane;
        f32x4 v[4], acc[4];
#pragma unroll
        for (int j = 0; j < 4; ++j) { v[j] = *(const f32x4*)(xr + 256 * j); acc[j] = (f32x4){0.f, 0.f, 0.f, 0.f}; }
        const int sl = lane < 16 ? slotg[(size_t)row * 16 + lane] : -1;
#pragma unroll
        for (int e = 0; e < 16; ++e) { const int s = __builtin_amdgcn_readlane(sl, e);
            if (s >= 0) { const bf16_t* yr = Y + ((size_t)(e * 16 + b) * CAP + s) * DM + 4 * lane;
#pragma unroll
                for (int j = 0; j < 4; ++j) { const u32x2 w = *(const u32x2*)(yr + 256 * j); acc[j] += (f32x4){bflo(w.x), bfhi(w.x), bflo(w.y), bfhi(w.y)}; } } }
        float ss = 0.f;
#pragma unroll
        for (int j = 0; j < 4; ++j) { v[j] = v[j] + G2[j] * acc[j]; ss += (v[j][0] * v[j][0] + v[j][1] * v[j][1]) + (v[j][2] * v[j][2] + v[j][3] * v[j][3]); }
        const float rstd = __builtin_amdgcn_rsqf(wave_sum(ss) * (1.0f / DM) + NORM_EPS);
        if (!fin) {
#pragma unroll
            for (int j = 0; j < 4; ++j) *(f32x4*)(xr + 256 * j) = v[j];
#pragma unroll
            for (int j = 0; j < 4; ++j) v[j] = v[j] * rstd * A[j] + Bv[j];
            st_row_bf16(H + (size_t)row * DM, lane, v);
        } else {
#pragma unroll
            for (int j = 0; j < 4; ++j) *(f32x4*)(xr + 256 * j) = v[j] * rstd * A[j];
        }
    }
}

__device__ __forceinline__ void p_attn_conv(Frame& F) {
    const float* lp = arg_in(9); float s1 = 0.f, s2 = 0.f;
    for (int i = 0; i < 64; ++i) { s1 += lp[i] * lp[64 + i]; s2 += lp[128 + i] * lp[192 + i]; }
    const float lam = __expf(s1) - __expf(s2) + 0.2f;
    const bf16_t* Q = (const bf16_t*)(arg_ws() + WS_Q); const bf16_t* Kb = (const bf16_t*)(arg_ws() + WS_K); const bf16_t* Vb = (const bf16_t*)(arg_ws() + WS_V); bf16_t* MIX = (bf16_t*)(arg_ws() + WS_MIX);
    for (int rep_ = 0; rep_ < 1 + (SUBREP & 1); ++rep_)
    for (int i = 0; i < 4; ++i) { const int bh = (F.vcu >> 5) * 8 + i * 2 + ((F.vcu >> 4) & 1), qb = F.vcu & 15, b = bh >> 2, h = bh & 3;
        att::attn_unit(Q + ((size_t)b * SEQ + qb * 128) * 512 + h * 128, Kb + (size_t)bh * SKV * 128, Vb + (size_t)bh * SKV * 128,
                       MIX + ((size_t)b * SEQ + qb * 128) * 1024 + h * 128, lam, arg_in(10), F.lds); }
    const bf16_t* Z = (const bf16_t*)(arg_ws() + WS_Z); const bf16_t* GB = (const bf16_t*)(arg_ws() + WS_GB); const float* cw = arg_in(11);
    const int c8 = F.lane * 8;
    f32x4 w0a = *(const f32x4*)(cw + c8), w0b = *(const f32x4*)(cw + c8 + 4), w1a = *(const f32x4*)(cw + 512 + c8), w1b = *(const f32x4*)(cw + 512 + c8 + 4), w2a = *(const f32x4*)(cw + 1024 + c8), w2b = *(const f32x4*)(cw + 1024 + c8 + 4);
    for (int rep_ = 0; rep_ < 1 + ((SUBREP >> 1) & 1); ++rep_)
    for (int it = 0; it < 16; ++it) { const int row = F.vcu * 128 + it * 8 + F.wave, npos = row & (SEQ - 1);
        const u32x4 zc = *(const u32x4*)(Z + (size_t)row * 512 + c8), gb = *(const u32x4*)(GB + (size_t)row * 512 + c8);
        u32x4 zp = (u32x4){0u, 0u, 0u, 0u}, zn = (u32x4){0u, 0u, 0u, 0u};
        if (npos > 0) zp = *(const u32x4*)(Z + (size_t)(row - 1) * 512 + c8);
        if (npos < SEQ - 1) zn = *(const u32x4*)(Z + (size_t)(row + 1) * 512 + c8);
        f32x4 ra, rb;
#define CONV2(k, R, W0, W1, W2, i0) R[i0] = bflo(gb[k]) * (W0[i0] * bflo(zp[k]) + W1[i0] * bflo(zc[k]) + W2[i0] * bflo(zn[k])); R[i0 + 1] = bfhi(gb[k]) * (W0[i0 + 1] * bfhi(zp[k]) + W1[i0 + 1] * bfhi(zc[k]) + W2[i0 + 1] * bfhi(zn[k]));
        CONV2(0, ra, w0a, w1a, w2a, 0) CONV2(1, ra, w0a, w1a, w2a, 2) CONV2(2, rb, w0b, w1b, w2b, 0) CONV2(3, rb, w0b, w1b, w2b, 2)
#undef CONV2
        pg8::st8bf(MIX + (size_t)row * 1024 + 512 + c8, ra, rb); }
}

__device__ __forceinline__ void p_spatial(Frame& F) {
    using namespace att;
    const int tid = F.tid, wid = F.wave, lane = F.lane, r32 = lane & 31, hi = lane >> 5, qw = wid & 3, wh = wid >> 2;
    const int b = F.vcu >> 4, ck = F.vcu & 15, R0 = b * SEQ + ck * 128;
    LAS unsigned char* Vl = F.lds; LAS float* rs = (LAS float*)(F.lds + 65536);
    const float* ssqv = (const float*)(arg_ws() + WS_SSQ);
    if (tid < 128) { float s = 0.f; for (int q = 0; q < 16; ++q) s += ssqv[(size_t)(R0 + tid) * 16 + q]; rs[tid] = __builtin_amdgcn_rsqf(s * (1.0f / DM) + NORM_EPS); }
    const bf16_t* VV = (const bf16_t*)(arg_ws() + WS_VV); const bf16_t* U = (const bf16_t*)(arg_ws() + WS_U); bf16_t* MIX1 = (bf16_t*)(arg_ws() + WS_MIX1);
    const int sr = tid >> 4, sc = (tid & 15) * 8;
    const int vb0 = (int)(uintptr_t)Vl + v_rd_base(lane);
    for (int g = 0; g < 4; ++g) {
        __syncthreads();
        { u32x4 t[8];
#pragma unroll
          for (int it = 0; it < 8; ++it) { const int buf = it >> 1, jh = buf >> 1, whh = buf & 1, k = sr + 32 * (it & 1); t[it] = *(const u32x4*)(VV + (size_t)(R0 + jh * 64 + k) * DM + g * 256 + whh * 128 + sc); }
#pragma unroll
          for (int it = 0; it < 8; ++it) { const int buf = it >> 1, k = sr + 32 * (it & 1); *(LAS u32x4*)(Vl + buf * 16384 + v_st(k, sc)) = t[it]; } }
        __syncthreads();
        f32x16 o[4] = {};
        const float* wsg = arg_in(14) + ((size_t)g * 128 + 32 * qw + r32) * 128;
#pragma unroll
        for (int jh = 0; jh < 2; ++jh) { bf16x8 pa[4];
#pragma unroll
            for (int ks = 0; ks < 4; ++ks) { const int j = jh * 64 + ks * 16 + hi * 8; const f32x4 wa = *(const f32x4*)(wsg + j), wb = *(const f32x4*)(wsg + j + 4); const f32x4 ra = *(const LAS f32x4*)(rs + j), rb = *(const LAS f32x4*)(rs + j + 4);
                const f32x4 xa = wa * ra, xb = wb * rb; u32x4 w; w.x = cvtpk(xa[0], xa[1]); w.y = cvtpk(xa[2], xa[3]); w.z = cvtpk(xb[0], xb[1]); w.w = cvtpk(xb[2], xb[3]); pa[ks] = *reinterpret_cast<bf16x8*>(&w); }
            pv_d0(o, vb0 + (jh * 2 + wh) * 16384, pa[0], pa[1], pa[2], pa[3]); }
        const float* vn = arg_in(13); const float* bs = arg_in(15) + g * 128 + 32 * qw;
        float bsv[16];
#pragma unroll
        for (int r = 0; r < 16; ++r) bsv[r] = bs[crow(r, hi)];
#pragma unroll
        for (int d0 = 0; d0 < 4; ++d0) { const int col = g * 256 + wh * 128 + 32 * d0 + r32; const float vnc = vn[col];
#pragma unroll
            for (int r = 0; r < 16; ++r) { const size_t off = (size_t)(R0 + 32 * qw + crow(r, hi)) * DM + col; const float s = o[d0][r] * vnc + bsv[r]; const float v = bf2f(U[off]) * s; MIX1[off] = (bf16_t)(cvtpk(v, v) & 0xffffu); } }
    }
}

__global__ void __launch_bounds__(NWAVES * 64, 2) fwd_kernel(Args args) {
    extern __shared__ __attribute__((aligned(16))) unsigned char lds[];
    Frame F;
    F.lds = (LAS unsigned char*)lds; F.tid = threadIdx.x; F.lane = F.tid & 63; F.wave = __builtin_amdgcn_readfirstlane(F.tid >> 6);
    F.G = gridDim.x; F.bx = blockIdx.x; F.vcu = (F.bx % 8) * (F.G / 8) + F.bx / 8;
    volatile LAS unsigned* MISC = (volatile LAS unsigned*)(F.lds + MISC_OFF);
    for (int u = F.tid; u < (LDS_BYTES - LDSCTL_OFF) / 4; u += NWAVES * 64) ((LAS unsigned*)(F.lds + LDSCTL_OFF))[u] = 0u;
    __syncthreads();
    XcdBarrier bar; bar.bar = (unsigned*)(arg_ws() + WS_CTL) + CW_BAR; bar.x = 0; bar.st = nullptr;
    const int lo = args.ph_lo, hi = args.ph_hi;
    if (hi - lo > 1) bar = xcd_barrier_post((unsigned*)(arg_ws() + WS_CTL) + CW_BAR, MISC + 8);
    LAS unsigned char* ring = (LAS unsigned char*)lds;
    for (int ph = lo, rep = 0; ph < hi; ) {
        { int t = threadIdx.x; asm volatile("" : "+v"(t)); F.tid = t; F.lane = t & 63; F.wave = __builtin_amdgcn_readfirstlane(t >> 6);
          int bx = blockIdx.x; asm volatile("" : "+s"(bx)); F.bx = bx; F.vcu = (bx % 8) * (F.G / 8) + bx / 8; }
        switch (ph) {
        case 0: if (PHMASK & 1) p0_prologue(F); break;
        case 1: if (PHMASK & 2) p1_norm_in(F); break;
        case 2: if (PHMASK & 4) { pg8::SchedInProj S{(const char*)(arg_ws() + WS_H), (const char*)(arg_ws() + WS_HC), (const char*)(arg_ws() + WS_WIN0), F.G, F.bx};
                  pg8::EpiInProj E{(bf16_t*)(arg_ws() + WS_Q), (bf16_t*)(arg_ws() + WS_K), (bf16_t*)(arg_ws() + WS_V), (bf16_t*)(arg_ws() + WS_GB), (bf16_t*)(arg_ws() + WS_Z), ROPE_TAB};
                  pg8::gemm_phase<pg8::EpiInProj, pg8::SchedInProj, true, true>(ring, DM, S, E, F.tid); } break;
        case 3: if (PHMASK & 8) p_attn_conv(F); break;
        case 4: case 12: if (PHMASK & 16) { const int l = ph == 12; const char* Ain = (const char*)(arg_ws() + (l ? WS_MIX1 : WS_MIX));
                  pg8::SchedSimple S{Ain, (const char*)(arg_ws() + WS_WOUT) + (size_t)l * DM * DM * 2, 128, 4, F.G, F.bx};
                  pg8::EpiOutProj E{l ? (const float*)arg_out() : arg_in(0), arg_out(), (const float*)(arg_ws() + WS_MOD) + (size_t)l * 17 * MODW + 2048, (float*)(arg_ws() + WS_SSQ)};
                  pg8::gemm_phase<pg8::EpiOutProj, pg8::SchedSimple, true, true>(ring, DM, S, E, F.tid); } break;
        case 5: case 13: if (PHMASK & 32) p_router(F, ph == 13); break;
        case 6: case 14: if (PHMASK & 64) p_topk(F); break;
        case 7: case 15: if (PHMASK & 128) { const int l = ph == 15;
                  pg8::SchedMoeGather S{(const char*)(arg_ws() + WS_H), (const char*)(arg_ws() + WS_WGU) + (size_t)l * 16 * 2048 * DM * 2, F.G, F.bx};
                  pg8::EpiGateUp E{(bf16_t*)(arg_ws() + WS_ACT)};
                  pg8::gemm_phase<pg8::EpiGateUp, pg8::SchedMoeGather, true, true, true>(ring, DM, S, E, F.tid, (const int*)(arg_ws() + WS_IDX)); } break;
        case 8: case 16: if (PHMASK & 256) { const int l = ph == 16;
                  pg8::SchedMoe S{(const char*)(arg_ws() + WS_ACT), (const char*)(arg_ws() + WS_WD) + (size_t)l * 16 * DM * DM * 2, 4, F.G, F.bx};
                  pg8::EpiDown E{(bf16_t*)(arg_ws() + WS_Y), (const float*)(arg_ws() + WS_VALS)};
                  pg8::gemm_phase<pg8::EpiDown, pg8::SchedMoe, true, true>(ring, DM, S, E, F.tid); } break;
        case 9: case 17: if (PHMASK & 512) p_combine(F, ph == 17, ph == 17); break;
        case 10: if (PHMASK & 1024) { pg8::SchedSimple S{(const char*)(arg_ws() + WS_H), (const char*)(arg_ws() + WS_WIN1), 128, 8, F.G, F.bx};
                  pg8::EpiOddIn E{(bf16_t*)(arg_ws() + WS_U), (bf16_t*)(arg_ws() + WS_VV), (float*)(arg_ws() + WS_SSQ)};
                  pg8::gemm_phase<pg8::EpiOddIn, pg8::SchedSimple, true, true>(ring, DM, S, E, F.tid); } break;
        case 11: if (PHMASK & 2048) p_spatial(F); break;
        default: break;
        }
        const bool again = (rep == 0) && ((REPMASK >> ph) & 1);
        if (again || ph + 1 < hi) xcd_barrier(bar);
        if (again) rep = 1; else { rep = 0; ++ph; }
    }
}

extern "C" void kernel_launch(void* const* d_in, const int* in_sizes, int n_in, void* d_out, int out_size, void* d_ws, size_t ws_size, hipStream_t stream) {
    static int grid = 0;
    if (grid == 0) {
        if (n_in != 22 || in_sizes[0] != MROWS * DM || out_size != MROWS * DM || ws_size < WS_END) { fprintf(stderr, "kernel_launch: unexpected shapes (n_in %d, in0 %d, out %d, ws %zu < %zu?); nothing launched\n", n_in, n_in > 0 ? in_sizes[0] : -1, out_size, ws_size, (size_t)WS_END); grid = -1; return; }
        int dev = 0, cus = 0;
        if (hipGetDevice(&dev) != hipSuccess || hipDeviceGetAttribute(&cus, hipDeviceAttributeMultiprocessorCount, dev) != hipSuccess) { grid = -1; return; }
        if (hipFuncSetAttribute((const void*)fwd_kernel, hipFuncAttributeMaxDynamicSharedMemorySize, LDS_BYTES) != hipSuccess) { fprintf(stderr, "kernel_launch: hipFuncSetAttribute failed\n"); grid = -1; return; }
        (void)hipGetLastError();
        grid = cus;
        if (grid != 256) { fprintf(stderr, "kernel_launch: built for 256 CUs, device has %d; nothing launched\n", cus); grid = -1; return; }
    }
    if (grid < 0) return;
    (void)hipMemsetAsync((char*)d_ws + WS_CTL, 0, CTL_ZERO_BYTES, stream);
    Args a{};
    for (int i = 0; i < 22; ++i) a.in[i] = (const float*)d_in[i];
    a.out = (float*)d_out; a.ws = (unsigned char*)d_ws;
#if MK_PER_PHASE
    for (int ph = 0; ph < N_PHASES; ++ph) { a.ph_lo = ph; a.ph_hi = ph + 1; hipLaunchKernelGGL(fwd_kernel, dim3(grid), dim3(NWAVES * 64), LDS_BYTES, stream, a); }
#else
    a.ph_lo = 0; a.ph_hi = N_PHASES; hipLaunchKernelGGL(fwd_kernel, dim3(grid), dim3(NWAVES * 64), LDS_BYTES, stream, a);
#endif
}
```

```cpp
#include <hip/hip_runtime.h>
#include <cstdio>
#include <cstdint>

#define GAS __attribute__((address_space(1)))
#define LAS __attribute__((address_space(3)))
typedef unsigned short bf16_t;
typedef short bf16x8 __attribute__((ext_vector_type(8)));
typedef short s16x4 __attribute__((ext_vector_type(4)));
typedef float f32x2 __attribute__((ext_vector_type(2)));
typedef float f32x4 __attribute__((ext_vector_type(4)));
typedef float f32x16 __attribute__((ext_vector_type(16)));
typedef unsigned u32x2 __attribute__((ext_vector_type(2)));
typedef unsigned u32x4 __attribute__((ext_vector_type(4)));
typedef int i32x4 __attribute__((ext_vector_type(4)));
typedef int i32x8 __attribute__((ext_vector_type(8)));

constexpr int DM = 1024, NB = 16, SEQ = 2048, CTX = 256, MROWS = NB * SEQ, CROWS = NB * CTX, SKV = CTX + SEQ;
constexpr int NE = 16, CAP = 256, MOE_ROWS = NB * NE * CAP;
constexpr float NORM_EPS = 1e-6f;
constexpr int MODW = 6 * DM;
constexpr int KSPLIT = 8;

__device__ __forceinline__ unsigned cvt_pk_bf16(float lo, float hi) { unsigned r; asm volatile("v_cvt_pk_bf16_f32 %0, %1, %2" : "=v"(r) : "v"(lo), "v"(hi)); return r; }
__device__ __forceinline__ float bf2f(unsigned short h) { return __uint_as_float(((unsigned)h) << 16); }
__device__ __forceinline__ float bflo(unsigned w) { return __uint_as_float(w << 16); }
__device__ __forceinline__ float bfhi(unsigned w) { return __uint_as_float(w & 0xffff0000u); }


__device__ __forceinline__ int lane_id_now() { int l_; asm volatile("v_mbcnt_lo_u32_b32 %0, -1, 0\n\tv_mbcnt_hi_u32_b32 %0, -1, %0" : "=v"(l_)); return l_; }

constexpr float FP8_SA = 8.0f, FP8_SW = 32.0f, FP8_UNSCALE = 1.0f / (FP8_SA * FP8_SW), FP8_SY = 64.0f;
__device__ __forceinline__ unsigned pk4_fp8(f32x4 v) {
    int w = 0;
    w = __builtin_amdgcn_cvt_pk_fp8_f32(__builtin_amdgcn_fmed3f(v[0], -448.f, 448.f), __builtin_amdgcn_fmed3f(v[1], -448.f, 448.f), w, false);
    w = __builtin_amdgcn_cvt_pk_fp8_f32(__builtin_amdgcn_fmed3f(v[2], -448.f, 448.f), __builtin_amdgcn_fmed3f(v[3], -448.f, 448.f), w, true);
    return (unsigned)w;
}

#ifndef PROF_ID
#define PROF_ID 0
#endif
#ifndef PROF_DRAIN
#define PROF_DRAIN 0
#endif
#ifndef PROF_MULT
#define PROF_MULT 8
#endif
constexpr int PROF_LDS_OFF = 131072 + 1024;
#define PROF_BEGIN(id) unsigned long long pt_##id = 0; if (PROF_ID == (id)) pt_##id = __builtin_amdgcn_s_memrealtime();
#ifndef PROF_PH
#define PROF_PH -1
#endif
#define PROF_END(id, ldsbase) if (PROF_ID == (id)) { const unsigned long long d_ = __builtin_amdgcn_s_memrealtime() - pt_##id; if (lane_id_now() == 0 && (PROF_PH < 0 || *(LAS int*)((ldsbase) + PROF_LDS_OFF + 128) == PROF_PH)) *(LAS unsigned long long*)((ldsbase) + PROF_LDS_OFF + __builtin_amdgcn_readfirstlane(threadIdx.x >> 6) * 8) += d_; }

#ifndef PG8_PRIO
#define PG8_PRIO 1
#endif
#ifndef PG8_WGM
#define PG8_WGM 8
#endif
namespace pg8 {
#define PG8_LAS __attribute__((address_space(3)))
constexpr int BM = 256, BK = 64, HALF = 128, HTB = HALF * BK * 2  , STAGE_BYTES = 8 * HTB, NXCD = 8, WGM = PG8_WGM;

__host__ __device__ __forceinline__ int lds_byte(int r, int c) { const int st = (r >> 4) * 2 + (c >> 5), rr = r & 15, cc = c & 31, ob = rr * 64 + cc * 2; return st * 1024 + (ob ^ (((ob >> 9) & 1) << 5)); }
__host__ __device__ __forceinline__ void stage_rc(int b, int& R, int& C) { const int st = b / 1024, sb = b % 1024, swz = sb ^ (((sb >> 9) & 1) << 5); R = (st >> 1) * 16 + swz / 64; C = (st & 1) * 32 + (swz % 64) / 2; }
__host__ __device__ __forceinline__ int perm32(int rho) { const int n = rho >> 4, i = rho & 15; return 8 * (i >> 2) + 4 * n + (i & 3); }

struct Unit { int pm, pn, kind; const char* A; const char* B; };

__device__ __forceinline__ int xcd_remap(int wgid, int nwg) { const int q = nwg / NXCD, r = nwg % NXCD, xcd = wgid % NXCD, off = wgid / NXCD; return (xcd < r ? xcd * (q + 1) : r * (q + 1) + (xcd - r) * q) + off; }
__device__ __forceinline__ void grouped(int wgid, int nM, int nN, int& pm, int& pn) {
    const int nig = WGM * nN, gid = wgid / nig, fm = gid * WGM, gsz = (nM - fm) < WGM ? (nM - fm) : WGM;
    pm = fm + ((wgid % nig) % gsz); pn = (wgid % nig) / gsz;
}

__device__ __forceinline__ f32x2 gelu_pk(f32x2 v) {
    f32x2 y = v * (1.0f / 4.5f); y.x = __builtin_amdgcn_fmed3f(y.x, -1.0f, 1.0f); y.y = __builtin_amdgcn_fmed3f(y.y, -1.0f, 1.0f);
    const f32x2 t = y * y;
    f32x2 r = t * (-3.800213194e+00f) + 2.248553468e+01f; r = r * t + (-5.949445673e+01f); r = r * t + 9.364556429e+01f; r = r * t + (-9.869310455e+01f); r = r * t + 7.450131619e+01f;
    r = r * t + (-4.205131993e+01f); r = r * t + 1.815734619e+01f; r = r * t + (-6.045664855e+00f); r = r * t + 1.794988889e+00f;
    const f32x2 h = y * r;
    return v * h + v * 0.5f;
}

template <class Epi, class Sched, bool ALIGN_EPI = false, bool SP2 = false, bool GATHER = false, bool FP8 = false>
__device__ __forceinline__ void gemm_phase(PG8_LAS unsigned char* lds, const int K, const Sched& S, const Epi& E, const int tid, const int* gidx = nullptr) {
    static_assert(SP2 || !GATHER, "row gather is wired into the SP2 loop only");
    const int wid = __builtin_amdgcn_readfirstlane(tid >> 6), lane = tid & 63, wr = wid >> 2, wc = wid & 3, fr = lane & 15, fq = lane >> 4;
    const int rowB = FP8 ? K : 2 * K, nt = rowB / 128;
    unsigned voffA, voffB;
    { int R, C; stage_rc(tid * 16, R, C); const int Rb = Epi::PERM ? ((R & ~31) + perm32(R & 31)) : R; voffA = (unsigned)(R * rowB + C * 2); voffB = (unsigned)(Rb * rowB + C * 2); }
    const size_t kstep = (size_t)(BK * 2);
    const size_t hstep = (size_t)HALF * rowB;
    const unsigned ldsbase32 = (unsigned)(uintptr_t)lds; const unsigned ldsdma_s = (unsigned)__builtin_amdgcn_readfirstlane((int)(ldsbase32 + (unsigned)wid * 1024u));
    const int aoff = lds_byte(wr * 64 + fr, fq * 8), boff = lds_byte(wc * 32 + fr, fq * 8);
    PG8_LAS unsigned char* ldsA = lds + aoff; PG8_LAS unsigned char* ldsB = lds + 4 * HTB + boff;
    asm volatile("" : "+v"(ldsA), "+v"(ldsB));
#define PG8_SA(b, h) (((b) * 2 + (h)) * HTB)
#define PG8_SB(b, h) ((4 + (b) * 2 + (h)) * HTB)
#define PG8_GLDS(gbase_, voff_, ldsdst_) do { unsigned keep_; asm volatile("s_mov_b32 %0, m0\n\ts_mov_b32 m0, %2\n\ts_nop 0\n\tglobal_load_lds_dwordx4 %1, %3\n\ts_mov_b32 m0, %0" \
        : "=&s"(keep_) : "v"(voff_), "s"(ldsdst_), "s"(gbase_) : "memory"); } while (0)
#define PG8_STAGE(bufoff, gbase, voff) do { _Pragma("unroll") for (int _i = 0; _i < 2; ++_i) \
        PG8_GLDS((const char*)(gbase) + (size_t)_i * 64 * rowB, voff, ldsdma_s + (unsigned)(bufoff) + (unsigned)(_i * 8192)); } while (0)
#define PG8_STAGE2(bufoff, gbase, voff) do { _Pragma("unroll") for (int _i = 0; _i < 2; ++_i) \
        PG8_GLDS((const char*)(gbase), (voff)[_i], ldsdma_s + (unsigned)(bufoff) + (unsigned)(_i * 8192)); } while (0)
#define PG8_STAGE_A(bufoff, gbase, half, nx) do { if constexpr (GATHER) { unsigned t_[2]; const unsigned w_ = (nx) ? ngp[half] : cgp[half]; \
            const unsigned gc2 = voffB & 127u; t_[0] = (w_ & 0xffffu) * (unsigned)rowB + gc2; t_[1] = (w_ >> 16) * (unsigned)rowB + gc2; PG8_STAGE2(bufoff, gbase, t_); } \
        else { PG8_STAGE(bufoff, (gbase) + ((half) ? hstep : 0), voffA); } } while (0)
#define PG8_LDA(dst, b, h) do { if constexpr (FP8) { _Pragma("unroll") for (int m = 0; m < 4; ++m) { const i32x4 lo_ = *(const PG8_LAS i32x4*)(ldsA + PG8_SA(b, h) + m * 2048), hi_ = *(const PG8_LAS i32x4*)(ldsA + PG8_SA(b, h) + m * 2048 + 1024); \
        dst##8[m].lo = lo_; dst##8[m].hi = hi_; } } \
    else { _Pragma("unroll") for (int m = 0; m < 4; ++m) _Pragma("unroll") for (int k = 0; k < 2; ++k) dst[m][k] = *(const PG8_LAS bf16x8*)(ldsA + PG8_SA(b, h) + m * 2048 + k * 1024); } } while (0)
#define PG8_LDB(dst, b, h) do { if constexpr (FP8) { _Pragma("unroll") for (int n = 0; n < 2; ++n) { const i32x4 lo_ = *(const PG8_LAS i32x4*)(ldsB + PG8_SA(b, h) + n * 2048), hi_ = *(const PG8_LAS i32x4*)(ldsB + PG8_SA(b, h) + n * 2048 + 1024); \
        dst##8[n].lo = lo_; dst##8[n].hi = hi_; } } \
    else { _Pragma("unroll") for (int n = 0; n < 2; ++n) _Pragma("unroll") for (int k = 0; k < 2; ++k) dst[n][k] = *(const PG8_LAS bf16x8*)(ldsB + PG8_SA(b, h) + n * 2048 + k * 1024); } } while (0)
#define PG8_MMA(ai, bj, At, Bt) do { if (PG8_PRIO) __builtin_amdgcn_s_setprio(1); if constexpr (FP8) { \
          \
        _Pragma("unroll") for (int m = 0; m < 4; ++m) _Pragma("unroll") for (int n = 0; n < 2; ++n) \
            acc[ai][bj][m][n] = __builtin_amdgcn_mfma_scale_f32_16x16x128_f8f6f4(Bt##8[n], At##8[m], acc[ai][bj][m][n], 0, 0, 0, 127, 0, 127); \
    } else { _Pragma("unroll") for (int m = 0; m < 4; ++m) _Pragma("unroll") for (int n = 0; n < 2; ++n) _Pragma("unroll") for (int k = 0; k < 2; ++k) \
        acc[ai][bj][m][n] = __builtin_amdgcn_mfma_f32_16x16x32_bf16(Bt[n][k], At[m][k], acc[ai][bj][m][n], 0, 0, 0); } if (PG8_PRIO) __builtin_amdgcn_s_setprio(0); } while (0)
#define PG8_TID() ({ int l_; asm volatile("v_mbcnt_lo_u32_b32 %0, -1, 0\n\tv_mbcnt_hi_u32_b32 %0, -1, %0" : "=v"(l_)); l_ + wid * 64; })
#define PG8_WAIT_V(n) asm volatile("s_waitcnt vmcnt(" #n ")" ::: "memory")
#define PG8_WAIT_L(n) asm volatile("s_waitcnt lgkmcnt(" #n ")" ::: "memory")
#define PG8_BAR __builtin_amdgcn_s_barrier()
#define PG8_SCHED __builtin_amdgcn_sched_barrier(0)
    Unit cur, nxt; int ui = 0;
    if (!S.next(0, cur)) return;
    f32x4 acc[2][2][4][2];
#pragma unroll
    for (int a = 0; a < 2; ++a)
#pragma unroll
        for (int b = 0; b < 2; ++b)
#pragma unroll
            for (int m = 0; m < 4; ++m)
#pragma unroll
                for (int n = 0; n < 2; ++n) acc[a][b][m][n] = (f32x4){0.f, 0.f, 0.f, 0.f};
    bf16x8 At[4][2], B0[2][2], B1[2][2]; i32x8 At8[4], B08[2], B18[2];
    const char* cA = cur.A; const char* cB = cur.B;
    u32x2 cgp = {0u, 0u}, ngp = {0u, 0u};
    if constexpr (GATHER) cgp = ((const u32x2*)gidx)[cur.pm * 512 + tid];
    if constexpr (SP2) {
        PG8_STAGE(PG8_SB(0, 0), cB, voffB); PG8_STAGE(PG8_SB(0, 1), cB + hstep, voffB); PG8_STAGE_A(PG8_SA(0, 0), cA, 0, false); PG8_STAGE_A(PG8_SA(0, 1), cA, 1, false);
        if (wr == 1) PG8_BAR;
        PG8_WAIT_V(2); PG8_BAR;
        PG8_STAGE(PG8_SB(1, 0), cB + kstep, voffB); PG8_STAGE_A(PG8_SA(1, 0), cA + kstep, 0, false); PG8_STAGE(PG8_SB(1, 1), cB + hstep + kstep, voffB);
        PG8_WAIT_V(6); PG8_BAR;
    } else {
        PG8_STAGE(PG8_SB(0, 0), cB, voffB); PG8_STAGE(PG8_SA(0, 0), cA, voffA); PG8_STAGE(PG8_SB(0, 1), cB + hstep, voffB); PG8_STAGE(PG8_SA(0, 1), cA + hstep, voffA);
        if (wr == 1) PG8_BAR;
        PG8_WAIT_V(4); PG8_BAR;
        PG8_STAGE(PG8_SB(1, 0), cB + kstep, voffB); PG8_STAGE(PG8_SA(1, 0), cA + kstep, voffA); PG8_STAGE(PG8_SB(1, 1), cB + hstep + kstep, voffB);
        PG8_WAIT_V(6); PG8_BAR;
    }
    for (;;) {
        const bool has_next = S.next(ui + 1, nxt);
        if constexpr (GATHER) { const Unit& gu = has_next ? nxt : cur; ngp = ((const u32x2*)gidx)[gu.pm * 512 + PG8_TID()]; }
        const char* nA = has_next ? nxt.A : cA; const char* nB = has_next ? nxt.B : cB;
        PROF_BEGIN(10)
_Pragma("unroll 1")
        for (int t = 0; t < nt; t += 2) {
            const bool last = (t == nt - 2);
            const char* a1 = cA + (size_t)(t + 1) * kstep;
            const char* a2 = last ? nA : cA + (size_t)(t + 2) * kstep; const char* b2 = last ? nB : cB + (size_t)(t + 2) * kstep;
            const char* a3 = a2 + kstep; const char* b3 = b2 + kstep;
            if constexpr (SP2) {
            PG8_LDB(B0, 0, 0); PG8_LDB(B1, 0, 1); PG8_SCHED; PG8_LDA(At, 0, 0); PG8_STAGE_A(PG8_SA(1, 1), a1, 1, false);
            PG8_WAIT_V(8); PG8_WAIT_L(0); PG8_BAR; PG8_MMA(0, 0, At, B0); PG8_MMA(0, 1, At, B1); PG8_BAR; PG8_SCHED;
            PG8_LDA(At, 0, 1); PG8_STAGE(PG8_SB(0, 0), b2, voffB); PG8_STAGE(PG8_SB(0, 1), b2 + hstep, voffB); PG8_STAGE_A(PG8_SA(0, 0), a2, 0, last);
            PG8_WAIT_V(8); PG8_WAIT_L(0); PG8_BAR; PG8_MMA(1, 0, At, B0); PG8_MMA(1, 1, At, B1); PG8_BAR; PG8_SCHED;
            PG8_LDB(B0, 1, 0); PG8_LDB(B1, 1, 1); PG8_SCHED; PG8_LDA(At, 1, 0); PG8_STAGE_A(PG8_SA(0, 1), a2, 1, last);
            PG8_WAIT_V(8); PG8_WAIT_L(0); PG8_BAR; PG8_MMA(0, 0, At, B0); PG8_MMA(0, 1, At, B1); PG8_BAR; PG8_SCHED;
            PG8_LDA(At, 1, 1); PG8_STAGE(PG8_SB(1, 0), b3, voffB); PG8_STAGE(PG8_SB(1, 1), b3 + hstep, voffB); PG8_STAGE_A(PG8_SA(1, 0), a3, 0, last);
            PG8_WAIT_V(8); PG8_WAIT_L(0); PG8_BAR; PG8_MMA(1, 0, At, B0); PG8_MMA(1, 1, At, B1); PG8_BAR; PG8_SCHED;
            } else {
            PG8_LDB(B0, 0, 0); PG8_SCHED; PG8_LDA(At, 0, 0); PG8_STAGE(PG8_SA(1, 1), a1 + hstep, voffA);
            PG8_WAIT_L(8); PG8_BAR; PG8_WAIT_L(0); PG8_MMA(0, 0, At, B0); PG8_BAR; PG8_SCHED;
            PG8_LDB(B1, 0, 1); PG8_STAGE(PG8_SB(0, 0), b2, voffB);
            PG8_BAR; PG8_WAIT_L(0); PG8_MMA(0, 1, At, B1); PG8_BAR;
            PG8_LDA(At, 0, 1); PG8_STAGE(PG8_SA(0, 0), a2, voffA);
            PG8_BAR; PG8_WAIT_L(0); PG8_MMA(1, 0, At, B0); PG8_BAR; PG8_SCHED;
            PG8_STAGE(PG8_SB(0, 1), b2 + hstep, voffB);
            PG8_WAIT_V(6); PG8_BAR; PG8_MMA(1, 1, At, B1); PG8_BAR;
            PG8_LDB(B0, 1, 0); PG8_SCHED; PG8_LDA(At, 1, 0); PG8_STAGE(PG8_SA(0, 1), a2 + hstep, voffA);
            PG8_WAIT_L(8); PG8_BAR; PG8_WAIT_L(0); PG8_MMA(0, 0, At, B0); PG8_BAR; PG8_SCHED;
            PG8_LDB(B1, 1, 1); PG8_STAGE(PG8_SB(1, 0), b3, voffB);
            PG8_BAR; PG8_WAIT_L(0); PG8_MMA(0, 1, At, B1); PG8_BAR;
            PG8_LDA(At, 1, 1); PG8_STAGE(PG8_SA(1, 0), a3, voffA);
            PG8_BAR; PG8_WAIT_L(0); PG8_MMA(1, 0, At, B0); PG8_BAR; PG8_SCHED;
            PG8_STAGE(PG8_SB(1, 1), b3 + hstep, voffB);
            PG8_WAIT_V(6); PG8_BAR; PG8_MMA(1, 1, At, B1); PG8_BAR;
            }
        }
        PROF_END(10, lds)
        PROF_BEGIN(11)
        if constexpr (ALIGN_EPI) { if (wr == 0) PG8_BAR; }
        { const int et_ = PG8_TID();
          E(acc, cur, wr, wc, et_ & 15, (et_ & 63) >> 4); } if (PROF_ID == 11 && PROF_DRAIN) asm volatile("s_waitcnt vmcnt(0)" ::: "memory");
        PROF_END(11, lds)
        if (!has_next) break;
#pragma unroll
        for (int a = 0; a < 2; ++a)
#pragma unroll
            for (int b = 0; b < 2; ++b)
#pragma unroll
                for (int m = 0; m < 4; ++m)
#pragma unroll
                    for (int n = 0; n < 2; ++n) acc[a][b][m][n] = (f32x4){0.f, 0.f, 0.f, 0.f};
        cur = nxt; cA = nA; cB = nB; ++ui;
        if constexpr (GATHER) cgp = ngp;
        if constexpr (ALIGN_EPI) { if (wr == 1) PG8_BAR; }
    }
    PG8_WAIT_V(0);
    if constexpr (!ALIGN_EPI) { if (wr == 0) PG8_BAR; }
    PG8_BAR;
#undef PG8_SA
#undef PG8_SB
#undef PG8_STAGE
#undef PG8_STAGE2
#undef PG8_GOFF
#undef PG8_STAGE_A
#undef PG8_LDA
#undef PG8_LDB
#undef PG8_MMA
#undef PG8_TID
#undef PG8_WAIT_V
#undef PG8_WAIT_L
#undef PG8_BAR
#undef PG8_SCHED
}

#ifndef EPI_NT
#define EPI_NT 0
#endif
#if EPI_NT == 2
__device__ __forceinline__ void st_wt(u32x4* p, u32x4 w) { asm volatile("global_store_dwordx4 %0, %1, off sc1" :: "v"(p), "v"(w) : "memory"); }
__device__ __forceinline__ void st_wt(u32x2* p, u32x2 w) { asm volatile("global_store_dwordx2 %0, %1, off sc1" :: "v"(p), "v"(w) : "memory"); }
#define EPI_STORE(T, p, w) st_wt((T*)(p), (w))
#elif EPI_NT
#define EPI_STORE(T, p, w) __builtin_nontemporal_store((w), (T*)(p))
#else
#define EPI_STORE(T, p, w) (*(T*)(p) = (w))
#endif
__device__ __forceinline__ void st4bf(bf16_t* p, f32x4 v) { u32x2 w; w.x = cvt_pk_bf16(v[0], v[1]); w.y = cvt_pk_bf16(v[2], v[3]); EPI_STORE(u32x2, p, w); }
__device__ __forceinline__ void st8bf(bf16_t* p, f32x4 a, f32x4 b) { u32x4 w; w.x = cvt_pk_bf16(a[0], a[1]); w.y = cvt_pk_bf16(a[2], a[3]); w.z = cvt_pk_bf16(b[0], b[1]); w.w = cvt_pk_bf16(b[2], b[3]); EPI_STORE(u32x4, p, w); }

struct EpiInProj {
    static constexpr bool PERM = false;
    bf16_t *Q, *Kb, *Vb, *GB, *Z; const float* rope;
    __device__ __forceinline__ void operator()(const f32x4 (&acc)[2][2][4][2], const Unit& u, int wr, int wc, int fr, int fq) const {
        const int lrow0 = wr * 64 + fr, lcol0 = wc * 32 + 4 * fq;
        if (u.kind == 0 && u.pn < 4) {
            const bool isq = u.pn < 2; const float qs = isq ? 0.125f * 1.4426950408889634f : 1.0f;
#pragma unroll
            for (int ai = 0; ai < 2; ++ai)
#pragma unroll
                for (int m = 0; m < 4; ++m) {
                    const int row = u.pm * 256 + ai * 128 + m * 16 + lrow0, npos = row & (SEQ - 1), b = row >> 11;
                    const int p = (wc & 1) ? (npos & 63) : (npos >> 6);
                    const f32x4 cs = *(const f32x4*)(rope + p * 32 + 4 * fq), sn = *(const f32x4*)(rope + p * 32 + 16 + 4 * fq);
                    bf16_t* dst = isq ? Q + (size_t)row * 512 + (u.pn & 1) * 256 + lcol0 : Kb + (((size_t)b * 4 + (u.pn & 1) * 2) * SKV + CTX + npos) * 128 + lcol0;
                    const size_t hstride = isq ? 128 : (size_t)SKV * 128;
#pragma unroll
                    for (int bj = 0; bj < 2; ++bj) {
                        const f32x4 lo = acc[ai][bj][m][0], hi = acc[ai][bj][m][1];
                        st4bf(dst + bj * hstride, (lo * cs - hi * sn) * qs); st4bf(dst + bj * hstride + 16, (hi * cs + lo * sn) * qs);
                    }
                    asm volatile("" ::: "memory");
                }
        } else if (u.kind == 0 && u.pn >= 8) {
#pragma unroll
            for (int ai = 0; ai < 2; ++ai)
#pragma unroll
                for (int m = 0; m < 4; ++m) {
                    const int row = u.pm * 256 + ai * 128 + m * 16 + lrow0;
                    bf16_t* dst = Z + (size_t)row * 512 + (u.pn - 8) * 128 + lcol0;
#pragma unroll
                    for (int n = 0; n < 2; ++n) st4bf(dst + n * 16, acc[ai][0][m][n] * acc[ai][1][m][n]);
                }
        } else {
#pragma unroll
            for (int ai = 0; ai < 2; ++ai)
#pragma unroll
                for (int m = 0; m < 4; ++m) {
                    const int row = u.pm * 256 + ai * 128 + m * 16 + lrow0;
                    bf16_t* dst; size_t hstride = (size_t)SKV * 128;
                    if (u.kind == 0) { const int npos = row & (SEQ - 1), b = row >> 11;
                        if (u.pn < 6) dst = Vb + (((size_t)b * 4 + (u.pn & 1) * 2) * SKV + CTX + npos) * 128; else { dst = GB + (size_t)row * 512 + (u.pn - 6) * 256; hstride = 128; } }
                    else { const int b = row >> 8, mpos = row & 255;
                        dst = ((u.pn < 2) ? Kb : Vb) + (((size_t)b * 4 + (u.pn & 1) * 2) * SKV + mpos) * 128; }
                    dst += lcol0;
#pragma unroll
                    for (int bj = 0; bj < 2; ++bj)
#pragma unroll
                        for (int n = 0; n < 2; ++n) st4bf(dst + bj * hstride + n * 16, acc[ai][bj][m][n]);
                }
        }
    }
};

template <bool BASE_F32> struct EpiOutProj {
    static constexpr bool PERM = true;
    const void* base; bf16_t* out; const float* g; float* ssq;
    __device__ __forceinline__ void operator()(const f32x4 (&acc)[2][2][4][2], const Unit& u, int wr, int wc, int fr, int fq) const {
        const int lrow0 = wr * 64 + fr, col0 = u.pn * 256 + wc * 32 + 8 * fq, b = u.pm >> 3;
        f32x4 gv[2][2];
#pragma unroll
        for (int bj = 0; bj < 2; ++bj)
#pragma unroll
            for (int n = 0; n < 2; ++n) gv[bj][n] = *(const f32x4*)(g + (size_t)b * MODW + col0 + bj * 128 + n * 4);
        if constexpr (BASE_F32) {
#pragma unroll
            for (int ai = 0; ai < 2; ++ai) { f32x4 bs[4][2][2];
#pragma unroll
                for (int m = 0; m < 4; ++m)
#pragma unroll
                    for (int bj = 0; bj < 2; ++bj)
#pragma unroll
                        for (int n = 0; n < 2; ++n) bs[m][bj][n] = *(const f32x4*)((const float*)base + (size_t)(u.pm * 256 + ai * 128 + m * 16 + lrow0) * DM + col0 + bj * 128 + n * 4);
                asm volatile("" ::: "memory");
#pragma unroll
                for (int m = 0; m < 4; ++m) { const int row = u.pm * 256 + ai * 128 + m * 16 + lrow0; const size_t off = (size_t)row * DM + col0;
#pragma unroll
                    for (int bj = 0; bj < 2; ++bj) { const f32x4 o0 = bs[m][bj][0] + gv[bj][0] * acc[ai][bj][m][0], o1 = bs[m][bj][1] + gv[bj][1] * acc[ai][bj][m][1];
                        st8bf(out + off + bj * 128, o0, o1); }
                }
                asm volatile("" ::: "memory"); }
        } else {
            u32x4 bw[2][4][2];
#pragma unroll
            for (int ai = 0; ai < 2; ++ai)
#pragma unroll
                for (int m = 0; m < 4; ++m)
#pragma unroll
                    for (int bj = 0; bj < 2; ++bj) bw[ai][m][bj] = *(const u32x4*)((const bf16_t*)base + (size_t)(u.pm * 256 + ai * 128 + m * 16 + lrow0) * DM + col0 + bj * 128);
            asm volatile("" ::: "memory");
#pragma unroll
            for (int ai = 0; ai < 2; ++ai)
#pragma unroll
                for (int m = 0; m < 4; ++m) { const int row = u.pm * 256 + ai * 128 + m * 16 + lrow0; const size_t off = (size_t)row * DM + col0;
#pragma unroll
                    for (int bj = 0; bj < 2; ++bj) { const u32x4 w = bw[ai][m][bj];
                        const f32x4 b0 = (f32x4){bflo(w.x), bfhi(w.x), bflo(w.y), bfhi(w.y)}, b1 = (f32x4){bflo(w.z), bfhi(w.z), bflo(w.w), bfhi(w.w)};
                        const f32x4 o0 = b0 + gv[bj][0] * acc[ai][bj][m][0], o1 = b1 + gv[bj][1] * acc[ai][bj][m][1];
                        st8bf(out + off + bj * 128, o0, o1); }
                }
        }
    }
};

struct EpiGateUp {
    static constexpr bool PERM = true;
    bf16_t* ACT;
    __device__ __forceinline__ void operator()(const f32x4 (&acc)[2][2][4][2], const Unit& u, int wr, int wc, int fr, int fq) const {
        const int lrow0 = wr * 64 + fr, col0 = u.pn * 128 + wc * 32 + 8 * fq;
#pragma unroll
        for (int ai = 0; ai < 2; ++ai)
#pragma unroll
            for (int m = 0; m < 4; ++m) {
                const int row = u.pm * 256 + ai * 128 + m * 16 + lrow0; f32x4 r[2];
#pragma unroll
                for (int n = 0; n < 2; ++n) { const f32x4 gt = acc[ai][0][m][n], up = acc[ai][1][m][n];
#pragma unroll
                    for (int i = 0; i < 4; ++i) { const float e = __builtin_amdgcn_exp2f(gt[i] * -1.4426950408889634f); r[n][i] = gt[i] * __builtin_amdgcn_rcpf(1.0f + e) * up[i]; } }
                st8bf(ACT + (size_t)row * DM + col0, r[0], r[1]);
            }
    }
};

struct EpiDown {
    static constexpr bool PERM = true;
    bf16_t* Y; const float* vals;
    __device__ __forceinline__ void operator()(const f32x4 (&acc)[2][2][4][2], const Unit& u, int wr, int wc, int fr, int fq) const {
        const int lrow0 = wr * 64 + fr, col0 = u.pn * 256 + wc * 32 + 8 * fq;
#pragma unroll
        for (int ai = 0; ai < 2; ++ai)
#pragma unroll
            for (int m = 0; m < 4; ++m) {
                const int row = u.pm * 256 + ai * 128 + m * 16 + lrow0; const float v = vals[row];
#pragma unroll
                for (int bj = 0; bj < 2; ++bj) st8bf(Y + (size_t)row * DM + col0 + bj * 128, acc[ai][bj][m][0] * v, acc[ai][bj][m][1] * v);
            }
    }
};

struct EpiGateUp8 {
    static constexpr bool PERM = true;
    unsigned char* ACT8;
    __device__ __forceinline__ void operator()(const f32x4 (&acc)[2][2][4][2], const Unit& u, int wr, int wc, int fr, int fq) const {
        const int lrow0 = wr * 64 + fr, col0 = u.pn * 128 + wc * 32 + 8 * fq;
#pragma unroll
        for (int ai = 0; ai < 2; ++ai)
#pragma unroll
            for (int m = 0; m < 4; ++m) {
                const int row = u.pm * 256 + ai * 128 + m * 16 + lrow0; f32x4 r[2];
#pragma unroll
                for (int n = 0; n < 2; ++n) { const f32x4 gt = acc[ai][0][m][n] * FP8_UNSCALE, up = acc[ai][1][m][n] * (FP8_UNSCALE * FP8_SA);
#pragma unroll
                    for (int i = 0; i < 4; ++i) { const float e = __builtin_amdgcn_exp2f(gt[i] * -1.4426950408889634f); r[n][i] = gt[i] * __builtin_amdgcn_rcpf(1.0f + e) * up[i]; } }
                u32x2 w; w.x = pk4_fp8(r[0]); w.y = pk4_fp8(r[1]); *(u32x2*)(ACT8 + (size_t)row * DM + col0) = w;
            }
    }
};
struct EpiDown8 {
    static constexpr bool PERM = true;
    unsigned char* Y; const float* vals;
    __device__ __forceinline__ void operator()(const f32x4 (&acc)[2][2][4][2], const Unit& u, int wr, int wc, int fr, int fq) const {
        const int lrow0 = wr * 64 + fr, col0 = u.pn * 256 + wc * 32 + 8 * fq;
#pragma unroll
        for (int ai = 0; ai < 2; ++ai)
#pragma unroll
            for (int m = 0; m < 4; ++m) {
                const int row = u.pm * 256 + ai * 128 + m * 16 + lrow0; const float v = vals[row] * (FP8_UNSCALE * FP8_SY);
#pragma unroll
                for (int bj = 0; bj < 2; ++bj) { u32x2 w; w.x = pk4_fp8(acc[ai][bj][m][0] * v); w.y = pk4_fp8(acc[ai][bj][m][1] * v); EPI_STORE(u32x2, Y + (size_t)row * DM + col0 + bj * 128, w); }
            }
    }
};

struct EpiOddIn {
    static constexpr bool PERM = true;
    bf16_t* U; bf16_t* VV; float* ssqv;
    __device__ __forceinline__ void operator()(const f32x4 (&acc)[2][2][4][2], const Unit& u, int wr, int wc, int fr, int fq) const {
        const int lrow0 = wr * 64 + fr; const bool isv = u.pn >= 4; const int pnl = u.pn & 3, col0 = pnl * 256 + wc * 32 + 8 * fq;
        bf16_t* dstb = isv ? VV : U;
#pragma unroll
        for (int ai = 0; ai < 2; ++ai)
#pragma unroll
            for (int m = 0; m < 4; ++m) {
                const int row = u.pm * 256 + ai * 128 + m * 16 + lrow0; float s = 0.f;
#pragma unroll
                for (int bj = 0; bj < 2; ++bj) { const f32x4 v0 = acc[ai][bj][m][0], v1 = acc[ai][bj][m][1];
                    const f32x2 a = gelu_pk((f32x2){v0[0], v0[1]}), b = gelu_pk((f32x2){v0[2], v0[3]}), c = gelu_pk((f32x2){v1[0], v1[1]}), d = gelu_pk((f32x2){v1[2], v1[3]});
                    s += (a.x * a.x + a.y * a.y) + (b.x * b.x + b.y * b.y) + (c.x * c.x + c.y * c.y) + (d.x * d.x + d.y * d.y);
                    st8bf(dstb + (size_t)row * DM + col0 + bj * 128, (f32x4){a.x, a.y, b.x, b.y}, (f32x4){c.x, c.y, d.x, d.y}); }
                if (isv) { s += __shfl_xor(s, 16); s += __shfl_xor(s, 32); if (fq == 0) ssqv[(size_t)(pnl * 4 + wc) * MROWS + row] = s; }
            }
    }
};

constexpr size_t TSTEP = (size_t)256 * DM * 2;
struct SchedSimple {
    const char* A; const char* B; int nM, nN, G, c;
    __device__ __forceinline__ bool next(int i, Unit& u) const {
        const int nwg = nM * nN; const long L = (long)i * G + c; if (L >= nwg) return false;
        const int w = xcd_remap((int)L, nwg); grouped(w, nM, nN, u.pm, u.pn); u.kind = 0; u.A = A + (size_t)u.pm * TSTEP; u.B = B + (size_t)u.pn * TSTEP; return true;
    }
};
struct SchedInProj {
    const char* A; const char* Ac; const char* B; int G, c;
    __device__ __forceinline__ bool next(int i, Unit& u) const {
        constexpr int n0 = 128 * 12, nwg = n0 + 64; const long L = (long)i * G + c; if (L >= nwg) return false;
        const int w = xcd_remap((int)L, nwg);
        if (w < n0) { grouped(w, 128, 12, u.pm, u.pn); u.kind = 0; u.A = A + (size_t)u.pm * TSTEP; u.B = B + (size_t)u.pn * TSTEP; }
        else { const int x = w - n0; u.pm = x >> 2; u.pn = x & 3; u.kind = 1; u.A = Ac + (size_t)u.pm * TSTEP; u.B = B + (size_t)(2 + u.pn) * TSTEP; }
        return true;
    }
};
struct SchedMoe {
    const char* A; const char* B; int nN, G, c;
    __device__ __forceinline__ bool next(int i, Unit& u) const {
        const int nwg = 256 * nN; const long L = (long)i * G + c; if (L >= nwg) return false;
        const int w = xcd_remap((int)L, nwg); grouped(w, 256, nN, u.pm, u.pn); u.kind = 0; u.A = A + (size_t)u.pm * TSTEP; u.B = B + (size_t)((u.pm >> 4) * nN + u.pn) * TSTEP; return true;
    }
};
struct SchedMoeGather {
    const char* A; const char* B; int G, c;
    __device__ __forceinline__ bool next(int i, Unit& u) const {
        constexpr int nN = 8, nwg = 256 * nN; const long L = (long)i * G + c; if (L >= nwg) return false;
        const int w = xcd_remap((int)L, nwg); grouped(w, 256, nN, u.pm, u.pn); u.kind = 0; u.A = A + (size_t)(u.pm & 15) * SEQ * DM * 2; u.B = B + (size_t)((u.pm >> 4) * nN + u.pn) * TSTEP; return true;
    }
};
constexpr size_t TSTEP8 = (size_t)256 * DM;
struct SchedMoe8 {
    const char* A; const char* B; int nN, G, c;
    __device__ __forceinline__ bool next(int i, Unit& u) const {
        const int nwg = 256 * nN; const long L = (long)i * G + c; if (L >= nwg) return false;
        const int w = xcd_remap((int)L, nwg); grouped(w, 256, nN, u.pm, u.pn); u.kind = 0; u.A = A + (size_t)u.pm * TSTEP8; u.B = B + (size_t)((u.pm >> 4) * nN + u.pn) * TSTEP8; return true;
    }
};
struct SchedMoeGather8 {
    const char* A; const char* B; int G, c;
    __device__ __forceinline__ bool next(int i, Unit& u) const {
        constexpr int nN = 8, nwg = 256 * nN; const long L = (long)i * G + c; if (L >= nwg) return false;
        const int w = xcd_remap((int)L, nwg); grouped(w, 256, nN, u.pm, u.pn); u.kind = 0; u.A = A + (size_t)(u.pm & 15) * SEQ * DM; u.B = B + (size_t)((u.pm >> 4) * nN + u.pn) * TSTEP8; return true;
    }
};
}

namespace att {
#ifndef ATT_PRIO
#define ATT_PRIO 0
#endif
#ifndef ATT_PV_FIRST
#define ATT_PV_FIRST 1
#endif
#ifndef ATT_STAGE_IN_M
#define ATT_STAGE_IN_M 3
#endif
constexpr int NW = 8, QBLK = 32, KVBLK = 64, LDQ = 512, LDK = 128;
constexpr float SCALE = 0.125f, THR = 8.f;
constexpr int SHM_V = KVBLK * 128 * 2, SHM_K = KVBLK * 128 * 2, SHM_ATTN = 3 * (SHM_V + SHM_K) + NW * 64 * 4;
#define KSWZ(row, colB) ((row) * 256 + ((colB) ^ (((row) & 7) << 4)))
#define SBAR() __builtin_amdgcn_sched_barrier(0)
__device__ __forceinline__ int crow(int r, int hi) { return (r & 3) + 8 * (r >> 2) + 4 * hi; }
__device__ __forceinline__ unsigned cvtpk(float lo, float hi) { unsigned r; asm volatile("v_cvt_pk_bf16_f32 %0, %1, %2" : "=v"(r) : "v"(lo), "v"(hi)); return r; }

__device__ __forceinline__ void partialSM(f32x16& p0, f32x16& p1, float& m_reg, float& mn, float& alpha) {
  constexpr float C = SCALE * 1.4426950408889634f;
  float pmax = p0[0]; for (int r = 1; r < 16; ++r) pmax = fmaxf(pmax, p0[r]); for (int r = 0; r < 16; ++r) pmax = fmaxf(pmax, p1[r]);
  { auto rr = __builtin_amdgcn_permlane32_swap(__float_as_uint(pmax), __float_as_uint(pmax), false, false);
    pmax = fmaxf(__uint_as_float(rr[0]), __uint_as_float(rr[1])); }
  if (__builtin_expect(__all(pmax - m_reg <= THR / SCALE), 1)) { mn = m_reg; alpha = 1.f; }
  else { mn = fmaxf(m_reg, pmax); alpha = __builtin_amdgcn_exp2f((m_reg - mn) * C); m_reg = mn; }
  float mnC = -mn * C;
  for (int r = 0; r < 16; ++r) p0[r] = fmaf(p0[r], C, mnC); for (int r = 0; r < 16; ++r) p1[r] = fmaf(p1[r], C, mnC);
  for (int r = 0; r < 16; ++r) p0[r] = __builtin_amdgcn_exp2f(p0[r]);
}
__device__ __forceinline__ void finishSM(f32x16& p0, f32x16& p1, float alpha, float& l_reg, bf16x8& pa0, bf16x8& pa1, bf16x8& pa2, bf16x8& pa3) {
  for (int r = 0; r < 16; ++r) p1[r] = __builtin_amdgcn_exp2f(p1[r]);
  float ps = 0; for (int r = 0; r < 16; ++r) ps += p0[r]; for (int r = 0; r < 16; ++r) ps += p1[r];
  { auto rr = __builtin_amdgcn_permlane32_swap(__float_as_uint(ps), __float_as_uint(ps), false, false);
    ps = __uint_as_float(rr[0]) + __uint_as_float(rr[1]); }
  l_reg = l_reg * alpha + ps;
#define PK4(P, BASE, OUT) do { unsigned a0 = cvtpk(P[BASE + 0], P[BASE + 1]), a1 = cvtpk(P[BASE + 2], P[BASE + 3]);   \
    unsigned b0 = cvtpk(P[BASE + 4], P[BASE + 5]), b1 = cvtpk(P[BASE + 6], P[BASE + 7]);                              \
    auto r0 = __builtin_amdgcn_permlane32_swap(a0, b0, false, false); auto r1 = __builtin_amdgcn_permlane32_swap(a1, b1, false, false); \
    u32x4 w = {r0[0], r1[0], r0[1], r1[1]}; OUT = *reinterpret_cast<bf16x8*>(&w); } while (0)
  PK4(p0, 0, pa0); PK4(p0, 8, pa1); PK4(p1, 0, pa2); PK4(p1, 8, pa3);
#undef PK4
}
__device__ __forceinline__ void qkt(f32x16& p0, f32x16& p1, const LAS unsigned char* Ks, const bf16x8* qr, int r32, int hi, int map) {
  p0 = f32x16{}; p1 = f32x16{};
#pragma unroll
  for (int d0 = 0; d0 < 4; ++d0) { const int cb = ((map * 4 + d0) * 16 + hi * 8) * 2;
    bf16x8 b0 = *(const LAS bf16x8*)(Ks + KSWZ(r32, cb));
    bf16x8 b1 = *(const LAS bf16x8*)(Ks + KSWZ(32 + r32, cb));
    p0 = __builtin_amdgcn_mfma_f32_32x32x16_bf16(b0, qr[d0], p0, 0, 0, 0);
    p1 = __builtin_amdgcn_mfma_f32_32x32x16_bf16(b1, qr[d0], p1, 0, 0, 0); }
}
__device__ __forceinline__ int v_st(int k, int c) { const int kk = (k & ~0xC) | ((k & 4) << 1) | ((k & 8) >> 1); return ((kk >> 3) * 4 + (c >> 5)) * 512 + ((kk & 7) * 32 + (c & 31)) * 2; }
__device__ __forceinline__ int v_rd_base(int lane) { return ((lane & 3) << 3) | (((lane >> 2) & 3) << 6) | (((lane >> 4) & 1) << 5) | (((lane >> 5) & 1) << 8); }
constexpr int v_rd_off(int d0, int ks, int half) { return d0 * 512 + ks * 4096 + half * 2048; }
template <int OFF> __device__ __forceinline__ s16x4 tr_read(int vb) {
  s16x4 r; asm volatile("ds_read_b64_tr_b16 %0, %1 offset:%2" : "=&v"(r) : "v"(vb), "i"(OFF) : "memory"); return r;
}
template <int D0> __device__ __forceinline__ void pv_one(f32x16& od, int vb, bf16x8 pa0, bf16x8 pa1, bf16x8 pa2, bf16x8 pa3) {
  const s16x4 l0 = tr_read<v_rd_off(D0, 0, 0)>(vb), h0 = tr_read<v_rd_off(D0, 0, 1)>(vb), l1 = tr_read<v_rd_off(D0, 1, 0)>(vb), h1 = tr_read<v_rd_off(D0, 1, 1)>(vb);
  const s16x4 l2 = tr_read<v_rd_off(D0, 2, 0)>(vb), h2 = tr_read<v_rd_off(D0, 2, 1)>(vb), l3 = tr_read<v_rd_off(D0, 3, 0)>(vb), h3 = tr_read<v_rd_off(D0, 3, 1)>(vb);
  asm volatile("s_waitcnt lgkmcnt(0)" ::: "memory"); SBAR();
#define PK(L, H) (bf16x8){L[0], L[1], L[2], L[3], H[0], H[1], H[2], H[3]}
  od = __builtin_amdgcn_mfma_f32_32x32x16_bf16(pa0, PK(l0, h0), od, 0, 0, 0);
  od = __builtin_amdgcn_mfma_f32_32x32x16_bf16(pa1, PK(l1, h1), od, 0, 0, 0);
  od = __builtin_amdgcn_mfma_f32_32x32x16_bf16(pa2, PK(l2, h2), od, 0, 0, 0);
  od = __builtin_amdgcn_mfma_f32_32x32x16_bf16(pa3, PK(l3, h3), od, 0, 0, 0);
#undef PK
}
__device__ __forceinline__ void pv_d0(f32x16* o, int vb, bf16x8 pa0, bf16x8 pa1, bf16x8 pa2, bf16x8 pa3) {
  pv_one<0>(o[0], vb, pa0, pa1, pa2, pa3); pv_one<1>(o[1], vb, pa0, pa1, pa2, pa3); pv_one<2>(o[2], vb, pa0, pa1, pa2, pa3); pv_one<3>(o[3], vb, pa0, pa1, pa2, pa3);
}

template <int OFF> __device__ __forceinline__ bf16x8 lds_read128(int addr) {
  bf16x8 r; asm volatile("ds_read_b128 %0, %1 offset:%2" : "=&v"(r) : "v"(addr), "i"(OFF) : "memory"); return r;
}
#define LGKM_WAIT(N) asm volatile("s_waitcnt lgkmcnt(" #N ")" ::: "memory")
#define VTR8(D0, L0, H0, L1, H1, L2, H2, L3, H3, vb) do { L0 = tr_read<v_rd_off(D0, 0, 0)>(vb); H0 = tr_read<v_rd_off(D0, 0, 1)>(vb); L1 = tr_read<v_rd_off(D0, 1, 0)>(vb); H1 = tr_read<v_rd_off(D0, 1, 1)>(vb); \
    L2 = tr_read<v_rd_off(D0, 2, 0)>(vb); H2 = tr_read<v_rd_off(D0, 2, 1)>(vb); L3 = tr_read<v_rd_off(D0, 3, 0)>(vb); H3 = tr_read<v_rd_off(D0, 3, 1)>(vb); } while (0)
#define VPK(L, H) (bf16x8){L[0], L[1], L[2], L[3], H[0], H[1], H[2], H[3]}
#define PV4(OD, L0, H0, L1, H1, L2, H2, L3, H3) do { OD = __builtin_amdgcn_mfma_f32_32x32x16_bf16(VPK(L0, H0), pa0, OD, 0, 0, 0); OD = __builtin_amdgcn_mfma_f32_32x32x16_bf16(VPK(L1, H1), pa1, OD, 0, 0, 0); \
    OD = __builtin_amdgcn_mfma_f32_32x32x16_bf16(VPK(L2, H2), pa2, OD, 0, 0, 0); OD = __builtin_amdgcn_mfma_f32_32x32x16_bf16(VPK(L3, H3), pa3, OD, 0, 0, 0); } while (0)
template <bool DO_QK, bool DO_PV>
__device__ __forceinline__ void m_phase(f32x16& p0, f32x16& p1, f32x16 (&o)[4], const bf16x8 (&qr)[4], const int (&kaddr)[4], int kb, int vb, bf16x8 pa0, bf16x8 pa1, bf16x8 pa2, bf16x8 pa3, float negm) {
  bf16x8 kf[4]; s16x4 a0, a1, a2, a3, a4, a5, a6, a7;
  SBAR();
  if (ATT_PRIO == 1) __builtin_amdgcn_s_setprio(1);
  if constexpr (DO_QK) {
#pragma unroll
    for (int d0 = 0; d0 < 2; ++d0) { kf[2 * d0] = lds_read128<0>(kaddr[d0] + kb); kf[2 * d0 + 1] = lds_read128<8192>(kaddr[d0] + kb); }
  }
  if constexpr (DO_PV) VTR8(0, a0, a1, a2, a3, a4, a5, a6, a7, vb);
  if constexpr (DO_QK) {
    if constexpr (DO_PV) LGKM_WAIT(8); else LGKM_WAIT(0);
    SBAR();
    f32x16 ini;
#pragma unroll
    for (int r = 0; r < 16; ++r) ini[r] = negm;
    p0 = __builtin_amdgcn_mfma_f32_32x32x16_bf16(kf[0], qr[0], ini, 0, 0, 0); p1 = __builtin_amdgcn_mfma_f32_32x32x16_bf16(kf[1], qr[0], ini, 0, 0, 0);
    p0 = __builtin_amdgcn_mfma_f32_32x32x16_bf16(kf[2], qr[1], p0, 0, 0, 0); p1 = __builtin_amdgcn_mfma_f32_32x32x16_bf16(kf[3], qr[1], p1, 0, 0, 0);
    SBAR();
#pragma unroll
    for (int d0 = 2; d0 < 4; ++d0) { kf[2 * d0 - 4] = lds_read128<0>(kaddr[d0] + kb); kf[2 * d0 - 3] = lds_read128<8192>(kaddr[d0] + kb); }
    LGKM_WAIT(0); SBAR();
    p0 = __builtin_amdgcn_mfma_f32_32x32x16_bf16(kf[0], qr[2], p0, 0, 0, 0); p1 = __builtin_amdgcn_mfma_f32_32x32x16_bf16(kf[1], qr[2], p1, 0, 0, 0);
    p0 = __builtin_amdgcn_mfma_f32_32x32x16_bf16(kf[2], qr[3], p0, 0, 0, 0); p1 = __builtin_amdgcn_mfma_f32_32x32x16_bf16(kf[3], qr[3], p1, 0, 0, 0);
    SBAR();
  }
  if constexpr (DO_PV) {
    LGKM_WAIT(0); SBAR(); PV4(o[0], a0, a1, a2, a3, a4, a5, a6, a7); SBAR(); VTR8(1, a0, a1, a2, a3, a4, a5, a6, a7, vb);
    LGKM_WAIT(0); SBAR(); PV4(o[1], a0, a1, a2, a3, a4, a5, a6, a7); SBAR(); VTR8(2, a0, a1, a2, a3, a4, a5, a6, a7, vb);
    LGKM_WAIT(0); SBAR(); PV4(o[2], a0, a1, a2, a3, a4, a5, a6, a7); SBAR(); VTR8(3, a0, a1, a2, a3, a4, a5, a6, a7, vb);
    LGKM_WAIT(0); SBAR(); PV4(o[3], a0, a1, a2, a3, a4, a5, a6, a7); SBAR();
  }
  if (ATT_PRIO == 1) __builtin_amdgcn_s_setprio(0);
}

template <bool DO_QK>
__device__ __forceinline__ void m_phase_pvfirst(f32x16& p0, f32x16& p1, f32x16 (&o)[4], const bf16x8 (&qr)[4], const int (&kaddr)[4], int kb, int vb, bf16x8 pa0, bf16x8 pa1, bf16x8 pa2, bf16x8 pa3, float negm,
                                                s16x4 a0, s16x4 a1, s16x4 a2, s16x4 a3, s16x4 a4, s16x4 a5, s16x4 a6, s16x4 a7) {
  bf16x8 kf[4];
  SBAR();
  if constexpr (DO_QK) {
#pragma unroll
    for (int d0 = 0; d0 < 2; ++d0) { kf[2 * d0] = lds_read128<0>(kaddr[d0] + kb); kf[2 * d0 + 1] = lds_read128<8192>(kaddr[d0] + kb); }
    LGKM_WAIT(4);
  } else LGKM_WAIT(0);
  SBAR(); PV4(o[0], a0, a1, a2, a3, a4, a5, a6, a7); SBAR(); VTR8(1, a0, a1, a2, a3, a4, a5, a6, a7, vb);
  if constexpr (DO_QK) {
    LGKM_WAIT(8); SBAR();
    f32x16 ini;
#pragma unroll
    for (int r = 0; r < 16; ++r) ini[r] = negm;
    p0 = __builtin_amdgcn_mfma_f32_32x32x16_bf16(kf[0], qr[0], ini, 0, 0, 0); p1 = __builtin_amdgcn_mfma_f32_32x32x16_bf16(kf[1], qr[0], ini, 0, 0, 0);
    p0 = __builtin_amdgcn_mfma_f32_32x32x16_bf16(kf[2], qr[1], p0, 0, 0, 0); p1 = __builtin_amdgcn_mfma_f32_32x32x16_bf16(kf[3], qr[1], p1, 0, 0, 0);
    SBAR();
#pragma unroll
    for (int d0 = 2; d0 < 4; ++d0) { kf[2 * d0 - 4] = lds_read128<0>(kaddr[d0] + kb); kf[2 * d0 - 3] = lds_read128<8192>(kaddr[d0] + kb); }
    LGKM_WAIT(4);
  } else LGKM_WAIT(0);
  SBAR(); PV4(o[1], a0, a1, a2, a3, a4, a5, a6, a7); SBAR(); VTR8(2, a0, a1, a2, a3, a4, a5, a6, a7, vb);
  if constexpr (DO_QK) {
    LGKM_WAIT(8); SBAR();
    p0 = __builtin_amdgcn_mfma_f32_32x32x16_bf16(kf[0], qr[2], p0, 0, 0, 0); p1 = __builtin_amdgcn_mfma_f32_32x32x16_bf16(kf[1], qr[2], p1, 0, 0, 0);
    p0 = __builtin_amdgcn_mfma_f32_32x32x16_bf16(kf[2], qr[3], p0, 0, 0, 0); p1 = __builtin_amdgcn_mfma_f32_32x32x16_bf16(kf[3], qr[3], p1, 0, 0, 0);
    SBAR();
  }
  LGKM_WAIT(0); SBAR(); PV4(o[2], a0, a1, a2, a3, a4, a5, a6, a7); SBAR(); VTR8(3, a0, a1, a2, a3, a4, a5, a6, a7, vb);
  LGKM_WAIT(0); SBAR(); PV4(o[3], a0, a1, a2, a3, a4, a5, a6, a7); SBAR();
}

constexpr float THR2 = 8.f * 1.4426950408889634f;
__device__ __forceinline__ void softmax_tile(const bool first, f32x16& p0, f32x16& p1, float& m_reg, float& l_reg, f32x16 (&o)[4], LAS float* al_l, int r32, int hi,
                                             bf16x8& pa0, bf16x8& pa1, bf16x8& pa2, bf16x8& pa3) {
  float mxa = fmaxf(fmaxf(p0[0], p0[1]), p0[2]), mxb = fmaxf(fmaxf(p0[3], p0[4]), p0[5]), mxc = fmaxf(fmaxf(p1[0], p1[1]), p1[2]), mxd = fmaxf(fmaxf(p1[3], p1[4]), p1[5]);
  mxa = fmaxf(fmaxf(mxa, p0[6]), p0[7]); mxb = fmaxf(fmaxf(mxb, p0[8]), p0[9]); mxc = fmaxf(fmaxf(mxc, p1[6]), p1[7]); mxd = fmaxf(fmaxf(mxd, p1[8]), p1[9]);
  mxa = fmaxf(fmaxf(mxa, p0[10]), p0[11]); mxb = fmaxf(fmaxf(mxb, p0[12]), p0[13]); mxc = fmaxf(fmaxf(mxc, p1[10]), p1[11]); mxd = fmaxf(fmaxf(mxd, p1[12]), p1[13]);
  mxa = fmaxf(fmaxf(mxa, p0[14]), p0[15]); mxc = fmaxf(fmaxf(mxc, p1[14]), p1[15]);
  float pmax = fmaxf(fmaxf(mxa, mxb), fmaxf(mxc, mxd));
  { auto rr = __builtin_amdgcn_permlane32_swap(__float_as_uint(pmax), __float_as_uint(pmax), false, false);
    pmax = fmaxf(__uint_as_float(rr[0]), __uint_as_float(rr[1])); }
  if (first || !__builtin_expect(__all(pmax <= THR2), 1)) {
    const float dl = first ? pmax : fmaxf(pmax, 0.f); m_reg += dl;
#pragma unroll
    for (int r = 0; r < 16; ++r) { p0[r] -= dl; p1[r] -= dl; }
    const float alpha = first ? 1.0f : __builtin_amdgcn_exp2f(-dl); l_reg *= alpha;
#pragma unroll
    for (int d = 0; d < 4; ++d)
#pragma unroll
      for (int r = 0; r < 16; ++r) o[d][r] *= alpha;
  }
#pragma unroll
  for (int r = 0; r < 16; ++r) { p0[r] = __builtin_amdgcn_exp2f(p0[r]); p1[r] = __builtin_amdgcn_exp2f(p1[r]); }
  float ps0 = p0[0] + p1[0], ps1 = p0[1] + p1[1], ps2 = p0[2] + p1[2], ps3 = p0[3] + p1[3];
#pragma unroll
  for (int r = 4; r < 16; r += 4) { ps0 += p0[r] + p1[r]; ps1 += p0[r + 1] + p1[r + 1]; ps2 += p0[r + 2] + p1[r + 2]; ps3 += p0[r + 3] + p1[r + 3]; }
  float ps = (ps0 + ps1) + (ps2 + ps3);
  { auto rr = __builtin_amdgcn_permlane32_swap(__float_as_uint(ps), __float_as_uint(ps), false, false);
    ps = __uint_as_float(rr[0]) + __uint_as_float(rr[1]); }
  l_reg += ps;
#define PK4(P, BASE, OUT) do { unsigned a0 = cvtpk(P[BASE + 0], P[BASE + 1]), a1 = cvtpk(P[BASE + 2], P[BASE + 3]);   \
    unsigned b0 = cvtpk(P[BASE + 4], P[BASE + 5]), b1 = cvtpk(P[BASE + 6], P[BASE + 7]);                              \
    auto r0 = __builtin_amdgcn_permlane32_swap(a0, b0, false, false); auto r1 = __builtin_amdgcn_permlane32_swap(a1, b1, false, false); \
    u32x4 w = {r0[0], r1[0], r0[1], r1[1]}; OUT = *reinterpret_cast<bf16x8*>(&w); } while (0)
  PK4(p0, 0, pa0); PK4(p0, 8, pa1); PK4(p1, 0, pa2); PK4(p1, 8, pa3);
#undef PK4
}

__device__ __forceinline__ void attn_unit(const bf16_t* Qb, const bf16_t* Kh, const bf16_t* Vh, bf16_t* Ob, float lam, const float* subln, LAS unsigned char* lds, int wave_s) {
  int tid = wave_s * 64 + lane_id_now();
  const int wid = tid >> 6, lane = tid & 63, r32 = lane & 31, hi = lane >> 5, map = wid >> 2, qw = wid & 3;
  const bool lead = __builtin_amdgcn_readfirstlane(wid) < 4;
  constexpr int SLOT = SHM_K + SHM_V;
  LAS float* ws = (LAS float*)(lds + 3 * SLOT) + wid * 64; LAS float* li_l = ws; LAS float* al_l = ws + 32;
  float m_reg = 0.f, l_reg = 0; f32x16 o[4] = {}; bf16x8 qr[4];
  const bf16_t* Qw = Qb + (long)(qw * QBLK + r32) * LDQ + map * 64 + hi * 8;
#pragma unroll
  for (int d0 = 0; d0 < 4; ++d0) qr[d0] = *(const bf16x8*)(Qw + d0 * 16);
  const int sr = tid >> 4, sc = (tid & 15) * 8, vst0 = v_st(sr, sc), kst0 = KSWZ(sr, sc * 2);
  const int vrb = (int)(uintptr_t)lds + SHM_K + v_rd_base(lane);
  int kaddr[4];
#pragma unroll
  for (int d0 = 0; d0 < 4; ++d0) kaddr[d0] = (int)(uintptr_t)lds + r32 * 256 + map * 128 + ((hi * 16 + d0 * 32) ^ ((r32 & 7) << 4));
  bf16x8 vs0, vs1, ks0, ks1;
  const unsigned slo = (unsigned)((sr * LDK + sc) * 2);
#define SLOAD(k0) do { const char* vb_ = (const char*)Vh + (size_t)(k0) * LDK * 2; const char* kb_ = (const char*)Kh + (size_t)(k0) * LDK * 2; \
    vs0 = *(const bf16x8*)(vb_ + slo); vs1 = *(const bf16x8*)(vb_ + (size_t)32 * LDK * 2 + slo); ks0 = *(const bf16x8*)(kb_ + slo); ks1 = *(const bf16x8*)(kb_ + (size_t)32 * LDK * 2 + slo); } while (0)
#define SWRITE(slot) do { LAS unsigned char* sb_ = lds + (slot) * SLOT; *(LAS bf16x8*)(sb_ + SHM_K + vst0) = vs0; *(LAS bf16x8*)(sb_ + SHM_K + vst0 + 8192) = vs1; \
    *(LAS bf16x8*)(sb_ + kst0) = ks0; *(LAS bf16x8*)(sb_ + kst0 + 8192) = ks1; } while (0)
  constexpr int NT = SKV / KVBLK;
  f32x16 p0, p1; bf16x8 pa0, pa1, pa2, pa3;
  PROF_BEGIN(2)
  {
    const char* vb1_ = (const char*)Vh + (size_t)KVBLK * LDK * 2; const char* kb1_ = (const char*)Kh + (size_t)KVBLK * LDK * 2;
    SLOAD(0);
    const bf16x8 wv0 = *(const bf16x8*)(vb1_ + slo), wv1 = *(const bf16x8*)(vb1_ + (size_t)32 * LDK * 2 + slo), wk0 = *(const bf16x8*)(kb1_ + slo), wk1 = *(const bf16x8*)(kb1_ + (size_t)32 * LDK * 2 + slo);
    SWRITE(0);
    vs0 = wv0; vs1 = wv1; ks0 = wk0; ks1 = wk1; SWRITE(1); }
  if (ATT_STAGE_IN_M < 2) SLOAD(2 * KVBLK);
  __syncthreads();
  PROF_END(2, lds)
  if (ATT_PRIO == 3 && !lead) __builtin_amdgcn_s_setprio(1);
  if (!lead) __syncthreads();
  pa0 = pa1 = pa2 = pa3 = bf16x8{};
  m_phase<true, false>(p0, p1, o, qr, kaddr, 0, vrb, pa0, pa1, pa2, pa3, 0.f);
  __syncthreads();
  int s_cur = 0, s_nxt = 1, s_nn = 2;
  for (int t = 0; t < NT; ++t) {
    PROF_BEGIN(3)
    if (ATT_STAGE_IN_M == 3) { if (t + 2 < NT) SLOAD((t + 2) * KVBLK); asm volatile("" ::: "memory"); }
    { PROF_BEGIN(7)
    if (ATT_PRIO == 2) __builtin_amdgcn_s_setprio(1);
    softmax_tile(t == 0, p0, p1, m_reg, l_reg, o, al_l, r32, hi, pa0, pa1, pa2, pa3);
    asm volatile("" :: "v"(pa0), "v"(pa1), "v"(pa2), "v"(pa3), "v"(l_reg));
    if (ATT_PRIO == 2) __builtin_amdgcn_s_setprio(0);
    PROF_END(7, lds) }
    PROF_BEGIN(8)
    if (!ATT_STAGE_IN_M) {
      if (lead) { if (t >= 1 && t + 1 < NT) { SWRITE(s_nxt); if (t + 2 < NT) SLOAD((t + 2) * KVBLK); } }
      else      { if (t + 2 < NT) { SWRITE(s_nn); if (t + 3 < NT) SLOAD((t + 3) * KVBLK); } }
    } else if (ATT_STAGE_IN_M == 2) { if (t + 2 < NT) SLOAD((t + 2) * KVBLK); }
    asm volatile("s_waitcnt lgkmcnt(0)" ::: "memory");
    PROF_END(8, lds)
    PROF_END(3, lds)
    s16x4 fa0, fa1, fa2, fa3, fa4, fa5, fa6, fa7;
    if (ATT_PV_FIRST) VTR8(0, fa0, fa1, fa2, fa3, fa4, fa5, fa6, fa7, vrb + s_cur * SLOT);
    PROF_BEGIN(5)
    __syncthreads();
    PROF_END(5, lds)
    PROF_BEGIN(4)
    if (ATT_STAGE_IN_M == 3) { if (t + 2 < NT) SWRITE(s_nn); asm volatile("" ::: "memory"); }
    if (ATT_PV_FIRST) {
      if (t + 1 < NT) m_phase_pvfirst<true>(p0, p1, o, qr, kaddr, s_nxt * SLOT, vrb + s_cur * SLOT, pa0, pa1, pa2, pa3, -m_reg, fa0, fa1, fa2, fa3, fa4, fa5, fa6, fa7);
      else m_phase_pvfirst<false>(p0, p1, o, qr, kaddr, 0, vrb + s_cur * SLOT, pa0, pa1, pa2, pa3, 0.f, fa0, fa1, fa2, fa3, fa4, fa5, fa6, fa7);
    } else {
      if (t + 1 < NT) m_phase<true, true>(p0, p1, o, qr, kaddr, s_nxt * SLOT, vrb + s_cur * SLOT, pa0, pa1, pa2, pa3, -m_reg);
      else m_phase<false, true>(p0, p1, o, qr, kaddr, 0, vrb + s_cur * SLOT, pa0, pa1, pa2, pa3, 0.f);
    }
    if (ATT_STAGE_IN_M == 1 || ATT_STAGE_IN_M == 2) { __builtin_amdgcn_sched_barrier(0); asm volatile("" ::: "memory"); if (t + 2 < NT) { SWRITE(s_nn); if (ATT_STAGE_IN_M == 1 && t + 3 < NT) SLOAD((t + 3) * KVBLK); } asm volatile("s_waitcnt lgkmcnt(0)" ::: "memory"); __builtin_amdgcn_sched_barrier(0); }
    asm volatile("s_nop 0" :: "v"(o[0]), "v"(o[1]), "v"(o[2]), "v"(o[3]), "v"(p0), "v"(p1));
    PROF_END(4, lds)
    { PROF_BEGIN(5)
    __syncthreads();
    PROF_END(5, lds) }
    { const int x = s_cur; s_cur = s_nxt; s_nxt = s_nn; s_nn = x; }
  }
  if (ATT_PRIO == 3 && !lead) __builtin_amdgcn_s_setprio(0);
  if (lead) __syncthreads();
  PROF_BEGIN(6)
  const float rl = __builtin_amdgcn_rcpf(l_reg);
  __syncthreads();
  LAS float* X = (LAS float*)lds + qw * 4096 + lane;
  if (map == 1) {
#pragma unroll
    for (int d0 = 0; d0 < 4; ++d0)
#pragma unroll
      for (int r = 0; r < 16; ++r) X[(d0 * 16 + r) * 64] = o[d0][r] * rl;
  }
  __syncthreads();
  if (map == 0) {
    float s0 = 0.f, s1 = 0.f, s2 = 0.f, s3 = 0.f;
#pragma unroll
    for (int d0 = 0; d0 < 4; ++d0)
#pragma unroll
      for (int r = 0; r < 16; r += 4) {
        const float e0 = o[d0][r] * rl - lam * X[(d0 * 16 + r) * 64], e1 = o[d0][r + 1] * rl - lam * X[(d0 * 16 + r + 1) * 64], e2 = o[d0][r + 2] * rl - lam * X[(d0 * 16 + r + 2) * 64], e3 = o[d0][r + 3] * rl - lam * X[(d0 * 16 + r + 3) * 64];
        o[d0][r] = e0; o[d0][r + 1] = e1; o[d0][r + 2] = e2; o[d0][r + 3] = e3; s0 += e0 * e0; s1 += e1 * e1; s2 += e2 * e2; s3 += e3 * e3; }
    float ssum = (s0 + s1) + (s2 + s3);
    { auto rr = __builtin_amdgcn_permlane32_swap(__float_as_uint(ssum), __float_as_uint(ssum), false, false); ssum = __uint_as_float(rr[0]) + __uint_as_float(rr[1]); }
    const float sc = __builtin_amdgcn_rsqf(ssum * (1.0f / 128.0f) + NORM_EPS) * 0.8f;
    bf16_t* orow = Ob + (long)(qw * QBLK + r32) * 1024 + hi * 8;
#pragma unroll
    for (int d0 = 0; d0 < 4; ++d0)
#pragma unroll
      for (int pr = 0; pr < 2; ++pr) {
        const f32x4 g0 = *(const f32x4*)(subln + 32 * d0 + 16 * pr + 4 * hi), g1 = *(const f32x4*)(subln + 32 * d0 + 16 * pr + 8 + 4 * hi);
        const int ra = 8 * pr, rb = 8 * pr + 4;
        unsigned ax = cvtpk(o[d0][ra] * sc * g0[0], o[d0][ra + 1] * sc * g0[1]), ay = cvtpk(o[d0][ra + 2] * sc * g0[2], o[d0][ra + 3] * sc * g0[3]);
        unsigned bx = cvtpk(o[d0][rb] * sc * g1[0], o[d0][rb + 1] * sc * g1[1]), by = cvtpk(o[d0][rb + 2] * sc * g1[2], o[d0][rb + 3] * sc * g1[3]);
        { auto rx = __builtin_amdgcn_permlane32_swap(ax, bx, false, false); ax = rx[0]; bx = rx[1]; auto ry = __builtin_amdgcn_permlane32_swap(ay, by, false, false); ay = ry[0]; by = ry[1]; }
        u32x4 w = {ax, ay, bx, by};
        *(u32x4*)(orow + 32 * d0 + 16 * pr) = w; }
  }
  __syncthreads();
  PROF_END(6, lds)
#undef SLOAD
#undef SWRITE
}
}

constexpr int NWAVES = 8;
#ifndef MK_PER_PHASE
#define MK_PER_PHASE 0
#endif
constexpr int N_PHASES = 18;
#ifndef REPMASK
#define REPMASK 0
#endif
#ifndef SUBREP
#define SUBREP 0
#endif
#ifndef GEMM_SKEW
#define GEMM_SKEW 0
#endif
#ifndef GEMM_ALIGN
#define GEMM_ALIGN true
#endif
#ifndef GEMM_ALIGN_GU
#define GEMM_ALIGN_GU GEMM_ALIGN
#endif
#ifndef GEMM_ALIGN_DN
#define GEMM_ALIGN_DN GEMM_ALIGN
#endif
#ifndef CVT_CLASS
#define CVT_CLASS(v) (((v) >> 4) & 3)
#endif
#ifndef MOE_CVT_IN_ATTN
#define MOE_CVT_IN_ATTN 1
#endif
#ifndef PHMASK_FULL
#define PHMASK_FULL 0x3ffff
#endif
#ifndef PHMASK
#define PHMASK 0xfff
#endif

constexpr size_t MiB = 1u << 20;
constexpr size_t WS_CTL = 0, CTL_ZERO_BYTES = 128 * 1024;
constexpr size_t WS_MODP = 1 * MiB;
constexpr size_t WS_MOD = 8 * MiB;
constexpr size_t WS_PROBS = 9 * MiB;
constexpr size_t WS_SLOT = 11 * MiB;
constexpr size_t WS_VALS = 13 * MiB;
constexpr size_t WS_SSQ = 14 * MiB;
constexpr size_t WS_IDX = 13 * MiB + 512 * 1024;
constexpr size_t WS_GPK = 126 * MiB;
constexpr size_t WS_WIN0 = 16 * MiB;
constexpr size_t WS_WIN1 = 22 * MiB;
constexpr size_t WS_WOUT = 26 * MiB;
constexpr size_t WS_WGU = 30 * MiB;
constexpr size_t WS_WD = 158 * MiB;
constexpr size_t WS_H = 222 * MiB;
constexpr size_t WS_HC = 286 * MiB;
constexpr size_t WS_R = 294 * MiB;
constexpr size_t WS_Q = WS_R, WS_K = WS_R + 32 * MiB, WS_V = WS_R + 68 * MiB, WS_GB = WS_R + 104 * MiB, WS_Z = WS_R + 136 * MiB, WS_MIX = WS_R + 168 * MiB;
constexpr size_t WS_XG = WS_R, WS_ACT = WS_R + 128 * MiB, WS_Y = WS_R;
constexpr size_t WS_U = WS_R, WS_VV = WS_R + 64 * MiB, WS_MIX1 = WS_R + 128 * MiB;
constexpr size_t WS_X2 = WS_R + 192 * MiB;
constexpr size_t WS_X3 = WS_WGU;
constexpr size_t WS_END = WS_R + 256 * MiB;
constexpr int CW_BAR = 4096, CW_GRP = 16384;

constexpr int RING_BYTES = 131072, LDSCTL_OFF = RING_BYTES, MISC_OFF = LDSCTL_OFF + 320, LDS_BYTES = 147456;

typedef GAS unsigned gu32;
#define RLX_AGENT __ATOMIC_RELAXED, __HIP_MEMORY_SCOPE_AGENT
#define LDS_WAIT() asm volatile("s_waitcnt lgkmcnt(0)" ::: "memory")
#define VM_WAIT() asm volatile("s_waitcnt vmcnt(0)" ::: "memory")

#define XB_TMO      128
#define XB_XCNT(j)  (256  + 64 * (j))
#define XB_XSUB(j)  (1280 + 64 * (j))
#define XB_XGEN(j)  (2304 + 64 * (j))
#define XB_TOP      3328
#define XB_TOPGEN   3392
#define XCD_BAR_WORDS 3456
#define XB_SPIN_CAP (1u << 20)
__device__ __forceinline__ unsigned xb_ld(unsigned* p)              { return __hip_atomic_load(p, __ATOMIC_RELAXED, __HIP_MEMORY_SCOPE_AGENT); }
__device__ __forceinline__ unsigned xb_add(unsigned* p, unsigned v) { return __hip_atomic_fetch_add(p, v, __ATOMIC_RELAXED, __HIP_MEMORY_SCOPE_AGENT); }
__device__ __forceinline__ unsigned xb_xcc_id() { return (unsigned)__builtin_amdgcn_s_getreg((3 << 11) | 20) & 0xFu; }
#define XB_SPIN(cond, bar) do { unsigned _sp = 0; while (cond) { __builtin_amdgcn_s_sleep(1); \
    if ((++_sp & 255u) == 0u) { if (xb_ld(&(bar)[XB_TMO])) break; if (_sp > XB_SPIN_CAP) { atomicAdd(&(bar)[XB_TMO], 1u); break; } } } } while (0)
struct XcdBarrier { unsigned* bar; unsigned x; volatile LAS unsigned* st; int w; };
__device__ __forceinline__ XcdBarrier xcd_barrier_post(unsigned* bar, volatile LAS unsigned* st, int wave_s) {
    XcdBarrier b; b.bar = bar; b.x = xb_xcc_id(); b.st = st; b.w = wave_s;
    if (wave_s == 0 && lane_id_now() == 0) (void)xb_add(&bar[XB_XCNT(b.x)], 1u);
    return b;
}
__device__ __forceinline__ void xcd_barrier_complete(unsigned* bar, unsigned x, unsigned& nloc, unsigned& nx) {
    const unsigned G = gridDim.x * gridDim.y * gridDim.z;
    unsigned sum, cnt, mine, sp = 0u;
    for (;;) {
        sum = 0u; cnt = 0u; mine = 0u;
#pragma unroll
        for (unsigned j = 0; j < 16; ++j) { const unsigned c = xb_ld(&bar[XB_XCNT(j)]); sum += c; cnt += (c > 0u) ? 1u : 0u; mine = (j == x) ? c : mine; }
        if (sum == G) break;
        __builtin_amdgcn_s_sleep(1);
        if ((++sp & 255u) == 0u) { if (xb_ld(&bar[XB_TMO])) break; if (sp > XB_SPIN_CAP) { atomicAdd(&bar[XB_TMO], 1u); break; } }
    }
    nloc = mine > 0u ? mine : 1u; nx = cnt > 0u ? cnt : 1u;
}
__device__ __forceinline__ void xcd_barrier(const XcdBarrier& b) {
    asm volatile("s_waitcnt vmcnt(0)" ::: "memory");
    __syncthreads();
    if (b.w == 0 && lane_id_now() == 0) {
        unsigned* bar = b.bar;
        __builtin_amdgcn_s_waitcnt(0);
        unsigned nloc = b.st[0], nx = b.st[1];
        if (nloc == 0u) { xcd_barrier_complete(bar, b.x, nloc, nx); b.st[0] = nloc; b.st[1] = nx; }
        const unsigned old = xb_add(&bar[XB_XSUB(b.x)], 1u);
        const unsigned gen = old / nloc;
        if (old + 1u == (gen + 1u) * nloc) {
            __builtin_amdgcn_fence(__ATOMIC_RELEASE, "agent");
            asm volatile("s_waitcnt vmcnt(0)" ::: "memory");
            const unsigned og = xb_add(&bar[XB_TOP], 1u);
            const unsigned tg = og / nx;
            if (og + 1u == (tg + 1u) * nx) xb_add(&bar[XB_TOPGEN], 1u);
            else XB_SPIN(xb_ld(&bar[XB_TOPGEN]) == tg, bar);
            __builtin_amdgcn_fence(__ATOMIC_ACQUIRE, "agent");
            xb_add(&bar[XB_XGEN(b.x)], 1u);
            asm volatile("s_waitcnt vmcnt(0)" ::: "memory");
        } else {
            XB_SPIN(xb_ld(&bar[XB_XGEN(b.x)]) == gen, bar);
            __builtin_amdgcn_fence(__ATOMIC_ACQUIRE, "agent");
            asm volatile("s_waitcnt vmcnt(0)" ::: "memory");
        }
    }
    __syncthreads();
}

__device__ __forceinline__ void group_barrier(unsigned* gw, int use, int wave_s) {
    asm volatile("s_waitcnt vmcnt(0)" ::: "memory");
    __syncthreads();
    if (wave_s == 0 && lane_id_now() == 0) {
        const unsigned x = xb_xcc_id(), nloc = xb_ld(&gw[x]);
        const unsigned old = xb_add(&gw[64 + 32 * use + x], 1u);
        if (old + 1u == nloc) {
            __builtin_amdgcn_fence(__ATOMIC_RELEASE, "agent");
            asm volatile("s_waitcnt vmcnt(0)" ::: "memory");
            (void)xb_add(&gw[32 + 16 * use], nloc);
        }
        unsigned sp = 0u;
        while (xb_ld(&gw[32 + 16 * use]) < 16u) { __builtin_amdgcn_s_sleep(1); if (++sp > XB_SPIN_CAP) break; }
        __builtin_amdgcn_fence(__ATOMIC_ACQUIRE, "agent");
        asm volatile("s_waitcnt vmcnt(0)" ::: "memory");
    }
    __syncthreads();
}

__device__ const float ROPE_TAB[64 * 32] = {
1.000000000e+00f, 1.000000000e+00f, 1.000000000e+00f, 1.000000000e+00f, 1.000000000e+00f, 1.000000000e+00f, 1.000000000e+00f, 1.000000000e+00f, 1.000000000e+00f, 1.000000000e+00f, 1.000000000e+00f, 1.000000000e+00f, 1.000000000e+00f, 1.000000000e+00f, 1.000000000e+00f, 1.000000000e+00f, 0.000000000e+00f, 0.000000000e+00f, 0.000000000e+00f, 0.000000000e+00f, 0.000000000e+00f, 0.000000000e+00f, 0.000000000e+00f, 0.000000000e+00f, 0.000000000e+00f, 0.000000000e+00f, 0.000000000e+00f, 0.000000000e+00f, 0.000000000e+00f, 0.000000000e+00f, 0.000000000e+00f, 0.000000000e+00f,
5.403023059e-01f, 8.460091103e-01f, 9.504152803e-01f, 9.842302345e-01f, 9.950041653e-01f, 9.984192778e-01f, 9.995000417e-01f, 9.998418903e-01f, 9.999500004e-01f, 9.999841887e-01f, 9.999950000e-01f, 9.999984189e-01f, 9.999995000e-01f, 9.999998419e-01f, 9.999999500e-01f, 9.999999842e-01f, 8.414709848e-01f, 5.331684399e-01f, 3.109835929e-01f, 1.768921862e-01f, 9.983341665e-02f, 5.620449921e-02f, 3.161750640e-02f, 1.778185688e-02f, 9.999833334e-03f, 5.623383614e-03f, 3.162272390e-03f, 1.778278473e-03f, 9.999998333e-04f, 5.623412956e-04f, 3.162277607e-04f, 1.778279401e-04f,
-4.161468365e-01f, 4.314628294e-01f, 8.065784099e-01f, 9.374183089e-01f, 9.800665778e-01f, 9.936821085e-01f, 9.980006666e-01f, 9.993676111e-01f, 9.998000067e-01f, 9.999367551e-01f, 9.999800001e-01f, 9.999936755e-01f, 9.999980000e-01f, 9.999993675e-01f, 9.999998000e-01f, 9.999999368e-01f, 9.092974268e-01f, 9.021307150e-01f, 5.911271172e-01f, 3.482052759e-01f, 1.986693308e-01f, 1.122313110e-01f, 6.320339793e-02f, 3.555809079e-02f, 1.999866669e-02f, 1.124658940e-02f, 6.324513157e-03f, 3.556551322e-03f, 1.999998667e-03f, 1.124682413e-03f, 6.324554899e-04f, 3.556558745e-04f,
-9.899924966e-01f, -1.159661415e-01f, 5.827536107e-01f, 8.610406494e-01f, 9.553364891e-01f, 9.858034685e-01f, 9.955033740e-01f, 9.985773125e-01f, 9.995500337e-01f, 9.998577009e-01f, 9.999550003e-01f, 9.999857698e-01f, 9.999955000e-01f, 9.999985770e-01f, 9.999995500e-01f, 9.999998577e-01f, 1.411200081e-01f, 9.932531671e-01f, 8.126488966e-01f, 5.085361344e-01f, 2.955202067e-01f, 1.679033098e-01f, 9.472609133e-02f, 5.332308054e-02f, 2.999550020e-02f, 1.686943954e-02f, 9.486690679e-03f, 5.334812925e-03f, 2.999995500e-03f, 1.687023175e-03f, 9.486831557e-04f, 5.334837977e-04f,
-6.536436209e-01f, -6.276796538e-01f, 3.011374626e-01f, 7.575061717e-01f, 9.210609940e-01f, 9.748082656e-01f, 9.920106610e-01f, 9.974712444e-01f, 9.992001067e-01f, 9.997470285e-01f, 9.999200011e-01f, 9.999747019e-01f, 9.999920000e-01f, 9.999974702e-01f, 9.999992000e-01f, 9.999997470e-01f, -7.568024953e-01f, 7.784717415e-01f, 9.535807405e-01f, 6.528280017e-01f, 3.894183423e-01f, 2.230444916e-01f, 1.261540665e-01f, 7.107120850e-02f, 3.998933419e-02f, 2.249175622e-02f, 1.264877333e-02f, 7.113057657e-03f, 3.999989333e-03f, 2.249363404e-03f, 1.264910727e-03f, 7.113117040e-04f,
2.836621855e-01f, -9.460792693e-01f, -1.034231891e-02f, 6.300803045e-01f, 8.775825619e-01f, 9.607312606e-01f, 9.875260200e-01f, 9.960497564e-01f, 9.987502604e-01f, 9.996047413e-01f, 9.998750026e-01f, 9.999604718e-01f, 9.999875000e-01f, 9.999960472e-01f, 9.999987500e-01f, 9.999996047e-01f, -9.589242747e-01f, 3.239352036e-01f, 9.999465168e-01f, 7.765299800e-01f, 4.794255386e-01f, 2.774805306e-01f, 1.574558982e-01f, 8.879686236e-02f, 4.997916927e-02f, 2.811336166e-02f, 1.581072950e-02f, 8.891279896e-03f, 4.999979167e-03f, 2.811702921e-03f, 1.581138171e-03f, 8.891395879e-04f,
9.601702867e-01f, -9.731037080e-01f, -3.207964584e-01f, 4.827820000e-01f, 8.253356149e-01f, 9.436169571e-01f, 9.820539352e-01f, 9.943132982e-01f, 9.982005399e-01f, 9.994308440e-01f, 9.998200054e-01f, 9.999430795e-01f, 9.999820001e-01f, 9.999943079e-01f, 9.999982000e-01f, 9.999994308e-01f, -2.794154982e-01f, -2.303674747e-01f, 9.471481575e-01f, 8.757405669e-01f, 5.646424734e-01f, 3.310393303e-01f, 1.886002871e-01f, 1.064944369e-01f, 5.996400648e-02f, 3.373407807e-02f, 1.897252756e-02f, 1.066947402e-02f, 5.999964000e-03f, 3.374041549e-03f, 1.897365458e-03f, 1.066967444e-03f,
7.539022543e-01f, -7.004299352e-01f, -5.994373930e-01f, 3.202569776e-01f, 7.648421873e-01f, 9.235194611e-01f, 9.755998784e-01f, 9.922624187e-01f, 9.975510003e-01f, 9.992253420e-01f, 9.997550100e-01f, 9.999225252e-01f, 9.999755001e-01f, 9.999922524e-01f, 9.999975500e-01f, 9.999992252e-01f, 6.569865987e-01f, -7.137211682e-01f, 8.004216463e-01f, 9.473307069e-01f, 6.442176872e-01f, 3.835515676e-01f, 2.195560914e-01f, 1.241583359e-01f, 6.994284734e-02f, 3.935372772e-02f, 2.213413590e-02f, 1.244763440e-02f, 6.999942833e-03f, 3.936379111e-03f, 2.213592554e-03f, 1.244795266e-03f,
-1.455000338e-01f, -2.120365045e-01f, -8.186324573e-01f, 1.476312003e-01f, 6.967067093e-01f, 9.005023096e-01f, 9.681703030e-01f, 9.898977666e-01f, 9.968017063e-01f, 9.989882418e-01f, 9.996800171e-01f, 9.998988088e-01f, 9.999680002e-01f, 9.999898807e-01f, 9.999968000e-01f, 9.999989881e-01f, 9.893582466e-01f, -9.772617463e-01f, 5.743177691e-01f, 9.890424807e-01f, 7.173560909e-01f, 4.348512280e-01f, 2.502923579e-01f, 1.417829736e-01f, 7.991469397e-02f, 4.497213290e-02f, 2.529552289e-02f, 1.422575542e-02f, 7.999914667e-03f, 4.498715427e-03f, 2.529819430e-03f, 1.422623048e-03f,
-9.111302619e-01f, 3.416603061e-01f, -9.566441996e-01f, -2.965079584e-02f, 6.216099683e-01f, 8.746382701e-01f, 9.597726380e-01f, 9.872200896e-01f, 9.959527330e-01f, 9.987195509e-01f, 9.995950273e-01f, 9.998719305e-01f, 9.999595003e-01f, 9.999871928e-01f, 9.999959500e-01f, 9.999987193e-01f, 4.121184852e-01f, -9.398235128e-01f, 2.912591207e-01f, 9.995603185e-01f, 7.833269096e-01f, 4.847761303e-01f, 2.807783529e-01f, 1.593627767e-01f, 8.987854920e-02f, 5.058911594e-02f, 2.845665693e-02f, 1.600383145e-02f, 8.999878500e-03f, 5.061050321e-03f, 2.846046052e-03f, 1.600450786e-03f,
-8.390715291e-01f, 7.901319677e-01f, -9.997860729e-01f, -2.059976198e-01f, 5.403023059e-01f, 8.460091103e-01f, 9.504152803e-01f, 9.842302345e-01f, 9.950041653e-01f, 9.984192778e-01f, 9.995000417e-01f, 9.998418903e-01f, 9.999500004e-01f, 9.999841887e-01f, 9.999950000e-01f, 9.999984189e-01f, -5.440211109e-01f, -6.129367615e-01f, -2.068353153e-02f, 9.785524925e-01f, 8.414709848e-01f, 5.331684399e-01f, 3.109835929e-01f, 1.768921862e-01f, 9.983341665e-02f, 5.620449921e-02f, 3.161750640e-02f, 1.778185688e-02f, 9.999833334e-03f, 5.623383614e-03f, 3.162272390e-03f, 1.778278473e-03f,
4.425697988e-03f, 9.952573799e-01f, -9.437797217e-01f, -3.758473754e-01f, 4.535961214e-01f, 8.147053397e-01f, 9.401075865e-01f, 9.809291466e-01f, 9.939560980e-01f, 9.980874320e-01f, 9.993950610e-01f, 9.998086883e-01f, 9.999395006e-01f, 9.999808683e-01f, 9.999939500e-01f, 9.999980868e-01f, -9.999902066e-01f, -9.727665569e-02f, -3.305750095e-01f, 9.266815798e-01f, 8.912073601e-01f, 5.798751671e-01f, 3.408778753e-01f, 1.943656590e-01f, 1.097783008e-01f, 6.181810515e-02f, 3.477803970e-02f, 1.955982607e-02f, 1.099977817e-02f, 6.185715129e-03f, 3.478498411e-03f, 1.956106104e-03f,
8.438539587e-01f, 8.938616532e-01f, -7.941792645e-01f, -5.338430810e-01f, 3.623577545e-01f, 7.808259235e-01f, 9.288598634e-01f, 9.773178698e-01f, 9.928086359e-01f, 9.977240240e-01f, 9.992800864e-01f, 9.997723246e-01f, 9.999280009e-01f, 9.999772317e-01f, 9.999928000e-01f, 9.999977232e-01f, -5.365729180e-01f, 4.483428876e-01f, -6.076835491e-01f, 8.455835647e-01f, 9.320390860e-01f, 6.247486512e-01f, 3.704313082e-01f, 2.117776696e-01f, 1.197122073e-01f, 6.742975624e-02f, 3.793822522e-02f, 2.133773341e-02f, 1.199971200e-02f, 6.748044688e-03f, 3.794724085e-03f, 2.133933673e-03f,
9.074467815e-01f, 5.171728240e-01f, -5.658204948e-01f, -6.750016262e-01f, 2.674988286e-01f, 7.444779696e-01f, 9.166833580e-01f, 9.733975461e-01f, 9.915618937e-01f, 9.973290652e-01f, 9.991551190e-01f, 9.997327994e-01f, 9.999155012e-01f, 9.999732789e-01f, 9.999915500e-01f, 9.999973279e-01f, 4.201670368e-01f, 8.558809906e-01f, -8.245284517e-01f, 7.378162404e-01f, 9.635581854e-01f, 6.676470271e-01f, 3.996143406e-01f, 2.291227120e-01f, 1.296341426e-01f, 7.303927501e-02f, 4.109803135e-02f, 2.311557328e-02f, 1.299963384e-02f, 7.310372113e-03f, 4.110949379e-03f, 2.311761174e-03f,
1.367372182e-01f, -1.879581181e-02f, -2.813496238e-01f, -7.948709366e-01f, 1.699671429e-01f, 7.057763899e-01f, 9.035902455e-01f, 9.691694153e-01f, 9.902159962e-01f, 9.969025682e-01f, 9.990201601e-01f, 9.996901128e-01f, 9.999020016e-01f, 9.999690098e-01f, 9.999902000e-01f, 9.999969010e-01f, 9.906073557e-01f, 9.998233431e-01f, -9.596053299e-01f, 6.067785379e-01f, 9.854497300e-01f, 7.084346741e-01f, 4.283977921e-01f, 2.463953013e-01f, 1.395431146e-01f, 7.864648408e-02f, 4.425742651e-02f, 2.489334005e-02f, 1.399954267e-02f, 7.872697226e-03f, 4.427174262e-03f, 2.489588602e-03f,
-7.596879129e-01f, -5.489756801e-01f, 3.102253171e-02f, -8.896703905e-01f, 7.073720167e-02f, 6.648435374e-01f, 8.895936181e-01f, 9.646348142e-01f, 9.887710779e-01f, 9.964445465e-01f, 9.988752109e-01f, 9.996442649e-01f, 9.998875021e-01f, 9.999644246e-01f, 9.999887500e-01f, 9.999964424e-01f, 6.502878402e-01f, 8.358383233e-01f, -9.995186854e-01f, 4.566033249e-01f, 9.974949866e-01f, 7.469826442e-01f, 4.567528814e-01f, 2.635899757e-01f, 1.494381325e-01f, 8.425120614e-02f, 4.741637909e-02f, 2.667102809e-02f, 1.499943751e-02f, 8.435019850e-03f, 4.743398702e-03f, 2.667415952e-03f,
-9.576594803e-01f, -9.100810415e-01f, 3.403182001e-01f, -9.564100574e-01f, -2.919952230e-02f, 6.218088190e-01f, 8.747074712e-01f, 9.597951768e-01f, 9.872272834e-01f, 9.959550145e-01f, 9.987202730e-01f, 9.995952558e-01f, 9.998720027e-01f, 9.999595231e-01f, 9.999872000e-01f, 9.999959523e-01f, -2.879033167e-01f, 4.144303293e-01f, -9.403103332e-01f, 2.920270571e-01f, 9.995736030e-01f, 7.831690702e-01f, 4.846512559e-01f, 2.807012978e-01f, 1.593182066e-01f, 8.985326395e-02f, 5.057485751e-02f, 2.844863180e-02f, 1.599931734e-02f, 8.997339806e-03f, 5.059622668e-03f, 2.845243217e-03f,
-2.751633381e-01f, -9.908980244e-01f, 6.158647034e-01f, -9.929849996e-01f, -1.288444943e-01f, 5.768082866e-01f, 8.589466897e-01f, 9.546520336e-01f, 9.855847669e-01f, 9.954339878e-01f, 9.985553480e-01f, 9.995430857e-01f, 9.998555035e-01f, 9.999543054e-01f, 9.999855500e-01f, 9.999954305e-01f, -9.613974919e-01f, -1.346146549e-01f, -7.878519322e-01f, 1.182403929e-01f, 9.916648105e-01f, 8.168795508e-01f, 5.120650195e-01f, 2.977238566e-01f, 1.691823491e-01f, 9.545248036e-02f, 5.373283018e-02f, 3.022614554e-02f, 1.699918118e-02f, 9.559656917e-03f, 5.375846129e-03f, 3.023070392e-03f,
6.603167082e-01f, -7.665364704e-01f, 8.303362493e-01f, -9.982416606e-01f, -2.272020947e-01f, 5.299842069e-01f, 8.423270331e-01f, 9.492070108e-01f, 9.838436928e-01f, 9.948814827e-01f, 9.983804374e-01f, 9.994877548e-01f, 9.998380044e-01f, 9.999487715e-01f, 9.999838000e-01f, 9.999948771e-01f, -7.509872468e-01f, -6.422007782e-01f, -5.572626967e-01f, -5.927551787e-02f, 9.738476309e-01f, 8.480075120e-01f, 5.389667608e-01f, 3.146522694e-01f, 1.790295734e-01f, 1.010486783e-01f, 5.689026552e-02f, 3.200356370e-02f, 1.799902802e-02f, 1.012197101e-02f, 5.692069051e-03f, 3.200897472e-03f,
9.887046182e-01f, -3.060956503e-01f, 9.624638147e-01f, -9.720142477e-01f, -3.232895669e-01f, 4.814846115e-01f, 8.248651197e-01f, 9.434618303e-01f, 9.820042351e-01f, 9.942975168e-01f, 9.981955429e-01f, 9.994292632e-01f, 9.998195054e-01f, 9.999429214e-01f, 9.999819501e-01f, 9.999942921e-01f, 1.498772097e-01f, -9.520007631e-01f, -2.714100320e-01f, -2.349219066e-01f, 9.463000877e-01f, 8.764545447e-01f, 5.653295802e-01f, 3.314811830e-01f, 1.888588950e-01f, 1.066416808e-01f, 6.004713196e-02f, 3.378088066e-02f, 1.899885685e-02f, 1.068428189e-02f, 6.008291404e-03f, 3.378724451e-03f,
4.080820618e-01f, 2.486170528e-01f, 9.991443830e-01f, -9.151299613e-01f, -4.161468365e-01f, 4.314628294e-01f, 8.065784099e-01f, 9.374183089e-01f, 9.800665778e-01f, 9.936821085e-01f, 9.980006666e-01f, 9.993676111e-01f, 9.998000067e-01f, 9.999367551e-01f, 9.999800001e-01f, 9.999936755e-01f, 9.129452507e-01f, -9.686018589e-01f, 4.135821352e-02f, -4.031589686e-01f, 9.092974268e-01f, 9.021307150e-01f, 5.911271172e-01f, 3.482052759e-01f, 1.986693308e-01f, 1.122313110e-01f, 6.320339793e-02f, 3.555809079e-02f, 1.999866669e-02f, 1.124658940e-02f, 6.324513157e-03f, 3.556551322e-03f,
-5.477292602e-01f, 7.267602337e-01f, 9.367403630e-01f, -8.293829050e-01f, -5.048461046e-01f, 3.800770014e-01f, 7.874851889e-01f, 9.310783576e-01f, 9.780309147e-01f, 9.930352774e-01f, 9.977958102e-01f, 9.993027988e-01f, 9.997795081e-01f, 9.999302726e-01f, 9.999779501e-01f, 9.999930272e-01f, 8.366556385e-01f, -6.868912307e-01f, 3.500249882e-01f, -5.586805857e-01f, 8.632093666e-01f, 9.249548492e-01f, 6.163335763e-01f, 3.648192595e-01f, 2.084598998e-01f, 1.178173922e-01f, 6.635903187e-02f, 3.733518848e-02f, 2.099845653e-02f, 1.180889335e-02f, 6.640734277e-03f, 3.734378081e-03f,
-9.999608264e-01f, 9.810745045e-01f, 7.814403262e-01f, -7.174775009e-01f, -5.885011173e-01f, 3.274895812e-01f, 7.676045483e-01f, 9.244439812e-01f, 9.758974493e-01f, 9.923570438e-01f, 9.975809759e-01f, 9.992348264e-01f, 9.997580098e-01f, 9.999234739e-01f, 9.999758001e-01f, 9.999923473e-01f, -8.851309290e-03f, -1.936306189e-01f, 6.239799809e-01f, -6.965816792e-01f, 8.084964038e-01f, 9.448547900e-01f, 6.409237532e-01f, 3.813178801e-01f, 2.182296231e-01f, 1.233997476e-01f, 6.951400222e-02f, 3.911216810e-02f, 2.199822538e-02f, 1.237119357e-02f, 6.956954733e-03f, 3.912204722e-03f,
-5.328330203e-01f, 9.332357037e-01f, 5.486452902e-01f, -5.829431928e-01f, -6.662760213e-01f, 2.738668208e-01f, 7.469563671e-01f, 9.175172776e-01f, 9.736663950e-01f, 9.916474291e-01f, 9.973561658e-01f, 9.991636942e-01f, 9.997355117e-01f, 9.999163589e-01f, 9.999735501e-01f, 9.999916358e-01f, -8.462204042e-01f, 3.592646954e-01f, 8.360552287e-01f, -8.125129131e-01f, 7.457052122e-01f, 9.617676250e-01f, 6.648730598e-01f, 3.976959206e-01f, 2.279775235e-01f, 1.289782009e-01f, 7.266827742e-02f, 4.088902404e-02f, 2.299797222e-02f, 1.293348988e-02f, 7.273174493e-03f, 4.090031240e-03f,
4.241790073e-01f, 5.979773102e-01f, 2.614414084e-01f, -4.300231298e-01f, -7.373937155e-01f, 2.193782457e-01f, 7.255612918e-01f, 9.103004373e-01f, 9.713379749e-01f, 9.909064559e-01f, 9.971213821e-01f, 9.990894023e-01f, 9.997120138e-01f, 9.999089278e-01f, 9.999712001e-01f, 9.999908927e-01f, -9.055783620e-01f, 8.015130295e-01f, 9.652193481e-01f, -9.028178708e-01f, 6.754631806e-01f, 9.756398851e-01f, 6.881575487e-01f, 4.139482019e-01f, 2.377026264e-01f, 1.345525755e-01f, 7.582182595e-02f, 4.266575068e-02f, 2.399769607e-02f, 1.349578209e-02f, 7.589393526e-03f, 4.267857628e-03f,
9.912028119e-01f, 7.855280068e-02f, -5.168947139e-02f, -2.635403389e-01f, -8.011436155e-01f, 1.641961185e-01f, 7.034407157e-01f, 9.027957423e-01f, 9.689124217e-01f, 9.901341476e-01f, 9.968766273e-01f, 9.990119510e-01f, 9.996875163e-01f, 9.999011805e-01f, 9.999687502e-01f, 9.999901179e-01f, -1.323517501e-01f, 9.969099546e-01f, 9.986632058e-01f, -9.646483762e-01f, 5.984721441e-01f, 9.864277139e-01f, 7.107539373e-01f, 4.300695848e-01f, 2.474039593e-01f, 1.401226951e-01f, 7.897461625e-02f, 4.444234239e-02f, 2.499739591e-02f, 1.405807004e-02f, 7.905611800e-03f, 4.445683881e-03f,
6.469193223e-01f, -4.650645402e-01f, -3.596943353e-01f, -8.874560929e-02f, -8.568887534e-01f, 1.084948944e-01f, 6.806167575e-01f, 8.950055657e-01f, 9.663899781e-01f, 9.893305286e-01f, 9.966219036e-01f, 9.989313405e-01f, 9.996620190e-01f, 9.998931169e-01f, 9.999662002e-01f, 9.999893115e-01f, 7.625584505e-01f, 8.852767779e-01f, 9.330701931e-01f, -9.960543242e-01f, 5.155013718e-01f, 9.940970063e-01f, 7.326396313e-01f, 4.460549713e-01f, 2.570805519e-01f, 1.456883837e-01f, 8.212661682e-02f, 4.621879357e-02f, 2.599707077e-02f, 1.462035354e-02f, 8.221829283e-03f, 4.623509993e-03f,
-2.921388087e-01f, -8.654504764e-01f, -6.320285135e-01f, 8.884811520e-02f, -9.040721420e-01f, 5.245066969e-02f, 6.571122393e-01f, 8.869323709e-01f, 9.637708964e-01f, 9.884956243e-01f, 9.963572138e-01f, 9.988475712e-01f, 9.996355221e-01f, 9.998847372e-01f, 9.999635502e-01f, 9.999884735e-01f, 9.563759284e-01f, 5.009944839e-01f, 7.749451323e-01f, -9.960451859e-01f, 4.273798802e-01f, 9.986235163e-01f, 7.537927467e-01f, 4.618993065e-01f, 2.667314367e-01f, 1.512494653e-01f, 8.527779611e-02f, 4.799509859e-02f, 2.699671962e-02f, 1.518263242e-02f, 8.538045944e-03f, 4.801335960e-03f,
-9.626058663e-01f, -9.992934349e-01f, -8.416847784e-01f, 2.636396118e-01f, -9.422223407e-01f, -3.759374883e-03f, 6.329506635e-01f, 8.785787110e-01f, 9.610554383e-01f, 9.876294611e-01f, 9.960825604e-01f, 9.987606432e-01f, 9.996080256e-01f, 9.998760413e-01f, 9.999608003e-01f, 9.999876039e-01f, 2.709057883e-01f, -3.758498280e-02f, 5.399691971e-01f, -9.646212496e-01f, 3.349881502e-01f, 9.999929335e-01f, 7.741921322e-01f, 4.775975802e-01f, 2.763556486e-01f, 1.568057639e-01f, 8.842812263e-02f, 4.977125184e-02f, 2.799634148e-02f, 1.574490650e-02f, 8.854261752e-03f, 4.979161774e-03f,
-7.480575297e-01f, -8.253722231e-01f, -9.678716355e-01f, 4.301160387e-01f, -9.709581651e-01f, -5.995753440e-02f, 6.081561899e-01f, 8.699472273e-01f, 9.582438755e-01f, 9.867320664e-01f, 9.957979462e-01f, 9.986705569e-01f, 9.995795295e-01f, 9.998670292e-01f, 9.999579503e-01f, 9.999867027e-01f, -6.636338842e-01f, -5.645889596e-01f, 2.514448194e-01f, -9.027736113e-01f, 2.392493292e-01f, 9.982009287e-01f, 7.938173900e-01f, 4.931448283e-01f, 2.859522251e-01f, 1.623571039e-01f, 9.157756487e-02f, 5.154724769e-02f, 2.899593534e-02f, 1.630717560e-02f, 9.170476674e-03f, 5.156987431e-03f,
1.542514499e-01f, -3.972514054e-01f, -9.980752051e-01f, 5.830268074e-01f, -9.899924966e-01f, -1.159661415e-01f, 5.827536107e-01f, 8.610406494e-01f, 9.553364891e-01f, 9.858034685e-01f, 9.955033740e-01f, 9.985773125e-01f, 9.995500337e-01f, 9.998577009e-01f, 9.999550003e-01f, 9.999857698e-01f, -9.880316241e-01f, -9.177098239e-01f, -6.201520023e-02f, -8.124529167e-01f, 1.411200081e-01f, 9.932531671e-01f, 8.126488966e-01f, 5.085361344e-01f, 2.955202067e-01f, 1.679033098e-01f, 9.472609133e-02f, 5.332308054e-02f, 2.999550020e-02f, 1.686943954e-02f, 9.486690679e-03f, 5.334812925e-03f,
9.147423578e-01f, 1.532156071e-01f, -9.293002159e-01f, 7.175491840e-01f, -9.991351503e-01f, -1.716081281e-01f, 5.567683265e-01f, 8.518617938e-01f, 9.523335699e-01f, 9.848436969e-01f, 9.951988468e-01f, 9.984809103e-01f, 9.995195385e-01f, 9.998480564e-01f, 9.999519504e-01f, 9.999848053e-01f, -4.040376453e-01f, -9.881927837e-01f, -3.693252072e-01f, -6.965078381e-01f, 4.158066243e-02f, 9.851652909e-01f, 8.306678221e-01f, 5.237666315e-01f, 3.050586364e-01f, 1.734442061e-01f, 9.787367054e-02f, 5.509874477e-02f, 3.099503507e-02f, 1.743169815e-02f, 9.802903735e-03f, 5.512638250e-03f,
8.342233605e-01f, 6.564950042e-01f, -7.683670453e-01f, 8.294403958e-01f, -9.982947758e-01f, -2.267075851e-01f, 5.302263203e-01f, 8.424135629e-01f, 9.492354181e-01f, 9.838527819e-01f, 9.948843676e-01f, 9.983813507e-01f, 9.994880437e-01f, 9.998380958e-01f, 9.999488004e-01f, 9.999838092e-01f, 5.514266812e-01f, -7.543303715e-01f, -6.400094403e-01f, -5.585952289e-01f, -5.837414343e-02f, 9.739628693e-01f, 8.478561489e-01f, 5.388315034e-01f, 3.145665606e-01f, 1.789796176e-01f, 1.010202710e-01f, 5.687423476e-02f, 3.199453895e-02f, 1.799395124e-02f, 1.011911581e-02f, 5.690463401e-03f,
-1.327674722e-02f, 9.575859018e-01f, -5.312353455e-01f, 9.151714465e-01f, -9.874797699e-01f, -2.810903188e-01f, 5.031541321e-01f, 8.326989444e-01f, 9.460423435e-01f, 9.828307548e-01f, 9.945599395e-01f, 9.982786339e-01f, 9.994555494e-01f, 9.998278189e-01f, 9.999455505e-01f, 9.999827814e-01f, 9.999118601e-01f, -2.881479492e-01f, -8.472242960e-01f, -4.030647882e-01f, -1.577456941e-01f, 9.596813183e-01f, 8.641966902e-01f, 5.537259863e-01f, 3.240430284e-01f, 1.845093693e-01f, 1.041658613e-01f, 5.864954490e-02f, 3.299401083e-02f, 1.855619865e-02f, 1.043532687e-02f, 5.868288372e-03f,
-8.485702748e-01f, 9.637577894e-01f, -2.414213342e-01f, 9.720384190e-01f, -9.667981926e-01f, -3.345844009e-01f, 4.755788316e-01f, 8.227210104e-01f, 9.427546655e-01f, 9.817776480e-01f, 9.942255659e-01f, 9.981727603e-01f, 9.994220557e-01f, 9.998172259e-01f, 9.999422006e-01f, 9.999817221e-01f, 5.290826861e-01f, 2.667787912e-01f, -9.704203931e-01f, -2.348218730e-01f, -2.555411020e-01f, 9.423657881e-01f, 8.796731069e-01f, 5.684453703e-01f, 3.334870921e-01f, 1.900332863e-01f, 1.073104099e-01f, 6.042466957e-02f, 3.399344971e-02f, 1.911844019e-02f, 1.075153690e-02f, 6.046113157e-03f,
-9.036922051e-01f, 6.731098380e-01f, 7.233429552e-02f, 9.982477555e-01f, -9.364566873e-01f, -3.870207132e-01f, 4.475279919e-01f, 8.124829160e-01f, 9.393727128e-01f, 9.806934947e-01f, 9.938812501e-01f, 9.980637301e-01f, 9.993875625e-01f, 9.998063167e-01f, 9.999387506e-01f, 9.999806311e-01f, -4.281826695e-01f, 7.395425248e-01f, -9.973804438e-01f, -5.917278607e-02f, -3.507832277e-01f, 9.220710209e-01f, 8.942699237e-01f, 5.829850008e-01f, 3.428978075e-01f, 1.955511940e-01f, 1.104538854e-01f, 6.219960316e-02f, 3.499285460e-02f, 1.968067568e-02f, 1.106774584e-02f, 6.223937751e-03f,
-1.279636896e-01f, 1.751563210e-01f, 3.789165737e-01f, 9.929728260e-01f, -8.967584163e-01f, -4.382334809e-01f, 4.190296615e-01f, 8.019878987e-01f, 9.358968237e-01f, 9.795783292e-01f, 9.935269954e-01f, 9.979515438e-01f, 9.993520700e-01f, 9.997950914e-01f, 9.999352007e-01f, 9.999795085e-01f, -9.917788534e-01f, 9.845406356e-01f, -9.254308349e-01f, 1.183425828e-01f, -4.425204433e-01f, 8.988611774e-01f, 9.079725452e-01f, 5.973402802e-01f, 3.522742333e-01f, 2.010629178e-01f, 1.135962563e-01f, 6.397434006e-02f, 3.599222450e-02f, 2.024290495e-02f, 1.138395368e-02f, 6.401762149e-03f,
7.654140519e-01f, -3.767421515e-01f, 6.479219076e-01f, 9.563799991e-01f, -8.481000317e-01f, -4.880607978e-01f, 3.901123364e-01f, 7.912392773e-01f, 9.323273456e-01f, 9.784321869e-01f, 9.931628054e-01f, 9.978362017e-01f, 9.993155781e-01f, 9.997835499e-01f, 9.999315508e-01f, 9.999783543e-01f, -6.435381334e-01f, 9.263181696e-01f, -7.617067688e-01f, 2.921254821e-01f, -5.298361409e-01f, 8.728096342e-01f, 9.207672697e-01f, 6.115066689e-01f, 3.616154320e-01f, 2.065682834e-01f, 1.167374914e-01f, 6.574887465e-02f, 3.699155841e-02f, 2.080512781e-02f, 1.170016038e-02f, 6.579586343e-03f,
9.550736440e-01f, -8.126109057e-01f, 8.526731891e-01f, 8.896233956e-01f, -7.909677119e-01f, -5.363451377e-01f, 3.608049314e-01f, 7.802404506e-01f, 9.286646356e-01f, 9.772551038e-01f, 9.927886839e-01f, 9.977177042e-01f, 9.992780869e-01f, 9.997716922e-01f, 9.999278009e-01f, 9.999771684e-01f, 2.963685787e-01f, 5.828065854e-01f, -5.224446694e-01f, 4.566948806e-01f, -6.118578909e-01f, 8.439987519e-01f, 9.326413038e-01f, 6.254796874e-01f, 3.709204694e-01f, 2.120671168e-01f, 1.198775590e-01f, 6.752320133e-02f, 3.799085533e-02f, 2.136734410e-02f, 1.201636591e-02f, 6.757410330e-03f,
2.666429324e-01f, -9.982103072e-01f, 9.728653484e-01f, 7.948084874e-01f, -7.259323042e-01f, -5.829338522e-01f, 3.311367516e-01f, 7.689948967e-01f, 9.249090599e-01f, 9.760471174e-01f, 9.924046345e-01f, 9.975960516e-01f, 9.992395964e-01f, 9.997595184e-01f, 9.999239510e-01f, 9.999759510e-01f, 9.637953863e-01f, 5.980119189e-02f, -2.313720250e-01f, 6.068603368e-01f, -6.877661592e-01f, 8.125196145e-01f, 9.435827742e-01f, 6.392549170e-01f, 3.801884151e-01f, 2.175592441e-01f, 1.230164278e-01f, 6.929731449e-02f, 3.899011425e-02f, 2.192955363e-02f, 1.233257024e-02f, 6.935234103e-03f,
-6.669380617e-01f, -8.763791221e-01f, 9.965789963e-01f, 6.749256921e-01f, -6.536436209e-01f, -6.276796538e-01f, 3.011374626e-01f, 7.575061717e-01f, 9.210609940e-01f, 9.748082656e-01f, 9.920106610e-01f, 9.974712444e-01f, 9.992001067e-01f, 9.997470285e-01f, 9.999200011e-01f, 9.999747019e-01f, 7.451131605e-01f, -4.816218791e-01f, 8.264565347e-02f, 7.378857026e-01f, -7.568024953e-01f, 7.784717415e-01f, 9.535807405e-01f, 6.528280017e-01f, 3.894183423e-01f, 2.230444916e-01f, 1.261540665e-01f, 7.107120850e-02f, 3.998933419e-02f, 2.249175622e-02f, 1.264877333e-02f, 7.113057657e-03f,
-9.873392775e-01f, -4.846391354e-01f, 9.214624639e-01f, 5.337560571e-01f, -5.748239465e-01f, -6.704410810e-01f, 2.708370612e-01f, 7.457779085e-01f, 9.171208228e-01f, 9.735385879e-01f, 9.916067674e-01f, 9.973432828e-01f, 9.991596177e-01f, 9.997342223e-01f, 9.999159512e-01f, 9.999734212e-01f, -1.586226688e-01f, -8.747141867e-01f, 3.884674088e-01f, 8.456384993e-01f, -8.182771111e-01f, 7.419627733e-01f, 9.626252055e-01f, 6.661946496e-01f, 3.986093280e-01f, 2.285226858e-01f, 1.292904437e-01f, 7.284487777e-02f, 4.098851413e-02f, 2.305395171e-02f, 1.296497516e-02f, 7.290880986e-03f,
-3.999853150e-01f, 5.636087450e-02f, 7.549650153e-01f, 3.757520063e-01f, -4.902608213e-01f, -7.110829460e-01f, 2.402658454e-01f, 7.338138159e-01f, 9.130889403e-01f, 9.722381242e-01f, 9.911929578e-01f, 9.972121674e-01f, 9.991181296e-01f, 9.997211001e-01f, 9.999118013e-01f, 9.999721088e-01f, -9.165215479e-01f, -9.984104626e-01f, 6.557650689e-01f, 9.267202543e-01f, -8.715757724e-01f, 7.031081310e-01f, 9.707071255e-01f, 6.793506338e-01f, 4.077604531e-01f, 2.339936535e-01f, 1.324255279e-01f, 7.461831668e-02f, 4.198765309e-02f, 2.361613990e-02f, 1.328117570e-02f, 7.468704084e-03f,
5.551133015e-01f, 5.800027620e-01f, 5.135981094e-01f, 2.058969135e-01f, -4.007991721e-01f, -7.494767618e-01f, 2.094543837e-01f, 7.216176770e-01f, 9.089657497e-01f, 9.709069157e-01f, 9.907692362e-01f, 9.970778985e-01f, 9.990756424e-01f, 9.997076617e-01f, 9.999075514e-01f, 9.999707649e-01f, -8.317747426e-01f, -8.146145076e-01f, 8.580308748e-01f, 9.785736871e-01f, -9.161659367e-01f, 6.620306515e-01f, 9.778184193e-01f, 6.922917941e-01f, 4.168708024e-01f, 2.394572216e-01f, 1.355592879e-01f, 7.639151963e-02f, 4.298675006e-02f, 2.417832062e-02f, 1.359737490e-02f, 7.646526947e-03f,
9.998433086e-01f, 9.250143668e-01f, 2.212979668e-01f, 2.954792850e-02f, -3.073328700e-01f, -7.855011484e-01f, 1.784334851e-01f, 7.091933487e-01f, 9.047516632e-01f, 9.695450046e-01f, 9.903356070e-01f, 9.969404766e-01f, 9.990321562e-01f, 9.996939071e-01f, 9.999032016e-01f, 9.999693893e-01f, 1.770192511e-02f, -3.799321270e-01f, 9.752062397e-01f, 9.995633646e-01f, -9.516020739e-01f, 6.188601989e-01f, 9.839519762e-01f, 7.050140383e-01f, 4.259394651e-01f, 2.449132175e-01f, 1.386916923e-01f, 7.816448100e-02f, 4.398580404e-02f, 2.474049370e-02f, 1.391357275e-02f, 7.824349567e-03f,
5.253219888e-01f, 9.851384009e-01f, -9.294817111e-02f, -1.477329843e-01f, -2.107957994e-01f, -8.190422169e-01f, 1.472341679e-01f, 6.965447596e-01f, 9.004471024e-01f, 9.681524338e-01f, 9.898920744e-01f, 9.967999021e-01f, 9.989876708e-01f, 9.996798365e-01f, 9.998987517e-01f, 9.999679821e-01f, 8.509035245e-01f, 1.717624261e-01f, 9.956709484e-01f, 9.890272824e-01f, -9.775301177e-01f, 5.737332542e-01f, 9.891016630e-01f, 7.175133434e-01f, 4.349655341e-01f, 2.503614686e-01f, 1.418227098e-01f, 7.993719520e-02f, 4.498481404e-02f, 2.530265896e-02f, 1.422976920e-02f, 8.002171940e-03f,
-4.321779449e-01f, 7.418577573e-01f, -3.979766910e-01f, -3.203544680e-01f, -1.121525269e-01f, -8.499939289e-01f, 1.158876288e-01f, 6.836759095e-01f, 8.960524975e-01f, 9.667292474e-01f, 9.894386429e-01f, 9.966561754e-01f, 9.989421865e-01f, 9.996654497e-01f, 9.998942019e-01f, 9.999665433e-01f, 9.017883476e-01f, 6.705572816e-01f, 9.173955273e-01f, 9.472977435e-01f, -9.936910036e-01f, 5.267924836e-01f, 9.932623307e-01f, 7.297857568e-01f, 4.439481070e-01f, 2.558018026e-01f, 1.449523091e-01f, 8.170965662e-02f, 4.598377905e-02f, 2.586481621e-02f, 1.454596424e-02f, 8.179994060e-03f,
-9.923354692e-01f, 2.700984415e-01f, -6.635380855e-01f, -4.828721220e-01f, -1.238866346e-02f, -8.782584324e-01f, 8.442521171e-02f, 6.705908678e-01f, 8.915682882e-01f, 9.652754904e-01f, 9.889753170e-01f, 9.965092971e-01f, 9.988957033e-01f, 9.996507468e-01f, 9.998895520e-01f, 9.999650728e-01f, 1.235731227e-01f, 9.628327123e-01f, 7.481425059e-01f, 8.756908780e-01f, -9.999232576e-01f, 4.781862879e-01f, 9.964298187e-01f, 7.418273977e-01f, 4.528862854e-01f, 2.612340474e-01f, 1.480804588e-01f, 8.348185965e-02f, 4.698269808e-02f, 2.642696529e-02f, 1.486215781e-02f, 8.357815921e-03f,
-6.401443395e-01f, -2.848462729e-01f, -8.632967800e-01f, -6.301602158e-01f, 8.749898344e-02f, -9.037463706e-01f, 5.287837645e-02f, 6.572937723e-01f, 8.869949228e-01f, 9.637912089e-01f, 9.885021014e-01f, 9.963592674e-01f, 9.988482212e-01f, 9.996357277e-01f, 9.998848022e-01f, 9.999635708e-01f, -7.682546613e-01f, 9.585732110e-01f, 5.046966116e-01f, 7.764651328e-01f, -9.961646088e-01f, 4.280683329e-01f, 9.986009600e-01f, 7.536344584e-01f, 4.617791755e-01f, 2.666580314e-01f, 1.512071278e-01f, 8.525379868e-02f, 4.798157012e-02f, 2.698910600e-02f, 1.517834990e-02f, 8.535637518e-03f,
3.005925437e-01f, -7.520635254e-01f, -9.774428167e-01f, -7.575733518e-01f, 1.865123694e-01f, -9.263771649e-01f, 2.127866722e-02f, 6.437888276e-01f, 8.823328586e-01f, 9.622764496e-01f, 9.880190008e-01f, 9.962060871e-01f, 9.987997402e-01f, 9.996203926e-01f, 9.998799524e-01f, 9.999620371e-01f, -9.537526528e-01f, 6.590906264e-01f, 2.112002371e-01f, 6.527500415e-01f, -9.824526126e-01f, 3.765970636e-01f, 9.997735835e-01f, 7.652032053e-01f, 4.706258882e-01f, 2.720735828e-01f, 1.543322846e-01f, 8.702546812e-02f, 4.898039419e-02f, 2.755123819e-02f, 1.549454048e-02f, 8.713458845e-03f,
9.649660285e-01f, -9.876589150e-01f, -9.946563971e-01f, -8.610929796e-01f, 2.836621855e-01f, -9.460792693e-01f, -1.034231891e-02f, 6.300803045e-01f, 8.775825619e-01f, 9.607312606e-01f, 9.875260200e-01f, 9.960497564e-01f, 9.987502604e-01f, 9.996047413e-01f, 9.998750026e-01f, 9.999604718e-01f, -2.623748537e-01f, 1.566201379e-01f, -1.032407464e-01f, 5.084475199e-01f, -9.589242747e-01f, 3.239352036e-01f, 9.999465168e-01f, 7.765299800e-01f, 4.794255386e-01f, 2.774805306e-01f, 1.574558982e-01f, 8.879686236e-02f, 4.997916927e-02f, 2.811336166e-02f, 1.581072950e-02f, 8.891279896e-03f,
7.421541968e-01f, -9.190733545e-01f, -9.132304601e-01f, -9.374541386e-01f, 3.779777427e-01f, -9.627903967e-01f, -4.195296357e-02f, 6.161725377e-01f, 8.727445076e-01f, 9.591556907e-01f, 9.870231639e-01f, 9.958902760e-01f, 9.986997819e-01f, 9.995887740e-01f, 9.998699528e-01f, 9.999588749e-01f, 6.702291758e-01f, -3.940864994e-01f, -4.074434030e-01f, 3.481088020e-01f, -9.258146823e-01f, 2.702492405e-01f, 9.991195869e-01f, 7.876112009e-01f, 4.881772469e-01f, 2.828787037e-01f, 1.605779372e-01f, 9.056797580e-02f, 5.097789438e-02f, 2.867547624e-02f, 1.612691694e-02f, 9.069100666e-03f,
-1.629907808e-01f, -5.674299469e-01f, -7.412399703e-01f, -9.842484337e-01f, 4.685166713e-01f, -9.764577158e-01f, -7.352165877e-02f, 6.020699252e-01f, 8.678191797e-01f, 9.575497897e-01f, 9.865104376e-01f, 9.957276462e-01f, 9.986483046e-01f, 9.995724905e-01f, 9.998648030e-01f, 9.999572463e-01f, 9.866275920e-01f, -8.234216753e-01f, -6.712401257e-01f, 1.767908958e-01f, -8.834546557e-01f, 2.157088994e-01f, 9.972936206e-01f, 7.984433638e-01f, 4.968801378e-01f, 2.882679314e-01f, 1.636983704e-01f, 9.233880284e-02f, 5.197656850e-02f, 2.923758175e-02f, 1.644310277e-02f, 9.246921150e-03f,
-9.182827862e-01f, -4.102845452e-02f, -4.957411282e-01f, -9.999999947e-01f, 5.543743362e-01f, -9.870380181e-01f, -1.050168384e-01f, 5.877769265e-01f, 8.628070705e-01f, 9.559136084e-01f, 9.859878462e-01f, 9.955618678e-01f, 9.985958287e-01f, 9.995558910e-01f, 9.998595533e-01f, 9.999555861e-01f, 3.959251502e-01f, -9.991579785e-01f, -8.684703414e-01f, -1.029124367e-04f, -8.322674422e-01f, 1.604866066e-01f, 9.944704438e-01f, 8.090230434e-01f, 5.055333412e-01f, 2.936480433e-01f, 1.668171666e-01f, 9.410933788e-02f, 5.297519065e-02f, 2.979967802e-02f, 1.675928696e-02f, 9.424741341e-03f,
-8.293098329e-01f, 4.980090543e-01f, -2.010799162e-01f, -9.842120249e-01f, 6.346928759e-01f, -9.944978545e-01f, -1.364070100e-01f, 5.732980613e-01f, 8.577086814e-01f, 9.542471985e-01f, 9.854553950e-01f, 9.953929410e-01f, 9.985423543e-01f, 9.995389753e-01f, 9.998542035e-01f, 9.999538943e-01f, -5.587890489e-01f, -8.671718295e-01f, -9.795748401e-01f, -1.769934748e-01f, -7.727644876e-01f, 1.047569444e-01f, 9.906528795e-01f, 8.193468942e-01f, 5.141359917e-01f, 2.990188692e-01f, 1.699342947e-01f, 9.587957531e-02f, 5.397375983e-02f, 3.036176486e-02f, 1.707546947e-02f, 9.602561234e-03f,
2.212675626e-02f, 8.836688484e-01f, 1.135222784e-01f, -9.373824693e-01f, 7.086697743e-01f, -9.988136413e-01f, -1.676607860e-01f, 5.586379081e-01f, 8.525245221e-01f, 9.525506128e-01f, 9.849130892e-01f, 9.952208666e-01f, 9.984878812e-01f, 9.995217436e-01f, 9.998487538e-01f, 9.999521709e-01f, -9.997551734e-01f, -4.681125574e-01f, -9.935354510e-01f, -3.483017460e-01f, -7.055403256e-01f, 4.869609889e-02f, 9.858447448e-01f, 8.294116515e-01f, 5.226872289e-01f, 3.043802394e-01f, 1.730497234e-01f, 9.764950955e-02f, 5.497227503e-02f, 3.092384210e-02f, 1.739165027e-02f, 9.780380823e-03f,
8.532201077e-01f, 9.971747381e-01f, 4.168665323e-01f, -8.609883102e-01f, 7.755658785e-01f, -9.999717342e-01f, -1.987469151e-01f, 5.438011027e-01f, 8.472551110e-01f, 9.508239048e-01f, 9.843609343e-01f, 9.950456450e-01f, 9.984324097e-01f, 9.995041958e-01f, 9.998432041e-01f, 9.999504159e-01f, -5.215510021e-01f, 7.511685313e-02f, -9.089677080e-01f, -5.086247435e-01f, -6.312666379e-01f, -7.518696635e-03f, 9.800508475e-01f, 8.392141328e-01f, 5.311861979e-01f, 3.097319842e-01f, 1.761634216e-01f, 9.941913500e-02f, 5.597073526e-02f, 3.148590956e-02f, 1.770782933e-02f, 9.958200103e-03f,
8.998668270e-01f, 8.035689776e-01f, 6.788703658e-01f, -7.574389836e-01f, 8.347127848e-01f, -9.979684721e-01f, -2.296343139e-01f, 5.287923369e-01f, 8.419009752e-01f, 9.490671292e-01f, 9.837989357e-01f, 9.948672768e-01f, 9.983759398e-01f, 9.994863320e-01f, 9.998375544e-01f, 9.999486292e-01f, 4.361647552e-01f, 5.952116415e-01f, -7.342581470e-01f, -6.529059551e-01f, -5.506855426e-01f, -6.370972221e-02f, 9.732769811e-01f, 8.487512383e-01f, 5.396320487e-01f, 3.150739345e-01f, 1.792753582e-01f, 1.011884461e-01f, 5.696913951e-02f, 3.204796707e-02f, 1.802400663e-02f, 1.013601907e-02f,
1.191801354e-01f, 3.624786135e-01f, 8.735510056e-01f, -6.300003866e-01f, 8.855195169e-01f, -9.928101881e-01f, -2.602920974e-01f, 5.136163566e-01f, 8.364626499e-01f, 9.472803416e-01f, 9.832270992e-01f, 9.946857625e-01f, 9.983184715e-01f, 9.994681520e-01f, 9.998318047e-01f, 9.999468110e-01f, 9.928726481e-01f, 9.319920894e-01f, -4.867326171e-01f, -7.765948190e-01f, -4.646021794e-01f, -1.196993330e-01f, 9.655299188e-01f, 8.580199521e-01f, 5.480239368e-01f, 3.204059213e-01f, 1.823855020e-01f, 1.029574371e-01f, 5.796748680e-02f, 3.261001444e-02f, 1.834018212e-02f, 1.031383771e-02f,
-7.710802230e-01f, -1.902485591e-01f, 9.816020819e-01f, -4.826918728e-01f, 9.274784307e-01f, -9.845131900e-01f, -2.906896106e-01f, 4.982779609e-01f, 8.309406791e-01f, 9.454635984e-01f, 9.826454305e-01f, 9.945011028e-01f, 9.982600048e-01f, 9.994496561e-01f, 9.998259550e-01f, 9.999449611e-01f, 6.367380071e-01f, 9.817359552e-01f, -1.909380864e-01f, -8.757902465e-01f, -3.738766648e-01f, -1.753105211e-01f, 9.568174070e-01f, 8.670173434e-01f, 5.563610229e-01f, 3.257277760e-01f, 1.854938220e-01f, 1.047261026e-01f, 5.896577612e-02f, 3.317205150e-02f, 1.865635577e-02f, 1.049165603e-02f,
-9.524129804e-01f, -6.843826418e-01f, 9.923082299e-01f, -3.201594838e-01f, 9.601702867e-01f, -9.731037080e-01f, -3.207964584e-01f, 4.827820000e-01f, 8.253356149e-01f, 9.436169571e-01f, 9.820539352e-01f, 9.943132982e-01f, 9.982005399e-01f, 9.994308440e-01f, 9.998200054e-01f, 9.999430795e-01f, -3.048106211e-01f, 7.291230346e-01f, 1.237916674e-01f, -9.473636604e-01f, -2.794154982e-01f, -2.303674747e-01f, 9.471481575e-01f, 8.757405669e-01f, 5.646424734e-01f, 3.310393303e-01f, 1.886002871e-01f, 1.064944369e-01f, 5.996400648e-02f, 3.373407807e-02f, 1.897252756e-02f, 1.066947402e-02f,
-2.581016359e-01f, -9.677393408e-01f, 9.046077269e-01f, -1.475294147e-01f, 9.832684384e-01f, -9.586178129e-01f, -3.505825365e-01f, 4.671333740e-01f, 8.196480178e-01f, 9.417404761e-01f, 9.814526195e-01f, 9.941223493e-01f, 9.981400768e-01f, 9.994117159e-01f, 9.998139558e-01f, 9.999411664e-01f, -9.661177700e-01f, 2.519535043e-01f, 4.262450708e-01f, -9.890576686e-01f, -1.821625043e-01f, -2.846961343e-01f, 9.365318388e-01f, 8.841868642e-01f, 5.728674601e-01f, 3.363404163e-01f, 1.917048661e-01f, 1.082624345e-01f, 6.096217687e-02f, 3.429609397e-02f, 1.928869745e-02f, 1.084729167e-02f,
6.735071623e-01f, -9.530499555e-01f, 7.271977827e-01f, 2.975366287e-02f, 9.965420970e-01f, -9.411013007e-01f, -3.800180612e-01f, 4.513370314e-01f, 8.138784567e-01f, 9.398342148e-01f, 9.808414892e-01f, 9.939282566e-01f, 9.980786156e-01f, 9.993922718e-01f, 9.998078062e-01f, 9.999392216e-01f, -7.391806966e-01f, -3.028131145e-01f, 6.864279895e-01f, -9.995572618e-01f, -8.308940282e-02f, -3.381247429e-01f, 9.249790663e-01f, 8.923535645e-01f, 5.810351605e-01f, 3.416308663e-01f, 1.948075281e-01f, 1.100300897e-01f, 6.196028630e-02f, 3.485809903e-02f, 1.960486542e-02f, 1.102510897e-02f,
9.858965816e-01f, -6.448385490e-01f, 4.776720420e-01f, 2.060983239e-01f, 9.998586364e-01f, -9.206095492e-01f, -4.090735996e-01f, 4.353979673e-01f, 8.080275083e-01f, 9.378982333e-01f, 9.802205506e-01f, 9.937310210e-01f, 9.980161563e-01f, 9.993725116e-01f, 9.998015566e-01f, 9.999372453e-01f, 1.673557003e-01f, -7.643188115e-01f, 8.785382293e-01f, -9.785312876e-01f, 1.681390048e-02f, -3.904843889e-01f, 9.125013918e-01f, 9.002380852e-01f, 5.891447579e-01f, 3.469105129e-01f, 1.979082420e-01f, 1.117973969e-01f, 6.295833377e-02f, 3.542009306e-02f, 1.992103142e-02f, 1.120292593e-02f
};

struct Args { const float* in[22]; float* out; unsigned char* ws; int ph_lo, ph_hi; };
struct Frame { LAS unsigned char* lds; int tid, lane, wave, vcu, G, bx; };
#define CAS __attribute__((address_space(4)))
typedef CAS const char* kptr_t;
__device__ __forceinline__ kptr_t kargp() { kptr_t kp = (kptr_t)__builtin_amdgcn_kernarg_segment_ptr(); asm volatile("" : "+s"(kp)); return kp; }
typedef const float* cfp_t; typedef float* fp_t; typedef unsigned char* ucp_t;
__device__ __forceinline__ const float* arg_in(int i) { return *(CAS const cfp_t*)(kargp() + 8 * i); }
__device__ __forceinline__ float* arg_out() { return *(CAS const fp_t*)(kargp() + 176); }
__device__ __forceinline__ unsigned char* arg_ws() { return *(CAS const ucp_t*)(kargp() + 184); }
__device__ __forceinline__ float wave_sum(float v) {
#pragma unroll
    for (int o = 1; o < 64; o <<= 1) v += __shfl_xor(v, o);
    return v;
}
__device__ __forceinline__ float silu_f(float v) { return v * __builtin_amdgcn_rcpf(1.0f + __builtin_amdgcn_exp2f(v * -1.4426950408889634f)); }

constexpr int TP_PITCH = 144;
constexpr int N_TILES = 768 + 512 + 512 + 96 * 256;
struct TileDesc { const float* src; bf16_t* dst; int N, k0, n0, drow0, fp8; };
__device__ __forceinline__ TileDesc p0_decode(int t) {
    TileDesc d; int it, kind = 0; d.fp8 = 0;
    if (t < 768) { d.src = arg_in(8); d.dst = (bf16_t*)(arg_ws() + WS_WIN0); d.N = 3072; it = t; kind = 1; }
    else if (t < 1280) { d.src = arg_in(12); d.dst = (bf16_t*)(arg_ws() + WS_WIN1); d.N = 2048; it = t - 768; }
    else if (t < 1792) { const int x = t - 1280, l = x >> 8; d.src = arg_in(16) + (size_t)l * DM * DM; d.dst = (bf16_t*)(arg_ws() + WS_WOUT) + (size_t)l * DM * DM; d.N = 1024; it = x & 255; }
    else { const int x = t - 1792, mat = x >> 8, which = mat >> 5, le = mat & 31; it = x & 255; d.N = 1024;
        d.src = arg_in(18 + which) + (size_t)le * DM * DM;
        d.fp8 = 1; const int l = le >> 4, e = le & 15;
        if (which == 2) d.dst = (bf16_t*)(arg_ws() + WS_WD + (size_t)l * 32 * MiB + (size_t)e * DM * DM); else { d.dst = (bf16_t*)(arg_ws() + WS_WGU + (size_t)l * 64 * MiB + (size_t)e * 2048 * DM); kind = 2 + which; } }
    const int nb = d.N >> 6, kb = it / nb, nblk = it - kb * nb; d.k0 = kb * 64; d.n0 = nblk * 64;
    int drow0 = d.n0;
    if (kind == 1) { if (d.n0 >= 2560) { const int c = d.n0 - 2560; drow0 = 2048 + (c >> 7) * 256 + 128 + (c & 127); } else if (d.n0 >= 2048) { const int c = d.n0 - 2048; drow0 = 2048 + (c >> 7) * 256 + (c & 127); } }
    else if (kind == 2) drow0 = (d.n0 >> 7) * 256 + (d.n0 & 127);
    else if (kind == 3) drow0 = (d.n0 >> 7) * 256 + 128 + (d.n0 & 127);
    d.drow0 = drow0; return d;
}
__device__ __forceinline__ void p0_tile_load(int t, int lane, f32x4 (&v)[16]) {
    const TileDesc d = p0_decode(t); const int nq = lane >> 2, kq = lane & 3;
    const float* s = d.src + (size_t)(d.k0 + 16 * kq) * d.N + d.n0 + 4 * nq;
#pragma unroll
    for (int i = 0; i < 16; ++i) v[i] = *(const f32x4*)(s + (size_t)i * d.N);
}
__device__ __forceinline__ void p0_tile_store(int t, int lane, const f32x4 (&v)[16], LAS unsigned char* T) {
    const TileDesc d = p0_decode(t); const int nq = lane >> 2, kq = lane & 3;
    if (d.fp8) {
#pragma unroll
        for (int j = 0; j < 4; ++j) { u32x4 w;
            w.x = pk4_fp8((f32x4){v[0][j], v[1][j], v[2][j], v[3][j]} * FP8_SW); w.y = pk4_fp8((f32x4){v[4][j], v[5][j], v[6][j], v[7][j]} * FP8_SW);
            w.z = pk4_fp8((f32x4){v[8][j], v[9][j], v[10][j], v[11][j]} * FP8_SW); w.w = pk4_fp8((f32x4){v[12][j], v[13][j], v[14][j], v[15][j]} * FP8_SW);
            *(LAS u32x4*)(T + (4 * nq + j) * 80 + 16 * kq) = w; }
        LDS_WAIT(); asm volatile("" ::: "memory");
        unsigned char* dp = (unsigned char*)d.dst + (size_t)(d.drow0 + (lane >> 2)) * DM + d.k0 + 16 * (lane & 3);
#pragma unroll
        for (int r = 0; r < 4; ++r) { const u32x4 w = *(const LAS u32x4*)(T + (16 * r + (lane >> 2)) * 80 + 16 * (lane & 3)); *(u32x4*)(dp + (size_t)(16 * r) * DM) = w; }
        LDS_WAIT(); asm volatile("" ::: "memory");
        return;
    }
#pragma unroll
    for (int j = 0; j < 4; ++j) { u32x4 w0, w1;
        w0.x = cvt_pk_bf16(v[0][j], v[1][j]); w0.y = cvt_pk_bf16(v[2][j], v[3][j]); w0.z = cvt_pk_bf16(v[4][j], v[5][j]); w0.w = cvt_pk_bf16(v[6][j], v[7][j]);
        w1.x = cvt_pk_bf16(v[8][j], v[9][j]); w1.y = cvt_pk_bf16(v[10][j], v[11][j]); w1.z = cvt_pk_bf16(v[12][j], v[13][j]); w1.w = cvt_pk_bf16(v[14][j], v[15][j]);
        LAS unsigned char* p = T + (4 * nq + j) * TP_PITCH + 32 * kq; *(LAS u32x4*)p = w0; *(LAS u32x4*)(p + 16) = w1; }
    LDS_WAIT(); asm volatile("" ::: "memory");
    bf16_t* dp = d.dst + (size_t)(d.drow0 + (lane >> 3)) * DM + d.k0 + 8 * (lane & 7);
#pragma unroll
    for (int r = 0; r < 8; ++r) { const u32x4 w = *(const LAS u32x4*)(T + (8 * r + (lane >> 3)) * TP_PITCH + 16 * (lane & 7)); *(u32x4*)(dp + (size_t)(8 * r) * DM) = w; }
    LDS_WAIT(); asm volatile("" ::: "memory");
}
__device__ __forceinline__ void p0_mod_block(Frame& F, int l, int cc, int kq4) {
    LAS float* sl = (LAS float*)F.lds;
    const int kbase = kq4 * 256;
    for (int idx = F.tid; idx < 17 * 256; idx += 512) { const int bb = idx >> 8, k = idx & 255; const float v = (bb < 16) ? arg_in(1)[bb * DM + kbase + k] : arg_in(3)[kbase + k]; sl[k * 20 + bb] = silu_f(v); }
    __syncthreads();
    const int ksub = F.lane >> 3, cq = F.lane & 7, j0 = cc * 256 + F.wave * 32 + 4 * cq;
    f32x4 acc[17];
#pragma unroll
    for (int bb = 0; bb < 17; ++bb) acc[bb] = (f32x4){0.f, 0.f, 0.f, 0.f};
    const float* wl = arg_in(4) + ((size_t)l * DM + kbase) * MODW; const unsigned loff = (unsigned)(ksub * MODW + j0);
#define MOD_LOAD(W, i0) do { _Pragma("unroll") for (int q = 0; q < 8; ++q) W[q] = *(const f32x4*)(wl + (size_t)(8 * ((i0) + q)) * MODW + loff); } while (0)
#define MOD_FMA(W, i0) do { _Pragma("unroll") for (int q = 0; q < 8; ++q) { const int k = 8 * ((i0) + q) + ksub; const f32x4 w = W[q]; \
        const f32x4 s0 = *(const LAS f32x4*)(sl + k * 20), s1 = *(const LAS f32x4*)(sl + k * 20 + 4), s2 = *(const LAS f32x4*)(sl + k * 20 + 8), s3 = *(const LAS f32x4*)(sl + k * 20 + 12); const float s4 = sl[k * 20 + 16]; \
        _Pragma("unroll") for (int z = 0; z < 4; ++z) { acc[z] += s0[z] * w; acc[4 + z] += s1[z] * w; acc[8 + z] += s2[z] * w; acc[12 + z] += s3[z] * w; } \
        acc[16] += s4 * w; __builtin_amdgcn_sched_barrier(0); } } while (0)
    { f32x4 wA[8], wB[8], wC[8], wD[8];
      MOD_LOAD(wA, 0); MOD_LOAD(wB, 8); MOD_LOAD(wC, 16); MOD_LOAD(wD, 24); asm volatile("" ::: "memory");
      MOD_FMA(wA, 0); MOD_FMA(wB, 8); MOD_FMA(wC, 16); MOD_FMA(wD, 24); }
#undef MOD_LOAD
#undef MOD_FMA
#pragma unroll
    for (int bb = 0; bb < 17; ++bb)
#pragma unroll
        for (int q = 0; q < 4; ++q) { float x = acc[bb][q]; x += __shfl_xor(x, 8); x += __shfl_xor(x, 16); x += __shfl_xor(x, 32); acc[bb][q] = x; }
    if (ksub == 0) { float* modp = (float*)(arg_ws() + WS_MODP) + ((size_t)(kq4 * 2 + l) * 17) * MODW + j0;
#pragma unroll
        for (int bb = 0; bb < 17; ++bb) *(f32x4*)(modp + (size_t)bb * MODW) = acc[bb]; }
    __syncthreads();
}
template <class MAP> __device__ __forceinline__ void p0_tiles(Frame& F0, int start, int end, const MAP& tile_of) {
    struct { LAS unsigned char* lds; int lane, wave; } F; { F.lds = F0.lds; F.lane = lane_id_now(); F.wave = F0.wave; }
    LAS unsigned char* T = F.lds + F.wave * (64 * TP_PITCH);
    f32x4 vA[16], vB[16];
    int t = start + F.wave;
    if (t < end) p0_tile_load(tile_of(t), F.lane, vA);
    while (t < end) {
        int t2 = t + NWAVES; if (t2 < end) p0_tile_load(tile_of(t2), F.lane, vB);
        p0_tile_store(tile_of(t), F.lane, vA, T);
        t = t2; if (t >= end) break;
        t2 = t + NWAVES; if (t2 < end) p0_tile_load(tile_of(t2), F.lane, vA);
        p0_tile_store(tile_of(t), F.lane, vB, T);
        t = t2;
    }
}
struct TileIdentity { __device__ __forceinline__ int operator()(int t) const { return t; } };
struct TileMoe { int c;
    __device__ __forceinline__ int operator()(int j) const {
        int l = 0, jj = j; if (j >= 48) { l = 1; jj = j - 48; }
        int mat, it;
        if (jj < 32) { const int g = c * 32 + jj; mat = (g >> 12) * 32 + l * 16 + ((g >> 8) & 15); it = g & 255; }
        else { const int g = c * 16 + (jj - 32); mat = 64 + l * 16 + (g >> 8); it = g & 255; }
        return 1792 + mat * 256 + it; } };
constexpr int N_TILES_DENSE = 768 + 512 + 512;
__device__ __forceinline__ void p0_prologue(Frame& F) {
    if ((F.vcu & 3) != 3) { const int m = (F.vcu >> 2) * 3 + (F.vcu & 3), kq4 = m & 3, lc = m >> 2; p0_mod_block(F, lc / 24, lc % 24, kq4); }
    p0_tiles(F, F.vcu * 7, F.vcu * 7 + 7, TileIdentity{});
}
__device__ __forceinline__ void p_moe_convert(Frame& F) {
    p0_tiles(F, N_TILES_DENSE + F.vcu * 96, N_TILES_DENSE + F.vcu * 96 + 96, TileIdentity{});
    __syncthreads();
}

__device__ __forceinline__ void st_row_bf16(bf16_t* orow, int lane, const f32x4 (&v)[4]) {
#pragma unroll
    for (int j = 0; j < 4; ++j) { u32x2 w; w.x = cvt_pk_bf16(v[j][0], v[j][1]); w.y = cvt_pk_bf16(v[j][2], v[j][3]); *(u32x2*)(orow + 4 * lane + 256 * j) = w; }
}
template <int NR> __device__ __forceinline__ void norm_rows(const float* const (&xr)[NR], bf16_t* const (&orow)[NR], int lane, const f32x4 (&A)[4], const f32x4 (&Bv)[4]) {
    f32x4 v[NR][4];
#pragma unroll
    for (int r = 0; r < NR; ++r)
#pragma unroll
        for (int j = 0; j < 4; ++j) v[r][j] = *(const f32x4*)(xr[r] + 4 * lane + 256 * j);
#pragma unroll
    for (int r = 0; r < NR; ++r) { float ss = 0.f;
#pragma unroll
        for (int j = 0; j < 4; ++j) ss += (v[r][j][0] * v[r][j][0] + v[r][j][1] * v[r][j][1]) + (v[r][j][2] * v[r][j][2] + v[r][j][3] * v[r][j][3]);
        const float rstd = __builtin_amdgcn_rsqf(wave_sum(ss) * (1.0f / DM) + NORM_EPS);
#pragma unroll
        for (int j = 0; j < 4; ++j) v[r][j] = v[r][j] * rstd * A[j] + Bv[j];
        st_row_bf16(orow[r], lane, v[r]); }
}
__device__ __forceinline__ void p1_norm_in(Frame& F) {
    const float* modp = (const float*)(arg_ws() + WS_MODP); const float* bmod = arg_in(5); float* modf = (float*)(arg_ws() + WS_MOD);
    for (int idx = F.vcu * 512 + F.tid; idx < 2 * 17 * MODW; idx += F.G * 512) { const int l = idx / (17 * MODW), r = idx - l * (17 * MODW), j = r % MODW; float s = bmod[l * MODW + j];
#pragma unroll
        for (int q = 0; q < 4; ++q) s += modp[(size_t)(q * 2 + l) * 17 * MODW + r];
        modf[idx] = s; }
    const int b = F.vcu >> 4; const float* n1 = arg_in(6);
    f32x4 A[4], Bv[4];
#define P1_COEF(BB) do { _Pragma("unroll") for (int j = 0; j < 4; ++j) { const int c = 4 * F.lane + 256 * j; f32x4 sh = *(const f32x4*)(bmod + c), sc = *(const f32x4*)(bmod + 1024 + c); \
        _Pragma("unroll") for (int q = 0; q < 4; ++q) { const float* pp = modp + ((size_t)(q * 2) * 17 + (BB)) * MODW; sh += *(const f32x4*)(pp + c); sc += *(const f32x4*)(pp + 1024 + c); } \
        A[j] = *(const f32x4*)(n1 + c) * (1.0f + sc); Bv[j] = sh; } } while (0)
    P1_COEF(b);
    bf16_t* H = (bf16_t*)(arg_ws() + WS_H); const float* X = arg_in(0);
    for (int i = 0; i < 16; i += 4) { const int row = F.vcu * 128 + F.wave + 8 * i;
        const float* const xr[4] = {X + (size_t)row * DM, X + (size_t)(row + 8) * DM, X + (size_t)(row + 16) * DM, X + (size_t)(row + 24) * DM};
        bf16_t* const orow[4] = {H + (size_t)row * DM, H + (size_t)(row + 8) * DM, H + (size_t)(row + 16) * DM, H + (size_t)(row + 24) * DM};
        norm_rows<4>(xr, orow, F.lane, A, Bv); }
    P1_COEF(16);
#undef P1_COEF
    bf16_t* HC = (bf16_t*)(arg_ws() + WS_HC); const float* XC = arg_in(2);
    { const int row = F.vcu * 16 + F.wave;
        const float* const xr[2] = {XC + (size_t)row * DM, XC + (size_t)(row + 8) * DM};
        bf16_t* const orow[2] = {HC + (size_t)row * DM, HC + (size_t)(row + 8) * DM};
        norm_rows<2>(xr, orow, F.lane, A, Bv); }
}

#ifndef RNR
#define RNR 2
#endif
__device__ __forceinline__ void router_finish(const float (&lg)[16], int lane, float* prow) {
    float a8[8], a4[4], a2[2], a1;
    { const bool up = (lane & 32) != 0;
#pragma unroll
      for (int q = 0; q < 8; ++q) { const float keep = up ? lg[q + 8] : lg[q], send = up ? lg[q] : lg[q + 8]; a8[q] = keep + __shfl_xor(send, 32); } }
    { const bool up = (lane & 16) != 0;
#pragma unroll
      for (int q = 0; q < 4; ++q) { const float keep = up ? a8[q + 4] : a8[q], send = up ? a8[q] : a8[q + 4]; a4[q] = keep + __shfl_xor(send, 16); } }
    { const bool up = (lane & 8) != 0;
#pragma unroll
      for (int q = 0; q < 2; ++q) { const float keep = up ? a4[q + 2] : a4[q], send = up ? a4[q] : a4[q + 2]; a2[q] = keep + __shfl_xor(send, 8); } }
    { const bool up = (lane & 4) != 0; const float keep = up ? a2[1] : a2[0], send = up ? a2[0] : a2[1]; a1 = keep + __shfl_xor(send, 4); }
    a1 += __shfl_xor(a1, 2); a1 += __shfl_xor(a1, 1);
    float mx = a1; mx = fmaxf(mx, __shfl_xor(mx, 4)); mx = fmaxf(mx, __shfl_xor(mx, 8)); mx = fmaxf(mx, __shfl_xor(mx, 16)); mx = fmaxf(mx, __shfl_xor(mx, 32));
    const float pe = __builtin_amdgcn_exp2f((a1 - mx) * 1.4426950408889634f);
    float sm = pe; sm += __shfl_xor(sm, 4); sm += __shfl_xor(sm, 8); sm += __shfl_xor(sm, 16); sm += __shfl_xor(sm, 32);
    const int e = ((lane >> 5) & 1) * 8 + ((lane >> 4) & 1) * 4 + ((lane >> 3) & 1) * 2 + ((lane >> 2) & 1);
    if ((lane & 3) == 0) prow[e] = pe / sm;
}
__device__ __forceinline__ void p_router(Frame& F, int l) {
    constexpr int WP = 2064;
    LAS unsigned char* WH = F.lds; LAS unsigned char* WL = F.lds + 16 * WP; LAS float* AC = (LAS float*)(F.lds + 32 * WP); LAS float* BC = AC + DM;
    const float* wsrc = arg_in(17) + (size_t)l * DM * NE;
    for (int idx = F.tid; idx < DM * NE; idx += 512) { const int k = idx >> 4, e = idx & 15; const float w = wsrc[idx]; const unsigned hi = cvt_pk_bf16(w, w) & 0xffffu; const float rem = w - __uint_as_float(hi << 16);
        *(LAS unsigned short*)(WH + e * WP + k * 2) = (unsigned short)hi; *(LAS unsigned short*)(WL + e * WP + k * 2) = (unsigned short)(cvt_pk_bf16(rem, rem) & 0xffffu); }
    const int b = F.vcu >> 4; const float* mod = (const float*)(arg_ws() + WS_MOD) + ((size_t)l * 17 + b) * MODW; const float* n2 = arg_in(7) + l * DM;
    for (int k = F.tid; k < DM; k += 512) { AC[k] = n2[k] * (1.0f + mod[4096 + k]); BC[k] = mod[3072 + k]; }
    __syncthreads();
    const int lane = F.lane, r = lane & 15, kq = lane >> 4, row = F.vcu * 128 + F.wave * 16 + r;
    const bf16_t* xr = (l ? (const bf16_t*)(arg_ws() + WS_X3) : (const bf16_t*)arg_out()) + (size_t)row * DM + kq * 8; unsigned char* hr = (unsigned char*)(arg_ws() + WS_H) + (size_t)row * DM + kq * 8;
    const LAS unsigned char* whp = WH + r * WP + kq * 16; const LAS unsigned char* wlp = WL + r * WP + kq * 16; const LAS float* acp = AC + kq * 8; const LAS float* bcp = BC + kq * 8;
    f32x4 acc = (f32x4){0.f, 0.f, 0.f, 0.f};
    u32x4 xs[32];
#pragma unroll
    for (int q = 0; q < 32; ++q) xs[q] = *(const u32x4*)(xr + 32 * q);
    asm volatile("" ::: "memory");
    float rstd; { f32x2 s0 = {0.f, 0.f}, s1 = {0.f, 0.f}, s2 = {0.f, 0.f}, s3 = {0.f, 0.f};
#pragma unroll
        for (int q = 0; q < 32; ++q) { const f32x2 v0 = {bflo(xs[q].x), bfhi(xs[q].x)}, v1 = {bflo(xs[q].y), bfhi(xs[q].y)}, v2 = {bflo(xs[q].z), bfhi(xs[q].z)}, v3 = {bflo(xs[q].w), bfhi(xs[q].w)};
            s0 += v0 * v0; s1 += v1 * v1; s2 += v2 * v2; s3 += v3 * v3; }
        const f32x2 st = (s0 + s1) + (s2 + s3); float sq = st.x + st.y; sq += __shfl_xor(sq, 16); sq += __shfl_xor(sq, 32);
        rstd = __builtin_amdgcn_rsqf(sq * (1.0f / DM) + NORM_EPS); }
#pragma unroll
    for (int q = 0; q < 32; ++q) asm volatile("" : "+v"(xs[q]));
#define RT_STEP1(X, s) do { \
        const f32x4 a0 = *(const LAS f32x4*)(acp + 32 * (s)), a1 = *(const LAS f32x4*)(acp + 32 * (s) + 4), c0 = *(const LAS f32x4*)(bcp + 32 * (s)), c1 = *(const LAS f32x4*)(bcp + 32 * (s) + 4); \
        const f32x4 x0 = (f32x4){bflo(X.x), bfhi(X.x), bflo(X.y), bfhi(X.y)}, x1 = (f32x4){bflo(X.z), bfhi(X.z), bflo(X.w), bfhi(X.w)}; \
        const f32x4 h0 = x0 * rstd * a0 + c0, h1 = x1 * rstd * a1 + c1; \
        u32x4 hw; hw.x = cvt_pk_bf16(h0[0], h0[1]); hw.y = cvt_pk_bf16(h0[2], h0[3]); hw.z = cvt_pk_bf16(h1[0], h1[1]); hw.w = cvt_pk_bf16(h1[2], h1[3]); \
        { u32x2 h8_; h8_.x = pk4_fp8(h0 * FP8_SA); h8_.y = pk4_fp8(h1 * FP8_SA); *(u32x2*)(hr + 32 * (s)) = h8_; } \
        u32x4 lw; lw.x = cvt_pk_bf16(h0[0] - bflo(hw.x), h0[1] - bfhi(hw.x)); lw.y = cvt_pk_bf16(h0[2] - bflo(hw.y), h0[3] - bfhi(hw.y)); lw.z = cvt_pk_bf16(h1[0] - bflo(hw.z), h1[1] - bfhi(hw.z)); lw.w = cvt_pk_bf16(h1[2] - bflo(hw.w), h1[3] - bfhi(hw.w)); \
        const bf16x8 wh = *(const LAS bf16x8*)(whp + 64 * (s)), wl = *(const LAS bf16x8*)(wlp + 64 * (s)); const bf16x8 ah = *reinterpret_cast<const bf16x8*>(&hw), al = *reinterpret_cast<const bf16x8*>(&lw); \
        acc = __builtin_amdgcn_mfma_f32_16x16x32_bf16(ah, wh, acc, 0, 0, 0); acc = __builtin_amdgcn_mfma_f32_16x16x32_bf16(ah, wl, acc, 0, 0, 0); acc = __builtin_amdgcn_mfma_f32_16x16x32_bf16(al, wh, acc, 0, 0, 0); } while (0)
#pragma unroll
    for (int s = 0; s < 32; ++s) RT_STEP1(xs[s], s);
#undef RT_STEP1
    float* probs = (float*)(arg_ws() + WS_PROBS) + (size_t)(F.vcu * 128 + F.wave * 16 + 4 * kq) * 16 + r;
#pragma unroll
    for (int i = 0; i < 4; ++i) { const float lg = acc[i]; float mx = lg; mx = fmaxf(mx, __shfl_xor(mx, 1)); mx = fmaxf(mx, __shfl_xor(mx, 2)); mx = fmaxf(mx, __shfl_xor(mx, 4)); mx = fmaxf(mx, __shfl_xor(mx, 8));
        const float pe = __builtin_amdgcn_exp2f((lg - mx) * 1.4426950408889634f); float sm = pe; sm += __shfl_xor(sm, 1); sm += __shfl_xor(sm, 2); sm += __shfl_xor(sm, 4); sm += __shfl_xor(sm, 8);
        probs[i * 16] = pe / sm; }
}

__device__ __forceinline__ void p_topk(Frame& F, const int e, const int b) {
    const int pm = e * 16 + b, lane = F.lane;
    LAS unsigned* hist = (LAS unsigned*)F.lds;
    LAS unsigned* wtot = (LAS unsigned*)(F.lds + 4096);
    LAS unsigned* sel = (LAS unsigned*)(F.lds + 4096 + 64);
    LAS int* idxs = (LAS int*)(F.lds + 8192);
    const float* probs = (const float*)(arg_ws() + WS_PROBS) + ((size_t)b * SEQ + 4 * F.tid) * 16 + e;
    unsigned u[4];
#pragma unroll
    for (int q = 0; q < 4; ++q) u[q] = __float_as_uint(probs[q * 16]);
    unsigned prefix = 0, need = CAP;
#pragma unroll 1
    for (int pass = 0; pass < 3; ++pass) {
        const int shift = 20 - 10 * pass;
        hist[F.tid] = 0; hist[F.tid + 512] = 0;
        __syncthreads();
#pragma unroll
        for (int q = 0; q < 4; ++q) if (pass == 0 || (u[q] >> (shift + 10)) == prefix) (void)__hip_atomic_fetch_add(&hist[(u[q] >> shift) & 1023u], 1u, __ATOMIC_RELAXED, __HIP_MEMORY_SCOPE_WORKGROUP);
        __syncthreads();
        if (F.wave == 0) {
            const u32x4 c0 = *(const LAS u32x4*)(hist + 16 * lane), c1 = *(const LAS u32x4*)(hist + 16 * lane + 4), c2 = *(const LAS u32x4*)(hist + 16 * lane + 8), c3 = *(const LAS u32x4*)(hist + 16 * lane + 12);
            const unsigned tot = ((c0.x + c0.y) + (c0.z + c0.w)) + ((c1.x + c1.y) + (c1.z + c1.w)) + ((c2.x + c2.y) + (c2.z + c2.w)) + ((c3.x + c3.y) + (c3.z + c3.w));
            unsigned incl = tot;
#pragma unroll
            for (int d = 1; d < 64; d <<= 1) { const unsigned o = __shfl_down(incl, d); if (lane + d < 64) incl += o; }
            const unsigned above = incl - tot;
            if (above < need && need <= above + tot) {
                unsigned run = above, fb = 0, fr = 0;
#define TK_BIN(k, cv) { if (run < need && need <= run + (cv)) { fb = (unsigned)(k); fr = need - run; } run += (cv); }
                TK_BIN(15, c3.w) TK_BIN(14, c3.z) TK_BIN(13, c3.y) TK_BIN(12, c3.x) TK_BIN(11, c2.w) TK_BIN(10, c2.z) TK_BIN(9, c2.y) TK_BIN(8, c2.x)
                TK_BIN(7, c1.w) TK_BIN(6, c1.z) TK_BIN(5, c1.y) TK_BIN(4, c1.x) TK_BIN(3, c0.w) TK_BIN(2, c0.z) TK_BIN(1, c0.y) TK_BIN(0, c0.x)
#undef TK_BIN
                sel[0] = (prefix << 10) | (16u * lane + fb); sel[1] = fr;
            }
        }
        __syncthreads();
        prefix = sel[0]; need = sel[1];
    }
    unsigned cnt = 0;
#pragma unroll
    for (int q = 0; q < 4; ++q) cnt += (u[q] > prefix ? 1u : 0u) + (u[q] == prefix ? 0x10000u : 0u);
    unsigned inc = cnt;
#pragma unroll
    for (int d = 1; d < 64; d <<= 1) { const unsigned o = __shfl_up(inc, d); if (lane >= d) inc += o; }
    if (lane == 63) wtot[F.wave] = inc;
    __syncthreads();
    unsigned run = inc - cnt;
#pragma unroll
    for (int w = 0; w < 8; ++w) run += (w < F.wave) ? wtot[w] : 0u;
    float* vals = (float*)(arg_ws() + WS_VALS) + (size_t)pm * CAP; int* slotg = (int*)(arg_ws() + WS_SLOT) + ((size_t)b * SEQ + 4 * F.tid) * 16 + e;
#pragma unroll
    for (int q = 0; q < 4; ++q) { const unsigned gtb = run & 0xffffu, eqb = run >> 16; const bool gt = u[q] > prefix, eq = u[q] == prefix, s_ = gt || (eq && eqb < need);
        const int sl = s_ ? (int)(gtb + (eqb < need ? eqb : need)) : -1;
        slotg[q * 16] = sl;
        if (s_) { idxs[sl] = 4 * F.tid + q; vals[sl] = __uint_as_float(u[q]); }
        run += (gt ? 1u : 0u) + (eq ? 0x10000u : 0u); }
    __syncthreads();
    { const int R0 = (F.tid >> 7) * 16 + ((F.tid & 63) >> 2);
      const unsigned a0 = (unsigned)idxs[R0], a1 = (unsigned)idxs[R0 + 64], b0 = (unsigned)idxs[128 + R0], b1 = (unsigned)idxs[192 + R0];
      ((u32x2*)(arg_ws() + WS_GPK))[(size_t)pm * 512 + F.tid] = (u32x2){a0 | (a1 << 16), b0 | (b1 << 16)}; }
}

__device__ __forceinline__ void p_combine(Frame& F, int l, bool fin) {
    const int b = F.vcu >> 4, lane = F.lane; const float* mod = (const float*)(arg_ws() + WS_MOD) + ((size_t)l * 17 + b) * MODW;
    f32x4 G2[2][2], A[2][2], Bv[2][2];
#pragma unroll
    for (int j = 0; j < 2; ++j)
#pragma unroll
        for (int h = 0; h < 2; ++h) { const int c = 8 * lane + 512 * j + 4 * h; G2[j][h] = *(const f32x4*)(mod + 5120 + c) * (1.0f / FP8_SY);
            if (fin) { A[j][h] = *(const f32x4*)(arg_in(21) + c); Bv[j][h] = (f32x4){0.f, 0.f, 0.f, 0.f}; }
            else { const float* mod1 = (const float*)(arg_ws() + WS_MOD) + ((size_t)(l + 1) * 17 + b) * MODW; A[j][h] = *(const f32x4*)(arg_in(6) + (l + 1) * DM + c) * (1.0f + *(const f32x4*)(mod1 + 1024 + c)); Bv[j][h] = *(const f32x4*)(mod1 + c); } }
    const int* slotg = (const int*)(arg_ws() + WS_SLOT); const unsigned char* Y = (const unsigned char*)(arg_ws() + WS_Y); bf16_t* H = (bf16_t*)(arg_ws() + WS_H);
    const bf16_t* XI = fin ? (const bf16_t*)(arg_ws() + WS_X3) : (const bf16_t*)arg_out(); bf16_t* XO = (bf16_t*)(arg_ws() + WS_X2); float* OUT = arg_out();
    for (int i = 0; i < 16; ++i) { const int row = F.vcu * 128 + F.wave + 8 * i; const bf16_t* xr = XI + (size_t)row * DM + 8 * lane;
        f32x4 v[2][2], acc[2][2];
#pragma unroll
        for (int j = 0; j < 2; ++j) { const u32x4 w = *(const u32x4*)(xr + 512 * j); v[j][0] = (f32x4){bflo(w.x), bfhi(w.x), bflo(w.y), bfhi(w.y)}; v[j][1] = (f32x4){bflo(w.z), bfhi(w.z), bflo(w.w), bfhi(w.w)};
            acc[j][0] = (f32x4){0.f, 0.f, 0.f, 0.f}; acc[j][1] = (f32x4){0.f, 0.f, 0.f, 0.f}; }
        const int sl = lane < 16 ? slotg[(size_t)row * 16 + lane] : -1;
#pragma unroll
        for (int e = 0; e < 16; ++e) { const int s = __builtin_amdgcn_readlane(sl, e);
            if (s >= 0) { const unsigned char* yr = Y + ((size_t)(e * 16 + b) * CAP + s) * DM + 8 * lane;
#pragma unroll
                for (int j = 0; j < 2; ++j) { const u32x2 w = *(const u32x2*)(yr + 512 * j);
                    const f32x2 p0 = __builtin_amdgcn_cvt_pk_f32_fp8((int)w.x, false), p1 = __builtin_amdgcn_cvt_pk_f32_fp8((int)w.x, true), p2 = __builtin_amdgcn_cvt_pk_f32_fp8((int)w.y, false), p3 = __builtin_amdgcn_cvt_pk_f32_fp8((int)w.y, true);
                    acc[j][0] += (f32x4){p0.x, p0.y, p1.x, p1.y}; acc[j][1] += (f32x4){p2.x, p2.y, p3.x, p3.y}; } } }
        float ss = 0.f;
#pragma unroll
        for (int j = 0; j < 2; ++j)
#pragma unroll
            for (int h = 0; h < 2; ++h) { v[j][h] = v[j][h] + G2[j][h] * acc[j][h]; ss += (v[j][h][0] * v[j][h][0] + v[j][h][1] * v[j][h][1]) + (v[j][h][2] * v[j][h][2] + v[j][h][3] * v[j][h][3]); }
        const float rstd = __builtin_amdgcn_rsqf(wave_sum(ss) * (1.0f / DM) + NORM_EPS);
        if (!fin) {
#pragma unroll
            for (int j = 0; j < 2; ++j) { u32x4 w; w.x = cvt_pk_bf16(v[j][0][0], v[j][0][1]); w.y = cvt_pk_bf16(v[j][0][2], v[j][0][3]); w.z = cvt_pk_bf16(v[j][1][0], v[j][1][1]); w.w = cvt_pk_bf16(v[j][1][2], v[j][1][3]);
                *(u32x4*)(XO + (size_t)row * DM + 8 * lane + 512 * j) = w; }
#pragma unroll
            for (int j = 0; j < 2; ++j) { const f32x4 h0 = v[j][0] * rstd * A[j][0] + Bv[j][0], h1 = v[j][1] * rstd * A[j][1] + Bv[j][1];
                u32x4 w; w.x = cvt_pk_bf16(h0[0], h0[1]); w.y = cvt_pk_bf16(h0[2], h0[3]); w.z = cvt_pk_bf16(h1[0], h1[1]); w.w = cvt_pk_bf16(h1[2], h1[3]);
                *(u32x4*)(H + (size_t)row * DM + 8 * lane + 512 * j) = w; }
        } else {
#pragma unroll
            for (int j = 0; j < 2; ++j)
#pragma unroll
                for (int h = 0; h < 2; ++h) *(f32x4*)(OUT + (size_t)row * DM + 8 * lane + 512 * j + 4 * h) = v[j][h] * rstd * A[j][h];
        }
    }
}

__device__ __forceinline__ void p_conv(Frame& F) {
    bf16_t* MIX = (bf16_t*)(arg_ws() + WS_MIX);
    const bf16_t* Z = (const bf16_t*)(arg_ws() + WS_Z); const bf16_t* GB = (const bf16_t*)(arg_ws() + WS_GB); const float* cw = arg_in(11);
    int c8 = F.lane * 8; asm volatile("" : "+v"(c8));
    f32x4 w0a = *(const f32x4*)(cw + c8), w0b = *(const f32x4*)(cw + c8 + 4), w1a = *(const f32x4*)(cw + 512 + c8), w1b = *(const f32x4*)(cw + 512 + c8 + 4), w2a = *(const f32x4*)(cw + 1024 + c8), w2b = *(const f32x4*)(cw + 1024 + c8 + 4);
    for (int rep_ = 0; rep_ < 1 + ((SUBREP >> 1) & 1); ++rep_)
#pragma unroll 1
    for (int it = 0; it < 4; ++it) { const int r0 = F.vcu * 128 + F.wave * 16 + it * 4;
        const bool lo_ok = (r0 & (SEQ - 1)) != 0, hi_ok = ((r0 + 4) & (SEQ - 1)) != 0;
        u32x4 z[6], g[4];
#pragma unroll
        for (int k = 0; k < 6; ++k) { int rr = r0 - 1 + k; rr = rr < 0 ? 0 : (rr > MROWS - 1 ? MROWS - 1 : rr); z[k] = *(const u32x4*)(Z + (size_t)rr * 512 + c8); }
#pragma unroll
        for (int k = 0; k < 4; ++k) g[k] = *(const u32x4*)(GB + (size_t)(r0 + k) * 512 + c8);
        if (!lo_ok) z[0] = (u32x4){0u, 0u, 0u, 0u};
        if (!hi_ok) z[5] = (u32x4){0u, 0u, 0u, 0u};
#pragma unroll
        for (int j = 0; j < 4; ++j) { const u32x4 zp = z[j], zc = z[j + 1], zn = z[j + 2], gb = g[j];
            f32x4 ra, rb;
#define CONV2(k, R, W0, W1, W2, i0) R[i0] = bflo(gb[k]) * (W0[i0] * bflo(zp[k]) + W1[i0] * bflo(zc[k]) + W2[i0] * bflo(zn[k])); R[i0 + 1] = bfhi(gb[k]) * (W0[i0 + 1] * bfhi(zp[k]) + W1[i0 + 1] * bfhi(zc[k]) + W2[i0 + 1] * bfhi(zn[k]));
            CONV2(0, ra, w0a, w1a, w2a, 0) CONV2(1, ra, w0a, w1a, w2a, 2) CONV2(2, rb, w0b, w1b, w2b, 0) CONV2(3, rb, w0b, w1b, w2b, 2)
#undef CONV2
            pg8::st8bf(MIX + (size_t)(r0 + j) * 1024 + 512 + c8, ra, rb); } }
}

__device__ __forceinline__ void p_attn_conv(Frame& F) {
    const float* lp = arg_in(9); float s1 = 0.f, s2 = 0.f;
    for (int i = 0; i < 64; ++i) { s1 += lp[i] * lp[64 + i]; s2 += lp[128 + i] * lp[192 + i]; }
    const float lam = __expf(s1) - __expf(s2) + 0.2f;
    const bf16_t* Q = (const bf16_t*)(arg_ws() + WS_Q); const bf16_t* Kb = (const bf16_t*)(arg_ws() + WS_K); const bf16_t* Vb = (const bf16_t*)(arg_ws() + WS_V); bf16_t* MIX = (bf16_t*)(arg_ws() + WS_MIX);
    PROF_BEGIN(1)
    for (int rep_ = 0; rep_ < 1 + (SUBREP & 1); ++rep_)
    for (int i = 0; i < 4; ++i) { const int bh = (F.vcu >> 5) * 8 + i * 2 + ((F.vcu >> 4) & 1), qb = F.vcu & 15, b = bh >> 2, h = bh & 3;
        if (MOE_CVT_IN_ATTN && rep_ == 0 && (CVT_CLASS(F.vcu)) == i) p_moe_convert(F);
        att::attn_unit(Q + ((size_t)b * SEQ + qb * 128) * 512 + h * 128, Kb + (size_t)bh * SKV * 128, Vb + (size_t)bh * SKV * 128,
                       MIX + ((size_t)b * SEQ + qb * 128) * 1024 + h * 128, lam, arg_in(10), F.lds, F.wave); }
    PROF_END(1, F.lds)
}

__device__ __forceinline__ void p_spatial(Frame& F) {
    using namespace att;
    const int tid = F.tid, wid = F.wave, lane = F.lane, r32 = lane & 31, hi = lane >> 5, qw = wid & 3, wh = wid >> 2;
    const int b = F.vcu >> 4, ck = F.vcu & 15, R0 = b * SEQ + ck * 128;
    LAS unsigned char* Vl = F.lds; LAS float* rs = (LAS float*)(F.lds + 131072 + 2048);
    const float* ssqv = (const float*)(arg_ws() + WS_SSQ);
    if (tid < 128) { float s = 0.f; for (int q = 0; q < 16; ++q) s += ssqv[(size_t)q * MROWS + R0 + tid]; rs[tid] = __builtin_amdgcn_rsqf(s * (1.0f / DM) + NORM_EPS); }
    const bf16_t* VV = (const bf16_t*)(arg_ws() + WS_VV); const bf16_t* U = (const bf16_t*)(arg_ws() + WS_U); bf16_t* MIX1 = (bf16_t*)(arg_ws() + WS_MIX1);
    const int sr = tid >> 4, sc = (tid & 15) * 8;
    constexpr int SP = 512;
    const int erow = tid >> 5, ecol = (tid & 31) * 8;
    u32x4 t[8];
    const unsigned vlo = (unsigned)((sr * DM + sc) * 2), ulo = (unsigned)((erow * DM + ecol) * 2);
#define SP_LOAD(g) do { _Pragma("unroll") for (int it = 0; it < 8; ++it) { const int buf = it >> 1, jh = buf >> 1, whh = buf & 1; \
        t[it] = *(const u32x4*)((const char*)VV + ((size_t)(R0 + jh * 64 + 32 * (it & 1)) * DM + (g) * 256 + whh * 128) * 2 + vlo); } } while (0)
    SP_LOAD(0);
    u32x4 uu[8], un[8];
#define UU_LOAD(X, g) do { _Pragma("unroll") for (int it = 0; it < 8; ++it) X[it] = *(const u32x4*)((const char*)U + ((size_t)(R0 + 16 * it) * DM + (g) * 256) * 2 + ulo); } while (0)
    UU_LOAD(uu, 0);
#pragma unroll 1
    for (int g = 0; g < 4; ++g) {
        LAS unsigned char* Vb = Vl + (g & 1) * 65536;
        const float* wsg = arg_in(14) + ((size_t)g * 128 + 32 * qw + r32) * 128;
        f32x4 wf[2][4][2];
#pragma unroll
        for (int jh = 0; jh < 2; ++jh)
#pragma unroll
            for (int ks = 0; ks < 4; ++ks) { const int j = jh * 64 + ks * 16 + hi * 8; wf[jh][ks][0] = *(const f32x4*)(wsg + j); wf[jh][ks][1] = *(const f32x4*)(wsg + j + 4); }
#pragma unroll
        for (int it = 0; it < 8; ++it) { const int buf = it >> 1, k = sr + 32 * (it & 1); *(LAS u32x4*)(Vb + buf * 16384 + v_st(k, sc)) = t[it]; }
        __syncthreads();
        { const int gn = g < 3 ? g + 1 : 3; SP_LOAD(gn); UU_LOAD(un, gn); }
        bf16x8 pa[2][4];
#pragma unroll
        for (int jh = 0; jh < 2; ++jh)
#pragma unroll
            for (int ks = 0; ks < 4; ++ks) { const int j = jh * 64 + ks * 16 + hi * 8; const f32x4 ra = *(const LAS f32x4*)(rs + j), rb = *(const LAS f32x4*)(rs + j + 4);
                const f32x4 xa = wf[jh][ks][0] * ra, xb = wf[jh][ks][1] * rb; u32x4 w; w.x = cvtpk(xa[0], xa[1]); w.y = cvtpk(xa[2], xa[3]); w.z = cvtpk(xb[0], xb[1]); w.w = cvtpk(xb[2], xb[3]); pa[jh][ks] = *reinterpret_cast<bf16x8*>(&w); }
        asm volatile("" ::: "memory");
        f32x16 o[4] = {};
        const int vb0 = (int)(uintptr_t)Vb + v_rd_base(lane);
#pragma unroll
        for (int jh = 0; jh < 2; ++jh) pv_d0(o, vb0 + (jh * 2 + wh) * 16384, pa[jh][0], pa[jh][1], pa[jh][2], pa[jh][3]);
        const float* vn = arg_in(13); const float* bs = arg_in(15) + g * 128 + 32 * qw;
        float bsv[16];
#pragma unroll
        for (int r = 0; r < 16; ++r) bsv[r] = bs[crow(r, hi)];
        __syncthreads();
#pragma unroll
        for (int d0 = 0; d0 < 4; ++d0) { const int colg = wh * 128 + 32 * d0 + r32; const float vnc = vn[g * 256 + colg];
#pragma unroll
            for (int r = 0; r < 16; ++r) { const float sv = o[d0][r] * vnc + bsv[r]; *(LAS unsigned short*)(Vb + (32 * qw + crow(r, hi)) * SP + colg * 2) = (unsigned short)(cvtpk(sv, sv) & 0xffffu); } }
        __syncthreads();
#pragma unroll
        for (int it = 0; it < 8; ++it) { const u32x4 sv = *(const LAS u32x4*)(Vb + (erow + 16 * it) * SP + ecol * 2); const u32x4 u4 = uu[it];
            f32x4 ra, rb; ra[0] = bflo(u4.x) * bflo(sv.x); ra[1] = bfhi(u4.x) * bfhi(sv.x); ra[2] = bflo(u4.y) * bflo(sv.y); ra[3] = bfhi(u4.y) * bfhi(sv.y);
            rb[0] = bflo(u4.z) * bflo(sv.z); rb[1] = bfhi(u4.z) * bfhi(sv.z); rb[2] = bflo(u4.w) * bflo(sv.w); rb[3] = bfhi(u4.w) * bfhi(sv.w);
            pg8::st8bf((bf16_t*)((char*)MIX1 + ((size_t)(R0 + 16 * it) * DM + g * 256) * 2 + ulo), ra, rb); }
#pragma unroll
        for (int it = 0; it < 8; ++it) uu[it] = un[it];
    }
#undef SP_LOAD
#undef UU_LOAD
}

__device__ __forceinline__ void gemm_skew(Frame& F) { if (GEMM_SKEW > 0 && ((F.vcu >> 3) & 1)) { const unsigned long long t0 = __builtin_amdgcn_s_memrealtime(); while (__builtin_amdgcn_s_memrealtime() - t0 < (unsigned long long)GEMM_SKEW) __builtin_amdgcn_s_sleep(8); } }

__global__ void __launch_bounds__(NWAVES * 64, 2) fwd_kernel(Args args) {
    extern __shared__ __attribute__((aligned(16))) unsigned char lds[];
    Frame F;
    const int wave0 = __builtin_amdgcn_readfirstlane((int)(threadIdx.x >> 6));
    F.lds = (LAS unsigned char*)lds; F.wave = wave0; F.lane = lane_id_now(); F.tid = wave0 * 64 + F.lane;
    F.G = gridDim.x; F.bx = blockIdx.x; F.vcu = (F.bx % 8) * (F.G / 8) + F.bx / 8;
    volatile LAS unsigned* MISC = (volatile LAS unsigned*)(F.lds + MISC_OFF);
    for (int u = F.tid; u < (LDS_BYTES - LDSCTL_OFF) / 4; u += NWAVES * 64) ((LAS unsigned*)(F.lds + LDSCTL_OFF))[u] = 0u;
    __syncthreads();
    XcdBarrier bar; bar.bar = (unsigned*)(arg_ws() + WS_CTL) + CW_BAR; bar.x = 0; bar.st = nullptr; bar.w = wave0;
    const int lo = args.ph_lo, hi = args.ph_hi;
    if (hi - lo > 1) bar = xcd_barrier_post((unsigned*)(arg_ws() + WS_CTL) + CW_BAR, MISC + 8, wave0);
    if (wave0 == 0 && F.lane == 0) (void)xb_add((unsigned*)(arg_ws() + WS_CTL) + CW_GRP + (F.vcu >> 4) * 128 + xb_xcc_id(), 1u);
    LAS unsigned char* ring = (LAS unsigned char*)lds;
#define RELAUNDER() do { int w_ = wave0; asm volatile("" : "+s"(w_)); F.wave = w_; F.lane = lane_id_now(); F.tid = w_ * 64 + F.lane; \
        int bx_ = blockIdx.x; asm volatile("" : "+s"(bx_)); F.bx = bx_; F.vcu = (bx_ % 8) * (F.G / 8) + bx_ / 8; } while (0)
#define RUN_PHASE(K, ...) if (lo <= (K) && (K) < hi && ((PHMASK_FULL >> (K)) & 1)) { \
        for (int rep_ph = 0; rep_ph <= (int)((REPMASK >> (K)) & 1); ++rep_ph) { RELAUNDER(); \
            if (PROF_ID != 0 && PROF_PH >= 0) { if (F.tid == 0) *(LAS int*)(F.lds + PROF_LDS_OFF + 128) = (K); __syncthreads(); } \
            { PROF_BEGIN(20) __VA_ARGS__ PROF_END(20, F.lds) } \
            if (rep_ph < (int)((REPMASK >> (K)) & 1) || (K) + 1 < hi) { PROF_BEGIN(30) xcd_barrier(bar); PROF_END(30, F.lds) } } }
#define MOE_PHASES(L, K0) \
      \
    RUN_PHASE((K0) + 0, { p_router(F, (L)); group_barrier((unsigned*)(arg_ws() + WS_CTL) + CW_GRP + (F.vcu >> 4) * 128, (L), F.wave); p_topk(F, F.vcu & 15, F.vcu >> 4); }) \
    RUN_PHASE((K0) + 2, { pg8::SchedMoeGather8 S{(const char*)(arg_ws() + WS_H), (const char*)(arg_ws() + WS_WGU) + (size_t)(L) * 64 * MiB, F.G, F.bx}; \
                  pg8::EpiGateUp8 E{(unsigned char*)(arg_ws() + WS_ACT)}; \
                  pg8::gemm_phase<pg8::EpiGateUp8, pg8::SchedMoeGather8, GEMM_ALIGN_GU, true, true, true>(ring, DM, S, E, F.tid, (const int*)(arg_ws() + WS_GPK)); }) \
    RUN_PHASE((K0) + 3, { pg8::SchedMoe8 S{(const char*)(arg_ws() + WS_ACT), (const char*)(arg_ws() + WS_WD) + (size_t)(L) * 32 * MiB, 4, F.G, F.bx}; \
                  pg8::EpiDown8 E{(unsigned char*)(arg_ws() + WS_Y), (const float*)(arg_ws() + WS_VALS)}; \
                  pg8::gemm_phase<pg8::EpiDown8, pg8::SchedMoe8, GEMM_ALIGN_DN, true, false, true>(ring, DM, S, E, F.tid); }) \
    RUN_PHASE((K0) + 4, { p_combine(F, (L), (L) == 1); })

    RUN_PHASE(0, { p0_prologue(F); })
    RUN_PHASE(1, { p1_norm_in(F); })
    RUN_PHASE(2, { pg8::SchedInProj S{(const char*)(arg_ws() + WS_H), (const char*)(arg_ws() + WS_HC), (const char*)(arg_ws() + WS_WIN0), F.G, F.bx};
                  pg8::EpiInProj E{(bf16_t*)(arg_ws() + WS_Q), (bf16_t*)(arg_ws() + WS_K), (bf16_t*)(arg_ws() + WS_V), (bf16_t*)(arg_ws() + WS_GB), (bf16_t*)(arg_ws() + WS_Z), ROPE_TAB};
                  pg8::gemm_phase<pg8::EpiInProj, pg8::SchedInProj, GEMM_ALIGN, true>(ring, DM, S, E, F.tid); })
    RUN_PHASE(3, { p_conv(F); RELAUNDER(); p_attn_conv(F); })
    RUN_PHASE(4, { pg8::SchedSimple S{(const char*)(arg_ws() + WS_MIX), (const char*)(arg_ws() + WS_WOUT), 128, 4, F.G, F.bx};
                  pg8::EpiOutProj<true> E{(const void*)arg_in(0), (bf16_t*)arg_out(), (const float*)(arg_ws() + WS_MOD) + 2048, (float*)(arg_ws() + WS_SSQ)};
                  pg8::gemm_phase<pg8::EpiOutProj<true>, pg8::SchedSimple, GEMM_ALIGN, true>(ring, DM, S, E, F.tid); })
    MOE_PHASES(0, 5)
    RUN_PHASE(10, { pg8::SchedSimple S{(const char*)(arg_ws() + WS_H), (const char*)(arg_ws() + WS_WIN1), 128, 8, F.G, F.bx};
                  pg8::EpiOddIn E{(bf16_t*)(arg_ws() + WS_U), (bf16_t*)(arg_ws() + WS_VV), (float*)(arg_ws() + WS_SSQ)};
                  pg8::gemm_phase<pg8::EpiOddIn, pg8::SchedSimple, GEMM_ALIGN, true>(ring, DM, S, E, F.tid); })
    RUN_PHASE(11, { p_spatial(F); })
    RUN_PHASE(12, { pg8::SchedSimple S{(const char*)(arg_ws() + WS_MIX1), (const char*)(arg_ws() + WS_WOUT) + (size_t)DM * DM * 2, 128, 4, F.G, F.bx};
                  pg8::EpiOutProj<false> E{(const void*)(arg_ws() + WS_X2), (bf16_t*)(arg_ws() + WS_X3), (const float*)(arg_ws() + WS_MOD) + (size_t)17 * MODW + 2048, (float*)(arg_ws() + WS_SSQ)};
                  pg8::gemm_phase<pg8::EpiOutProj<false>, pg8::SchedSimple, GEMM_ALIGN, true>(ring, DM, S, E, F.tid); })
    MOE_PHASES(1, 13)
#undef MOE_PHASES
#undef RUN_PHASE
#undef RELAUNDER
    if (PROF_ID != 0) { const unsigned long long acc = *(LAS unsigned long long*)(F.lds + PROF_LDS_OFF + wave0 * 8), t0 = __builtin_amdgcn_s_memrealtime();
        while (__builtin_amdgcn_s_memrealtime() - t0 < (unsigned long long)PROF_MULT * acc) __builtin_amdgcn_s_sleep(8); }
}

extern "C" void kernel_launch(void* const* d_in, const int* in_sizes, int n_in, void* d_out, int out_size, void* d_ws, size_t ws_size, hipStream_t stream) {
    static int grid = 0;
    if (grid == 0) {
        if (n_in != 22 || in_sizes[0] != MROWS * DM || out_size != MROWS * DM || ws_size < WS_END) { fprintf(stderr, "kernel_launch: unexpected shapes (n_in %d, in0 %d, out %d, ws %zu < %zu?); nothing launched\n", n_in, n_in > 0 ? in_sizes[0] : -1, out_size, ws_size, (size_t)WS_END); grid = -1; return; }
        int dev = 0, cus = 0;
        if (hipGetDevice(&dev) != hipSuccess || hipDeviceGetAttribute(&cus, hipDeviceAttributeMultiprocessorCount, dev) != hipSuccess) { grid = -1; return; }
        if (hipFuncSetAttribute((const void*)fwd_kernel, hipFuncAttributeMaxDynamicSharedMemorySize, LDS_BYTES) != hipSuccess) { fprintf(stderr, "kernel_launch: hipFuncSetAttribute failed\n"); grid = -1; return; }
        (void)hipGetLastError();
        grid = cus;
        if (grid != 256) { fprintf(stderr, "kernel_launch: built for 256 CUs, device has %d; nothing launched\n", cus); grid = -1; return; }
    }
    if (grid < 0) return;
    (void)hipMemsetAsync((char*)d_ws + WS_CTL, 0, CTL_ZERO_BYTES, stream);
    Args a{};
    for (int i = 0; i < 22; ++i) a.in[i] = (const float*)d_in[i];
    a.out = (float*)d_out; a.ws = (unsigned char*)d_ws;
#if MK_PER_PHASE
    for (int ph = 0; ph < N_PHASES; ++ph) { a.ph_lo = ph; a.ph_hi = ph + 1; hipLaunchKernelGGL(fwd_kernel, dim3(grid), dim3(NWAVES * 64), LDS_BYTES, stream, a); }
#else
    a.ph_lo = 0; a.ph_hi = N_PHASES; hipLaunchKernelGGL(fwd_kernel, dim3(grid), dim3(NWAVES * 64), LDS_BYTES, stream, a);
#endif
}
```

```cpp
#include <hip/hip_runtime.h>
#include <cstdio>
#include <cstdint>

#define GAS __attribute__((address_space(1)))
#define LAS __attribute__((address_space(3)))
typedef unsigned short bf16_t;
typedef short bf16x8 __attribute__((ext_vector_type(8)));
typedef short s16x4 __attribute__((ext_vector_type(4)));
typedef float f32x2 __attribute__((ext_vector_type(2)));
typedef float f32x4 __attribute__((ext_vector_type(4)));
typedef float f32x16 __attribute__((ext_vector_type(16)));
typedef unsigned u32x2 __attribute__((ext_vector_type(2)));
typedef unsigned u32x4 __attribute__((ext_vector_type(4)));
typedef int i32x4 __attribute__((ext_vector_type(4)));
typedef int i32x8 __attribute__((ext_vector_type(8)));

constexpr int DM = 1024, NB = 16, SEQ = 2048, CTX = 256, MROWS = NB * SEQ, CROWS = NB * CTX, SKV = CTX + SEQ;
constexpr int NE = 16, CAP = 256, MOE_ROWS = NB * NE * CAP;
constexpr float NORM_EPS = 1e-6f;
constexpr int MODW = 6 * DM;
constexpr int KSPLIT = 8;

__device__ __forceinline__ unsigned cvt_pk_bf16(float lo, float hi) { unsigned r; asm volatile("v_cvt_pk_bf16_f32 %0, %1, %2" : "=v"(r) : "v"(lo), "v"(hi)); return r; }
__device__ __forceinline__ float bf2f(unsigned short h) { return __uint_as_float(((unsigned)h) << 16); }
__device__ __forceinline__ float bflo(unsigned w) { return __uint_as_float(w << 16); }
__device__ __forceinline__ float bfhi(unsigned w) { return __uint_as_float(w & 0xffff0000u); }


__device__ __forceinline__ int lane_id_now() { int l_; asm volatile("v_mbcnt_lo_u32_b32 %0, -1, 0\n\tv_mbcnt_hi_u32_b32 %0, -1, %0" : "=v"(l_)); return l_; }

constexpr float FP8_SA = 8.0f, FP8_SW = 32.0f, FP8_UNSCALE = 1.0f / (FP8_SA * FP8_SW), FP8_SY = 64.0f;
__device__ __forceinline__ unsigned pk4_fp8(f32x4 v) {
    int w = 0;
    w = __builtin_amdgcn_cvt_pk_fp8_f32(__builtin_amdgcn_fmed3f(v[0], -448.f, 448.f), __builtin_amdgcn_fmed3f(v[1], -448.f, 448.f), w, false);
    w = __builtin_amdgcn_cvt_pk_fp8_f32(__builtin_amdgcn_fmed3f(v[2], -448.f, 448.f), __builtin_amdgcn_fmed3f(v[3], -448.f, 448.f), w, true);
    return (unsigned)w;
}

#ifndef PROF_ID
#define PROF_ID 0
#endif
#ifndef PROF_DRAIN
#define PROF_DRAIN 0
#endif
#ifndef PROF_MULT
#define PROF_MULT 8
#endif
constexpr int PROF_LDS_OFF = 131072 + 1024;
#define PROF_BEGIN(id) unsigned long long pt_##id = 0; if (PROF_ID == (id)) pt_##id = __builtin_amdgcn_s_memrealtime();
#ifndef PROF_PH
#define PROF_PH -1
#endif
#define PROF_END(id, ldsbase) if (PROF_ID == (id)) { const unsigned long long d_ = __builtin_amdgcn_s_memrealtime() - pt_##id; if (lane_id_now() == 0 && (PROF_PH < 0 || *(LAS int*)((ldsbase) + PROF_LDS_OFF + 128) == PROF_PH)) *(LAS unsigned long long*)((ldsbase) + PROF_LDS_OFF + __builtin_amdgcn_readfirstlane(threadIdx.x >> 6) * 8) += d_; }

#ifndef PG8_PRIO
#define PG8_PRIO 1
#endif
#ifndef PG8_WGM
#define PG8_WGM 8
#endif
namespace pg8 {
#define PG8_LAS __attribute__((address_space(3)))
constexpr int BM = 256, BK = 64, HALF = 128, HTB = HALF * BK * 2  , STAGE_BYTES = 8 * HTB, NXCD = 8, WGM = PG8_WGM;

__host__ __device__ __forceinline__ int lds_byte(int r, int c) { const int st = (r >> 4) * 2 + (c >> 5), rr = r & 15, cc = c & 31, ob = rr * 64 + cc * 2; return st * 1024 + (ob ^ (((ob >> 9) & 1) << 5)); }
__host__ __device__ __forceinline__ void stage_rc(int b, int& R, int& C) { const int st = b / 1024, sb = b % 1024, swz = sb ^ (((sb >> 9) & 1) << 5); R = (st >> 1) * 16 + swz / 64; C = (st & 1) * 32 + (swz % 64) / 2; }
__host__ __device__ __forceinline__ int perm32(int rho) { const int n = rho >> 4, i = rho & 15; return 8 * (i >> 2) + 4 * n + (i & 3); }

struct Unit { int pm, pn, kind; const char* A; const char* B; };

__device__ __forceinline__ int xcd_remap(int wgid, int nwg) { const int q = nwg / NXCD, r = nwg % NXCD, xcd = wgid % NXCD, off = wgid / NXCD; return (xcd < r ? xcd * (q + 1) : r * (q + 1) + (xcd - r) * q) + off; }
__device__ __forceinline__ void grouped(int wgid, int nM, int nN, int& pm, int& pn) {
    const int nig = WGM * nN, gid = wgid / nig, fm = gid * WGM, gsz = (nM - fm) < WGM ? (nM - fm) : WGM;
    pm = fm + ((wgid % nig) % gsz); pn = (wgid % nig) / gsz;
}

__device__ __forceinline__ f32x2 gelu_pk(f32x2 v) {
    f32x2 y = v * (1.0f / 4.5f); y.x = __builtin_amdgcn_fmed3f(y.x, -1.0f, 1.0f); y.y = __builtin_amdgcn_fmed3f(y.y, -1.0f, 1.0f);
    const f32x2 t = y * y;
    f32x2 r = t * (-3.800213194e+00f) + 2.248553468e+01f; r = r * t + (-5.949445673e+01f); r = r * t + 9.364556429e+01f; r = r * t + (-9.869310455e+01f); r = r * t + 7.450131619e+01f;
    r = r * t + (-4.205131993e+01f); r = r * t + 1.815734619e+01f; r = r * t + (-6.045664855e+00f); r = r * t + 1.794988889e+00f;
    const f32x2 h = y * r;
    return v * h + v * 0.5f;
}

template <class Epi, class Sched, bool ALIGN_EPI = false, bool SP2 = false, bool GATHER = false, bool FP8 = false>
__device__ __forceinline__ void gemm_phase(PG8_LAS unsigned char* lds, const int K, const Sched& S, const Epi& E, const int tid, const int* gidx = nullptr) {
    static_assert(SP2 || !GATHER, "row gather is wired into the SP2 loop only");
    const int wid = __builtin_amdgcn_readfirstlane(tid >> 6), lane = tid & 63, wr = wid >> 2, wc = wid & 3, fr = lane & 15, fq = lane >> 4;
    const int rowB = FP8 ? K : 2 * K, nt = rowB / 128;
    unsigned voffA, voffB;
    { int R, C; stage_rc(tid * 16, R, C); const int Rb = Epi::PERM ? ((R & ~31) + perm32(R & 31)) : R; voffA = (unsigned)(R * rowB + C * 2); voffB = (unsigned)(Rb * rowB + C * 2); }
    const size_t kstep = (size_t)(BK * 2);
    const size_t hstep = (size_t)HALF * rowB;
    const unsigned ldsbase32 = (unsigned)(uintptr_t)lds; const unsigned ldsdma_s = (unsigned)__builtin_amdgcn_readfirstlane((int)(ldsbase32 + (unsigned)wid * 1024u));
    const int aoff = lds_byte(wr * 64 + fr, fq * 8), boff = lds_byte(wc * 32 + fr, fq * 8);
    PG8_LAS unsigned char* ldsA = lds + aoff; PG8_LAS unsigned char* ldsB = lds + 4 * HTB + boff;
    asm volatile("" : "+v"(ldsA), "+v"(ldsB));
#define PG8_SA(b, h) (((b) * 2 + (h)) * HTB)
#define PG8_SB(b, h) ((4 + (b) * 2 + (h)) * HTB)
#define PG8_GLDS(gbase_, voff_, ldsdst_) do { unsigned keep_; asm volatile("s_mov_b32 %0, m0\n\ts_mov_b32 m0, %2\n\ts_nop 0\n\tglobal_load_lds_dwordx4 %1, %3\n\ts_mov_b32 m0, %0" \
        : "=&s"(keep_) : "v"(voff_), "s"(ldsdst_), "s"(gbase_) : "memory"); } while (0)
#define PG8_STAGE(bufoff, gbase, voff) do { _Pragma("unroll") for (int _i = 0; _i < 2; ++_i) \
        PG8_GLDS((const char*)(gbase) + (size_t)_i * 64 * rowB, voff, ldsdma_s + (unsigned)(bufoff) + (unsigned)(_i * 8192)); } while (0)
#define PG8_STAGE2(bufoff, gbase, voff) do { _Pragma("unroll") for (int _i = 0; _i < 2; ++_i) \
        PG8_GLDS((const char*)(gbase), (voff)[_i], ldsdma_s + (unsigned)(bufoff) + (unsigned)(_i * 8192)); } while (0)
#define PG8_STAGE_A(bufoff, gbase, half, nx) do { if constexpr (GATHER) { unsigned t_[2]; const unsigned w_ = (nx) ? ngp[half] : cgp[half]; \
            const unsigned gc2 = voffB & 127u; t_[0] = (w_ & 0xffffu) * (unsigned)rowB + gc2; t_[1] = (w_ >> 16) * (unsigned)rowB + gc2; PG8_STAGE2(bufoff, gbase, t_); } \
        else { PG8_STAGE(bufoff, (gbase) + ((half) ? hstep : 0), voffA); } } while (0)
#define PG8_LDA(dst, b, h) do { if constexpr (FP8) { _Pragma("unroll") for (int m = 0; m < 4; ++m) { const i32x4 lo_ = *(const PG8_LAS i32x4*)(ldsA + PG8_SA(b, h) + m * 2048), hi_ = *(const PG8_LAS i32x4*)(ldsA + PG8_SA(b, h) + m * 2048 + 1024); \
        dst##8[m].lo = lo_; dst##8[m].hi = hi_; } } \
    else { _Pragma("unroll") for (int m = 0; m < 4; ++m) _Pragma("unroll") for (int k = 0; k < 2; ++k) dst[m][k] = *(const PG8_LAS bf16x8*)(ldsA + PG8_SA(b, h) + m * 2048 + k * 1024); } } while (0)
#define PG8_LDB(dst, b, h) do { if constexpr (FP8) { _Pragma("unroll") for (int n = 0; n < 2; ++n) { const i32x4 lo_ = *(const PG8_LAS i32x4*)(ldsB + PG8_SA(b, h) + n * 2048), hi_ = *(const PG8_LAS i32x4*)(ldsB + PG8_SA(b, h) + n * 2048 + 1024); \
        dst##8[n].lo = lo_; dst##8[n].hi = hi_; } } \
    else { _Pragma("unroll") for (int n = 0; n < 2; ++n) _Pragma("unroll") for (int k = 0; k < 2; ++k) dst[n][k] = *(const PG8_LAS bf16x8*)(ldsB + PG8_SA(b, h) + n * 2048 + k * 1024); } } while (0)
#define PG8_MMA(ai, bj, At, Bt) do { if (PG8_PRIO) __builtin_amdgcn_s_setprio(1); if constexpr (FP8) { \
          \
        _Pragma("unroll") for (int m = 0; m < 4; ++m) _Pragma("unroll") for (int n = 0; n < 2; ++n) \
            acc[ai][bj][m][n] = __builtin_amdgcn_mfma_scale_f32_16x16x128_f8f6f4(Bt##8[n], At##8[m], acc[ai][bj][m][n], 0, 0, 0, 127, 0, 127); \
    } else { _Pragma("unroll") for (int m = 0; m < 4; ++m) _Pragma("unroll") for (int n = 0; n < 2; ++n) _Pragma("unroll") for (int k = 0; k < 2; ++k) \
        acc[ai][bj][m][n] = __builtin_amdgcn_mfma_f32_16x16x32_bf16(Bt[n][k], At[m][k], acc[ai][bj][m][n], 0, 0, 0); } if (PG8_PRIO) __builtin_amdgcn_s_setprio(0); } while (0)
#define PG8_TID() ({ int l_; asm volatile("v_mbcnt_lo_u32_b32 %0, -1, 0\n\tv_mbcnt_hi_u32_b32 %0, -1, %0" : "=v"(l_)); l_ + wid * 64; })
#define PG8_WAIT_V(n) asm volatile("s_waitcnt vmcnt(" #n ")" ::: "memory")
#define PG8_WAIT_L(n) asm volatile("s_waitcnt lgkmcnt(" #n ")" ::: "memory")
#define PG8_BAR __builtin_amdgcn_s_barrier()
#define PG8_SCHED __builtin_amdgcn_sched_barrier(0)
    Unit cur, nxt; int ui = 0;
    if (!S.next(0, cur)) return;
    f32x4 acc[2][2][4][2];
#pragma unroll
    for (int a = 0; a < 2; ++a)
#pragma unroll
        for (int b = 0; b < 2; ++b)
#pragma unroll
            for (int m = 0; m < 4; ++m)
#pragma unroll
                for (int n = 0; n < 2; ++n) acc[a][b][m][n] = (f32x4){0.f, 0.f, 0.f, 0.f};
    bf16x8 At[4][2], B0[2][2], B1[2][2]; i32x8 At8[4], B08[2], B18[2];
    const char* cA = cur.A; const char* cB = cur.B;
    u32x2 cgp = {0u, 0u}, ngp = {0u, 0u};
    if constexpr (GATHER) cgp = ((const u32x2*)gidx)[cur.pm * 512 + tid];
    if constexpr (SP2) {
        PG8_STAGE(PG8_SB(0, 0), cB, voffB); PG8_STAGE(PG8_SB(0, 1), cB + hstep, voffB); PG8_STAGE_A(PG8_SA(0, 0), cA, 0, false); PG8_STAGE_A(PG8_SA(0, 1), cA, 1, false);
        if (wr == 1) PG8_BAR;
        PG8_WAIT_V(2); PG8_BAR;
        PG8_STAGE(PG8_SB(1, 0), cB + kstep, voffB); PG8_STAGE_A(PG8_SA(1, 0), cA + kstep, 0, false); PG8_STAGE(PG8_SB(1, 1), cB + hstep + kstep, voffB);
        PG8_WAIT_V(6); PG8_BAR;
    } else {
        PG8_STAGE(PG8_SB(0, 0), cB, voffB); PG8_STAGE(PG8_SA(0, 0), cA, voffA); PG8_STAGE(PG8_SB(0, 1), cB + hstep, voffB); PG8_STAGE(PG8_SA(0, 1), cA + hstep, voffA);
        if (wr == 1) PG8_BAR;
        PG8_WAIT_V(4); PG8_BAR;
        PG8_STAGE(PG8_SB(1, 0), cB + kstep, voffB); PG8_STAGE(PG8_SA(1, 0), cA + kstep, voffA); PG8_STAGE(PG8_SB(1, 1), cB + hstep + kstep, voffB);
        PG8_WAIT_V(6); PG8_BAR;
    }
    for (;;) {
        const bool has_next = S.next(ui + 1, nxt);
        if constexpr (GATHER) { const Unit& gu = has_next ? nxt : cur; ngp = ((const u32x2*)gidx)[gu.pm * 512 + PG8_TID()]; }
        const char* nA = has_next ? nxt.A : cA; const char* nB = has_next ? nxt.B : cB;
        PROF_BEGIN(10)
_Pragma("unroll 1")
        for (int t = 0; t < nt; t += 2) {
            const bool last = (t == nt - 2);
            const char* a1 = cA + (size_t)(t + 1) * kstep;
            const char* a2 = last ? nA : cA + (size_t)(t + 2) * kstep; const char* b2 = last ? nB : cB + (size_t)(t + 2) * kstep;
            const char* a3 = a2 + kstep; const char* b3 = b2 + kstep;
            if constexpr (SP2) {
            PG8_LDB(B0, 0, 0); PG8_LDB(B1, 0, 1); PG8_SCHED; PG8_LDA(At, 0, 0); PG8_STAGE_A(PG8_SA(1, 1), a1, 1, false);
            PG8_WAIT_V(8); PG8_WAIT_L(0); PG8_BAR; PG8_MMA(0, 0, At, B0); PG8_MMA(0, 1, At, B1); PG8_BAR; PG8_SCHED;
            PG8_LDA(At, 0, 1); PG8_STAGE(PG8_SB(0, 0), b2, voffB); PG8_STAGE(PG8_SB(0, 1), b2 + hstep, voffB); PG8_STAGE_A(PG8_SA(0, 0), a2, 0, last);
            PG8_WAIT_V(8); PG8_WAIT_L(0); PG8_BAR; PG8_MMA(1, 0, At, B0); PG8_MMA(1, 1, At, B1); PG8_BAR; PG8_SCHED;
            PG8_LDB(B0, 1, 0); PG8_LDB(B1, 1, 1); PG8_SCHED; PG8_LDA(At, 1, 0); PG8_STAGE_A(PG8_SA(0, 1), a2, 1, last);
            PG8_WAIT_V(8); PG8_WAIT_L(0); PG8_BAR; PG8_MMA(0, 0, At, B0); PG8_MMA(0, 1, At, B1); PG8_BAR; PG8_SCHED;
            PG8_LDA(At, 1, 1); PG8_STAGE(PG8_SB(1, 0), b3, voffB); PG8_STAGE(PG8_SB(1, 1), b3 + hstep, voffB); PG8_STAGE_A(PG8_SA(1, 0), a3, 0, last);
            PG8_WAIT_V(8); PG8_WAIT_L(0); PG8_BAR; PG8_MMA(1, 0, At, B0); PG8_MMA(1, 1, At, B1); PG8_BAR; PG8_SCHED;
            } else {
            PG8_LDB(B0, 0, 0); PG8_SCHED; PG8_LDA(At, 0, 0); PG8_STAGE(PG8_SA(1, 1), a1 + hstep, voffA);
            PG8_WAIT_L(8); PG8_BAR; PG8_WAIT_L(0); PG8_MMA(0, 0, At, B0); PG8_BAR; PG8_SCHED;
            PG8_LDB(B1, 0, 1); PG8_STAGE(PG8_SB(0, 0), b2, voffB);
            PG8_BAR; PG8_WAIT_L(0); PG8_MMA(0, 1, At, B1); PG8_BAR;
            PG8_LDA(At, 0, 1); PG8_STAGE(PG8_SA(0, 0), a2, voffA);
            PG8_BAR; PG8_WAIT_L(0); PG8_MMA(1, 0, At, B0); PG8_BAR; PG8_SCHED;
            PG8_STAGE(PG8_SB(0, 1), b2 + hstep, voffB);
            PG8_WAIT_V(6); PG8_BAR; PG8_MMA(1, 1, At, B1); PG8_BAR;
            PG8_LDB(B0, 1, 0); PG8_SCHED; PG8_LDA(At, 1, 0); PG8_STAGE(PG8_SA(0, 1), a2 + hstep, voffA);
            PG8_WAIT_L(8); PG8_BAR; PG8_WAIT_L(0); PG8_MMA(0, 0, At, B0); PG8_BAR; PG8_SCHED;
            PG8_LDB(B1, 1, 1); PG8_STAGE(PG8_SB(1, 0), b3, voffB);
            PG8_BAR; PG8_WAIT_L(0); PG8_MMA(0, 1, At, B1); PG8_BAR;
            PG8_LDA(At, 1, 1); PG8_STAGE(PG8_SA(1, 0), a3, voffA);
            PG8_BAR; PG8_WAIT_L(0); PG8_MMA(1, 0, At, B0); PG8_BAR; PG8_SCHED;
            PG8_STAGE(PG8_SB(1, 1), b3 + hstep, voffB);
            PG8_WAIT_V(6); PG8_BAR; PG8_MMA(1, 1, At, B1); PG8_BAR;
            }
        }
        PROF_END(10, lds)
        PROF_BEGIN(11)
        if constexpr (ALIGN_EPI) { if (wr == 0) PG8_BAR; }
        { const int et_ = PG8_TID();
          E(acc, cur, wr, wc, et_ & 15, (et_ & 63) >> 4); } if (PROF_ID == 11 && PROF_DRAIN) asm volatile("s_waitcnt vmcnt(0)" ::: "memory");
        PROF_END(11, lds)
        if (!has_next) break;
#pragma unroll
        for (int a = 0; a < 2; ++a)
#pragma unroll
            for (int b = 0; b < 2; ++b)
#pragma unroll
                for (int m = 0; m < 4; ++m)
#pragma unroll
                    for (int n = 0; n < 2; ++n) acc[a][b][m][n] = (f32x4){0.f, 0.f, 0.f, 0.f};
        cur = nxt; cA = nA; cB = nB; ++ui;
        if constexpr (GATHER) cgp = ngp;
        if constexpr (ALIGN_EPI) { if (wr == 1) PG8_BAR; }
    }
    PG8_WAIT_V(0);
    if constexpr (!ALIGN_EPI) { if (wr == 0) PG8_BAR; }
    PG8_BAR;
#undef PG8_SA
#undef PG8_SB
#undef PG8_STAGE
#undef PG8_STAGE2
#undef PG8_GOFF
#undef PG8_STAGE_A
#undef PG8_LDA
#undef PG8_LDB
#undef PG8_MMA
#undef PG8_TID
#undef PG8_WAIT_V
#undef PG8_WAIT_L
#undef PG8_BAR
#undef PG8_SCHED
}

#ifndef EPI_NT
#define EPI_NT 0
#endif
#if EPI_NT == 2
__device__ __forceinline__ void st_wt(u32x4* p, u32x4 w) { asm volatile("global_store_dwordx4 %0, %1, off sc1" :: "v"(p), "v"(w) : "memory"); }
__device__ __forceinline__ void st_wt(u32x2* p, u32x2 w) { asm volatile("global_store_dwordx2 %0, %1, off sc1" :: "v"(p), "v"(w) : "memory"); }
#define EPI_STORE(T, p, w) st_wt((T*)(p), (w))
#elif EPI_NT
#define EPI_STORE(T, p, w) __builtin_nontemporal_store((w), (T*)(p))
#else
#define EPI_STORE(T, p, w) (*(T*)(p) = (w))
#endif
__device__ __forceinline__ void st4bf(bf16_t* p, f32x4 v) { u32x2 w; w.x = cvt_pk_bf16(v[0], v[1]); w.y = cvt_pk_bf16(v[2], v[3]); EPI_STORE(u32x2, p, w); }
__device__ __forceinline__ void st8bf(bf16_t* p, f32x4 a, f32x4 b) { u32x4 w; w.x = cvt_pk_bf16(a[0], a[1]); w.y = cvt_pk_bf16(a[2], a[3]); w.z = cvt_pk_bf16(b[0], b[1]); w.w = cvt_pk_bf16(b[2], b[3]); EPI_STORE(u32x4, p, w); }

struct EpiInProj {
    static constexpr bool PERM = false;
    bf16_t *Q, *Kb, *Vb, *GB, *Z; const float* rope;
    __device__ __forceinline__ void operator()(const f32x4 (&acc)[2][2][4][2], const Unit& u, int wr, int wc, int fr, int fq) const {
        const int lrow0 = wr * 64 + fr, lcol0 = wc * 32 + 4 * fq;
        if (u.kind == 0 && u.pn < 4) {
            const bool isq = u.pn < 2; const float qs = isq ? 0.125f * 1.4426950408889634f : 1.0f;
#pragma unroll
            for (int ai = 0; ai < 2; ++ai) {
                f32x4 csv[4], snv[4];
#pragma unroll
                for (int m = 0; m < 4; ++m) { const int npos = (u.pm * 256 + ai * 128 + m * 16 + lrow0) & (SEQ - 1); const int p = (wc & 1) ? (npos & 63) : (npos >> 6);
                    csv[m] = *(const f32x4*)(rope + p * 32 + 4 * fq); snv[m] = *(const f32x4*)(rope + p * 32 + 16 + 4 * fq); }
                asm volatile("" ::: "memory");
#pragma unroll
                for (int m = 0; m < 4; ++m) {
                    const int row = u.pm * 256 + ai * 128 + m * 16 + lrow0, npos = row & (SEQ - 1), b = row >> 11;
                    const f32x4 cs = csv[m], sn = snv[m];
                    bf16_t* dst = isq ? Q + (size_t)row * 512 + (u.pn & 1) * 256 + lcol0 : Kb + (((size_t)b * 4 + (u.pn & 1) * 2) * SKV + CTX + npos) * 128 + lcol0;
                    const size_t hstride = isq ? 128 : (size_t)SKV * 128;
#pragma unroll
                    for (int bj = 0; bj < 2; ++bj) {
                        const f32x4 lo = acc[ai][bj][m][0], hi = acc[ai][bj][m][1];
                        st4bf(dst + bj * hstride, (lo * cs - hi * sn) * qs); st4bf(dst + bj * hstride + 16, (hi * cs + lo * sn) * qs);
                    }
                }
                asm volatile("" ::: "memory");
            }
        } else if (u.kind == 0 && u.pn >= 8) {
#pragma unroll
            for (int ai = 0; ai < 2; ++ai)
#pragma unroll
                for (int m = 0; m < 4; ++m) {
                    const int row = u.pm * 256 + ai * 128 + m * 16 + lrow0;
                    bf16_t* dst = Z + (size_t)row * 512 + (u.pn - 8) * 128 + lcol0;
#pragma unroll
                    for (int n = 0; n < 2; ++n) st4bf(dst + n * 16, acc[ai][0][m][n] * acc[ai][1][m][n]);
                }
        } else {
#pragma unroll
            for (int ai = 0; ai < 2; ++ai)
#pragma unroll
                for (int m = 0; m < 4; ++m) {
                    const int row = u.pm * 256 + ai * 128 + m * 16 + lrow0;
                    bf16_t* dst; size_t hstride = (size_t)SKV * 128;
                    if (u.kind == 0) { const int npos = row & (SEQ - 1), b = row >> 11;
                        if (u.pn < 6) dst = Vb + (((size_t)b * 4 + (u.pn & 1) * 2) * SKV + CTX + npos) * 128; else { dst = GB + (size_t)row * 512 + (u.pn - 6) * 256; hstride = 128; } }
                    else { const int b = row >> 8, mpos = row & 255;
                        dst = ((u.pn < 2) ? Kb : Vb) + (((size_t)b * 4 + (u.pn & 1) * 2) * SKV + mpos) * 128; }
                    dst += lcol0;
#pragma unroll
                    for (int bj = 0; bj < 2; ++bj)
#pragma unroll
                        for (int n = 0; n < 2; ++n) st4bf(dst + bj * hstride + n * 16, acc[ai][bj][m][n]);
                }
        }
    }
};

template <bool BASE_F32> struct EpiOutProj {
    static constexpr bool PERM = true;
    const void* base; bf16_t* out; const float* g; float* ssq;
    __device__ __forceinline__ void operator()(const f32x4 (&acc)[2][2][4][2], const Unit& u, int wr, int wc, int fr, int fq) const {
        const int lrow0 = wr * 64 + fr, col0 = u.pn * 256 + wc * 32 + 8 * fq, b = u.pm >> 3;
        f32x4 gv[2][2];
#pragma unroll
        for (int bj = 0; bj < 2; ++bj)
#pragma unroll
            for (int n = 0; n < 2; ++n) gv[bj][n] = *(const f32x4*)(g + (size_t)b * MODW + col0 + bj * 128 + n * 4);
        if constexpr (BASE_F32) {
#pragma unroll
            for (int ai = 0; ai < 2; ++ai) { f32x4 bs[4][2][2];
#pragma unroll
                for (int m = 0; m < 4; ++m)
#pragma unroll
                    for (int bj = 0; bj < 2; ++bj)
#pragma unroll
                        for (int n = 0; n < 2; ++n) bs[m][bj][n] = *(const f32x4*)((const float*)base + (size_t)(u.pm * 256 + ai * 128 + m * 16 + lrow0) * DM + col0 + bj * 128 + n * 4);
                asm volatile("" ::: "memory");
#pragma unroll
                for (int m = 0; m < 4; ++m) { const int row = u.pm * 256 + ai * 128 + m * 16 + lrow0; const size_t off = (size_t)row * DM + col0;
#pragma unroll
                    for (int bj = 0; bj < 2; ++bj) { const f32x4 o0 = bs[m][bj][0] + gv[bj][0] * acc[ai][bj][m][0], o1 = bs[m][bj][1] + gv[bj][1] * acc[ai][bj][m][1];
                        st8bf(out + off + bj * 128, o0, o1); }
                }
                asm volatile("" ::: "memory"); }
        } else {
            u32x4 bw[2][4][2];
#pragma unroll
            for (int ai = 0; ai < 2; ++ai)
#pragma unroll
                for (int m = 0; m < 4; ++m)
#pragma unroll
                    for (int bj = 0; bj < 2; ++bj) bw[ai][m][bj] = *(const u32x4*)((const bf16_t*)base + (size_t)(u.pm * 256 + ai * 128 + m * 16 + lrow0) * DM + col0 + bj * 128);
            asm volatile("" ::: "memory");
#pragma unroll
            for (int ai = 0; ai < 2; ++ai)
#pragma unroll
                for (int m = 0; m < 4; ++m) { const int row = u.pm * 256 + ai * 128 + m * 16 + lrow0; const size_t off = (size_t)row * DM + col0;
#pragma unroll
                    for (int bj = 0; bj < 2; ++bj) { const u32x4 w = bw[ai][m][bj];
                        const f32x4 b0 = (f32x4){bflo(w.x), bfhi(w.x), bflo(w.y), bfhi(w.y)}, b1 = (f32x4){bflo(w.z), bfhi(w.z), bflo(w.w), bfhi(w.w)};
                        const f32x4 o0 = b0 + gv[bj][0] * acc[ai][bj][m][0], o1 = b1 + gv[bj][1] * acc[ai][bj][m][1];
                        st8bf(out + off + bj * 128, o0, o1); }
                }
        }
    }
};

struct EpiGateUp {
    static constexpr bool PERM = true;
    bf16_t* ACT;
    __device__ __forceinline__ void operator()(const f32x4 (&acc)[2][2][4][2], const Unit& u, int wr, int wc, int fr, int fq) const {
        const int lrow0 = wr * 64 + fr, col0 = u.pn * 128 + wc * 32 + 8 * fq;
#pragma unroll
        for (int ai = 0; ai < 2; ++ai)
#pragma unroll
            for (int m = 0; m < 4; ++m) {
                const int row = u.pm * 256 + ai * 128 + m * 16 + lrow0; f32x4 r[2];
#pragma unroll
                for (int n = 0; n < 2; ++n) { const f32x4 gt = acc[ai][0][m][n], up = acc[ai][1][m][n];
#pragma unroll
                    for (int i = 0; i < 4; ++i) { const float e = __builtin_amdgcn_exp2f(gt[i] * -1.4426950408889634f); r[n][i] = gt[i] * __builtin_amdgcn_rcpf(1.0f + e) * up[i]; } }
                st8bf(ACT + (size_t)row * DM + col0, r[0], r[1]);
            }
    }
};

struct EpiDown {
    static constexpr bool PERM = true;
    bf16_t* Y; const float* vals;
    __device__ __forceinline__ void operator()(const f32x4 (&acc)[2][2][4][2], const Unit& u, int wr, int wc, int fr, int fq) const {
        const int lrow0 = wr * 64 + fr, col0 = u.pn * 256 + wc * 32 + 8 * fq;
#pragma unroll
        for (int ai = 0; ai < 2; ++ai)
#pragma unroll
            for (int m = 0; m < 4; ++m) {
                const int row = u.pm * 256 + ai * 128 + m * 16 + lrow0; const float v = vals[row];
#pragma unroll
                for (int bj = 0; bj < 2; ++bj) st8bf(Y + (size_t)row * DM + col0 + bj * 128, acc[ai][bj][m][0] * v, acc[ai][bj][m][1] * v);
            }
    }
};

struct EpiGateUp8 {
    static constexpr bool PERM = true;
    unsigned char* ACT8;
    __device__ __forceinline__ void operator()(const f32x4 (&acc)[2][2][4][2], const Unit& u, int wr, int wc, int fr, int fq) const {
        const int lrow0 = wr * 64 + fr, col0 = u.pn * 128 + wc * 32 + 8 * fq;
#pragma unroll
        for (int ai = 0; ai < 2; ++ai)
#pragma unroll
            for (int m = 0; m < 4; ++m) {
                const int row = u.pm * 256 + ai * 128 + m * 16 + lrow0; f32x4 r[2];
#pragma unroll
                for (int n = 0; n < 2; ++n) { const f32x4 gt = acc[ai][0][m][n] * FP8_UNSCALE, up = acc[ai][1][m][n] * (FP8_UNSCALE * FP8_SA);
#pragma unroll
                    for (int i = 0; i < 4; ++i) { const float e = __builtin_amdgcn_exp2f(gt[i] * -1.4426950408889634f); r[n][i] = gt[i] * __builtin_amdgcn_rcpf(1.0f + e) * up[i]; } }
                u32x2 w; w.x = pk4_fp8(r[0]); w.y = pk4_fp8(r[1]); *(u32x2*)(ACT8 + (size_t)row * DM + col0) = w;
            }
    }
};
struct EpiDown8 {
    static constexpr bool PERM = true;
    unsigned char* Y; const float* vals;
    __device__ __forceinline__ void operator()(const f32x4 (&acc)[2][2][4][2], const Unit& u, int wr, int wc, int fr, int fq) const {
        const int lrow0 = wr * 64 + fr, col0 = u.pn * 256 + wc * 32 + 8 * fq;
#pragma unroll
        for (int ai = 0; ai < 2; ++ai)
#pragma unroll
            for (int m = 0; m < 4; ++m) {
                const int row = u.pm * 256 + ai * 128 + m * 16 + lrow0; const float v = vals[row] * (FP8_UNSCALE * FP8_SY);
#pragma unroll
                for (int bj = 0; bj < 2; ++bj) { u32x2 w; w.x = pk4_fp8(acc[ai][bj][m][0] * v); w.y = pk4_fp8(acc[ai][bj][m][1] * v); EPI_STORE(u32x2, Y + (size_t)row * DM + col0 + bj * 128, w); }
            }
    }
};

struct EpiOddIn {
    static constexpr bool PERM = true;
    bf16_t* U; bf16_t* VV; float* ssqv;
    __device__ __forceinline__ void operator()(const f32x4 (&acc)[2][2][4][2], const Unit& u, int wr, int wc, int fr, int fq) const {
        const int lrow0 = wr * 64 + fr; const bool isv = u.pn >= 4; const int pnl = u.pn & 3, col0 = pnl * 256 + wc * 32 + 8 * fq;
        bf16_t* dstb = isv ? VV : U;
#pragma unroll
        for (int ai = 0; ai < 2; ++ai)
#pragma unroll
            for (int m = 0; m < 4; ++m) {
                const int row = u.pm * 256 + ai * 128 + m * 16 + lrow0; float s = 0.f;
#pragma unroll
                for (int bj = 0; bj < 2; ++bj) { const f32x4 v0 = acc[ai][bj][m][0], v1 = acc[ai][bj][m][1];
                    const f32x2 a = gelu_pk((f32x2){v0[0], v0[1]}), b = gelu_pk((f32x2){v0[2], v0[3]}), c = gelu_pk((f32x2){v1[0], v1[1]}), d = gelu_pk((f32x2){v1[2], v1[3]});
                    s += (a.x * a.x + a.y * a.y) + (b.x * b.x + b.y * b.y) + (c.x * c.x + c.y * c.y) + (d.x * d.x + d.y * d.y);
                    st8bf(dstb + (size_t)row * DM + col0 + bj * 128, (f32x4){a.x, a.y, b.x, b.y}, (f32x4){c.x, c.y, d.x, d.y}); }
                if (isv) { s += __shfl_xor(s, 16); s += __shfl_xor(s, 32); if (fq == 0) ssqv[(size_t)(pnl * 4 + wc) * MROWS + row] = s; }
            }
    }
};

constexpr size_t TSTEP = (size_t)256 * DM * 2;
struct SchedSimple {
    const char* A; const char* B; int nM, nN, G, c;
    __device__ __forceinline__ bool next(int i, Unit& u) const {
        const int nwg = nM * nN; const long L = (long)i * G + c; if (L >= nwg) return false;
        const int w = xcd_remap((int)L, nwg); grouped(w, nM, nN, u.pm, u.pn); u.kind = 0; u.A = A + (size_t)u.pm * TSTEP; u.B = B + (size_t)u.pn * TSTEP; return true;
    }
};
struct SchedInProj {
    const char* A; const char* Ac; const char* B; int G, c;
    __device__ __forceinline__ bool next(int i, Unit& u) const {
        constexpr int n0 = 128 * 12, nwg = n0 + 64; const long L = (long)i * G + c; if (L >= nwg) return false;
        const int w = xcd_remap((int)L, nwg);
        if (w < n0) { grouped(w, 128, 12, u.pm, u.pn); u.kind = 0; u.A = A + (size_t)u.pm * TSTEP; u.B = B + (size_t)u.pn * TSTEP; }
        else { const int x = w - n0; u.pm = x >> 2; u.pn = x & 3; u.kind = 1; u.A = Ac + (size_t)u.pm * TSTEP; u.B = B + (size_t)(2 + u.pn) * TSTEP; }
        return true;
    }
};
struct SchedMoe {
    const char* A; const char* B; int nN, G, c;
    __device__ __forceinline__ bool next(int i, Unit& u) const {
        const int nwg = 256 * nN; const long L = (long)i * G + c; if (L >= nwg) return false;
        const int w = xcd_remap((int)L, nwg); grouped(w, 256, nN, u.pm, u.pn); u.kind = 0; u.A = A + (size_t)u.pm * TSTEP; u.B = B + (size_t)((u.pm >> 4) * nN + u.pn) * TSTEP; return true;
    }
};
struct SchedMoeGather {
    const char* A; const char* B; int G, c;
    __device__ __forceinline__ bool next(int i, Unit& u) const {
        constexpr int nN = 8, nwg = 256 * nN; const long L = (long)i * G + c; if (L >= nwg) return false;
        const int w = xcd_remap((int)L, nwg); grouped(w, 256, nN, u.pm, u.pn); u.kind = 0; u.A = A + (size_t)(u.pm & 15) * SEQ * DM * 2; u.B = B + (size_t)((u.pm >> 4) * nN + u.pn) * TSTEP; return true;
    }
};
constexpr size_t TSTEP8 = (size_t)256 * DM;
struct SchedMoe8 {
    const char* A; const char* B; int nN, G, c;
    __device__ __forceinline__ bool next(int i, Unit& u) const {
        const int nwg = 256 * nN; const long L = (long)i * G + c; if (L >= nwg) return false;
        const int w = xcd_remap((int)L, nwg); grouped(w, 256, nN, u.pm, u.pn); u.kind = 0; u.A = A + (size_t)u.pm * TSTEP8; u.B = B + (size_t)((u.pm >> 4) * nN + u.pn) * TSTEP8; return true;
    }
};
struct SchedMoeGather8 {
    const char* A; const char* B; int G, c;
    __device__ __forceinline__ bool next(int i, Unit& u) const {
        constexpr int nN = 8, nwg = 256 * nN; const long L = (long)i * G + c; if (L >= nwg) return false;
        const int w = xcd_remap((int)L, nwg); grouped(w, 256, nN, u.pm, u.pn); u.kind = 0; u.A = A + (size_t)(u.pm & 15) * SEQ * DM; u.B = B + (size_t)((u.pm >> 4) * nN + u.pn) * TSTEP8; return true;
    }
};
}

namespace att {
#ifndef ATT_PRIO
#define ATT_PRIO 0
#endif
#ifndef ATT_PV_FIRST
#define ATT_PV_FIRST 1
#endif
#ifndef ATT_STAGE_IN_M
#define ATT_STAGE_IN_M 3
#endif
constexpr int NW = 8, QBLK = 32, KVBLK = 64, LDQ = 512, LDK = 128;
constexpr float SCALE = 0.125f, THR = 8.f;
constexpr int SHM_V = KVBLK * 128 * 2, SHM_K = KVBLK * 128 * 2, SHM_ATTN = 3 * (SHM_V + SHM_K) + NW * 64 * 4;
#define KSWZ(row, colB) ((row) * 256 + ((colB) ^ (((row) & 7) << 4)))
#define SBAR() __builtin_amdgcn_sched_barrier(0)
__device__ __forceinline__ int crow(int r, int hi) { return (r & 3) + 8 * (r >> 2) + 4 * hi; }
__device__ __forceinline__ unsigned cvtpk(float lo, float hi) { unsigned r; asm volatile("v_cvt_pk_bf16_f32 %0, %1, %2" : "=v"(r) : "v"(lo), "v"(hi)); return r; }

__device__ __forceinline__ void partialSM(f32x16& p0, f32x16& p1, float& m_reg, float& mn, float& alpha) {
  constexpr float C = SCALE * 1.4426950408889634f;
  float pmax = p0[0]; for (int r = 1; r < 16; ++r) pmax = fmaxf(pmax, p0[r]); for (int r = 0; r < 16; ++r) pmax = fmaxf(pmax, p1[r]);
  { auto rr = __builtin_amdgcn_permlane32_swap(__float_as_uint(pmax), __float_as_uint(pmax), false, false);
    pmax = fmaxf(__uint_as_float(rr[0]), __uint_as_float(rr[1])); }
  if (__builtin_expect(__all(pmax - m_reg <= THR / SCALE), 1)) { mn = m_reg; alpha = 1.f; }
  else { mn = fmaxf(m_reg, pmax); alpha = __builtin_amdgcn_exp2f((m_reg - mn) * C); m_reg = mn; }
  float mnC = -mn * C;
  for (int r = 0; r < 16; ++r) p0[r] = fmaf(p0[r], C, mnC); for (int r = 0; r < 16; ++r) p1[r] = fmaf(p1[r], C, mnC);
  for (int r = 0; r < 16; ++r) p0[r] = __builtin_amdgcn_exp2f(p0[r]);
}
__device__ __forceinline__ void finishSM(f32x16& p0, f32x16& p1, float alpha, float& l_reg, bf16x8& pa0, bf16x8& pa1, bf16x8& pa2, bf16x8& pa3) {
  for (int r = 0; r < 16; ++r) p1[r] = __builtin_amdgcn_exp2f(p1[r]);
  float ps = 0; for (int r = 0; r < 16; ++r) ps += p0[r]; for (int r = 0; r < 16; ++r) ps += p1[r];
  { auto rr = __builtin_amdgcn_permlane32_swap(__float_as_uint(ps), __float_as_uint(ps), false, false);
    ps = __uint_as_float(rr[0]) + __uint_as_float(rr[1]); }
  l_reg = l_reg * alpha + ps;
#define PK4(P, BASE, OUT) do { unsigned a0 = cvtpk(P[BASE + 0], P[BASE + 1]), a1 = cvtpk(P[BASE + 2], P[BASE + 3]);   \
    unsigned b0 = cvtpk(P[BASE + 4], P[BASE + 5]), b1 = cvtpk(P[BASE + 6], P[BASE + 7]);                              \
    auto r0 = __builtin_amdgcn_permlane32_swap(a0, b0, false, false); auto r1 = __builtin_amdgcn_permlane32_swap(a1, b1, false, false); \
    u32x4 w = {r0[0], r1[0], r0[1], r1[1]}; OUT = *reinterpret_cast<bf16x8*>(&w); } while (0)
  PK4(p0, 0, pa0); PK4(p0, 8, pa1); PK4(p1, 0, pa2); PK4(p1, 8, pa3);
#undef PK4
}
__device__ __forceinline__ void qkt(f32x16& p0, f32x16& p1, const LAS unsigned char* Ks, const bf16x8* qr, int r32, int hi, int map) {
  p0 = f32x16{}; p1 = f32x16{};
#pragma unroll
  for (int d0 = 0; d0 < 4; ++d0) { const int cb = ((map * 4 + d0) * 16 + hi * 8) * 2;
    bf16x8 b0 = *(const LAS bf16x8*)(Ks + KSWZ(r32, cb));
    bf16x8 b1 = *(const LAS bf16x8*)(Ks + KSWZ(32 + r32, cb));
    p0 = __builtin_amdgcn_mfma_f32_32x32x16_bf16(b0, qr[d0], p0, 0, 0, 0);
    p1 = __builtin_amdgcn_mfma_f32_32x32x16_bf16(b1, qr[d0], p1, 0, 0, 0); }
}
__device__ __forceinline__ int v_st(int k, int c) { const int kk = (k & ~0xC) | ((k & 4) << 1) | ((k & 8) >> 1); return ((kk >> 3) * 4 + (c >> 5)) * 512 + ((kk & 7) * 32 + (c & 31)) * 2; }
__device__ __forceinline__ int v_rd_base(int lane) { return ((lane & 3) << 3) | (((lane >> 2) & 3) << 6) | (((lane >> 4) & 1) << 5) | (((lane >> 5) & 1) << 8); }
constexpr int v_rd_off(int d0, int ks, int half) { return d0 * 512 + ks * 4096 + half * 2048; }
template <int OFF> __device__ __forceinline__ s16x4 tr_read(int vb) {
  s16x4 r; asm volatile("ds_read_b64_tr_b16 %0, %1 offset:%2" : "=&v"(r) : "v"(vb), "i"(OFF) : "memory"); return r;
}
template <int D0> __device__ __forceinline__ void pv_one(f32x16& od, int vb, bf16x8 pa0, bf16x8 pa1, bf16x8 pa2, bf16x8 pa3) {
  const s16x4 l0 = tr_read<v_rd_off(D0, 0, 0)>(vb), h0 = tr_read<v_rd_off(D0, 0, 1)>(vb), l1 = tr_read<v_rd_off(D0, 1, 0)>(vb), h1 = tr_read<v_rd_off(D0, 1, 1)>(vb);
  const s16x4 l2 = tr_read<v_rd_off(D0, 2, 0)>(vb), h2 = tr_read<v_rd_off(D0, 2, 1)>(vb), l3 = tr_read<v_rd_off(D0, 3, 0)>(vb), h3 = tr_read<v_rd_off(D0, 3, 1)>(vb);
  asm volatile("s_waitcnt lgkmcnt(0)" ::: "memory"); SBAR();
#define PK(L, H) (bf16x8){L[0], L[1], L[2], L[3], H[0], H[1], H[2], H[3]}
  od = __builtin_amdgcn_mfma_f32_32x32x16_bf16(pa0, PK(l0, h0), od, 0, 0, 0);
  od = __builtin_amdgcn_mfma_f32_32x32x16_bf16(pa1, PK(l1, h1), od, 0, 0, 0);
  od = __builtin_amdgcn_mfma_f32_32x32x16_bf16(pa2, PK(l2, h2), od, 0, 0, 0);
  od = __builtin_amdgcn_mfma_f32_32x32x16_bf16(pa3, PK(l3, h3), od, 0, 0, 0);
#undef PK
}
__device__ __forceinline__ void pv_d0(f32x16* o, int vb, bf16x8 pa0, bf16x8 pa1, bf16x8 pa2, bf16x8 pa3) {
  pv_one<0>(o[0], vb, pa0, pa1, pa2, pa3); pv_one<1>(o[1], vb, pa0, pa1, pa2, pa3); pv_one<2>(o[2], vb, pa0, pa1, pa2, pa3); pv_one<3>(o[3], vb, pa0, pa1, pa2, pa3);
}

template <int OFF> __device__ __forceinline__ bf16x8 lds_read128(int addr) {
  bf16x8 r; asm volatile("ds_read_b128 %0, %1 offset:%2" : "=&v"(r) : "v"(addr), "i"(OFF) : "memory"); return r;
}
#define LGKM_WAIT(N) asm volatile("s_waitcnt lgkmcnt(" #N ")" ::: "memory")
#define VTR8(D0, L0, H0, L1, H1, L2, H2, L3, H3, vb) do { L0 = tr_read<v_rd_off(D0, 0, 0)>(vb); H0 = tr_read<v_rd_off(D0, 0, 1)>(vb); L1 = tr_read<v_rd_off(D0, 1, 0)>(vb); H1 = tr_read<v_rd_off(D0, 1, 1)>(vb); \
    L2 = tr_read<v_rd_off(D0, 2, 0)>(vb); H2 = tr_read<v_rd_off(D0, 2, 1)>(vb); L3 = tr_read<v_rd_off(D0, 3, 0)>(vb); H3 = tr_read<v_rd_off(D0, 3, 1)>(vb); } while (0)
#define VPK(L, H) (bf16x8){L[0], L[1], L[2], L[3], H[0], H[1], H[2], H[3]}
#define PV4(OD, L0, H0, L1, H1, L2, H2, L3, H3) do { OD = __builtin_amdgcn_mfma_f32_32x32x16_bf16(VPK(L0, H0), pa0, OD, 0, 0, 0); OD = __builtin_amdgcn_mfma_f32_32x32x16_bf16(VPK(L1, H1), pa1, OD, 0, 0, 0); \
    OD = __builtin_amdgcn_mfma_f32_32x32x16_bf16(VPK(L2, H2), pa2, OD, 0, 0, 0); OD = __builtin_amdgcn_mfma_f32_32x32x16_bf16(VPK(L3, H3), pa3, OD, 0, 0, 0); } while (0)
template <bool DO_QK, bool DO_PV>
__device__ __forceinline__ void m_phase(f32x16& p0, f32x16& p1, f32x16 (&o)[4], const bf16x8 (&qr)[4], const int (&kaddr)[4], int kb, int vb, bf16x8 pa0, bf16x8 pa1, bf16x8 pa2, bf16x8 pa3, float negm) {
  bf16x8 kf[4]; s16x4 a0, a1, a2, a3, a4, a5, a6, a7;
  SBAR();
  if (ATT_PRIO == 1) __builtin_amdgcn_s_setprio(1);
  if constexpr (DO_QK) {
#pragma unroll
    for (int d0 = 0; d0 < 2; ++d0) { kf[2 * d0] = lds_read128<0>(kaddr[d0] + kb); kf[2 * d0 + 1] = lds_read128<8192>(kaddr[d0] + kb); }
  }
  if constexpr (DO_PV) VTR8(0, a0, a1, a2, a3, a4, a5, a6, a7, vb);
  if constexpr (DO_QK) {
    if constexpr (DO_PV) LGKM_WAIT(8); else LGKM_WAIT(0);
    SBAR();
    f32x16 ini;
#pragma unroll
    for (int r = 0; r < 16; ++r) ini[r] = negm;
    p0 = __builtin_amdgcn_mfma_f32_32x32x16_bf16(kf[0], qr[0], ini, 0, 0, 0); p1 = __builtin_amdgcn_mfma_f32_32x32x16_bf16(kf[1], qr[0], ini, 0, 0, 0);
    p0 = __builtin_amdgcn_mfma_f32_32x32x16_bf16(kf[2], qr[1], p0, 0, 0, 0); p1 = __builtin_amdgcn_mfma_f32_32x32x16_bf16(kf[3], qr[1], p1, 0, 0, 0);
    SBAR();
#pragma unroll
    for (int d0 = 2; d0 < 4; ++d0) { kf[2 * d0 - 4] = lds_read128<0>(kaddr[d0] + kb); kf[2 * d0 - 3] = lds_read128<8192>(kaddr[d0] + kb); }
    LGKM_WAIT(0); SBAR();
    p0 = __builtin_amdgcn_mfma_f32_32x32x16_bf16(kf[0], qr[2], p0, 0, 0, 0); p1 = __builtin_amdgcn_mfma_f32_32x32x16_bf16(kf[1], qr[2], p1, 0, 0, 0);
    p0 = __builtin_amdgcn_mfma_f32_32x32x16_bf16(kf[2], qr[3], p0, 0, 0, 0); p1 = __builtin_amdgcn_mfma_f32_32x32x16_bf16(kf[3], qr[3], p1, 0, 0, 0);
    SBAR();
  }
  if constexpr (DO_PV) {
    LGKM_WAIT(0); SBAR(); PV4(o[0], a0, a1, a2, a3, a4, a5, a6, a7); SBAR(); VTR8(1, a0, a1, a2, a3, a4, a5, a6, a7, vb);
    LGKM_WAIT(0); SBAR(); PV4(o[1], a0, a1, a2, a3, a4, a5, a6, a7); SBAR(); VTR8(2, a0, a1, a2, a3, a4, a5, a6, a7, vb);
    LGKM_WAIT(0); SBAR(); PV4(o[2], a0, a1, a2, a3, a4, a5, a6, a7); SBAR(); VTR8(3, a0, a1, a2, a3, a4, a5, a6, a7, vb);
    LGKM_WAIT(0); SBAR(); PV4(o[3], a0, a1, a2, a3, a4, a5, a6, a7); SBAR();
  }
  if (ATT_PRIO == 1) __builtin_amdgcn_s_setprio(0);
}

template <bool DO_QK>
__device__ __forceinline__ void m_phase_pvfirst(f32x16& p0, f32x16& p1, f32x16 (&o)[4], const bf16x8 (&qr)[4], const int (&kaddr)[4], int kb, int vb, bf16x8 pa0, bf16x8 pa1, bf16x8 pa2, bf16x8 pa3, float negm,
                                                s16x4 a0, s16x4 a1, s16x4 a2, s16x4 a3, s16x4 a4, s16x4 a5, s16x4 a6, s16x4 a7) {
  bf16x8 kf[4];
  SBAR();
  if constexpr (DO_QK) {
#pragma unroll
    for (int d0 = 0; d0 < 2; ++d0) { kf[2 * d0] = lds_read128<0>(kaddr[d0] + kb); kf[2 * d0 + 1] = lds_read128<8192>(kaddr[d0] + kb); }
    LGKM_WAIT(4);
  } else LGKM_WAIT(0);
  SBAR(); PV4(o[0], a0, a1, a2, a3, a4, a5, a6, a7); SBAR(); VTR8(1, a0, a1, a2, a3, a4, a5, a6, a7, vb);
  if constexpr (DO_QK) {
    LGKM_WAIT(8); SBAR();
    f32x16 ini;
#pragma unroll
    for (int r = 0; r < 16; ++r) ini[r] = negm;
    p0 = __builtin_amdgcn_mfma_f32_32x32x16_bf16(kf[0], qr[0], ini, 0, 0, 0); p1 = __builtin_amdgcn_mfma_f32_32x32x16_bf16(kf[1], qr[0], ini, 0, 0, 0);
    p0 = __builtin_amdgcn_mfma_f32_32x32x16_bf16(kf[2], qr[1], p0, 0, 0, 0); p1 = __builtin_amdgcn_mfma_f32_32x32x16_bf16(kf[3], qr[1], p1, 0, 0, 0);
    SBAR();
#pragma unroll
    for (int d0 = 2; d0 < 4; ++d0) { kf[2 * d0 - 4] = lds_read128<0>(kaddr[d0] + kb); kf[2 * d0 - 3] = lds_read128<8192>(kaddr[d0] + kb); }
    LGKM_WAIT(4);
  } else LGKM_WAIT(0);
  SBAR(); PV4(o[1], a0, a1, a2, a3, a4, a5, a6, a7); SBAR(); VTR8(2, a0, a1, a2, a3, a4, a5, a6, a7, vb);
  if constexpr (DO_QK) {
    LGKM_WAIT(8); SBAR();
    p0 = __builtin_amdgcn_mfma_f32_32x32x16_bf16(kf[0], qr[2], p0, 0, 0, 0); p1 = __builtin_amdgcn_mfma_f32_32x32x16_bf16(kf[1], qr[2], p1, 0, 0, 0);
    p0 = __builtin_amdgcn_mfma_f32_32x32x16_bf16(kf[2], qr[3], p0, 0, 0, 0); p1 = __builtin_amdgcn_mfma_f32_32x32x16_bf16(kf[3], qr[3], p1, 0, 0, 0);
    SBAR();
  }
  LGKM_WAIT(0); SBAR(); PV4(o[2], a0, a1, a2, a3, a4, a5, a6, a7); SBAR(); VTR8(3, a0, a1, a2, a3, a4, a5, a6, a7, vb);
  LGKM_WAIT(0); SBAR(); PV4(o[3], a0, a1, a2, a3, a4, a5, a6, a7); SBAR();
}

constexpr float THR2 = 8.f * 1.4426950408889634f;
__device__ __forceinline__ void softmax_tile(const bool first, f32x16& p0, f32x16& p1, float& m_reg, float& l_reg, f32x16 (&o)[4], LAS float* al_l, int r32, int hi,
                                             bf16x8& pa0, bf16x8& pa1, bf16x8& pa2, bf16x8& pa3) {
  float mxa = fmaxf(fmaxf(p0[0], p0[1]), p0[2]), mxb = fmaxf(fmaxf(p0[3], p0[4]), p0[5]), mxc = fmaxf(fmaxf(p1[0], p1[1]), p1[2]), mxd = fmaxf(fmaxf(p1[3], p1[4]), p1[5]);
  mxa = fmaxf(fmaxf(mxa, p0[6]), p0[7]); mxb = fmaxf(fmaxf(mxb, p0[8]), p0[9]); mxc = fmaxf(fmaxf(mxc, p1[6]), p1[7]); mxd = fmaxf(fmaxf(mxd, p1[8]), p1[9]);
  mxa = fmaxf(fmaxf(mxa, p0[10]), p0[11]); mxb = fmaxf(fmaxf(mxb, p0[12]), p0[13]); mxc = fmaxf(fmaxf(mxc, p1[10]), p1[11]); mxd = fmaxf(fmaxf(mxd, p1[12]), p1[13]);
  mxa = fmaxf(fmaxf(mxa, p0[14]), p0[15]); mxc = fmaxf(fmaxf(mxc, p1[14]), p1[15]);
  float pmax = fmaxf(fmaxf(mxa, mxb), fmaxf(mxc, mxd));
  { auto rr = __builtin_amdgcn_permlane32_swap(__float_as_uint(pmax), __float_as_uint(pmax), false, false);
    pmax = fmaxf(__uint_as_float(rr[0]), __uint_as_float(rr[1])); }
  if (first || !__builtin_expect(__all(pmax <= THR2), 1)) {
    const float dl = first ? pmax : fmaxf(pmax, 0.f); m_reg += dl;
#pragma unroll
    for (int r = 0; r < 16; ++r) { p0[r] -= dl; p1[r] -= dl; }
    const float alpha = first ? 1.0f : __builtin_amdgcn_exp2f(-dl); l_reg *= alpha;
#pragma unroll
    for (int d = 0; d < 4; ++d)
#pragma unroll
      for (int r = 0; r < 16; ++r) o[d][r] *= alpha;
  }
#pragma unroll
  for (int r = 0; r < 16; ++r) { p0[r] = __builtin_amdgcn_exp2f(p0[r]); p1[r] = __builtin_amdgcn_exp2f(p1[r]); }
  float ps0 = p0[0] + p1[0], ps1 = p0[1] + p1[1], ps2 = p0[2] + p1[2], ps3 = p0[3] + p1[3];
#pragma unroll
  for (int r = 4; r < 16; r += 4) { ps0 += p0[r] + p1[r]; ps1 += p0[r + 1] + p1[r + 1]; ps2 += p0[r + 2] + p1[r + 2]; ps3 += p0[r + 3] + p1[r + 3]; }
  float ps = (ps0 + ps1) + (ps2 + ps3);
  { auto rr = __builtin_amdgcn_permlane32_swap(__float_as_uint(ps), __float_as_uint(ps), false, false);
    ps = __uint_as_float(rr[0]) + __uint_as_float(rr[1]); }
  l_reg += ps;
#define PK4(P, BASE, OUT) do { unsigned a0 = cvtpk(P[BASE + 0], P[BASE + 1]), a1 = cvtpk(P[BASE + 2], P[BASE + 3]);   \
    unsigned b0 = cvtpk(P[BASE + 4], P[BASE + 5]), b1 = cvtpk(P[BASE + 6], P[BASE + 7]);                              \
    auto r0 = __builtin_amdgcn_permlane32_swap(a0, b0, false, false); auto r1 = __builtin_amdgcn_permlane32_swap(a1, b1, false, false); \
    u32x4 w = {r0[0], r1[0], r0[1], r1[1]}; OUT = *reinterpret_cast<bf16x8*>(&w); } while (0)
  PK4(p0, 0, pa0); PK4(p0, 8, pa1); PK4(p1, 0, pa2); PK4(p1, 8, pa3);
#undef PK4
}

__device__ __forceinline__ void attn_unit(const bf16_t* Qb, const bf16_t* Kh, const bf16_t* Vh, bf16_t* Ob, float lam, const float* subln, LAS unsigned char* lds, int wave_s) {
  int tid = wave_s * 64 + lane_id_now();
  const int wid = tid >> 6, lane = tid & 63, r32 = lane & 31, hi = lane >> 5, map = wid >> 2, qw = wid & 3;
  const bool lead = __builtin_amdgcn_readfirstlane(wid) < 4;
  constexpr int SLOT = SHM_K + SHM_V;
  LAS float* ws = (LAS float*)(lds + 3 * SLOT) + wid * 64; LAS float* li_l = ws; LAS float* al_l = ws + 32;
  float m_reg = 0.f, l_reg = 0; f32x16 o[4] = {}; bf16x8 qr[4];
  const bf16_t* Qw = Qb + (long)(qw * QBLK + r32) * LDQ + map * 64 + hi * 8;
#pragma unroll
  for (int d0 = 0; d0 < 4; ++d0) qr[d0] = *(const bf16x8*)(Qw + d0 * 16);
  const int sr = tid >> 4, sc = (tid & 15) * 8, vst0 = v_st(sr, sc), kst0 = KSWZ(sr, sc * 2);
  const int vrb = (int)(uintptr_t)lds + SHM_K + v_rd_base(lane);
  int kaddr[4];
#pragma unroll
  for (int d0 = 0; d0 < 4; ++d0) kaddr[d0] = (int)(uintptr_t)lds + r32 * 256 + map * 128 + ((hi * 16 + d0 * 32) ^ ((r32 & 7) << 4));
  bf16x8 vs0, vs1, ks0, ks1;
  const unsigned slo = (unsigned)((sr * LDK + sc) * 2);
#define SLOAD(k0) do { const char* vb_ = (const char*)Vh + (size_t)(k0) * LDK * 2; const char* kb_ = (const char*)Kh + (size_t)(k0) * LDK * 2; \
    vs0 = *(const bf16x8*)(vb_ + slo); vs1 = *(const bf16x8*)(vb_ + (size_t)32 * LDK * 2 + slo); ks0 = *(const bf16x8*)(kb_ + slo); ks1 = *(const bf16x8*)(kb_ + (size_t)32 * LDK * 2 + slo); } while (0)
#define SWRITE(slot) do { LAS unsigned char* sb_ = lds + (slot) * SLOT; *(LAS bf16x8*)(sb_ + SHM_K + vst0) = vs0; *(LAS bf16x8*)(sb_ + SHM_K + vst0 + 8192) = vs1; \
    *(LAS bf16x8*)(sb_ + kst0) = ks0; *(LAS bf16x8*)(sb_ + kst0 + 8192) = ks1; } while (0)
  constexpr int NT = SKV / KVBLK;
  f32x16 p0, p1; bf16x8 pa0, pa1, pa2, pa3;
  PROF_BEGIN(2)
  {
    const char* vb1_ = (const char*)Vh + (size_t)KVBLK * LDK * 2; const char* kb1_ = (const char*)Kh + (size_t)KVBLK * LDK * 2;
    SLOAD(0);
    const bf16x8 wv0 = *(const bf16x8*)(vb1_ + slo), wv1 = *(const bf16x8*)(vb1_ + (size_t)32 * LDK * 2 + slo), wk0 = *(const bf16x8*)(kb1_ + slo), wk1 = *(const bf16x8*)(kb1_ + (size_t)32 * LDK * 2 + slo);
    SWRITE(0);
    vs0 = wv0; vs1 = wv1; ks0 = wk0; ks1 = wk1; SWRITE(1); }
  if (ATT_STAGE_IN_M < 2) SLOAD(2 * KVBLK);
  __syncthreads();
  PROF_END(2, lds)
  if (ATT_PRIO == 3 && !lead) __builtin_amdgcn_s_setprio(1);
  if (!lead) __syncthreads();
  pa0 = pa1 = pa2 = pa3 = bf16x8{};
  m_phase<true, false>(p0, p1, o, qr, kaddr, 0, vrb, pa0, pa1, pa2, pa3, 0.f);
  __syncthreads();
  int s_cur = 0, s_nxt = 1, s_nn = 2;
  for (int t = 0; t < NT; ++t) {
    PROF_BEGIN(3)
    if (ATT_STAGE_IN_M == 3) { if (t + 2 < NT) SLOAD((t + 2) * KVBLK); asm volatile("" ::: "memory"); }
    { PROF_BEGIN(7)
    if (ATT_PRIO == 2) __builtin_amdgcn_s_setprio(1);
    softmax_tile(t == 0, p0, p1, m_reg, l_reg, o, al_l, r32, hi, pa0, pa1, pa2, pa3);
    asm volatile("" :: "v"(pa0), "v"(pa1), "v"(pa2), "v"(pa3), "v"(l_reg));
    if (ATT_PRIO == 2) __builtin_amdgcn_s_setprio(0);
    PROF_END(7, lds) }
    PROF_BEGIN(8)
    if (!ATT_STAGE_IN_M) {
      if (lead) { if (t >= 1 && t + 1 < NT) { SWRITE(s_nxt); if (t + 2 < NT) SLOAD((t + 2) * KVBLK); } }
      else      { if (t + 2 < NT) { SWRITE(s_nn); if (t + 3 < NT) SLOAD((t + 3) * KVBLK); } }
    } else if (ATT_STAGE_IN_M == 2) { if (t + 2 < NT) SLOAD((t + 2) * KVBLK); }
    asm volatile("s_waitcnt lgkmcnt(0)" ::: "memory");
    PROF_END(8, lds)
    PROF_END(3, lds)
    s16x4 fa0, fa1, fa2, fa3, fa4, fa5, fa6, fa7;
    if (ATT_PV_FIRST) VTR8(0, fa0, fa1, fa2, fa3, fa4, fa5, fa6, fa7, vrb + s_cur * SLOT);
    PROF_BEGIN(5)
    __syncthreads();
    PROF_END(5, lds)
    PROF_BEGIN(4)
    if (ATT_STAGE_IN_M == 3) { if (t + 2 < NT) SWRITE(s_nn); asm volatile("" ::: "memory"); }
    if (ATT_PV_FIRST) {
      if (t + 1 < NT) m_phase_pvfirst<true>(p0, p1, o, qr, kaddr, s_nxt * SLOT, vrb + s_cur * SLOT, pa0, pa1, pa2, pa3, -m_reg, fa0, fa1, fa2, fa3, fa4, fa5, fa6, fa7);
      else m_phase_pvfirst<false>(p0, p1, o, qr, kaddr, 0, vrb + s_cur * SLOT, pa0, pa1, pa2, pa3, 0.f, fa0, fa1, fa2, fa3, fa4, fa5, fa6, fa7);
    } else {
      if (t + 1 < NT) m_phase<true, true>(p0, p1, o, qr, kaddr, s_nxt * SLOT, vrb + s_cur * SLOT, pa0, pa1, pa2, pa3, -m_reg);
      else m_phase<false, true>(p0, p1, o, qr, kaddr, 0, vrb + s_cur * SLOT, pa0, pa1, pa2, pa3, 0.f);
    }
    if (ATT_STAGE_IN_M == 1 || ATT_STAGE_IN_M == 2) { __builtin_amdgcn_sched_barrier(0); asm volatile("" ::: "memory"); if (t + 2 < NT) { SWRITE(s_nn); if (ATT_STAGE_IN_M == 1 && t + 3 < NT) SLOAD((t + 3) * KVBLK); } asm volatile("s_waitcnt lgkmcnt(0)" ::: "memory"); __builtin_amdgcn_sched_barrier(0); }
    asm volatile("s_nop 0" :: "v"(o[0]), "v"(o[1]), "v"(o[2]), "v"(o[3]), "v"(p0), "v"(p1));
    PROF_END(4, lds)
    { PROF_BEGIN(5)
    __syncthreads();
    PROF_END(5, lds) }
    { const int x = s_cur; s_cur = s_nxt; s_nxt = s_nn; s_nn = x; }
  }
  if (ATT_PRIO == 3 && !lead) __builtin_amdgcn_s_setprio(0);
  if (lead) __syncthreads();
  PROF_BEGIN(6)
  const float rl = __builtin_amdgcn_rcpf(l_reg);
  __syncthreads();
  LAS float* X = (LAS float*)lds + qw * 4096 + lane;
  if (map == 1) {
#pragma unroll
    for (int d0 = 0; d0 < 4; ++d0)
#pragma unroll
      for (int r = 0; r < 16; ++r) X[(d0 * 16 + r) * 64] = o[d0][r] * rl;
  }
  __syncthreads();
  if (map == 0) {
    float s0 = 0.f, s1 = 0.f, s2 = 0.f, s3 = 0.f;
#pragma unroll
    for (int d0 = 0; d0 < 4; ++d0)
#pragma unroll
      for (int r = 0; r < 16; r += 4) {
        const float e0 = o[d0][r] * rl - lam * X[(d0 * 16 + r) * 64], e1 = o[d0][r + 1] * rl - lam * X[(d0 * 16 + r + 1) * 64], e2 = o[d0][r + 2] * rl - lam * X[(d0 * 16 + r + 2) * 64], e3 = o[d0][r + 3] * rl - lam * X[(d0 * 16 + r + 3) * 64];
        o[d0][r] = e0; o[d0][r + 1] = e1; o[d0][r + 2] = e2; o[d0][r + 3] = e3; s0 += e0 * e0; s1 += e1 * e1; s2 += e2 * e2; s3 += e3 * e3; }
    float ssum = (s0 + s1) + (s2 + s3);
    { auto rr = __builtin_amdgcn_permlane32_swap(__float_as_uint(ssum), __float_as_uint(ssum), false, false); ssum = __uint_as_float(rr[0]) + __uint_as_float(rr[1]); }
    const float sc = __builtin_amdgcn_rsqf(ssum * (1.0f / 128.0f) + NORM_EPS) * 0.8f;
    bf16_t* orow = Ob + (long)(qw * QBLK + r32) * 1024 + hi * 8;
#pragma unroll
    for (int d0 = 0; d0 < 4; ++d0)
#pragma unroll
      for (int pr = 0; pr < 2; ++pr) {
        const f32x4 g0 = *(const f32x4*)(subln + 32 * d0 + 16 * pr + 4 * hi), g1 = *(const f32x4*)(subln + 32 * d0 + 16 * pr + 8 + 4 * hi);
        const int ra = 8 * pr, rb = 8 * pr + 4;
        unsigned ax = cvtpk(o[d0][ra] * sc * g0[0], o[d0][ra + 1] * sc * g0[1]), ay = cvtpk(o[d0][ra + 2] * sc * g0[2], o[d0][ra + 3] * sc * g0[3]);
        unsigned bx = cvtpk(o[d0][rb] * sc * g1[0], o[d0][rb + 1] * sc * g1[1]), by = cvtpk(o[d0][rb + 2] * sc * g1[2], o[d0][rb + 3] * sc * g1[3]);
        { auto rx = __builtin_amdgcn_permlane32_swap(ax, bx, false, false); ax = rx[0]; bx = rx[1]; auto ry = __builtin_amdgcn_permlane32_swap(ay, by, false, false); ay = ry[0]; by = ry[1]; }
        u32x4 w = {ax, ay, bx, by};
        *(u32x4*)(orow + 32 * d0 + 16 * pr) = w; }
  }
  __syncthreads();
  PROF_END(6, lds)
#undef SLOAD
#undef SWRITE
}
}

constexpr int NWAVES = 8;
#ifndef MK_PER_PHASE
#define MK_PER_PHASE 0
#endif
constexpr int N_PHASES = 18;
#ifndef REPMASK
#define REPMASK 0
#endif
#ifndef SUBREP
#define SUBREP 0
#endif
#ifndef GEMM_SKEW
#define GEMM_SKEW 0
#endif
#ifndef GEMM_ALIGN
#define GEMM_ALIGN true
#endif
#ifndef GEMM_ALIGN_GU
#define GEMM_ALIGN_GU GEMM_ALIGN
#endif
#ifndef GEMM_ALIGN_DN
#define GEMM_ALIGN_DN GEMM_ALIGN
#endif
#ifndef CVT_CLASS
#define CVT_CLASS(v) (((v) >> 4) & 3)
#endif
#ifndef MOE_CVT_IN_ATTN
#define MOE_CVT_IN_ATTN 1
#endif
#ifndef PHMASK_FULL
#define PHMASK_FULL 0x3ffff
#endif
#ifndef PHMASK
#define PHMASK 0xfff
#endif

constexpr size_t MiB = 1u << 20;
constexpr size_t WS_CTL = 0, CTL_ZERO_BYTES = 128 * 1024;
constexpr size_t WS_MODP = 1 * MiB;
constexpr size_t WS_MOD = 8 * MiB;
constexpr size_t WS_PROBS = 9 * MiB;
constexpr size_t WS_SLOT = 11 * MiB;
constexpr size_t WS_VALS = 13 * MiB;
constexpr size_t WS_SSQ = 14 * MiB;
constexpr size_t WS_IDX = 13 * MiB + 512 * 1024;
constexpr size_t WS_GPK = 126 * MiB;
constexpr size_t WS_WIN0 = 16 * MiB;
constexpr size_t WS_WIN1 = 22 * MiB;
constexpr size_t WS_WOUT = 26 * MiB;
constexpr size_t WS_WGU = 30 * MiB;
constexpr size_t WS_WD = 158 * MiB;
constexpr size_t WS_H = 222 * MiB;
constexpr size_t WS_HC = 286 * MiB;
constexpr size_t WS_R = 294 * MiB;
constexpr size_t WS_Q = WS_R, WS_K = WS_R + 32 * MiB, WS_V = WS_R + 68 * MiB, WS_GB = WS_R + 104 * MiB, WS_Z = WS_R + 136 * MiB, WS_MIX = WS_R + 168 * MiB;
constexpr size_t WS_XG = WS_R, WS_ACT = WS_R + 128 * MiB, WS_Y = WS_R;
constexpr size_t WS_U = WS_R, WS_VV = WS_R + 64 * MiB, WS_MIX1 = WS_R + 128 * MiB;
constexpr size_t WS_X2 = WS_R + 192 * MiB;
constexpr size_t WS_X3 = WS_WGU;
constexpr size_t WS_END = WS_R + 256 * MiB;
constexpr int CW_BAR = 4096, CW_GRP = 16384;

constexpr int RING_BYTES = 131072, LDSCTL_OFF = RING_BYTES, MISC_OFF = LDSCTL_OFF + 320, LDS_BYTES = 147456;

typedef GAS unsigned gu32;
#define RLX_AGENT __ATOMIC_RELAXED, __HIP_MEMORY_SCOPE_AGENT
#define LDS_WAIT() asm volatile("s_waitcnt lgkmcnt(0)" ::: "memory")
#define VM_WAIT() asm volatile("s_waitcnt vmcnt(0)" ::: "memory")

#define XB_TMO      128
#define XB_XCNT(j)  (256  + 64 * (j))
#define XB_XSUB(j)  (1280 + 64 * (j))
#define XB_XGEN(j)  (2304 + 64 * (j))
#define XB_TOP      3328
#define XB_TOPGEN   3392
#define XCD_BAR_WORDS 3456
#define XB_SPIN_CAP (1u << 20)
__device__ __forceinline__ unsigned xb_ld(unsigned* p)              { return __hip_atomic_load(p, __ATOMIC_RELAXED, __HIP_MEMORY_SCOPE_AGENT); }
__device__ __forceinline__ unsigned xb_add(unsigned* p, unsigned v) { return __hip_atomic_fetch_add(p, v, __ATOMIC_RELAXED, __HIP_MEMORY_SCOPE_AGENT); }
__device__ __forceinline__ unsigned xb_xcc_id() { return (unsigned)__builtin_amdgcn_s_getreg((3 << 11) | 20) & 0xFu; }
#define XB_SPIN(cond, bar) do { unsigned _sp = 0; while (cond) { __builtin_amdgcn_s_sleep(1); \
    if ((++_sp & 255u) == 0u) { if (xb_ld(&(bar)[XB_TMO])) break; if (_sp > XB_SPIN_CAP) { atomicAdd(&(bar)[XB_TMO], 1u); break; } } } } while (0)
struct XcdBarrier { unsigned* bar; unsigned x; volatile LAS unsigned* st; int w; };
__device__ __forceinline__ XcdBarrier xcd_barrier_post(unsigned* bar, volatile LAS unsigned* st, int wave_s) {
    XcdBarrier b; b.bar = bar; b.x = xb_xcc_id(); b.st = st; b.w = wave_s;
    if (wave_s == 0 && lane_id_now() == 0) (void)xb_add(&bar[XB_XCNT(b.x)], 1u);
    return b;
}
__device__ __forceinline__ void xcd_barrier_complete(unsigned* bar, unsigned x, unsigned& nloc, unsigned& nx) {
    const unsigned G = gridDim.x * gridDim.y * gridDim.z;
    unsigned sum, cnt, mine, sp = 0u;
    for (;;) {
        sum = 0u; cnt = 0u; mine = 0u;
#pragma unroll
        for (unsigned j = 0; j < 16; ++j) { const unsigned c = xb_ld(&bar[XB_XCNT(j)]); sum += c; cnt += (c > 0u) ? 1u : 0u; mine = (j == x) ? c : mine; }
        if (sum == G) break;
        __builtin_amdgcn_s_sleep(1);
        if ((++sp & 255u) == 0u) { if (xb_ld(&bar[XB_TMO])) break; if (sp > XB_SPIN_CAP) { atomicAdd(&bar[XB_TMO], 1u); break; } }
    }
    nloc = mine > 0u ? mine : 1u; nx = cnt > 0u ? cnt : 1u;
}
__device__ __forceinline__ void xcd_barrier(const XcdBarrier& b) {
    asm volatile("s_waitcnt vmcnt(0)" ::: "memory");
    __syncthreads();
    if (b.w == 0 && lane_id_now() == 0) {
        unsigned* bar = b.bar;
        __builtin_amdgcn_s_waitcnt(0);
        unsigned nloc = b.st[0], nx = b.st[1];
        if (nloc == 0u) { xcd_barrier_complete(bar, b.x, nloc, nx); b.st[0] = nloc; b.st[1] = nx; }
        const unsigned old = xb_add(&bar[XB_XSUB(b.x)], 1u);
        const unsigned gen = old / nloc;
        if (old + 1u == (gen + 1u) * nloc) {
            __builtin_amdgcn_fence(__ATOMIC_RELEASE, "agent");
            asm volatile("s_waitcnt vmcnt(0)" ::: "memory");
            const unsigned og = xb_add(&bar[XB_TOP], 1u);
            const unsigned tg = og / nx;
            if (og + 1u == (tg + 1u) * nx) xb_add(&bar[XB_TOPGEN], 1u);
            else XB_SPIN(xb_ld(&bar[XB_TOPGEN]) == tg, bar);
            __builtin_amdgcn_fence(__ATOMIC_ACQUIRE, "agent");
            xb_add(&bar[XB_XGEN(b.x)], 1u);
            asm volatile("s_waitcnt vmcnt(0)" ::: "memory");
        } else {
            XB_SPIN(xb_ld(&bar[XB_XGEN(b.x)]) == gen, bar);
            __builtin_amdgcn_fence(__ATOMIC_ACQUIRE, "agent");
            asm volatile("s_waitcnt vmcnt(0)" ::: "memory");
        }
    }
    __syncthreads();
}

__device__ __forceinline__ void group_barrier(unsigned* gw, int use, int wave_s) {
    asm volatile("s_waitcnt vmcnt(0)" ::: "memory");
    __syncthreads();
    if (wave_s == 0 && lane_id_now() == 0) {
        const unsigned x = xb_xcc_id(), nloc = xb_ld(&gw[x]);
        const unsigned old = xb_add(&gw[64 + 32 * use + x], 1u);
        if (old + 1u == nloc) {
            __builtin_amdgcn_fence(__ATOMIC_RELEASE, "agent");
            asm volatile("s_waitcnt vmcnt(0)" ::: "memory");
            (void)xb_add(&gw[32 + 16 * use], nloc);
        }
        unsigned sp = 0u;
        while (xb_ld(&gw[32 + 16 * use]) < 16u) { __builtin_amdgcn_s_sleep(1); if (++sp > XB_SPIN_CAP) break; }
        __builtin_amdgcn_fence(__ATOMIC_ACQUIRE, "agent");
        asm volatile("s_waitcnt vmcnt(0)" ::: "memory");
    }
    __syncthreads();
}

__device__ const float ROPE_TAB[64 * 32] = {
1.000000000e+00f, 1.000000000e+00f, 1.000000000e+00f, 1.000000000e+00f, 1.000000000e+00f, 1.000000000e+00f, 1.000000000e+00f, 1.000000000e+00f, 1.000000000e+00f, 1.000000000e+00f, 1.000000000e+00f, 1.000000000e+00f, 1.000000000e+00f, 1.000000000e+00f, 1.000000000e+00f, 1.000000000e+00f, 0.000000000e+00f, 0.000000000e+00f, 0.000000000e+00f, 0.000000000e+00f, 0.000000000e+00f, 0.000000000e+00f, 0.000000000e+00f, 0.000000000e+00f, 0.000000000e+00f, 0.000000000e+00f, 0.000000000e+00f, 0.000000000e+00f, 0.000000000e+00f, 0.000000000e+00f, 0.000000000e+00f, 0.000000000e+00f,
5.403023059e-01f, 8.460091103e-01f, 9.504152803e-01f, 9.842302345e-01f, 9.950041653e-01f, 9.984192778e-01f, 9.995000417e-01f, 9.998418903e-01f, 9.999500004e-01f, 9.999841887e-01f, 9.999950000e-01f, 9.999984189e-01f, 9.999995000e-01f, 9.999998419e-01f, 9.999999500e-01f, 9.999999842e-01f, 8.414709848e-01f, 5.331684399e-01f, 3.109835929e-01f, 1.768921862e-01f, 9.983341665e-02f, 5.620449921e-02f, 3.161750640e-02f, 1.778185688e-02f, 9.999833334e-03f, 5.623383614e-03f, 3.162272390e-03f, 1.778278473e-03f, 9.999998333e-04f, 5.623412956e-04f, 3.162277607e-04f, 1.778279401e-04f,
-4.161468365e-01f, 4.314628294e-01f, 8.065784099e-01f, 9.374183089e-01f, 9.800665778e-01f, 9.936821085e-01f, 9.980006666e-01f, 9.993676111e-01f, 9.998000067e-01f, 9.999367551e-01f, 9.999800001e-01f, 9.999936755e-01f, 9.999980000e-01f, 9.999993675e-01f, 9.999998000e-01f, 9.999999368e-01f, 9.092974268e-01f, 9.021307150e-01f, 5.911271172e-01f, 3.482052759e-01f, 1.986693308e-01f, 1.122313110e-01f, 6.320339793e-02f, 3.555809079e-02f, 1.999866669e-02f, 1.124658940e-02f, 6.324513157e-03f, 3.556551322e-03f, 1.999998667e-03f, 1.124682413e-03f, 6.324554899e-04f, 3.556558745e-04f,
-9.899924966e-01f, -1.159661415e-01f, 5.827536107e-01f, 8.610406494e-01f, 9.553364891e-01f, 9.858034685e-01f, 9.955033740e-01f, 9.985773125e-01f, 9.995500337e-01f, 9.998577009e-01f, 9.999550003e-01f, 9.999857698e-01f, 9.999955000e-01f, 9.999985770e-01f, 9.999995500e-01f, 9.999998577e-01f, 1.411200081e-01f, 9.932531671e-01f, 8.126488966e-01f, 5.085361344e-01f, 2.955202067e-01f, 1.679033098e-01f, 9.472609133e-02f, 5.332308054e-02f, 2.999550020e-02f, 1.686943954e-02f, 9.486690679e-03f, 5.334812925e-03f, 2.999995500e-03f, 1.687023175e-03f, 9.486831557e-04f, 5.334837977e-04f,
-6.536436209e-01f, -6.276796538e-01f, 3.011374626e-01f, 7.575061717e-01f, 9.210609940e-01f, 9.748082656e-01f, 9.920106610e-01f, 9.974712444e-01f, 9.992001067e-01f, 9.997470285e-01f, 9.999200011e-01f, 9.999747019e-01f, 9.999920000e-01f, 9.999974702e-01f, 9.999992000e-01f, 9.999997470e-01f, -7.568024953e-01f, 7.784717415e-01f, 9.535807405e-01f, 6.528280017e-01f, 3.894183423e-01f, 2.230444916e-01f, 1.261540665e-01f, 7.107120850e-02f, 3.998933419e-02f, 2.249175622e-02f, 1.264877333e-02f, 7.113057657e-03f, 3.999989333e-03f, 2.249363404e-03f, 1.264910727e-03f, 7.113117040e-04f,
2.836621855e-01f, -9.460792693e-01f, -1.034231891e-02f, 6.300803045e-01f, 8.775825619e-01f, 9.607312606e-01f, 9.875260200e-01f, 9.960497564e-01f, 9.987502604e-01f, 9.996047413e-01f, 9.998750026e-01f, 9.999604718e-01f, 9.999875000e-01f, 9.999960472e-01f, 9.999987500e-01f, 9.999996047e-01f, -9.589242747e-01f, 3.239352036e-01f, 9.999465168e-01f, 7.765299800e-01f, 4.794255386e-01f, 2.774805306e-01f, 1.574558982e-01f, 8.879686236e-02f, 4.997916927e-02f, 2.811336166e-02f, 1.581072950e-02f, 8.891279896e-03f, 4.999979167e-03f, 2.811702921e-03f, 1.581138171e-03f, 8.891395879e-04f,
9.601702867e-01f, -9.731037080e-01f, -3.207964584e-01f, 4.827820000e-01f, 8.253356149e-01f, 9.436169571e-01f, 9.820539352e-01f, 9.943132982e-01f, 9.982005399e-01f, 9.994308440e-01f, 9.998200054e-01f, 9.999430795e-01f, 9.999820001e-01f, 9.999943079e-01f, 9.999982000e-01f, 9.999994308e-01f, -2.794154982e-01f, -2.303674747e-01f, 9.471481575e-01f, 8.757405669e-01f, 5.646424734e-01f, 3.310393303e-01f, 1.886002871e-01f, 1.064944369e-01f, 5.996400648e-02f, 3.373407807e-02f, 1.897252756e-02f, 1.066947402e-02f, 5.999964000e-03f, 3.374041549e-03f, 1.897365458e-03f, 1.066967444e-03f,
7.539022543e-01f, -7.004299352e-01f, -5.994373930e-01f, 3.202569776e-01f, 7.648421873e-01f, 9.235194611e-01f, 9.755998784e-01f, 9.922624187e-01f, 9.975510003e-01f, 9.992253420e-01f, 9.997550100e-01f, 9.999225252e-01f, 9.999755001e-01f, 9.999922524e-01f, 9.999975500e-01f, 9.999992252e-01f, 6.569865987e-01f, -7.137211682e-01f, 8.004216463e-01f, 9.473307069e-01f, 6.442176872e-01f, 3.835515676e-01f, 2.195560914e-01f, 1.241583359e-01f, 6.994284734e-02f, 3.935372772e-02f, 2.213413590e-02f, 1.244763440e-02f, 6.999942833e-03f, 3.936379111e-03f, 2.213592554e-03f, 1.244795266e-03f,
-1.455000338e-01f, -2.120365045e-01f, -8.186324573e-01f, 1.476312003e-01f, 6.967067093e-01f, 9.005023096e-01f, 9.681703030e-01f, 9.898977666e-01f, 9.968017063e-01f, 9.989882418e-01f, 9.996800171e-01f, 9.998988088e-01f, 9.999680002e-01f, 9.999898807e-01f, 9.999968000e-01f, 9.999989881e-01f, 9.893582466e-01f, -9.772617463e-01f, 5.743177691e-01f, 9.890424807e-01f, 7.173560909e-01f, 4.348512280e-01f, 2.502923579e-01f, 1.417829736e-01f, 7.991469397e-02f, 4.497213290e-02f, 2.529552289e-02f, 1.422575542e-02f, 7.999914667e-03f, 4.498715427e-03f, 2.529819430e-03f, 1.422623048e-03f,
-9.111302619e-01f, 3.416603061e-01f, -9.566441996e-01f, -2.965079584e-02f, 6.216099683e-01f, 8.746382701e-01f, 9.597726380e-01f, 9.872200896e-01f, 9.959527330e-01f, 9.987195509e-01f, 9.995950273e-01f, 9.998719305e-01f, 9.999595003e-01f, 9.999871928e-01f, 9.999959500e-01f, 9.999987193e-01f, 4.121184852e-01f, -9.398235128e-01f, 2.912591207e-01f, 9.995603185e-01f, 7.833269096e-01f, 4.847761303e-01f, 2.807783529e-01f, 1.593627767e-01f, 8.987854920e-02f, 5.058911594e-02f, 2.845665693e-02f, 1.600383145e-02f, 8.999878500e-03f, 5.061050321e-03f, 2.846046052e-03f, 1.600450786e-03f,
-8.390715291e-01f, 7.901319677e-01f, -9.997860729e-01f, -2.059976198e-01f, 5.403023059e-01f, 8.460091103e-01f, 9.504152803e-01f, 9.842302345e-01f, 9.950041653e-01f, 9.984192778e-01f, 9.995000417e-01f, 9.998418903e-01f, 9.999500004e-01f, 9.999841887e-01f, 9.999950000e-01f, 9.999984189e-01f, -5.440211109e-01f, -6.129367615e-01f, -2.068353153e-02f, 9.785524925e-01f, 8.414709848e-01f, 5.331684399e-01f, 3.109835929e-01f, 1.768921862e-01f, 9.983341665e-02f, 5.620449921e-02f, 3.161750640e-02f, 1.778185688e-02f, 9.999833334e-03f, 5.623383614e-03f, 3.162272390e-03f, 1.778278473e-03f,
4.425697988e-03f, 9.952573799e-01f, -9.437797217e-01f, -3.758473754e-01f, 4.535961214e-01f, 8.147053397e-01f, 9.401075865e-01f, 9.809291466e-01f, 9.939560980e-01f, 9.980874320e-01f, 9.993950610e-01f, 9.998086883e-01f, 9.999395006e-01f, 9.999808683e-01f, 9.999939500e-01f, 9.999980868e-01f, -9.999902066e-01f, -9.727665569e-02f, -3.305750095e-01f, 9.266815798e-01f, 8.912073601e-01f, 5.798751671e-01f, 3.408778753e-01f, 1.943656590e-01f, 1.097783008e-01f, 6.181810515e-02f, 3.477803970e-02f, 1.955982607e-02f, 1.099977817e-02f, 6.185715129e-03f, 3.478498411e-03f, 1.956106104e-03f,
8.438539587e-01f, 8.938616532e-01f, -7.941792645e-01f, -5.338430810e-01f, 3.623577545e-01f, 7.808259235e-01f, 9.288598634e-01f, 9.773178698e-01f, 9.928086359e-01f, 9.977240240e-01f, 9.992800864e-01f, 9.997723246e-01f, 9.999280009e-01f, 9.999772317e-01f, 9.999928000e-01f, 9.999977232e-01f, -5.365729180e-01f, 4.483428876e-01f, -6.076835491e-01f, 8.455835647e-01f, 9.320390860e-01f, 6.247486512e-01f, 3.704313082e-01f, 2.117776696e-01f, 1.197122073e-01f, 6.742975624e-02f, 3.793822522e-02f, 2.133773341e-02f, 1.199971200e-02f, 6.748044688e-03f, 3.794724085e-03f, 2.133933673e-03f,
9.074467815e-01f, 5.171728240e-01f, -5.658204948e-01f, -6.750016262e-01f, 2.674988286e-01f, 7.444779696e-01f, 9.166833580e-01f, 9.733975461e-01f, 9.915618937e-01f, 9.973290652e-01f, 9.991551190e-01f, 9.997327994e-01f, 9.999155012e-01f, 9.999732789e-01f, 9.999915500e-01f, 9.999973279e-01f, 4.201670368e-01f, 8.558809906e-01f, -8.245284517e-01f, 7.378162404e-01f, 9.635581854e-01f, 6.676470271e-01f, 3.996143406e-01f, 2.291227120e-01f, 1.296341426e-01f, 7.303927501e-02f, 4.109803135e-02f, 2.311557328e-02f, 1.299963384e-02f, 7.310372113e-03f, 4.110949379e-03f, 2.311761174e-03f,
1.367372182e-01f, -1.879581181e-02f, -2.813496238e-01f, -7.948709366e-01f, 1.699671429e-01f, 7.057763899e-01f, 9.035902455e-01f, 9.691694153e-01f, 9.902159962e-01f, 9.969025682e-01f, 9.990201601e-01f, 9.996901128e-01f, 9.999020016e-01f, 9.999690098e-01f, 9.999902000e-01f, 9.999969010e-01f, 9.906073557e-01f, 9.998233431e-01f, -9.596053299e-01f, 6.067785379e-01f, 9.854497300e-01f, 7.084346741e-01f, 4.283977921e-01f, 2.463953013e-01f, 1.395431146e-01f, 7.864648408e-02f, 4.425742651e-02f, 2.489334005e-02f, 1.399954267e-02f, 7.872697226e-03f, 4.427174262e-03f, 2.489588602e-03f,
-7.596879129e-01f, -5.489756801e-01f, 3.102253171e-02f, -8.896703905e-01f, 7.073720167e-02f, 6.648435374e-01f, 8.895936181e-01f, 9.646348142e-01f, 9.887710779e-01f, 9.964445465e-01f, 9.988752109e-01f, 9.996442649e-01f, 9.998875021e-01f, 9.999644246e-01f, 9.999887500e-01f, 9.999964424e-01f, 6.502878402e-01f, 8.358383233e-01f, -9.995186854e-01f, 4.566033249e-01f, 9.974949866e-01f, 7.469826442e-01f, 4.567528814e-01f, 2.635899757e-01f, 1.494381325e-01f, 8.425120614e-02f, 4.741637909e-02f, 2.667102809e-02f, 1.499943751e-02f, 8.435019850e-03f, 4.743398702e-03f, 2.667415952e-03f,
-9.576594803e-01f, -9.100810415e-01f, 3.403182001e-01f, -9.564100574e-01f, -2.919952230e-02f, 6.218088190e-01f, 8.747074712e-01f, 9.597951768e-01f, 9.872272834e-01f, 9.959550145e-01f, 9.987202730e-01f, 9.995952558e-01f, 9.998720027e-01f, 9.999595231e-01f, 9.999872000e-01f, 9.999959523e-01f, -2.879033167e-01f, 4.144303293e-01f, -9.403103332e-01f, 2.920270571e-01f, 9.995736030e-01f, 7.831690702e-01f, 4.846512559e-01f, 2.807012978e-01f, 1.593182066e-01f, 8.985326395e-02f, 5.057485751e-02f, 2.844863180e-02f, 1.599931734e-02f, 8.997339806e-03f, 5.059622668e-03f, 2.845243217e-03f,
-2.751633381e-01f, -9.908980244e-01f, 6.158647034e-01f, -9.929849996e-01f, -1.288444943e-01f, 5.768082866e-01f, 8.589466897e-01f, 9.546520336e-01f, 9.855847669e-01f, 9.954339878e-01f, 9.985553480e-01f, 9.995430857e-01f, 9.998555035e-01f, 9.999543054e-01f, 9.999855500e-01f, 9.999954305e-01f, -9.613974919e-01f, -1.346146549e-01f, -7.878519322e-01f, 1.182403929e-01f, 9.916648105e-01f, 8.168795508e-01f, 5.120650195e-01f, 2.977238566e-01f, 1.691823491e-01f, 9.545248036e-02f, 5.373283018e-02f, 3.022614554e-02f, 1.699918118e-02f, 9.559656917e-03f, 5.375846129e-03f, 3.023070392e-03f,
6.603167082e-01f, -7.665364704e-01f, 8.303362493e-01f, -9.982416606e-01f, -2.272020947e-01f, 5.299842069e-01f, 8.423270331e-01f, 9.492070108e-01f, 9.838436928e-01f, 9.948814827e-01f, 9.983804374e-01f, 9.994877548e-01f, 9.998380044e-01f, 9.999487715e-01f, 9.999838000e-01f, 9.999948771e-01f, -7.509872468e-01f, -6.422007782e-01f, -5.572626967e-01f, -5.927551787e-02f, 9.738476309e-01f, 8.480075120e-01f, 5.389667608e-01f, 3.146522694e-01f, 1.790295734e-01f, 1.010486783e-01f, 5.689026552e-02f, 3.200356370e-02f, 1.799902802e-02f, 1.012197101e-02f, 5.692069051e-03f, 3.200897472e-03f,
9.887046182e-01f, -3.060956503e-01f, 9.624638147e-01f, -9.720142477e-01f, -3.232895669e-01f, 4.814846115e-01f, 8.248651197e-01f, 9.434618303e-01f, 9.820042351e-01f, 9.942975168e-01f, 9.981955429e-01f, 9.994292632e-01f, 9.998195054e-01f, 9.999429214e-01f, 9.999819501e-01f, 9.999942921e-01f, 1.498772097e-01f, -9.520007631e-01f, -2.714100320e-01f, -2.349219066e-01f, 9.463000877e-01f, 8.764545447e-01f, 5.653295802e-01f, 3.314811830e-01f, 1.888588950e-01f, 1.066416808e-01f, 6.004713196e-02f, 3.378088066e-02f, 1.899885685e-02f, 1.068428189e-02f, 6.008291404e-03f, 3.378724451e-03f,
4.080820618e-01f, 2.486170528e-01f, 9.991443830e-01f, -9.151299613e-01f, -4.161468365e-01f, 4.314628294e-01f, 8.065784099e-01f, 9.374183089e-01f, 9.800665778e-01f, 9.936821085e-01f, 9.980006666e-01f, 9.993676111e-01f, 9.998000067e-01f, 9.999367551e-01f, 9.999800001e-01f, 9.999936755e-01f, 9.129452507e-01f, -9.686018589e-01f, 4.135821352e-02f, -4.031589686e-01f, 9.092974268e-01f, 9.021307150e-01f, 5.911271172e-01f, 3.482052759e-01f, 1.986693308e-01f, 1.122313110e-01f, 6.320339793e-02f, 3.555809079e-02f, 1.999866669e-02f, 1.124658940e-02f, 6.324513157e-03f, 3.556551322e-03f,
-5.477292602e-01f, 7.267602337e-01f, 9.367403630e-01f, -8.293829050e-01f, -5.048461046e-01f, 3.800770014e-01f, 7.874851889e-01f, 9.310783576e-01f, 9.780309147e-01f, 9.930352774e-01f, 9.977958102e-01f, 9.993027988e-01f, 9.997795081e-01f, 9.999302726e-01f, 9.999779501e-01f, 9.999930272e-01f, 8.366556385e-01f, -6.868912307e-01f, 3.500249882e-01f, -5.586805857e-01f, 8.632093666e-01f, 9.249548492e-01f, 6.163335763e-01f, 3.648192595e-01f, 2.084598998e-01f, 1.178173922e-01f, 6.635903187e-02f, 3.733518848e-02f, 2.099845653e-02f, 1.180889335e-02f, 6.640734277e-03f, 3.734378081e-03f,
-9.999608264e-01f, 9.810745045e-01f, 7.814403262e-01f, -7.174775009e-01f, -5.885011173e-01f, 3.274895812e-01f, 7.676045483e-01f, 9.244439812e-01f, 9.758974493e-01f, 9.923570438e-01f, 9.975809759e-01f, 9.992348264e-01f, 9.997580098e-01f, 9.999234739e-01f, 9.999758001e-01f, 9.999923473e-01f, -8.851309290e-03f, -1.936306189e-01f, 6.239799809e-01f, -6.965816792e-01f, 8.084964038e-01f, 9.448547900e-01f, 6.409237532e-01f, 3.813178801e-01f, 2.182296231e-01f, 1.233997476e-01f, 6.951400222e-02f, 3.911216810e-02f, 2.199822538e-02f, 1.237119357e-02f, 6.956954733e-03f, 3.912204722e-03f,
-5.328330203e-01f, 9.332357037e-01f, 5.486452902e-01f, -5.829431928e-01f, -6.662760213e-01f, 2.738668208e-01f, 7.469563671e-01f, 9.175172776e-01f, 9.736663950e-01f, 9.916474291e-01f, 9.973561658e-01f, 9.991636942e-01f, 9.997355117e-01f, 9.999163589e-01f, 9.999735501e-01f, 9.999916358e-01f, -8.462204042e-01f, 3.592646954e-01f, 8.360552287e-01f, -8.125129131e-01f, 7.457052122e-01f, 9.617676250e-01f, 6.648730598e-01f, 3.976959206e-01f, 2.279775235e-01f, 1.289782009e-01f, 7.266827742e-02f, 4.088902404e-02f, 2.299797222e-02f, 1.293348988e-02f, 7.273174493e-03f, 4.090031240e-03f,
4.241790073e-01f, 5.979773102e-01f, 2.614414084e-01f, -4.300231298e-01f, -7.373937155e-01f, 2.193782457e-01f, 7.255612918e-01f, 9.103004373e-01f, 9.713379749e-01f, 9.909064559e-01f, 9.971213821e-01f, 9.990894023e-01f, 9.997120138e-01f, 9.999089278e-01f, 9.999712001e-01f, 9.999908927e-01f, -9.055783620e-01f, 8.015130295e-01f, 9.652193481e-01f, -9.028178708e-01f, 6.754631806e-01f, 9.756398851e-01f, 6.881575487e-01f, 4.139482019e-01f, 2.377026264e-01f, 1.345525755e-01f, 7.582182595e-02f, 4.266575068e-02f, 2.399769607e-02f, 1.349578209e-02f, 7.589393526e-03f, 4.267857628e-03f,
9.912028119e-01f, 7.855280068e-02f, -5.168947139e-02f, -2.635403389e-01f, -8.011436155e-01f, 1.641961185e-01f, 7.034407157e-01f, 9.027957423e-01f, 9.689124217e-01f, 9.901341476e-01f, 9.968766273e-01f, 9.990119510e-01f, 9.996875163e-01f, 9.999011805e-01f, 9.999687502e-01f, 9.999901179e-01f, -1.323517501e-01f, 9.969099546e-01f, 9.986632058e-01f, -9.646483762e-01f, 5.984721441e-01f, 9.864277139e-01f, 7.107539373e-01f, 4.300695848e-01f, 2.474039593e-01f, 1.401226951e-01f, 7.897461625e-02f, 4.444234239e-02f, 2.499739591e-02f, 1.405807004e-02f, 7.905611800e-03f, 4.445683881e-03f,
6.469193223e-01f, -4.650645402e-01f, -3.596943353e-01f, -8.874560929e-02f, -8.568887534e-01f, 1.084948944e-01f, 6.806167575e-01f, 8.950055657e-01f, 9.663899781e-01f, 9.893305286e-01f, 9.966219036e-01f, 9.989313405e-01f, 9.996620190e-01f, 9.998931169e-01f, 9.999662002e-01f, 9.999893115e-01f, 7.625584505e-01f, 8.852767779e-01f, 9.330701931e-01f, -9.960543242e-01f, 5.155013718e-01f, 9.940970063e-01f, 7.326396313e-01f, 4.460549713e-01f, 2.570805519e-01f, 1.456883837e-01f, 8.212661682e-02f, 4.621879357e-02f, 2.599707077e-02f, 1.462035354e-02f, 8.221829283e-03f, 4.623509993e-03f,
-2.921388087e-01f, -8.654504764e-01f, -6.320285135e-01f, 8.884811520e-02f, -9.040721420e-01f, 5.245066969e-02f, 6.571122393e-01f, 8.869323709e-01f, 9.637708964e-01f, 9.884956243e-01f, 9.963572138e-01f, 9.988475712e-01f, 9.996355221e-01f, 9.998847372e-01f, 9.999635502e-01f, 9.999884735e-01f, 9.563759284e-01f, 5.009944839e-01f, 7.749451323e-01f, -9.960451859e-01f, 4.273798802e-01f, 9.986235163e-01f, 7.537927467e-01f, 4.618993065e-01f, 2.667314367e-01f, 1.512494653e-01f, 8.527779611e-02f, 4.799509859e-02f, 2.699671962e-02f, 1.518263242e-02f, 8.538045944e-03f, 4.801335960e-03f,
-9.626058663e-01f, -9.992934349e-01f, -8.416847784e-01f, 2.636396118e-01f, -9.422223407e-01f, -3.759374883e-03f, 6.329506635e-01f, 8.785787110e-01f, 9.610554383e-01f, 9.876294611e-01f, 9.960825604e-01f, 9.987606432e-01f, 9.996080256e-01f, 9.998760413e-01f, 9.999608003e-01f, 9.999876039e-01f, 2.709057883e-01f, -3.758498280e-02f, 5.399691971e-01f, -9.646212496e-01f, 3.349881502e-01f, 9.999929335e-01f, 7.741921322e-01f, 4.775975802e-01f, 2.763556486e-01f, 1.568057639e-01f, 8.842812263e-02f, 4.977125184e-02f, 2.799634148e-02f, 1.574490650e-02f, 8.854261752e-03f, 4.979161774e-03f,
-7.480575297e-01f, -8.253722231e-01f, -9.678716355e-01f, 4.301160387e-01f, -9.709581651e-01f, -5.995753440e-02f, 6.081561899e-01f, 8.699472273e-01f, 9.582438755e-01f, 9.867320664e-01f, 9.957979462e-01f, 9.986705569e-01f, 9.995795295e-01f, 9.998670292e-01f, 9.999579503e-01f, 9.999867027e-01f, -6.636338842e-01f, -5.645889596e-01f, 2.514448194e-01f, -9.027736113e-01f, 2.392493292e-01f, 9.982009287e-01f, 7.938173900e-01f, 4.931448283e-01f, 2.859522251e-01f, 1.623571039e-01f, 9.157756487e-02f, 5.154724769e-02f, 2.899593534e-02f, 1.630717560e-02f, 9.170476674e-03f, 5.156987431e-03f,
1.542514499e-01f, -3.972514054e-01f, -9.980752051e-01f, 5.830268074e-01f, -9.899924966e-01f, -1.159661415e-01f, 5.827536107e-01f, 8.610406494e-01f, 9.553364891e-01f, 9.858034685e-01f, 9.955033740e-01f, 9.985773125e-01f, 9.995500337e-01f, 9.998577009e-01f, 9.999550003e-01f, 9.999857698e-01f, -9.880316241e-01f, -9.177098239e-01f, -6.201520023e-02f, -8.124529167e-01f, 1.411200081e-01f, 9.932531671e-01f, 8.126488966e-01f, 5.085361344e-01f, 2.955202067e-01f, 1.679033098e-01f, 9.472609133e-02f, 5.332308054e-02f, 2.999550020e-02f, 1.686943954e-02f, 9.486690679e-03f, 5.334812925e-03f,
9.147423578e-01f, 1.532156071e-01f, -9.293002159e-01f, 7.175491840e-01f, -9.991351503e-01f, -1.716081281e-01f, 5.567683265e-01f, 8.518617938e-01f, 9.523335699e-01f, 9.848436969e-01f, 9.951988468e-01f, 9.984809103e-01f, 9.995195385e-01f, 9.998480564e-01f, 9.999519504e-01f, 9.999848053e-01f, -4.040376453e-01f, -9.881927837e-01f, -3.693252072e-01f, -6.965078381e-01f, 4.158066243e-02f, 9.851652909e-01f, 8.306678221e-01f, 5.237666315e-01f, 3.050586364e-01f, 1.734442061e-01f, 9.787367054e-02f, 5.509874477e-02f, 3.099503507e-02f, 1.743169815e-02f, 9.802903735e-03f, 5.512638250e-03f,
8.342233605e-01f, 6.564950042e-01f, -7.683670453e-01f, 8.294403958e-01f, -9.982947758e-01f, -2.267075851e-01f, 5.302263203e-01f, 8.424135629e-01f, 9.492354181e-01f, 9.838527819e-01f, 9.948843676e-01f, 9.983813507e-01f, 9.994880437e-01f, 9.998380958e-01f, 9.999488004e-01f, 9.999838092e-01f, 5.514266812e-01f, -7.543303715e-01f, -6.400094403e-01f, -5.585952289e-01f, -5.837414343e-02f, 9.739628693e-01f, 8.478561489e-01f, 5.388315034e-01f, 3.145665606e-01f, 1.789796176e-01f, 1.010202710e-01f, 5.687423476e-02f, 3.199453895e-02f, 1.799395124e-02f, 1.011911581e-02f, 5.690463401e-03f,
-1.327674722e-02f, 9.575859018e-01f, -5.312353455e-01f, 9.151714465e-01f, -9.874797699e-01f, -2.810903188e-01f, 5.031541321e-01f, 8.326989444e-01f, 9.460423435e-01f, 9.828307548e-01f, 9.945599395e-01f, 9.982786339e-01f, 9.994555494e-01f, 9.998278189e-01f, 9.999455505e-01f, 9.999827814e-01f, 9.999118601e-01f, -2.881479492e-01f, -8.472242960e-01f, -4.030647882e-01f, -1.577456941e-01f, 9.596813183e-01f, 8.641966902e-01f, 5.537259863e-01f, 3.240430284e-01f, 1.845093693e-01f, 1.041658613e-01f, 5.864954490e-02f, 3.299401083e-02f, 1.855619865e-02f, 1.043532687e-02f, 5.868288372e-03f,
-8.485702748e-01f, 9.637577894e-01f, -2.414213342e-01f, 9.720384190e-01f, -9.667981926e-01f, -3.345844009e-01f, 4.755788316e-01f, 8.227210104e-01f, 9.427546655e-01f, 9.817776480e-01f, 9.942255659e-01f, 9.981727603e-01f, 9.994220557e-01f, 9.998172259e-01f, 9.999422006e-01f, 9.999817221e-01f, 5.290826861e-01f, 2.667787912e-01f, -9.704203931e-01f, -2.348218730e-01f, -2.555411020e-01f, 9.423657881e-01f, 8.796731069e-01f, 5.684453703e-01f, 3.334870921e-01f, 1.900332863e-01f, 1.073104099e-01f, 6.042466957e-02f, 3.399344971e-02f, 1.911844019e-02f, 1.075153690e-02f, 6.046113157e-03f,
-9.036922051e-01f, 6.731098380e-01f, 7.233429552e-02f, 9.982477555e-01f, -9.364566873e-01f, -3.870207132e-01f, 4.475279919e-01f, 8.124829160e-01f, 9.393727128e-01f, 9.806934947e-01f, 9.938812501e-01f, 9.980637301e-01f, 9.993875625e-01f, 9.998063167e-01f, 9.999387506e-01f, 9.999806311e-01f, -4.281826695e-01f, 7.395425248e-01f, -9.973804438e-01f, -5.917278607e-02f, -3.507832277e-01f, 9.220710209e-01f, 8.942699237e-01f, 5.829850008e-01f, 3.428978075e-01f, 1.955511940e-01f, 1.104538854e-01f, 6.219960316e-02f, 3.499285460e-02f, 1.968067568e-02f, 1.106774584e-02f, 6.223937751e-03f,
-1.279636896e-01f, 1.751563210e-01f, 3.789165737e-01f, 9.929728260e-01f, -8.967584163e-01f, -4.382334809e-01f, 4.190296615e-01f, 8.019878987e-01f, 9.358968237e-01f, 9.795783292e-01f, 9.935269954e-01f, 9.979515438e-01f, 9.993520700e-01f, 9.997950914e-01f, 9.999352007e-01f, 9.999795085e-01f, -9.917788534e-01f, 9.845406356e-01f, -9.254308349e-01f, 1.183425828e-01f, -4.425204433e-01f, 8.988611774e-01f, 9.079725452e-01f, 5.973402802e-01f, 3.522742333e-01f, 2.010629178e-01f, 1.135962563e-01f, 6.397434006e-02f, 3.599222450e-02f, 2.024290495e-02f, 1.138395368e-02f, 6.401762149e-03f,
7.654140519e-01f, -3.767421515e-01f, 6.479219076e-01f, 9.563799991e-01f, -8.481000317e-01f, -4.880607978e-01f, 3.901123364e-01f, 7.912392773e-01f, 9.323273456e-01f, 9.784321869e-01f, 9.931628054e-01f, 9.978362017e-01f, 9.993155781e-01f, 9.997835499e-01f, 9.999315508e-01f, 9.999783543e-01f, -6.435381334e-01f, 9.263181696e-01f, -7.617067688e-01f, 2.921254821e-01f, -5.298361409e-01f, 8.728096342e-01f, 9.207672697e-01f, 6.115066689e-01f, 3.616154320e-01f, 2.065682834e-01f, 1.167374914e-01f, 6.574887465e-02f, 3.699155841e-02f, 2.080512781e-02f, 1.170016038e-02f, 6.579586343e-03f,
9.550736440e-01f, -8.126109057e-01f, 8.526731891e-01f, 8.896233956e-01f, -7.909677119e-01f, -5.363451377e-01f, 3.608049314e-01f, 7.802404506e-01f, 9.286646356e-01f, 9.772551038e-01f, 9.927886839e-01f, 9.977177042e-01f, 9.992780869e-01f, 9.997716922e-01f, 9.999278009e-01f, 9.999771684e-01f, 2.963685787e-01f, 5.828065854e-01f, -5.224446694e-01f, 4.566948806e-01f, -6.118578909e-01f, 8.439987519e-01f, 9.326413038e-01f, 6.254796874e-01f, 3.709204694e-01f, 2.120671168e-01f, 1.198775590e-01f, 6.752320133e-02f, 3.799085533e-02f, 2.136734410e-02f, 1.201636591e-02f, 6.757410330e-03f,
2.666429324e-01f, -9.982103072e-01f, 9.728653484e-01f, 7.948084874e-01f, -7.259323042e-01f, -5.829338522e-01f, 3.311367516e-01f, 7.689948967e-01f, 9.249090599e-01f, 9.760471174e-01f, 9.924046345e-01f, 9.975960516e-01f, 9.992395964e-01f, 9.997595184e-01f, 9.999239510e-01f, 9.999759510e-01f, 9.637953863e-01f, 5.980119189e-02f, -2.313720250e-01f, 6.068603368e-01f, -6.877661592e-01f, 8.125196145e-01f, 9.435827742e-01f, 6.392549170e-01f, 3.801884151e-01f, 2.175592441e-01f, 1.230164278e-01f, 6.929731449e-02f, 3.899011425e-02f, 2.192955363e-02f, 1.233257024e-02f, 6.935234103e-03f,
-6.669380617e-01f, -8.763791221e-01f, 9.965789963e-01f, 6.749256921e-01f, -6.536436209e-01f, -6.276796538e-01f, 3.011374626e-01f, 7.575061717e-01f, 9.210609940e-01f, 9.748082656e-01f, 9.920106610e-01f, 9.974712444e-01f, 9.992001067e-01f, 9.997470285e-01f, 9.999200011e-01f, 9.999747019e-01f, 7.451131605e-01f, -4.816218791e-01f, 8.264565347e-02f, 7.378857026e-01f, -7.568024953e-01f, 7.784717415e-01f, 9.535807405e-01f, 6.528280017e-01f, 3.894183423e-01f, 2.230444916e-01f, 1.261540665e-01f, 7.107120850e-02f, 3.998933419e-02f, 2.249175622e-02f, 1.264877333e-02f, 7.113057657e-03f,
-9.873392775e-01f, -4.846391354e-01f, 9.214624639e-01f, 5.337560571e-01f, -5.748239465e-01f, -6.704410810e-01f, 2.708370612e-01f, 7.457779085e-01f, 9.171208228e-01f, 9.735385879e-01f, 9.916067674e-01f, 9.973432828e-01f, 9.991596177e-01f, 9.997342223e-01f, 9.999159512e-01f, 9.999734212e-01f, -1.586226688e-01f, -8.747141867e-01f, 3.884674088e-01f, 8.456384993e-01f, -8.182771111e-01f, 7.419627733e-01f, 9.626252055e-01f, 6.661946496e-01f, 3.986093280e-01f, 2.285226858e-01f, 1.292904437e-01f, 7.284487777e-02f, 4.098851413e-02f, 2.305395171e-02f, 1.296497516e-02f, 7.290880986e-03f,
-3.999853150e-01f, 5.636087450e-02f, 7.549650153e-01f, 3.757520063e-01f, -4.902608213e-01f, -7.110829460e-01f, 2.402658454e-01f, 7.338138159e-01f, 9.130889403e-01f, 9.722381242e-01f, 9.911929578e-01f, 9.972121674e-01f, 9.991181296e-01f, 9.997211001e-01f, 9.999118013e-01f, 9.999721088e-01f, -9.165215479e-01f, -9.984104626e-01f, 6.557650689e-01f, 9.267202543e-01f, -8.715757724e-01f, 7.031081310e-01f, 9.707071255e-01f, 6.793506338e-01f, 4.077604531e-01f, 2.339936535e-01f, 1.324255279e-01f, 7.461831668e-02f, 4.198765309e-02f, 2.361613990e-02f, 1.328117570e-02f, 7.468704084e-03f,
5.551133015e-01f, 5.800027620e-01f, 5.135981094e-01f, 2.058969135e-01f, -4.007991721e-01f, -7.494767618e-01f, 2.094543837e-01f, 7.216176770e-01f, 9.089657497e-01f, 9.709069157e-01f, 9.907692362e-01f, 9.970778985e-01f, 9.990756424e-01f, 9.997076617e-01f, 9.999075514e-01f, 9.999707649e-01f, -8.317747426e-01f, -8.146145076e-01f, 8.580308748e-01f, 9.785736871e-01f, -9.161659367e-01f, 6.620306515e-01f, 9.778184193e-01f, 6.922917941e-01f, 4.168708024e-01f, 2.394572216e-01f, 1.355592879e-01f, 7.639151963e-02f, 4.298675006e-02f, 2.417832062e-02f, 1.359737490e-02f, 7.646526947e-03f,
9.998433086e-01f, 9.250143668e-01f, 2.212979668e-01f, 2.954792850e-02f, -3.073328700e-01f, -7.855011484e-01f, 1.784334851e-01f, 7.091933487e-01f, 9.047516632e-01f, 9.695450046e-01f, 9.903356070e-01f, 9.969404766e-01f, 9.990321562e-01f, 9.996939071e-01f, 9.999032016e-01f, 9.999693893e-01f, 1.770192511e-02f, -3.799321270e-01f, 9.752062397e-01f, 9.995633646e-01f, -9.516020739e-01f, 6.188601989e-01f, 9.839519762e-01f, 7.050140383e-01f, 4.259394651e-01f, 2.449132175e-01f, 1.386916923e-01f, 7.816448100e-02f, 4.398580404e-02f, 2.474049370e-02f, 1.391357275e-02f, 7.824349567e-03f,
5.253219888e-01f, 9.851384009e-01f, -9.294817111e-02f, -1.477329843e-01f, -2.107957994e-01f, -8.190422169e-01f, 1.472341679e-01f, 6.965447596e-01f, 9.004471024e-01f, 9.681524338e-01f, 9.898920744e-01f, 9.967999021e-01f, 9.989876708e-01f, 9.996798365e-01f, 9.998987517e-01f, 9.999679821e-01f, 8.509035245e-01f, 1.717624261e-01f, 9.956709484e-01f, 9.890272824e-01f, -9.775301177e-01f, 5.737332542e-01f, 9.891016630e-01f, 7.175133434e-01f, 4.349655341e-01f, 2.503614686e-01f, 1.418227098e-01f, 7.993719520e-02f, 4.498481404e-02f, 2.530265896e-02f, 1.422976920e-02f, 8.002171940e-03f,
-4.321779449e-01f, 7.418577573e-01f, -3.979766910e-01f, -3.203544680e-01f, -1.121525269e-01f, -8.499939289e-01f, 1.158876288e-01f, 6.836759095e-01f, 8.960524975e-01f, 9.667292474e-01f, 9.894386429e-01f, 9.966561754e-01f, 9.989421865e-01f, 9.996654497e-01f, 9.998942019e-01f, 9.999665433e-01f, 9.017883476e-01f, 6.705572816e-01f, 9.173955273e-01f, 9.472977435e-01f, -9.936910036e-01f, 5.267924836e-01f, 9.932623307e-01f, 7.297857568e-01f, 4.439481070e-01f, 2.558018026e-01f, 1.449523091e-01f, 8.170965662e-02f, 4.598377905e-02f, 2.586481621e-02f, 1.454596424e-02f, 8.179994060e-03f,
-9.923354692e-01f, 2.700984415e-01f, -6.635380855e-01f, -4.828721220e-01f, -1.238866346e-02f, -8.782584324e-01f, 8.442521171e-02f, 6.705908678e-01f, 8.915682882e-01f, 9.652754904e-01f, 9.889753170e-01f, 9.965092971e-01f, 9.988957033e-01f, 9.996507468e-01f, 9.998895520e-01f, 9.999650728e-01f, 1.235731227e-01f, 9.628327123e-01f, 7.481425059e-01f, 8.756908780e-01f, -9.999232576e-01f, 4.781862879e-01f, 9.964298187e-01f, 7.418273977e-01f, 4.528862854e-01f, 2.612340474e-01f, 1.480804588e-01f, 8.348185965e-02f, 4.698269808e-02f, 2.642696529e-02f, 1.486215781e-02f, 8.357815921e-03f,
-6.401443395e-01f, -2.848462729e-01f, -8.632967800e-01f, -6.301602158e-01f, 8.749898344e-02f, -9.037463706e-01f, 5.287837645e-02f, 6.572937723e-01f, 8.869949228e-01f, 9.637912089e-01f, 9.885021014e-01f, 9.963592674e-01f, 9.988482212e-01f, 9.996357277e-01f, 9.998848022e-01f, 9.999635708e-01f, -7.682546613e-01f, 9.585732110e-01f, 5.046966116e-01f, 7.764651328e-01f, -9.961646088e-01f, 4.280683329e-01f, 9.986009600e-01f, 7.536344584e-01f, 4.617791755e-01f, 2.666580314e-01f, 1.512071278e-01f, 8.525379868e-02f, 4.798157012e-02f, 2.698910600e-02f, 1.517834990e-02f, 8.535637518e-03f,
3.005925437e-01f, -7.520635254e-01f, -9.774428167e-01f, -7.575733518e-01f, 1.865123694e-01f, -9.263771649e-01f, 2.127866722e-02f, 6.437888276e-01f, 8.823328586e-01f, 9.622764496e-01f, 9.880190008e-01f, 9.962060871e-01f, 9.987997402e-01f, 9.996203926e-01f, 9.998799524e-01f, 9.999620371e-01f, -9.537526528e-01f, 6.590906264e-01f, 2.112002371e-01f, 6.527500415e-01f, -9.824526126e-01f, 3.765970636e-01f, 9.997735835e-01f, 7.652032053e-01f, 4.706258882e-01f, 2.720735828e-01f, 1.543322846e-01f, 8.702546812e-02f, 4.898039419e-02f, 2.755123819e-02f, 1.549454048e-02f, 8.713458845e-03f,
9.649660285e-01f, -9.876589150e-01f, -9.946563971e-01f, -8.610929796e-01f, 2.836621855e-01f, -9.460792693e-01f, -1.034231891e-02f, 6.300803045e-01f, 8.775825619e-01f, 9.607312606e-01f, 9.875260200e-01f, 9.960497564e-01f, 9.987502604e-01f, 9.996047413e-01f, 9.998750026e-01f, 9.999604718e-01f, -2.623748537e-01f, 1.566201379e-01f, -1.032407464e-01f, 5.084475199e-01f, -9.589242747e-01f, 3.239352036e-01f, 9.999465168e-01f, 7.765299800e-01f, 4.794255386e-01f, 2.774805306e-01f, 1.574558982e-01f, 8.879686236e-02f, 4.997916927e-02f, 2.811336166e-02f, 1.581072950e-02f, 8.891279896e-03f,
7.421541968e-01f, -9.190733545e-01f, -9.132304601e-01f, -9.374541386e-01f, 3.779777427e-01f, -9.627903967e-01f, -4.195296357e-02f, 6.161725377e-01f, 8.727445076e-01f, 9.591556907e-01f, 9.870231639e-01f, 9.958902760e-01f, 9.986997819e-01f, 9.995887740e-01f, 9.998699528e-01f, 9.999588749e-01f, 6.702291758e-01f, -3.940864994e-01f, -4.074434030e-01f, 3.481088020e-01f, -9.258146823e-01f, 2.702492405e-01f, 9.991195869e-01f, 7.876112009e-01f, 4.881772469e-01f, 2.828787037e-01f, 1.605779372e-01f, 9.056797580e-02f, 5.097789438e-02f, 2.867547624e-02f, 1.612691694e-02f, 9.069100666e-03f,
-1.629907808e-01f, -5.674299469e-01f, -7.412399703e-01f, -9.842484337e-01f, 4.685166713e-01f, -9.764577158e-01f, -7.352165877e-02f, 6.020699252e-01f, 8.678191797e-01f, 9.575497897e-01f, 9.865104376e-01f, 9.957276462e-01f, 9.986483046e-01f, 9.995724905e-01f, 9.998648030e-01f, 9.999572463e-01f, 9.866275920e-01f, -8.234216753e-01f, -6.712401257e-01f, 1.767908958e-01f, -8.834546557e-01f, 2.157088994e-01f, 9.972936206e-01f, 7.984433638e-01f, 4.968801378e-01f, 2.882679314e-01f, 1.636983704e-01f, 9.233880284e-02f, 5.197656850e-02f, 2.923758175e-02f, 1.644310277e-02f, 9.246921150e-03f,
-9.182827862e-01f, -4.102845452e-02f, -4.957411282e-01f, -9.999999947e-01f, 5.543743362e-01f, -9.870380181e-01f, -1.050168384e-01f, 5.877769265e-01f, 8.628070705e-01f, 9.559136084e-01f, 9.859878462e-01f, 9.955618678e-01f, 9.985958287e-01f, 9.995558910e-01f, 9.998595533e-01f, 9.999555861e-01f, 3.959251502e-01f, -9.991579785e-01f, -8.684703414e-01f, -1.029124367e-04f, -8.322674422e-01f, 1.604866066e-01f, 9.944704438e-01f, 8.090230434e-01f, 5.055333412e-01f, 2.936480433e-01f, 1.668171666e-01f, 9.410933788e-02f, 5.297519065e-02f, 2.979967802e-02f, 1.675928696e-02f, 9.424741341e-03f,
-8.293098329e-01f, 4.980090543e-01f, -2.010799162e-01f, -9.842120249e-01f, 6.346928759e-01f, -9.944978545e-01f, -1.364070100e-01f, 5.732980613e-01f, 8.577086814e-01f, 9.542471985e-01f, 9.854553950e-01f, 9.953929410e-01f, 9.985423543e-01f, 9.995389753e-01f, 9.998542035e-01f, 9.999538943e-01f, -5.587890489e-01f, -8.671718295e-01f, -9.795748401e-01f, -1.769934748e-01f, -7.727644876e-01f, 1.047569444e-01f, 9.906528795e-01f, 8.193468942e-01f, 5.141359917e-01f, 2.990188692e-01f, 1.699342947e-01f, 9.587957531e-02f, 5.397375983e-02f, 3.036176486e-02f, 1.707546947e-02f, 9.602561234e-03f,
2.212675626e-02f, 8.836688484e-01f, 1.135222784e-01f, -9.373824693e-01f, 7.086697743e-01f, -9.988136413e-01f, -1.676607860e-01f, 5.586379081e-01f, 8.525245221e-01f, 9.525506128e-01f, 9.849130892e-01f, 9.952208666e-01f, 9.984878812e-01f, 9.995217436e-01f, 9.998487538e-01f, 9.999521709e-01f, -9.997551734e-01f, -4.681125574e-01f, -9.935354510e-01f, -3.483017460e-01f, -7.055403256e-01f, 4.869609889e-02f, 9.858447448e-01f, 8.294116515e-01f, 5.226872289e-01f, 3.043802394e-01f, 1.730497234e-01f, 9.764950955e-02f, 5.497227503e-02f, 3.092384210e-02f, 1.739165027e-02f, 9.780380823e-03f,
8.532201077e-01f, 9.971747381e-01f, 4.168665323e-01f, -8.609883102e-01f, 7.755658785e-01f, -9.999717342e-01f, -1.987469151e-01f, 5.438011027e-01f, 8.472551110e-01f, 9.508239048e-01f, 9.843609343e-01f, 9.950456450e-01f, 9.984324097e-01f, 9.995041958e-01f, 9.998432041e-01f, 9.999504159e-01f, -5.215510021e-01f, 7.511685313e-02f, -9.089677080e-01f, -5.086247435e-01f, -6.312666379e-01f, -7.518696635e-03f, 9.800508475e-01f, 8.392141328e-01f, 5.311861979e-01f, 3.097319842e-01f, 1.761634216e-01f, 9.941913500e-02f, 5.597073526e-02f, 3.148590956e-02f, 1.770782933e-02f, 9.958200103e-03f,
8.998668270e-01f, 8.035689776e-01f, 6.788703658e-01f, -7.574389836e-01f, 8.347127848e-01f, -9.979684721e-01f, -2.296343139e-01f, 5.287923369e-01f, 8.419009752e-01f, 9.490671292e-01f, 9.837989357e-01f, 9.948672768e-01f, 9.983759398e-01f, 9.994863320e-01f, 9.998375544e-01f, 9.999486292e-01f, 4.361647552e-01f, 5.952116415e-01f, -7.342581470e-01f, -6.529059551e-01f, -5.506855426e-01f, -6.370972221e-02f, 9.732769811e-01f, 8.487512383e-01f, 5.396320487e-01f, 3.150739345e-01f, 1.792753582e-01f, 1.011884461e-01f, 5.696913951e-02f, 3.204796707e-02f, 1.802400663e-02f, 1.013601907e-02f,
1.191801354e-01f, 3.624786135e-01f, 8.735510056e-01f, -6.300003866e-01f, 8.855195169e-01f, -9.928101881e-01f, -2.602920974e-01f, 5.136163566e-01f, 8.364626499e-01f, 9.472803416e-01f, 9.832270992e-01f, 9.946857625e-01f, 9.983184715e-01f, 9.994681520e-01f, 9.998318047e-01f, 9.999468110e-01f, 9.928726481e-01f, 9.319920894e-01f, -4.867326171e-01f, -7.765948190e-01f, -4.646021794e-01f, -1.196993330e-01f, 9.655299188e-01f, 8.580199521e-01f, 5.480239368e-01f, 3.204059213e-01f, 1.823855020e-01f, 1.029574371e-01f, 5.796748680e-02f, 3.261001444e-02f, 1.834018212e-02f, 1.031383771e-02f,
-7.710802230e-01f, -1.902485591e-01f, 9.816020819e-01f, -4.826918728e-01f, 9.274784307e-01f, -9.845131900e-01f, -2.906896106e-01f, 4.982779609e-01f, 8.309406791e-01f, 9.454635984e-01f, 9.826454305e-01f, 9.945011028e-01f, 9.982600048e-01f, 9.994496561e-01f, 9.998259550e-01f, 9.999449611e-01f, 6.367380071e-01f, 9.817359552e-01f, -1.909380864e-01f, -8.757902465e-01f, -3.738766648e-01f, -1.753105211e-01f, 9.568174070e-01f, 8.670173434e-01f, 5.563610229e-01f, 3.257277760e-01f, 1.854938220e-01f, 1.047261026e-01f, 5.896577612e-02f, 3.317205150e-02f, 1.865635577e-02f, 1.049165603e-02f,
-9.524129804e-01f, -6.843826418e-01f, 9.923082299e-01f, -3.201594838e-01f, 9.601702867e-01f, -9.731037080e-01f, -3.207964584e-01f, 4.827820000e-01f, 8.253356149e-01f, 9.436169571e-01f, 9.820539352e-01f, 9.943132982e-01f, 9.982005399e-01f, 9.994308440e-01f, 9.998200054e-01f, 9.999430795e-01f, -3.048106211e-01f, 7.291230346e-01f, 1.237916674e-01f, -9.473636604e-01f, -2.794154982e-01f, -2.303674747e-01f, 9.471481575e-01f, 8.757405669e-01f, 5.646424734e-01f, 3.310393303e-01f, 1.886002871e-01f, 1.064944369e-01f, 5.996400648e-02f, 3.373407807e-02f, 1.897252756e-02f, 1.066947402e-02f,
-2.581016359e-01f, -9.677393408e-01f, 9.046077269e-01f, -1.475294147e-01f, 9.832684384e-01f, -9.586178129e-01f, -3.505825365e-01f, 4.671333740e-01f, 8.196480178e-01f, 9.417404761e-01f, 9.814526195e-01f, 9.941223493e-01f, 9.981400768e-01f, 9.994117159e-01f, 9.998139558e-01f, 9.999411664e-01f, -9.661177700e-01f, 2.519535043e-01f, 4.262450708e-01f, -9.890576686e-01f, -1.821625043e-01f, -2.846961343e-01f, 9.365318388e-01f, 8.841868642e-01f, 5.728674601e-01f, 3.363404163e-01f, 1.917048661e-01f, 1.082624345e-01f, 6.096217687e-02f, 3.429609397e-02f, 1.928869745e-02f, 1.084729167e-02f,
6.735071623e-01f, -9.530499555e-01f, 7.271977827e-01f, 2.975366287e-02f, 9.965420970e-01f, -9.411013007e-01f, -3.800180612e-01f, 4.513370314e-01f, 8.138784567e-01f, 9.398342148e-01f, 9.808414892e-01f, 9.939282566e-01f, 9.980786156e-01f, 9.993922718e-01f, 9.998078062e-01f, 9.999392216e-01f, -7.391806966e-01f, -3.028131145e-01f, 6.864279895e-01f, -9.995572618e-01f, -8.308940282e-02f, -3.381247429e-01f, 9.249790663e-01f, 8.923535645e-01f, 5.810351605e-01f, 3.416308663e-01f, 1.948075281e-01f, 1.100300897e-01f, 6.196028630e-02f, 3.485809903e-02f, 1.960486542e-02f, 1.102510897e-02f,
9.858965816e-01f, -6.448385490e-01f, 4.776720420e-01f, 2.060983239e-01f, 9.998586364e-01f, -9.206095492e-01f, -4.090735996e-01f, 4.353979673e-01f, 8.080275083e-01f, 9.378982333e-01f, 9.802205506e-01f, 9.937310210e-01f, 9.980161563e-01f, 9.993725116e-01f, 9.998015566e-01f, 9.999372453e-01f, 1.673557003e-01f, -7.643188115e-01f, 8.785382293e-01f, -9.785312876e-01f, 1.681390048e-02f, -3.904843889e-01f, 9.125013918e-01f, 9.002380852e-01f, 5.891447579e-01f, 3.469105129e-01f, 1.979082420e-01f, 1.117973969e-01f, 6.295833377e-02f, 3.542009306e-02f, 1.992103142e-02f, 1.120292593e-02f
};

struct Args { const float* in[22]; float* out; unsigned char* ws; int ph_lo, ph_hi; };
struct Frame { LAS unsigned char* lds; int tid, lane, wave, vcu, G, bx; };
#define CAS __attribute__((address_space(4)))
typedef CAS const char* kptr_t;
__device__ __forceinline__ kptr_t kargp() { kptr_t kp = (kptr_t)__builtin_amdgcn_kernarg_segment_ptr(); asm volatile("" : "+s"(kp)); return kp; }
typedef const float* cfp_t; typedef float* fp_t; typedef unsigned char* ucp_t;
__device__ __forceinline__ const float* arg_in(int i) { return *(CAS const cfp_t*)(kargp() + 8 * i); }
__device__ __forceinline__ float* arg_out() { return *(CAS const fp_t*)(kargp() + 176); }
__device__ __forceinline__ unsigned char* arg_ws() { return *(CAS const ucp_t*)(kargp() + 184); }
__device__ __forceinline__ float wave_sum(float v) {
#pragma unroll
    for (int o = 1; o < 64; o <<= 1) v += __shfl_xor(v, o);
    return v;
}
__device__ __forceinline__ float silu_f(float v) { return v * __builtin_amdgcn_rcpf(1.0f + __builtin_amdgcn_exp2f(v * -1.4426950408889634f)); }

constexpr int TP_PITCH = 144;
constexpr int N_TILES = 768 + 512 + 512 + 96 * 256;
struct TileDesc { const float* src; bf16_t* dst; int N, k0, n0, drow0, fp8; };
__device__ __forceinline__ TileDesc p0_decode(int t) {
    TileDesc d; int it, kind = 0; d.fp8 = 0;
    if (t < 768) { d.src = arg_in(8); d.dst = (bf16_t*)(arg_ws() + WS_WIN0); d.N = 3072; it = t; kind = 1; }
    else if (t < 1280) { d.src = arg_in(12); d.dst = (bf16_t*)(arg_ws() + WS_WIN1); d.N = 2048; it = t - 768; }
    else if (t < 1792) { const int x = t - 1280, l = x >> 8; d.src = arg_in(16) + (size_t)l * DM * DM; d.dst = (bf16_t*)(arg_ws() + WS_WOUT) + (size_t)l * DM * DM; d.N = 1024; it = x & 255; }
    else { const int x = t - 1792, mat = x >> 8, which = mat >> 5, le = mat & 31; it = x & 255; d.N = 1024;
        d.src = arg_in(18 + which) + (size_t)le * DM * DM;
        d.fp8 = 1; const int l = le >> 4, e = le & 15;
        if (which == 2) d.dst = (bf16_t*)(arg_ws() + WS_WD + (size_t)l * 32 * MiB + (size_t)e * DM * DM); else { d.dst = (bf16_t*)(arg_ws() + WS_WGU + (size_t)l * 64 * MiB + (size_t)e * 2048 * DM); kind = 2 + which; } }
    const int nb = d.N >> 6, kb = it / nb, nblk = it - kb * nb; d.k0 = kb * 64; d.n0 = nblk * 64;
    int drow0 = d.n0;
    if (kind == 1) { if (d.n0 >= 2560) { const int c = d.n0 - 2560; drow0 = 2048 + (c >> 7) * 256 + 128 + (c & 127); } else if (d.n0 >= 2048) { const int c = d.n0 - 2048; drow0 = 2048 + (c >> 7) * 256 + (c & 127); } }
    else if (kind == 2) drow0 = (d.n0 >> 7) * 256 + (d.n0 & 127);
    else if (kind == 3) drow0 = (d.n0 >> 7) * 256 + 128 + (d.n0 & 127);
    d.drow0 = drow0; return d;
}
__device__ __forceinline__ void p0_tile_load(int t, int lane, f32x4 (&v)[16]) {
    const TileDesc d = p0_decode(t); const int nq = lane >> 2, kq = lane & 3;
    const float* s = d.src + (size_t)(d.k0 + 16 * kq) * d.N + d.n0 + 4 * nq;
#pragma unroll
    for (int i = 0; i < 16; ++i) v[i] = *(const f32x4*)(s + (size_t)i * d.N);
}
__device__ __forceinline__ void p0_tile_store(int t, int lane, const f32x4 (&v)[16], LAS unsigned char* T) {
    const TileDesc d = p0_decode(t); const int nq = lane >> 2, kq = lane & 3;
    if (d.fp8) {
#pragma unroll
        for (int j = 0; j < 4; ++j) { u32x4 w;
            w.x = pk4_fp8((f32x4){v[0][j], v[1][j], v[2][j], v[3][j]} * FP8_SW); w.y = pk4_fp8((f32x4){v[4][j], v[5][j], v[6][j], v[7][j]} * FP8_SW);
            w.z = pk4_fp8((f32x4){v[8][j], v[9][j], v[10][j], v[11][j]} * FP8_SW); w.w = pk4_fp8((f32x4){v[12][j], v[13][j], v[14][j], v[15][j]} * FP8_SW);
            *(LAS u32x4*)(T + (4 * nq + j) * 80 + 16 * kq) = w; }
        LDS_WAIT(); asm volatile("" ::: "memory");
        unsigned char* dp = (unsigned char*)d.dst + (size_t)(d.drow0 + (lane >> 2)) * DM + d.k0 + 16 * (lane & 3);
#pragma unroll
        for (int r = 0; r < 4; ++r) { const u32x4 w = *(const LAS u32x4*)(T + (16 * r + (lane >> 2)) * 80 + 16 * (lane & 3)); *(u32x4*)(dp + (size_t)(16 * r) * DM) = w; }
        LDS_WAIT(); asm volatile("" ::: "memory");
        return;
    }
#pragma unroll
    for (int j = 0; j < 4; ++j) { u32x4 w0, w1;
        w0.x = cvt_pk_bf16(v[0][j], v[1][j]); w0.y = cvt_pk_bf16(v[2][j], v[3][j]); w0.z = cvt_pk_bf16(v[4][j], v[5][j]); w0.w = cvt_pk_bf16(v[6][j], v[7][j]);
        w1.x = cvt_pk_bf16(v[8][j], v[9][j]); w1.y = cvt_pk_bf16(v[10][j], v[11][j]); w1.z = cvt_pk_bf16(v[12][j], v[13][j]); w1.w = cvt_pk_bf16(v[14][j], v[15][j]);
        LAS unsigned char* p = T + (4 * nq + j) * TP_PITCH + 32 * kq; *(LAS u32x4*)p = w0; *(LAS u32x4*)(p + 16) = w1; }
    LDS_WAIT(); asm volatile("" ::: "memory");
    bf16_t* dp = d.dst + (size_t)(d.drow0 + (lane >> 3)) * DM + d.k0 + 8 * (lane & 7);
#pragma unroll
    for (int r = 0; r < 8; ++r) { const u32x4 w = *(const LAS u32x4*)(T + (8 * r + (lane >> 3)) * TP_PITCH + 16 * (lane & 7)); *(u32x4*)(dp + (size_t)(8 * r) * DM) = w; }
    LDS_WAIT(); asm volatile("" ::: "memory");
}
__device__ __forceinline__ void p0_mod_block(Frame& F, int l, int cc, int kq4) {
    LAS float* sl = (LAS float*)F.lds;
    const int kbase = kq4 * 256;
    for (int idx = F.tid; idx < 17 * 256; idx += 512) { const int bb = idx >> 8, k = idx & 255; const float v = (bb < 16) ? arg_in(1)[bb * DM + kbase + k] : arg_in(3)[kbase + k]; sl[k * 20 + bb] = silu_f(v); }
    __syncthreads();
    const int ksub = F.lane >> 3, cq = F.lane & 7, j0 = cc * 256 + F.wave * 32 + 4 * cq;
    f32x4 acc[17];
#pragma unroll
    for (int bb = 0; bb < 17; ++bb) acc[bb] = (f32x4){0.f, 0.f, 0.f, 0.f};
    const float* wl = arg_in(4) + ((size_t)l * DM + kbase) * MODW; const unsigned loff = (unsigned)(ksub * MODW + j0);
#define MOD_LOAD(W, i0) do { _Pragma("unroll") for (int q = 0; q < 8; ++q) W[q] = *(const f32x4*)(wl + (size_t)(8 * ((i0) + q)) * MODW + loff); } while (0)
#define MOD_FMA(W, i0) do { _Pragma("unroll") for (int q = 0; q < 8; ++q) { const int k = 8 * ((i0) + q) + ksub; const f32x4 w = W[q]; \
        const f32x4 s0 = *(const LAS f32x4*)(sl + k * 20), s1 = *(const LAS f32x4*)(sl + k * 20 + 4), s2 = *(const LAS f32x4*)(sl + k * 20 + 8), s3 = *(const LAS f32x4*)(sl + k * 20 + 12); const float s4 = sl[k * 20 + 16]; \
        _Pragma("unroll") for (int z = 0; z < 4; ++z) { acc[z] += s0[z] * w; acc[4 + z] += s1[z] * w; acc[8 + z] += s2[z] * w; acc[12 + z] += s3[z] * w; } \
        acc[16] += s4 * w; __builtin_amdgcn_sched_barrier(0); } } while (0)
    { f32x4 wA[8], wB[8], wC[8], wD[8];
      MOD_LOAD(wA, 0); MOD_LOAD(wB, 8); MOD_LOAD(wC, 16); MOD_LOAD(wD, 24); asm volatile("" ::: "memory");
      MOD_FMA(wA, 0); MOD_FMA(wB, 8); MOD_FMA(wC, 16); MOD_FMA(wD, 24); }
#undef MOD_LOAD
#undef MOD_FMA
#pragma unroll
    for (int bb = 0; bb < 17; ++bb)
#pragma unroll
        for (int q = 0; q < 4; ++q) { float x = acc[bb][q]; x += __shfl_xor(x, 8); x += __shfl_xor(x, 16); x += __shfl_xor(x, 32); acc[bb][q] = x; }
    if (ksub == 0) { float* modp = (float*)(arg_ws() + WS_MODP) + ((size_t)(kq4 * 2 + l) * 17) * MODW + j0;
#pragma unroll
        for (int bb = 0; bb < 17; ++bb) *(f32x4*)(modp + (size_t)bb * MODW) = acc[bb]; }
    __syncthreads();
}
template <class MAP> __device__ __forceinline__ void p0_tiles(Frame& F0, int start, int end, const MAP& tile_of) {
    struct { LAS unsigned char* lds; int lane, wave; } F; { F.lds = F0.lds; F.lane = lane_id_now(); F.wave = F0.wave; }
    LAS unsigned char* T = F.lds + F.wave * (64 * TP_PITCH);
    f32x4 vA[16], vB[16];
    int t = start + F.wave;
    if (t < end) p0_tile_load(tile_of(t), F.lane, vA);
    while (t < end) {
        int t2 = t + NWAVES; if (t2 < end) p0_tile_load(tile_of(t2), F.lane, vB);
        p0_tile_store(tile_of(t), F.lane, vA, T);
        t = t2; if (t >= end) break;
        t2 = t + NWAVES; if (t2 < end) p0_tile_load(tile_of(t2), F.lane, vA);
        p0_tile_store(tile_of(t), F.lane, vB, T);
        t = t2;
    }
}
struct TileIdentity { __device__ __forceinline__ int operator()(int t) const { return t; } };
struct TileMoe { int c;
    __device__ __forceinline__ int operator()(int j) const {
        int l = 0, jj = j; if (j >= 48) { l = 1; jj = j - 48; }
        int mat, it;
        if (jj < 32) { const int g = c * 32 + jj; mat = (g >> 12) * 32 + l * 16 + ((g >> 8) & 15); it = g & 255; }
        else { const int g = c * 16 + (jj - 32); mat = 64 + l * 16 + (g >> 8); it = g & 255; }
        return 1792 + mat * 256 + it; } };
constexpr int N_TILES_DENSE = 768 + 512 + 512;
__device__ __forceinline__ void p0_prologue(Frame& F) {
    if ((F.vcu & 3) != 3) { const int m = (F.vcu >> 2) * 3 + (F.vcu & 3), kq4 = m & 3, lc = m >> 2; p0_mod_block(F, lc / 24, lc % 24, kq4); }
    p0_tiles(F, F.vcu * 7, F.vcu * 7 + 7, TileIdentity{});
}
__device__ __forceinline__ void p_moe_convert(Frame& F) {
    p0_tiles(F, N_TILES_DENSE + F.vcu * 96, N_TILES_DENSE + F.vcu * 96 + 96, TileIdentity{});
    __syncthreads();
}

__device__ __forceinline__ void st_row_bf16(bf16_t* orow, int lane, const f32x4 (&v)[4]) {
#pragma unroll
    for (int j = 0; j < 4; ++j) { u32x2 w; w.x = cvt_pk_bf16(v[j][0], v[j][1]); w.y = cvt_pk_bf16(v[j][2], v[j][3]); *(u32x2*)(orow + 4 * lane + 256 * j) = w; }
}
template <int NR> __device__ __forceinline__ void norm_rows(const float* const (&xr)[NR], bf16_t* const (&orow)[NR], int lane, const f32x4 (&A)[4], const f32x4 (&Bv)[4]) {
    f32x4 v[NR][4];
#pragma unroll
    for (int r = 0; r < NR; ++r)
#pragma unroll
        for (int j = 0; j < 4; ++j) v[r][j] = *(const f32x4*)(xr[r] + 4 * lane + 256 * j);
#pragma unroll
    for (int r = 0; r < NR; ++r) { float ss = 0.f;
#pragma unroll
        for (int j = 0; j < 4; ++j) ss += (v[r][j][0] * v[r][j][0] + v[r][j][1] * v[r][j][1]) + (v[r][j][2] * v[r][j][2] + v[r][j][3] * v[r][j][3]);
        const float rstd = __builtin_amdgcn_rsqf(wave_sum(ss) * (1.0f / DM) + NORM_EPS);
#pragma unroll
        for (int j = 0; j < 4; ++j) v[r][j] = v[r][j] * rstd * A[j] + Bv[j];
        st_row_bf16(orow[r], lane, v[r]); }
}
__device__ __forceinline__ void p1_norm_in(Frame& F) {
    const float* modp = (const float*)(arg_ws() + WS_MODP); const float* bmod = arg_in(5); float* modf = (float*)(arg_ws() + WS_MOD);
    for (int idx = F.vcu * 512 + F.tid; idx < 2 * 17 * MODW; idx += F.G * 512) { const int l = idx / (17 * MODW), r = idx - l * (17 * MODW), j = r % MODW; float s = bmod[l * MODW + j];
#pragma unroll
        for (int q = 0; q < 4; ++q) s += modp[(size_t)(q * 2 + l) * 17 * MODW + r];
        modf[idx] = s; }
    const int b = F.vcu >> 4; const float* n1 = arg_in(6);
    f32x4 A[4], Bv[4];
#define P1_COEF(BB) do { _Pragma("unroll") for (int j = 0; j < 4; ++j) { const int c = 4 * F.lane + 256 * j; f32x4 sh = *(const f32x4*)(bmod + c), sc = *(const f32x4*)(bmod + 1024 + c); \
        _Pragma("unroll") for (int q = 0; q < 4; ++q) { const float* pp = modp + ((size_t)(q * 2) * 17 + (BB)) * MODW; sh += *(const f32x4*)(pp + c); sc += *(const f32x4*)(pp + 1024 + c); } \
        A[j] = *(const f32x4*)(n1 + c) * (1.0f + sc); Bv[j] = sh; } } while (0)
    P1_COEF(b);
    bf16_t* H = (bf16_t*)(arg_ws() + WS_H); const float* X = arg_in(0);
    for (int i = 0; i < 16; i += 4) { const int row = F.vcu * 128 + F.wave + 8 * i;
        const float* const xr[4] = {X + (size_t)row * DM, X + (size_t)(row + 8) * DM, X + (size_t)(row + 16) * DM, X + (size_t)(row + 24) * DM};
        bf16_t* const orow[4] = {H + (size_t)row * DM, H + (size_t)(row + 8) * DM, H + (size_t)(row + 16) * DM, H + (size_t)(row + 24) * DM};
        norm_rows<4>(xr, orow, F.lane, A, Bv); }
    P1_COEF(16);
#undef P1_COEF
    bf16_t* HC = (bf16_t*)(arg_ws() + WS_HC); const float* XC = arg_in(2);
    { const int row = F.vcu * 16 + F.wave;
        const float* const xr[2] = {XC + (size_t)row * DM, XC + (size_t)(row + 8) * DM};
        bf16_t* const orow[2] = {HC + (size_t)row * DM, HC + (size_t)(row + 8) * DM};
        norm_rows<2>(xr, orow, F.lane, A, Bv); }
}

#ifndef RNR
#define RNR 2
#endif
__device__ __forceinline__ void router_finish(const float (&lg)[16], int lane, float* prow) {
    float a8[8], a4[4], a2[2], a1;
    { const bool up = (lane & 32) != 0;
#pragma unroll
      for (int q = 0; q < 8; ++q) { const float keep = up ? lg[q + 8] : lg[q], send = up ? lg[q] : lg[q + 8]; a8[q] = keep + __shfl_xor(send, 32); } }
    { const bool up = (lane & 16) != 0;
#pragma unroll
      for (int q = 0; q < 4; ++q) { const float keep = up ? a8[q + 4] : a8[q], send = up ? a8[q] : a8[q + 4]; a4[q] = keep + __shfl_xor(send, 16); } }
    { const bool up = (lane & 8) != 0;
#pragma unroll
      for (int q = 0; q < 2; ++q) { const float keep = up ? a4[q + 2] : a4[q], send = up ? a4[q] : a4[q + 2]; a2[q] = keep + __shfl_xor(send, 8); } }
    { const bool up = (lane & 4) != 0; const float keep = up ? a2[1] : a2[0], send = up ? a2[0] : a2[1]; a1 = keep + __shfl_xor(send, 4); }
    a1 += __shfl_xor(a1, 2); a1 += __shfl_xor(a1, 1);
    float mx = a1; mx = fmaxf(mx, __shfl_xor(mx, 4)); mx = fmaxf(mx, __shfl_xor(mx, 8)); mx = fmaxf(mx, __shfl_xor(mx, 16)); mx = fmaxf(mx, __shfl_xor(mx, 32));
    const float pe = __builtin_amdgcn_exp2f((a1 - mx) * 1.4426950408889634f);
    float sm = pe; sm += __shfl_xor(sm, 4); sm += __shfl_xor(sm, 8); sm += __shfl_xor(sm, 16); sm += __shfl_xor(sm, 32);
    const int e = ((lane >> 5) & 1) * 8 + ((lane >> 4) & 1) * 4 + ((lane >> 3) & 1) * 2 + ((lane >> 2) & 1);
    if ((lane & 3) == 0) prow[e] = pe / sm;
}
__device__ __forceinline__ void p_router(Frame& F, int l) {
    constexpr int WP = 2064;
    LAS unsigned char* WH = F.lds; LAS unsigned char* WL = F.lds + 16 * WP; LAS float* AC = (LAS float*)(F.lds + 32 * WP); LAS float* BC = AC + DM;
    const float* wsrc = arg_in(17) + (size_t)l * DM * NE;
    for (int idx = F.tid; idx < DM * NE; idx += 512) { const int k = idx >> 4, e = idx & 15; const float w = wsrc[idx]; const unsigned hi = cvt_pk_bf16(w, w) & 0xffffu; const float rem = w - __uint_as_float(hi << 16);
        *(LAS unsigned short*)(WH + e * WP + k * 2) = (unsigned short)hi; *(LAS unsigned short*)(WL + e * WP + k * 2) = (unsigned short)(cvt_pk_bf16(rem, rem) & 0xffffu); }
    const int b = F.vcu >> 4; const float* mod = (const float*)(arg_ws() + WS_MOD) + ((size_t)l * 17 + b) * MODW; const float* n2 = arg_in(7) + l * DM;
    for (int k = F.tid; k < DM; k += 512) { AC[k] = n2[k] * (1.0f + mod[4096 + k]); BC[k] = mod[3072 + k]; }
    __syncthreads();
    const int lane = F.lane, r = lane & 15, kq = lane >> 4, row = F.vcu * 128 + F.wave * 16 + r;
    const bf16_t* xr = (l ? (const bf16_t*)(arg_ws() + WS_X3) : (const bf16_t*)arg_out()) + (size_t)row * DM + kq * 8; unsigned char* hr = (unsigned char*)(arg_ws() + WS_H) + (size_t)row * DM + kq * 8;
    const LAS unsigned char* whp = WH + r * WP + kq * 16; const LAS unsigned char* wlp = WL + r * WP + kq * 16; const LAS float* acp = AC + kq * 8; const LAS float* bcp = BC + kq * 8;
    f32x4 acc = (f32x4){0.f, 0.f, 0.f, 0.f};
    u32x4 xs[32];
#pragma unroll
    for (int q = 0; q < 32; ++q) xs[q] = *(const u32x4*)(xr + 32 * q);
    asm volatile("" ::: "memory");
    float rstd; { f32x2 s0 = {0.f, 0.f}, s1 = {0.f, 0.f}, s2 = {0.f, 0.f}, s3 = {0.f, 0.f};
#pragma unroll
        for (int q = 0; q < 32; ++q) { const f32x2 v0 = {bflo(xs[q].x), bfhi(xs[q].x)}, v1 = {bflo(xs[q].y), bfhi(xs[q].y)}, v2 = {bflo(xs[q].z), bfhi(xs[q].z)}, v3 = {bflo(xs[q].w), bfhi(xs[q].w)};
            s0 += v0 * v0; s1 += v1 * v1; s2 += v2 * v2; s3 += v3 * v3; }
        const f32x2 st = (s0 + s1) + (s2 + s3); float sq = st.x + st.y; sq += __shfl_xor(sq, 16); sq += __shfl_xor(sq, 32);
        rstd = __builtin_amdgcn_rsqf(sq * (1.0f / DM) + NORM_EPS); }
#pragma unroll
    for (int q = 0; q < 32; ++q) asm volatile("" : "+v"(xs[q]));
#define RT_STEP1(X, s) do { \
        const f32x4 a0 = *(const LAS f32x4*)(acp + 32 * (s)), a1 = *(const LAS f32x4*)(acp + 32 * (s) + 4), c0 = *(const LAS f32x4*)(bcp + 32 * (s)), c1 = *(const LAS f32x4*)(bcp + 32 * (s) + 4); \
        const f32x4 x0 = (f32x4){bflo(X.x), bfhi(X.x), bflo(X.y), bfhi(X.y)}, x1 = (f32x4){bflo(X.z), bfhi(X.z), bflo(X.w), bfhi(X.w)}; \
        const f32x4 h0 = x0 * rstd * a0 + c0, h1 = x1 * rstd * a1 + c1; \
        u32x4 hw; hw.x = cvt_pk_bf16(h0[0], h0[1]); hw.y = cvt_pk_bf16(h0[2], h0[3]); hw.z = cvt_pk_bf16(h1[0], h1[1]); hw.w = cvt_pk_bf16(h1[2], h1[3]); \
        { u32x2 h8_; h8_.x = pk4_fp8(h0 * FP8_SA); h8_.y = pk4_fp8(h1 * FP8_SA); *(u32x2*)(hr + 32 * (s)) = h8_; } \
        u32x4 lw; lw.x = cvt_pk_bf16(h0[0] - bflo(hw.x), h0[1] - bfhi(hw.x)); lw.y = cvt_pk_bf16(h0[2] - bflo(hw.y), h0[3] - bfhi(hw.y)); lw.z = cvt_pk_bf16(h1[0] - bflo(hw.z), h1[1] - bfhi(hw.z)); lw.w = cvt_pk_bf16(h1[2] - bflo(hw.w), h1[3] - bfhi(hw.w)); \
        const bf16x8 wh = *(const LAS bf16x8*)(whp + 64 * (s)), wl = *(const LAS bf16x8*)(wlp + 64 * (s)); const bf16x8 ah = *reinterpret_cast<const bf16x8*>(&hw), al = *reinterpret_cast<const bf16x8*>(&lw); \
        acc = __builtin_amdgcn_mfma_f32_16x16x32_bf16(ah, wh, acc, 0, 0, 0); acc = __builtin_amdgcn_mfma_f32_16x16x32_bf16(ah, wl, acc, 0, 0, 0); acc = __builtin_amdgcn_mfma_f32_16x16x32_bf16(al, wh, acc, 0, 0, 0); } while (0)
#pragma unroll
    for (int s = 0; s < 32; ++s) RT_STEP1(xs[s], s);
#undef RT_STEP1
    float* probs = (float*)(arg_ws() + WS_PROBS) + (size_t)(F.vcu * 128 + F.wave * 16 + 4 * kq) * 16 + r;
#pragma unroll
    for (int i = 0; i < 4; ++i) { const float lg = acc[i]; float mx = lg; mx = fmaxf(mx, __shfl_xor(mx, 1)); mx = fmaxf(mx, __shfl_xor(mx, 2)); mx = fmaxf(mx, __shfl_xor(mx, 4)); mx = fmaxf(mx, __shfl_xor(mx, 8));
        const float pe = __builtin_amdgcn_exp2f((lg - mx) * 1.4426950408889634f); float sm = pe; sm += __shfl_xor(sm, 1); sm += __shfl_xor(sm, 2); sm += __shfl_xor(sm, 4); sm += __shfl_xor(sm, 8);
        probs[i * 16] = pe / sm; }
}

__device__ __forceinline__ void p_topk(Frame& F, const int e, const int b) {
    const int pm = e * 16 + b, lane = F.lane;
    LAS unsigned* hist = (LAS unsigned*)F.lds;
    LAS unsigned* wtot = (LAS unsigned*)(F.lds + 4096);
    LAS unsigned* sel = (LAS unsigned*)(F.lds + 4096 + 64);
    LAS int* idxs = (LAS int*)(F.lds + 8192);
    const float* probs = (const float*)(arg_ws() + WS_PROBS) + ((size_t)b * SEQ + 4 * F.tid) * 16 + e;
    unsigned u[4];
#pragma unroll
    for (int q = 0; q < 4; ++q) u[q] = __float_as_uint(probs[q * 16]);
    unsigned prefix = 0, need = CAP;
#pragma unroll 1
    for (int pass = 0; pass < 3; ++pass) {
        const int shift = 20 - 10 * pass;
        hist[F.tid] = 0; hist[F.tid + 512] = 0;
        __syncthreads();
#pragma unroll
        for (int q = 0; q < 4; ++q) if (pass == 0 || (u[q] >> (shift + 10)) == prefix) (void)__hip_atomic_fetch_add(&hist[(u[q] >> shift) & 1023u], 1u, __ATOMIC_RELAXED, __HIP_MEMORY_SCOPE_WORKGROUP);
        __syncthreads();
        if (F.wave == 0) {
            const u32x4 c0 = *(const LAS u32x4*)(hist + 16 * lane), c1 = *(const LAS u32x4*)(hist + 16 * lane + 4), c2 = *(const LAS u32x4*)(hist + 16 * lane + 8), c3 = *(const LAS u32x4*)(hist + 16 * lane + 12);
            const unsigned tot = ((c0.x + c0.y) + (c0.z + c0.w)) + ((c1.x + c1.y) + (c1.z + c1.w)) + ((c2.x + c2.y) + (c2.z + c2.w)) + ((c3.x + c3.y) + (c3.z + c3.w));
            unsigned incl = tot;
#pragma unroll
            for (int d = 1; d < 64; d <<= 1) { const unsigned o = __shfl_down(incl, d); if (lane + d < 64) incl += o; }
            const unsigned above = incl - tot;
            if (above < need && need <= above + tot) {
                unsigned run = above, fb = 0, fr = 0;
#define TK_BIN(k, cv) { if (run < need && need <= run + (cv)) { fb = (unsigned)(k); fr = need - run; } run += (cv); }
                TK_BIN(15, c3.w) TK_BIN(14, c3.z) TK_BIN(13, c3.y) TK_BIN(12, c3.x) TK_BIN(11, c2.w) TK_BIN(10, c2.z) TK_BIN(9, c2.y) TK_BIN(8, c2.x)
                TK_BIN(7, c1.w) TK_BIN(6, c1.z) TK_BIN(5, c1.y) TK_BIN(4, c1.x) TK_BIN(3, c0.w) TK_BIN(2, c0.z) TK_BIN(1, c0.y) TK_BIN(0, c0.x)
#undef TK_BIN
                sel[0] = (prefix << 10) | (16u * lane + fb); sel[1] = fr;
            }
        }
        __syncthreads();
        prefix = sel[0]; need = sel[1];
    }
    unsigned cnt = 0;
#pragma unroll
    for (int q = 0; q < 4; ++q) cnt += (u[q] > prefix ? 1u : 0u) + (u[q] == prefix ? 0x10000u : 0u);
    unsigned inc = cnt;
#pragma unroll
    for (int d = 1; d < 64; d <<= 1) { const unsigned o = __shfl_up(inc, d); if (lane >= d) inc += o; }
    if (lane == 63) wtot[F.wave] = inc;
    __syncthreads();
    unsigned run = inc - cnt;
#pragma unroll
    for (int w = 0; w < 8; ++w) run += (w < F.wave) ? wtot[w] : 0u;
    float* vals = (float*)(arg_ws() + WS_VALS) + (size_t)pm * CAP; int* slotg = (int*)(arg_ws() + WS_SLOT) + ((size_t)b * SEQ + 4 * F.tid) * 16 + e;
#pragma unroll
    for (int q = 0; q < 4; ++q) { const unsigned gtb = run & 0xffffu, eqb = run >> 16; const bool gt = u[q] > prefix, eq = u[q] == prefix, s_ = gt || (eq && eqb < need);
        const int sl = s_ ? (int)(gtb + (eqb < need ? eqb : need)) : -1;
        slotg[q * 16] = sl;
        if (s_) { idxs[sl] = 4 * F.tid + q; vals[sl] = __uint_as_float(u[q]); }
        run += (gt ? 1u : 0u) + (eq ? 0x10000u : 0u); }
    __syncthreads();
    { const int R0 = (F.tid >> 7) * 16 + ((F.tid & 63) >> 2);
      const unsigned a0 = (unsigned)idxs[R0], a1 = (unsigned)idxs[R0 + 64], b0 = (unsigned)idxs[128 + R0], b1 = (unsigned)idxs[192 + R0];
      ((u32x2*)(arg_ws() + WS_GPK))[(size_t)pm * 512 + F.tid] = (u32x2){a0 | (a1 << 16), b0 | (b1 << 16)}; }
}

__device__ __forceinline__ void p_combine(Frame& F, int l, bool fin) {
    const int b = F.vcu >> 4, lane = F.lane; const float* mod = (const float*)(arg_ws() + WS_MOD) + ((size_t)l * 17 + b) * MODW;
    f32x4 G2[2][2], A[2][2], Bv[2][2];
#pragma unroll
    for (int j = 0; j < 2; ++j)
#pragma unroll
        for (int h = 0; h < 2; ++h) { const int c = 8 * lane + 512 * j + 4 * h; G2[j][h] = *(const f32x4*)(mod + 5120 + c) * (1.0f / FP8_SY);
            if (fin) { A[j][h] = *(const f32x4*)(arg_in(21) + c); Bv[j][h] = (f32x4){0.f, 0.f, 0.f, 0.f}; }
            else { const float* mod1 = (const float*)(arg_ws() + WS_MOD) + ((size_t)(l + 1) * 17 + b) * MODW; A[j][h] = *(const f32x4*)(arg_in(6) + (l + 1) * DM + c) * (1.0f + *(const f32x4*)(mod1 + 1024 + c)); Bv[j][h] = *(const f32x4*)(mod1 + c); } }
    const int* slotg = (const int*)(arg_ws() + WS_SLOT); const unsigned char* Y = (const unsigned char*)(arg_ws() + WS_Y); bf16_t* H = (bf16_t*)(arg_ws() + WS_H);
    const bf16_t* XI = fin ? (const bf16_t*)(arg_ws() + WS_X3) : (const bf16_t*)arg_out(); bf16_t* XO = (bf16_t*)(arg_ws() + WS_X2); float* OUT = arg_out();
    for (int i = 0; i < 16; ++i) { const int row = F.vcu * 128 + F.wave + 8 * i; const bf16_t* xr = XI + (size_t)row * DM + 8 * lane;
        f32x4 v[2][2], acc[2][2];
#pragma unroll
        for (int j = 0; j < 2; ++j) { const u32x4 w = *(const u32x4*)(xr + 512 * j); v[j][0] = (f32x4){bflo(w.x), bfhi(w.x), bflo(w.y), bfhi(w.y)}; v[j][1] = (f32x4){bflo(w.z), bfhi(w.z), bflo(w.w), bfhi(w.w)};
            acc[j][0] = (f32x4){0.f, 0.f, 0.f, 0.f}; acc[j][1] = (f32x4){0.f, 0.f, 0.f, 0.f}; }
        const int sl = lane < 16 ? slotg[(size_t)row * 16 + lane] : -1;
#pragma unroll
        for (int e = 0; e < 16; ++e) { const int s = __builtin_amdgcn_readlane(sl, e);
            if (s >= 0) { const unsigned char* yr = Y + ((size_t)(e * 16 + b) * CAP + s) * DM + 8 * lane;
#pragma unroll
                for (int j = 0; j < 2; ++j) { const u32x2 w = *(const u32x2*)(yr + 512 * j);
                    const f32x2 p0 = __builtin_amdgcn_cvt_pk_f32_fp8((int)w.x, false), p1 = __builtin_amdgcn_cvt_pk_f32_fp8((int)w.x, true), p2 = __builtin_amdgcn_cvt_pk_f32_fp8((int)w.y, false), p3 = __builtin_amdgcn_cvt_pk_f32_fp8((int)w.y, true);
                    acc[j][0] += (f32x4){p0.x, p0.y, p1.x, p1.y}; acc[j][1] += (f32x4){p2.x, p2.y, p3.x, p3.y}; } } }
        float ss = 0.f;
#pragma unroll
        for (int j = 0; j < 2; ++j)
#pragma unroll
            for (int h = 0; h < 2; ++h) { v[j][h] = v[j][h] + G2[j][h] * acc[j][h]; ss += (v[j][h][0] * v[j][h][0] + v[j][h][1] * v[j][h][1]) + (v[j][h][2] * v[j][h][2] + v[j][h][3] * v[j][h][3]); }
        const float rstd = __builtin_amdgcn_rsqf(wave_sum(ss) * (1.0f / DM) + NORM_EPS);
        if (!fin) {
#pragma unroll
            for (int j = 0; j < 2; ++j) { u32x4 w; w.x = cvt_pk_bf16(v[j][0][0], v[j][0][1]); w.y = cvt_pk_bf16(v[j][0][2], v[j][0][3]); w.z = cvt_pk_bf16(v[j][1][0], v[j][1][1]); w.w = cvt_pk_bf16(v[j][1][2], v[j][1][3]);
                *(u32x4*)(XO + (size_t)row * DM + 8 * lane + 512 * j) = w; }
#pragma unroll
            for (int j = 0; j < 2; ++j) { const f32x4 h0 = v[j][0] * rstd * A[j][0] + Bv[j][0], h1 = v[j][1] * rstd * A[j][1] + Bv[j][1];
                u32x4 w; w.x = cvt_pk_bf16(h0[0], h0[1]); w.y = cvt_pk_bf16(h0[2], h0[3]); w.z = cvt_pk_bf16(h1[0], h1[1]); w.w = cvt_pk_bf16(h1[2], h1[3]);
                *(u32x4*)(H + (size_t)row * DM + 8 * lane + 512 * j) = w; }
        } else {
#pragma unroll
            for (int j = 0; j < 2; ++j)
#pragma unroll
                for (int h = 0; h < 2; ++h) *(f32x4*)(OUT + (size_t)row * DM + 8 * lane + 512 * j + 4 * h) = v[j][h] * rstd * A[j][h];
        }
    }
}

__device__ __forceinline__ void p_conv(Frame& F) {
    bf16_t* MIX = (bf16_t*)(arg_ws() + WS_MIX);
    const bf16_t* Z = (const bf16_t*)(arg_ws() + WS_Z); const bf16_t* GB = (const bf16_t*)(arg_ws() + WS_GB); const float* cw = arg_in(11);
    int c8 = F.lane * 8; asm volatile("" : "+v"(c8));
    f32x4 w0a = *(const f32x4*)(cw + c8), w0b = *(const f32x4*)(cw + c8 + 4), w1a = *(const f32x4*)(cw + 512 + c8), w1b = *(const f32x4*)(cw + 512 + c8 + 4), w2a = *(const f32x4*)(cw + 1024 + c8), w2b = *(const f32x4*)(cw + 1024 + c8 + 4);
    for (int rep_ = 0; rep_ < 1 + ((SUBREP >> 1) & 1); ++rep_)
#pragma unroll 1
    for (int it = 0; it < 4; ++it) { const int r0 = F.vcu * 128 + F.wave * 16 + it * 4;
        const bool lo_ok = (r0 & (SEQ - 1)) != 0, hi_ok = ((r0 + 4) & (SEQ - 1)) != 0;
        u32x4 z[6], g[4];
#pragma unroll
        for (int k = 0; k < 6; ++k) { int rr = r0 - 1 + k; rr = rr < 0 ? 0 : (rr > MROWS - 1 ? MROWS - 1 : rr); z[k] = *(const u32x4*)(Z + (size_t)rr * 512 + c8); }
#pragma unroll
        for (int k = 0; k < 4; ++k) g[k] = *(const u32x4*)(GB + (size_t)(r0 + k) * 512 + c8);
        if (!lo_ok) z[0] = (u32x4){0u, 0u, 0u, 0u};
        if (!hi_ok) z[5] = (u32x4){0u, 0u, 0u, 0u};
#pragma unroll
        for (int j = 0; j < 4; ++j) { const u32x4 zp = z[j], zc = z[j + 1], zn = z[j + 2], gb = g[j];
            f32x4 ra, rb;
#define CONV2(k, R, W0, W1, W2, i0) R[i0] = bflo(gb[k]) * (W0[i0] * bflo(zp[k]) + W1[i0] * bflo(zc[k]) + W2[i0] * bflo(zn[k])); R[i0 + 1] = bfhi(gb[k]) * (W0[i0 + 1] * bfhi(zp[k]) + W1[i0 + 1] * bfhi(zc[k]) + W2[i0 + 1] * bfhi(zn[k]));
            CONV2(0, ra, w0a, w1a, w2a, 0) CONV2(1, ra, w0a, w1a, w2a, 2) CONV2(2, rb, w0b, w1b, w2b, 0) CONV2(3, rb, w0b, w1b, w2b, 2)
#undef CONV2
            pg8::st8bf(MIX + (size_t)(r0 + j) * 1024 + 512 + c8, ra, rb); } }
}

__device__ __forceinline__ void p_attn_conv(Frame& F) {
    const float* lp = arg_in(9); float s1 = 0.f, s2 = 0.f;
    for (int i = 0; i < 64; ++i) { s1 += lp[i] * lp[64 + i]; s2 += lp[128 + i] * lp[192 + i]; }
    const float lam = __expf(s1) - __expf(s2) + 0.2f;
    const bf16_t* Q = (const bf16_t*)(arg_ws() + WS_Q); const bf16_t* Kb = (const bf16_t*)(arg_ws() + WS_K); const bf16_t* Vb = (const bf16_t*)(arg_ws() + WS_V); bf16_t* MIX = (bf16_t*)(arg_ws() + WS_MIX);
    PROF_BEGIN(1)
    for (int rep_ = 0; rep_ < 1 + (SUBREP & 1); ++rep_)
    for (int i = 0; i < 4; ++i) { const int bh = (F.vcu >> 5) * 8 + i * 2 + ((F.vcu >> 4) & 1), qb = F.vcu & 15, b = bh >> 2, h = bh & 3;
        if (MOE_CVT_IN_ATTN && rep_ == 0 && (CVT_CLASS(F.vcu)) == i) p_moe_convert(F);
        att::attn_unit(Q + ((size_t)b * SEQ + qb * 128) * 512 + h * 128, Kb + (size_t)bh * SKV * 128, Vb + (size_t)bh * SKV * 128,
                       MIX + ((size_t)b * SEQ + qb * 128) * 1024 + h * 128, lam, arg_in(10), F.lds, F.wave); }
    PROF_END(1, F.lds)
}

__device__ __forceinline__ void p_spatial(Frame& F) {
    using namespace att;
    const int tid = F.tid, wid = F.wave, lane = F.lane, r32 = lane & 31, hi = lane >> 5, qw = wid & 3, wh = wid >> 2;
    const int b = F.vcu >> 4, ck = F.vcu & 15, R0 = b * SEQ + ck * 128;
    LAS unsigned char* Vl = F.lds; LAS float* rs = (LAS float*)(F.lds + 131072 + 2048);
    const float* ssqv = (const float*)(arg_ws() + WS_SSQ);
    if (tid < 128) { float s = 0.f; for (int q = 0; q < 16; ++q) s += ssqv[(size_t)q * MROWS + R0 + tid]; rs[tid] = __builtin_amdgcn_rsqf(s * (1.0f / DM) + NORM_EPS); }
    const bf16_t* VV = (const bf16_t*)(arg_ws() + WS_VV); const bf16_t* U = (const bf16_t*)(arg_ws() + WS_U); bf16_t* MIX1 = (bf16_t*)(arg_ws() + WS_MIX1);
    const int sr = tid >> 4, sc = (tid & 15) * 8;
    constexpr int SP = 512;
    const int erow = tid >> 5, ecol = (tid & 31) * 8;
    u32x4 t[8];
    const unsigned vlo = (unsigned)((sr * DM + sc) * 2), ulo = (unsigned)((erow * DM + ecol) * 2);
#define SP_LOAD(g) do { _Pragma("unroll") for (int it = 0; it < 8; ++it) { const int buf = it >> 1, jh = buf >> 1, whh = buf & 1; \
        t[it] = *(const u32x4*)((const char*)VV + ((size_t)(R0 + jh * 64 + 32 * (it & 1)) * DM + (g) * 256 + whh * 128) * 2 + vlo); } } while (0)
    SP_LOAD(0);
    u32x4 uu[8], un[8];
#define UU_LOAD(X, g) do { _Pragma("unroll") for (int it = 0; it < 8; ++it) X[it] = *(const u32x4*)((const char*)U + ((size_t)(R0 + 16 * it) * DM + (g) * 256) * 2 + ulo); } while (0)
    UU_LOAD(uu, 0);
#pragma unroll 1
    for (int g = 0; g < 4; ++g) {
        LAS unsigned char* Vb = Vl + (g & 1) * 65536;
        const float* wsg = arg_in(14) + ((size_t)g * 128 + 32 * qw + r32) * 128;
        f32x4 wf[2][4][2];
#pragma unroll
        for (int jh = 0; jh < 2; ++jh)
#pragma unroll
            for (int ks = 0; ks < 4; ++ks) { const int j = jh * 64 + ks * 16 + hi * 8; wf[jh][ks][0] = *(const f32x4*)(wsg + j); wf[jh][ks][1] = *(const f32x4*)(wsg + j + 4); }
#pragma unroll
        for (int it = 0; it < 8; ++it) { const int buf = it >> 1, k = sr + 32 * (it & 1); *(LAS u32x4*)(Vb + buf * 16384 + v_st(k, sc)) = t[it]; }
        __syncthreads();
        { const int gn = g < 3 ? g + 1 : 3; SP_LOAD(gn); UU_LOAD(un, gn); }
        bf16x8 pa[2][4];
#pragma unroll
        for (int jh = 0; jh < 2; ++jh)
#pragma unroll
            for (int ks = 0; ks < 4; ++ks) { const int j = jh * 64 + ks * 16 + hi * 8; const f32x4 ra = *(const LAS f32x4*)(rs + j), rb = *(const LAS f32x4*)(rs + j + 4);
                const f32x4 xa = wf[jh][ks][0] * ra, xb = wf[jh][ks][1] * rb; u32x4 w; w.x = cvtpk(xa[0], xa[1]); w.y = cvtpk(xa[2], xa[3]); w.z = cvtpk(xb[0], xb[1]); w.w = cvtpk(xb[2], xb[3]); pa[jh][ks] = *reinterpret_cast<bf16x8*>(&w); }
        asm volatile("" ::: "memory");
        f32x16 o[4] = {};
        const int vb0 = (int)(uintptr_t)Vb + v_rd_base(lane);
#pragma unroll
        for (int jh = 0; jh < 2; ++jh) pv_d0(o, vb0 + (jh * 2 + wh) * 16384, pa[jh][0], pa[jh][1], pa[jh][2], pa[jh][3]);
        const float* vn = arg_in(13); const float* bs = arg_in(15) + g * 128 + 32 * qw;
        float bsv[16];
#pragma unroll
        for (int r = 0; r < 16; ++r) bsv[r] = bs[crow(r, hi)];
        __syncthreads();
#pragma unroll
        for (int d0 = 0; d0 < 4; ++d0) { const int colg = wh * 128 + 32 * d0 + r32; const float vnc = vn[g * 256 + colg];
#pragma unroll
            for (int r = 0; r < 16; ++r) { const float sv = o[d0][r] * vnc + bsv[r]; *(LAS unsigned short*)(Vb + (32 * qw + crow(r, hi)) * SP + colg * 2) = (unsigned short)(cvtpk(sv, sv) & 0xffffu); } }
        __syncthreads();
#pragma unroll
        for (int it = 0; it < 8; ++it) { const u32x4 sv = *(const LAS u32x4*)(Vb + (erow + 16 * it) * SP + ecol * 2); const u32x4 u4 = uu[it];
            f32x4 ra, rb; ra[0] = bflo(u4.x) * bflo(sv.x); ra[1] = bfhi(u4.x) * bfhi(sv.x); ra[2] = bflo(u4.y) * bflo(sv.y); ra[3] = bfhi(u4.y) * bfhi(sv.y);
            rb[0] = bflo(u4.z) * bflo(sv.z); rb[1] = bfhi(u4.z) * bfhi(sv.z); rb[2] = bflo(u4.w) * bflo(sv.w); rb[3] = bfhi(u4.w) * bfhi(sv.w);
            pg8::st8bf((bf16_t*)((char*)MIX1 + ((size_t)(R0 + 16 * it) * DM + g * 256) * 2 + ulo), ra, rb); }
#pragma unroll
        for (int it = 0; it < 8; ++it) uu[it] = un[it];
    }
#undef SP_LOAD
#undef UU_LOAD
}

__device__ __forceinline__ void gemm_skew(Frame& F) { if (GEMM_SKEW > 0 && ((F.vcu >> 3) & 1)) { const unsigned long long t0 = __builtin_amdgcn_s_memrealtime(); while (__builtin_amdgcn_s_memrealtime() - t0 < (unsigned long long)GEMM_SKEW) __builtin_amdgcn_s_sleep(8); } }

__global__ void __launch_bounds__(NWAVES * 64, 2) fwd_kernel(Args args) {
    extern __shared__ __attribute__((aligned(16))) unsigned char lds[];
    Frame F;
    const int wave0 = __builtin_amdgcn_readfirstlane((int)(threadIdx.x >> 6));
    F.lds = (LAS unsigned char*)lds; F.wave = wave0; F.lane = lane_id_now(); F.tid = wave0 * 64 + F.lane;
    F.G = gridDim.x; F.bx = blockIdx.x; F.vcu = (F.bx % 8) * (F.G / 8) + F.bx / 8;
    volatile LAS unsigned* MISC = (volatile LAS unsigned*)(F.lds + MISC_OFF);
    for (int u = F.tid; u < (LDS_BYTES - LDSCTL_OFF) / 4; u += NWAVES * 64) ((LAS unsigned*)(F.lds + LDSCTL_OFF))[u] = 0u;
    __syncthreads();
    XcdBarrier bar; bar.bar = (unsigned*)(arg_ws() + WS_CTL) + CW_BAR; bar.x = 0; bar.st = nullptr; bar.w = wave0;
    const int lo = args.ph_lo, hi = args.ph_hi;
    if (hi - lo > 1) bar = xcd_barrier_post((unsigned*)(arg_ws() + WS_CTL) + CW_BAR, MISC + 8, wave0);
    if (wave0 == 0 && F.lane == 0) (void)xb_add((unsigned*)(arg_ws() + WS_CTL) + CW_GRP + (F.vcu >> 4) * 128 + xb_xcc_id(), 1u);
    LAS unsigned char* ring = (LAS unsigned char*)lds;
#define RELAUNDER() do { int w_ = wave0; asm volatile("" : "+s"(w_)); F.wave = w_; F.lane = lane_id_now(); F.tid = w_ * 64 + F.lane; \
        int bx_ = blockIdx.x; asm volatile("" : "+s"(bx_)); F.bx = bx_; F.vcu = (bx_ % 8) * (F.G / 8) + bx_ / 8; } while (0)
#define RUN_PHASE(K, ...) if (lo <= (K) && (K) < hi && ((PHMASK_FULL >> (K)) & 1)) { \
        for (int rep_ph = 0; rep_ph <= (int)((REPMASK >> (K)) & 1); ++rep_ph) { RELAUNDER(); \
            if (PROF_ID != 0 && PROF_PH >= 0) { if (F.tid == 0) *(LAS int*)(F.lds + PROF_LDS_OFF + 128) = (K); __syncthreads(); } \
            { PROF_BEGIN(20) __VA_ARGS__ PROF_END(20, F.lds) } \
            if (rep_ph < (int)((REPMASK >> (K)) & 1) || (K) + 1 < hi) { PROF_BEGIN(30) xcd_barrier(bar); PROF_END(30, F.lds) } } }
#define MOE_PHASES(L, K0) \
      \
    RUN_PHASE((K0) + 0, { p_router(F, (L)); group_barrier((unsigned*)(arg_ws() + WS_CTL) + CW_GRP + (F.vcu >> 4) * 128, (L), F.wave); p_topk(F, F.vcu & 15, F.vcu >> 4); }) \
    RUN_PHASE((K0) + 2, { pg8::SchedMoeGather8 S{(const char*)(arg_ws() + WS_H), (const char*)(arg_ws() + WS_WGU) + (size_t)(L) * 64 * MiB, F.G, F.bx}; \
                  pg8::EpiGateUp8 E{(unsigned char*)(arg_ws() + WS_ACT)}; \
                  pg8::gemm_phase<pg8::EpiGateUp8, pg8::SchedMoeGather8, GEMM_ALIGN_GU, true, true, true>(ring, DM, S, E, F.tid, (const int*)(arg_ws() + WS_GPK)); }) \
    RUN_PHASE((K0) + 3, { pg8::SchedMoe8 S{(const char*)(arg_ws() + WS_ACT), (const char*)(arg_ws() + WS_WD) + (size_t)(L) * 32 * MiB, 4, F.G, F.bx}; \
                  pg8::EpiDown8 E{(unsigned char*)(arg_ws() + WS_Y), (const float*)(arg_ws() + WS_VALS)}; \
                  pg8::gemm_phase<pg8::EpiDown8, pg8::SchedMoe8, GEMM_ALIGN_DN, true, false, true>(ring, DM, S, E, F.tid); }) \
    RUN_PHASE((K0) + 4, { p_combine(F, (L), (L) == 1); })

    RUN_PHASE(0, { p0_prologue(F); })
    RUN_PHASE(1, { p1_norm_in(F); })
    RUN_PHASE(2, { pg8::SchedInProj S{(const char*)(arg_ws() + WS_H), (const char*)(arg_ws() + WS_HC), (const char*)(arg_ws() + WS_WIN0), F.G, F.bx};
                  pg8::EpiInProj E{(bf16_t*)(arg_ws() + WS_Q), (bf16_t*)(arg_ws() + WS_K), (bf16_t*)(arg_ws() + WS_V), (bf16_t*)(arg_ws() + WS_GB), (bf16_t*)(arg_ws() + WS_Z), ROPE_TAB};
                  pg8::gemm_phase<pg8::EpiInProj, pg8::SchedInProj, GEMM_ALIGN, true>(ring, DM, S, E, F.tid); })
    RUN_PHASE(3, { p_conv(F); RELAUNDER(); p_attn_conv(F); })
    RUN_PHASE(4, { pg8::SchedSimple S{(const char*)(arg_ws() + WS_MIX), (const char*)(arg_ws() + WS_WOUT), 128, 4, F.G, F.bx};
                  pg8::EpiOutProj<true> E{(const void*)arg_in(0), (bf16_t*)arg_out(), (const float*)(arg_ws() + WS_MOD) + 2048, (float*)(arg_ws() + WS_SSQ)};
                  pg8::gemm_phase<pg8::EpiOutProj<true>, pg8::SchedSimple, GEMM_ALIGN, true>(ring, DM, S, E, F.tid); })
    MOE_PHASES(0, 5)
    RUN_PHASE(10, { pg8::SchedSimple S{(const char*)(arg_ws() + WS_H), (const char*)(arg_ws() + WS_WIN1), 128, 8, F.G, F.bx};
                  pg8::EpiOddIn E{(bf16_t*)(arg_ws() + WS_U), (bf16_t*)(arg_ws() + WS_VV), (float*)(arg_ws() + WS_SSQ)};
                  pg8::gemm_phase<pg8::EpiOddIn, pg8::SchedSimple, GEMM_ALIGN, true>(ring, DM, S, E, F.tid); })
    RUN_PHASE(11, { p_spatial(F); })
    RUN_PHASE(12, { pg8::SchedSimple S{(const char*)(arg_ws() + WS_MIX1), (const char*)(arg_ws() + WS_WOUT) + (size_t)DM * DM * 2, 128, 4, F.G, F.bx};
                  pg8::EpiOutProj<false> E{(const void*)(arg_ws() + WS_X2), (bf16_t*)(arg_ws() + WS_X3), (const float*)(arg_ws() + WS_MOD) + (size_t)17 * MODW + 2048, (float*)(arg_ws() + WS_SSQ)};
                  pg8::gemm_phase<pg8::EpiOutProj<false>, pg8::SchedSimple, GEMM_ALIGN, true>(ring, DM, S, E, F.tid); })
    MOE_PHASES(1, 13)
#undef MOE_PHASES
#undef RUN_PHASE
#undef RELAUNDER
    if (PROF_ID != 0) { const unsigned long long acc = *(LAS unsigned long long*)(F.lds + PROF_LDS_OFF + wave0 * 8), t0 = __builtin_amdgcn_s_memrealtime();
        while (__builtin_amdgcn_s_memrealtime() - t0 < (unsigned long long)PROF_MULT * acc) __builtin_amdgcn_s_sleep(8); }
}

extern "C" void kernel_launch(void* const* d_in, const int* in_sizes, int n_in, void* d_out, int out_size, void* d_ws, size_t ws_size, hipStream_t stream) {
    static int grid = 0;
    if (grid == 0) {
        if (n_in != 22 || in_sizes[0] != MROWS * DM || out_size != MROWS * DM || ws_size < WS_END) { fprintf(stderr, "kernel_launch: unexpected shapes (n_in %d, in0 %d, out %d, ws %zu < %zu?); nothing launched\n", n_in, n_in > 0 ? in_sizes[0] : -1, out_size, ws_size, (size_t)WS_END); grid = -1; return; }
        int dev = 0, cus = 0;
        if (hipGetDevice(&dev) != hipSuccess || hipDeviceGetAttribute(&cus, hipDeviceAttributeMultiprocessorCount, dev) != hipSuccess) { grid = -1; return; }
        if (hipFuncSetAttribute((const void*)fwd_kernel, hipFuncAttributeMaxDynamicSharedMemorySize, LDS_BYTES) != hipSuccess) { fprintf(stderr, "kernel_launch: hipFuncSetAttribute failed\n"); grid = -1; return; }
        (void)hipGetLastError();
        grid = cus;
        if (grid != 256) { fprintf(stderr, "kernel_launch: built for 256 CUs, device has %d; nothing launched\n", cus); grid = -1; return; }
    }
    if (grid < 0) return;
    (void)hipMemsetAsync((char*)d_ws + WS_CTL, 0, CTL_ZERO_BYTES, stream);
    Args a{};
    for (int i = 0; i < 22; ++i) a.in[i] = (const float*)d_in[i];
    a.out = (float*)d_out; a.ws = (unsigned char*)d_ws;
#if MK_PER_PHASE
    for (int ph = 0; ph < N_PHASES; ++ph) { a.ph_lo = ph; a.ph_hi = ph + 1; hipLaunchKernelGGL(fwd_kernel, dim3(grid), dim3(NWAVES * 64), LDS_BYTES, stream, a); }
#else
    a.ph_lo = 0; a.ph_hi = N_PHASES; hipLaunchKernelGGL(fwd_kernel, dim3(grid), dim3(NWAVES * 64), LDS_BYTES, stream, a);
#endif
}
```

```cpp
#include <hip/hip_runtime.h>
#include <cstdio>
#include <cstdint>

#define GAS __attribute__((address_space(1)))
#define LAS __attribute__((address_space(3)))
typedef unsigned short bf16_t;
typedef short bf16x8 __attribute__((ext_vector_type(8)));
typedef short s16x4 __attribute__((ext_vector_type(4)));
typedef float f32x2 __attribute__((ext_vector_type(2)));
typedef float f32x4 __attribute__((ext_vector_type(4)));
typedef float f32x16 __attribute__((ext_vector_type(16)));
typedef unsigned u32x2 __attribute__((ext_vector_type(2)));
typedef unsigned u32x4 __attribute__((ext_vector_type(4)));
typedef int i32x4 __attribute__((ext_vector_type(4)));
typedef int i32x8 __attribute__((ext_vector_type(8)));

constexpr int DM = 1024, NB = 16, SEQ = 2048, CTX = 256, MROWS = NB * SEQ, CROWS = NB * CTX, SKV = CTX + SEQ;
constexpr int NE = 16, CAP = 256, MOE_ROWS = NB * NE * CAP;
constexpr float NORM_EPS = 1e-6f;
constexpr int MODW = 6 * DM;
constexpr int KSPLIT = 8;

__device__ __forceinline__ unsigned cvt_pk_bf16(float lo, float hi) { unsigned r; asm volatile("v_cvt_pk_bf16_f32 %0, %1, %2" : "=v"(r) : "v"(lo), "v"(hi)); return r; }
__device__ __forceinline__ float bf2f(unsigned short h) { return __uint_as_float(((unsigned)h) << 16); }
__device__ __forceinline__ float bflo(unsigned w) { return __uint_as_float(w << 16); }
__device__ __forceinline__ float bfhi(unsigned w) { return __uint_as_float(w & 0xffff0000u); }


__device__ __forceinline__ int lane_id_now() { int l_; asm volatile("v_mbcnt_lo_u32_b32 %0, -1, 0\n\tv_mbcnt_hi_u32_b32 %0, -1, %0" : "=v"(l_)); return l_; }

constexpr float FP8_SA = 8.0f, FP8_SW = 32.0f, FP8_UNSCALE = 1.0f / (FP8_SA * FP8_SW), FP8_SY = 64.0f;
__device__ __forceinline__ unsigned pk4_fp8(f32x4 v) {
    int w = 0;
    w = __builtin_amdgcn_cvt_pk_fp8_f32(__builtin_amdgcn_fmed3f(v[0], -448.f, 448.f), __builtin_amdgcn_fmed3f(v[1], -448.f, 448.f), w, false);
    w = __builtin_amdgcn_cvt_pk_fp8_f32(__builtin_amdgcn_fmed3f(v[2], -448.f, 448.f), __builtin_amdgcn_fmed3f(v[3], -448.f, 448.f), w, true);
    return (unsigned)w;
}

#ifndef PROF_ID
#define PROF_ID 0
#endif
#ifndef PROF_DRAIN
#define PROF_DRAIN 0
#endif
#ifndef PROF_MULT
#define PROF_MULT 8
#endif
constexpr int PROF_LDS_OFF = 131072 + 1024;
#define PROF_BEGIN(id) unsigned long long pt_##id = 0; if (PROF_ID == (id)) pt_##id = __builtin_amdgcn_s_memrealtime();
#ifndef PROF_PH
#define PROF_PH -1
#endif
#define PROF_END(id, ldsbase) if (PROF_ID == (id)) { const unsigned long long d_ = __builtin_amdgcn_s_memrealtime() - pt_##id; if (lane_id_now() == 0 && (PROF_PH < 0 || *(LAS int*)((ldsbase) + PROF_LDS_OFF + 128) == PROF_PH)) *(LAS unsigned long long*)((ldsbase) + PROF_LDS_OFF + __builtin_amdgcn_readfirstlane(threadIdx.x >> 6) * 8) += d_; }

#ifndef PG8_PRIO
#define PG8_PRIO 1
#endif
#ifndef PG8_WGM
#define PG8_WGM 8
#endif
namespace pg8 {
#define PG8_LAS __attribute__((address_space(3)))
constexpr int BM = 256, BK = 64, HALF = 128, HTB = HALF * BK * 2  , STAGE_BYTES = 8 * HTB, NXCD = 8, WGM = PG8_WGM;

__host__ __device__ __forceinline__ int lds_byte(int r, int c) { const int st = (r >> 4) * 2 + (c >> 5), rr = r & 15, cc = c & 31, ob = rr * 64 + cc * 2; return st * 1024 + (ob ^ (((ob >> 9) & 1) << 5)); }
__host__ __device__ __forceinline__ void stage_rc(int b, int& R, int& C) { const int st = b / 1024, sb = b % 1024, swz = sb ^ (((sb >> 9) & 1) << 5); R = (st >> 1) * 16 + swz / 64; C = (st & 1) * 32 + (swz % 64) / 2; }
__host__ __device__ __forceinline__ int perm32(int rho) { const int n = rho >> 4, i = rho & 15; return 8 * (i >> 2) + 4 * n + (i & 3); }

struct Unit { int pm, pn, kind; const char* A; const char* B; };

__device__ __forceinline__ int xcd_remap(int wgid, int nwg) { const int q = nwg / NXCD, r = nwg % NXCD, xcd = wgid % NXCD, off = wgid / NXCD; return (xcd < r ? xcd * (q + 1) : r * (q + 1) + (xcd - r) * q) + off; }
__device__ __forceinline__ void grouped(int wgid, int nM, int nN, int& pm, int& pn) {
    const int nig = WGM * nN, gid = wgid / nig, fm = gid * WGM, gsz = (nM - fm) < WGM ? (nM - fm) : WGM;
    pm = fm + ((wgid % nig) % gsz); pn = (wgid % nig) / gsz;
}

__device__ __forceinline__ f32x2 gelu_pk(f32x2 v) {
    const f32x2 av = __builtin_elementwise_abs(v), d = av * 0.2316418882f + 1.0f;
    f32x2 t; t.x = __builtin_amdgcn_rcpf(d.x); t.y = __builtin_amdgcn_rcpf(d.y);
    f32x2 q = t * 0.5307027145f + (-0.7265760135f); q = q * t + 0.7107068705f; q = q * t + (-0.142248368f); q = q * t + 0.127414796f; q = q * t;
    const f32x2 s = (v * v) * (-0.72134752044f);
    f32x2 e; e.x = __builtin_amdgcn_exp2f(s.x); e.y = __builtin_amdgcn_exp2f(s.y);
    const f32x2 m = v * (q * e), r = v - m;
    f32x2 o; o.x = v.x < 0.f ? m.x : r.x; o.y = v.y < 0.f ? m.y : r.y; return o;
}

template <class Epi, class Sched, bool ALIGN_EPI = false, bool SP2 = false, bool GATHER = false, bool FP8 = false>
__device__ __forceinline__ void gemm_phase(PG8_LAS unsigned char* lds, const int K, const Sched& S, const Epi& E, const int tid, const int* gidx = nullptr) {
    static_assert(SP2 || !GATHER, "row gather is wired into the SP2 loop only");
    const int wid = __builtin_amdgcn_readfirstlane(tid >> 6), lane = tid & 63, wr = wid >> 2, wc = wid & 3, fr = lane & 15, fq = lane >> 4;
    const int rowB = FP8 ? K : 2 * K, nt = rowB / 128;
    unsigned voffA, voffB;
    { int R, C; stage_rc(tid * 16, R, C); const int Rb = Epi::PERM ? ((R & ~31) + perm32(R & 31)) : R; voffA = (unsigned)(R * rowB + C * 2); voffB = (unsigned)(Rb * rowB + C * 2); }
    const size_t kstep = (size_t)(BK * 2);
    const size_t hstep = (size_t)HALF * rowB;
    const unsigned ldsbase32 = (unsigned)(uintptr_t)lds; const unsigned ldsdma_s = (unsigned)__builtin_amdgcn_readfirstlane((int)(ldsbase32 + (unsigned)wid * 1024u));
    const int aoff = lds_byte(wr * 64 + fr, fq * 8), boff = lds_byte(wc * 32 + fr, fq * 8);
    PG8_LAS unsigned char* ldsA = lds + aoff; PG8_LAS unsigned char* ldsB = lds + 4 * HTB + boff;
    asm volatile("" : "+v"(ldsA), "+v"(ldsB));
#define PG8_SA(b, h) (((b) * 2 + (h)) * HTB)
#define PG8_SB(b, h) ((4 + (b) * 2 + (h)) * HTB)
#define PG8_GLDS(gbase_, voff_, ldsdst_) do { unsigned keep_; asm volatile("s_mov_b32 %0, m0\n\ts_mov_b32 m0, %2\n\ts_nop 0\n\tglobal_load_lds_dwordx4 %1, %3\n\ts_mov_b32 m0, %0" \
        : "=&s"(keep_) : "v"(voff_), "s"(ldsdst_), "s"(gbase_) : "memory"); } while (0)
#define PG8_STAGE(bufoff, gbase, voff) do { _Pragma("unroll") for (int _i = 0; _i < 2; ++_i) \
        PG8_GLDS((const char*)(gbase) + (size_t)_i * 64 * rowB, voff, ldsdma_s + (unsigned)(bufoff) + (unsigned)(_i * 8192)); } while (0)
#define PG8_STAGE2(bufoff, gbase, voff) do { _Pragma("unroll") for (int _i = 0; _i < 2; ++_i) \
        PG8_GLDS((const char*)(gbase), (voff)[_i], ldsdma_s + (unsigned)(bufoff) + (unsigned)(_i * 8192)); } while (0)
#define PG8_STAGE_A(bufoff, gbase, half, nx) do { if constexpr (GATHER) { unsigned t_[2]; const unsigned w_ = (nx) ? ngp[half] : cgp[half]; \
            const unsigned gc2 = voffB & 127u; t_[0] = (w_ & 0xffffu) * (unsigned)rowB + gc2; t_[1] = (w_ >> 16) * (unsigned)rowB + gc2; PG8_STAGE2(bufoff, gbase, t_); } \
        else { PG8_STAGE(bufoff, (gbase) + ((half) ? hstep : 0), voffA); } } while (0)
#define PG8_LDA(dst, b, h) do { if constexpr (FP8) { _Pragma("unroll") for (int m = 0; m < 4; ++m) { const i32x4 lo_ = *(const PG8_LAS i32x4*)(ldsA + PG8_SA(b, h) + m * 2048), hi_ = *(const PG8_LAS i32x4*)(ldsA + PG8_SA(b, h) + m * 2048 + 1024); \
        dst##8[m].lo = lo_; dst##8[m].hi = hi_; } } \
    else { _Pragma("unroll") for (int m = 0; m < 4; ++m) _Pragma("unroll") for (int k = 0; k < 2; ++k) dst[m][k] = *(const PG8_LAS bf16x8*)(ldsA + PG8_SA(b, h) + m * 2048 + k * 1024); } } while (0)
#define PG8_LDB(dst, b, h) do { if constexpr (FP8) { _Pragma("unroll") for (int n = 0; n < 2; ++n) { const i32x4 lo_ = *(const PG8_LAS i32x4*)(ldsB + PG8_SA(b, h) + n * 2048), hi_ = *(const PG8_LAS i32x4*)(ldsB + PG8_SA(b, h) + n * 2048 + 1024); \
        dst##8[n].lo = lo_; dst##8[n].hi = hi_; } } \
    else { _Pragma("unroll") for (int n = 0; n < 2; ++n) _Pragma("unroll") for (int k = 0; k < 2; ++k) dst[n][k] = *(const PG8_LAS bf16x8*)(ldsB + PG8_SA(b, h) + n * 2048 + k * 1024); } } while (0)
#define PG8_MMA(ai, bj, At, Bt) do { if (PG8_PRIO) __builtin_amdgcn_s_setprio(1); if constexpr (FP8) { \
          \
        _Pragma("unroll") for (int m = 0; m < 4; ++m) _Pragma("unroll") for (int n = 0; n < 2; ++n) \
            acc[ai][bj][m][n] = __builtin_amdgcn_mfma_scale_f32_16x16x128_f8f6f4(Bt##8[n], At##8[m], acc[ai][bj][m][n], 0, 0, 0, 127, 0, 127); \
    } else { _Pragma("unroll") for (int m = 0; m < 4; ++m) _Pragma("unroll") for (int n = 0; n < 2; ++n) _Pragma("unroll") for (int k = 0; k < 2; ++k) \
        acc[ai][bj][m][n] = __builtin_amdgcn_mfma_f32_16x16x32_bf16(Bt[n][k], At[m][k], acc[ai][bj][m][n], 0, 0, 0); } if (PG8_PRIO) __builtin_amdgcn_s_setprio(0); } while (0)
#define PG8_TID() ({ int l_; asm volatile("v_mbcnt_lo_u32_b32 %0, -1, 0\n\tv_mbcnt_hi_u32_b32 %0, -1, %0" : "=v"(l_)); l_ + wid * 64; })
#define PG8_WAIT_V(n) asm volatile("s_waitcnt vmcnt(" #n ")" ::: "memory")
#define PG8_WAIT_L(n) asm volatile("s_waitcnt lgkmcnt(" #n ")" ::: "memory")
#define PG8_BAR __builtin_amdgcn_s_barrier()
#define PG8_SCHED __builtin_amdgcn_sched_barrier(0)
    Unit cur, nxt; int ui = 0;
    if (!S.next(0, cur)) return;
    f32x4 acc[2][2][4][2];
#pragma unroll
    for (int a = 0; a < 2; ++a)
#pragma unroll
        for (int b = 0; b < 2; ++b)
#pragma unroll
            for (int m = 0; m < 4; ++m)
#pragma unroll
                for (int n = 0; n < 2; ++n) acc[a][b][m][n] = (f32x4){0.f, 0.f, 0.f, 0.f};
    bf16x8 At[4][2], B0[2][2], B1[2][2]; i32x8 At8[4], B08[2], B18[2];
    const char* cA = cur.A; const char* cB = cur.B;
    u32x2 cgp = {0u, 0u}, ngp = {0u, 0u};
    if constexpr (GATHER) cgp = ((const u32x2*)gidx)[cur.pm * 512 + tid];
    if constexpr (SP2) {
        PG8_STAGE(PG8_SB(0, 0), cB, voffB); PG8_STAGE(PG8_SB(0, 1), cB + hstep, voffB); PG8_STAGE_A(PG8_SA(0, 0), cA, 0, false); PG8_STAGE_A(PG8_SA(0, 1), cA, 1, false);
        if (wr == 1) PG8_BAR;
        PG8_WAIT_V(2); PG8_BAR;
        PG8_STAGE(PG8_SB(1, 0), cB + kstep, voffB); PG8_STAGE_A(PG8_SA(1, 0), cA + kstep, 0, false); PG8_STAGE(PG8_SB(1, 1), cB + hstep + kstep, voffB);
        PG8_WAIT_V(6); PG8_BAR;
    } else {
        PG8_STAGE(PG8_SB(0, 0), cB, voffB); PG8_STAGE(PG8_SA(0, 0), cA, voffA); PG8_STAGE(PG8_SB(0, 1), cB + hstep, voffB); PG8_STAGE(PG8_SA(0, 1), cA + hstep, voffA);
        if (wr == 1) PG8_BAR;
        PG8_WAIT_V(4); PG8_BAR;
        PG8_STAGE(PG8_SB(1, 0), cB + kstep, voffB); PG8_STAGE(PG8_SA(1, 0), cA + kstep, voffA); PG8_STAGE(PG8_SB(1, 1), cB + hstep + kstep, voffB);
        PG8_WAIT_V(6); PG8_BAR;
    }
    for (;;) {
        const bool has_next = S.next(ui + 1, nxt);
        if constexpr (GATHER) { const Unit& gu = has_next ? nxt : cur; ngp = ((const u32x2*)gidx)[gu.pm * 512 + PG8_TID()]; }
        const char* nA = has_next ? nxt.A : cA; const char* nB = has_next ? nxt.B : cB;
        PROF_BEGIN(10)
_Pragma("unroll 1")
        for (int t = 0; t < nt; t += 2) {
            const bool last = (t == nt - 2);
            const char* a1 = cA + (size_t)(t + 1) * kstep;
            const char* a2 = last ? nA : cA + (size_t)(t + 2) * kstep; const char* b2 = last ? nB : cB + (size_t)(t + 2) * kstep;
            const char* a3 = a2 + kstep; const char* b3 = b2 + kstep;
            if constexpr (SP2) {
            PG8_LDB(B0, 0, 0); PG8_LDB(B1, 0, 1); PG8_SCHED; PG8_LDA(At, 0, 0); PG8_STAGE_A(PG8_SA(1, 1), a1, 1, false);
            PG8_WAIT_V(8); PG8_WAIT_L(0); PG8_BAR; PG8_MMA(0, 0, At, B0); PG8_MMA(0, 1, At, B1); PG8_BAR; PG8_SCHED;
            PG8_LDA(At, 0, 1); PG8_STAGE(PG8_SB(0, 0), b2, voffB); PG8_STAGE(PG8_SB(0, 1), b2 + hstep, voffB); PG8_STAGE_A(PG8_SA(0, 0), a2, 0, last);
            PG8_WAIT_V(8); PG8_WAIT_L(0); PG8_BAR; PG8_MMA(1, 0, At, B0); PG8_MMA(1, 1, At, B1); PG8_BAR; PG8_SCHED;
            PG8_LDB(B0, 1, 0); PG8_LDB(B1, 1, 1); PG8_SCHED; PG8_LDA(At, 1, 0); PG8_STAGE_A(PG8_SA(0, 1), a2, 1, last);
            PG8_WAIT_V(8); PG8_WAIT_L(0); PG8_BAR; PG8_MMA(0, 0, At, B0); PG8_MMA(0, 1, At, B1); PG8_BAR; PG8_SCHED;
            PG8_LDA(At, 1, 1); PG8_STAGE(PG8_SB(1, 0), b3, voffB); PG8_STAGE(PG8_SB(1, 1), b3 + hstep, voffB); PG8_STAGE_A(PG8_SA(1, 0), a3, 0, last);
            PG8_WAIT_V(8); PG8_WAIT_L(0); PG8_BAR; PG8_MMA(1, 0, At, B0); PG8_MMA(1, 1, At, B1); PG8_BAR; PG8_SCHED;
            } else {
            PG8_LDB(B0, 0, 0); PG8_SCHED; PG8_LDA(At, 0, 0); PG8_STAGE(PG8_SA(1, 1), a1 + hstep, voffA);
            PG8_WAIT_L(8); PG8_BAR; PG8_WAIT_L(0); PG8_MMA(0, 0, At, B0); PG8_BAR; PG8_SCHED;
            PG8_LDB(B1, 0, 1); PG8_STAGE(PG8_SB(0, 0), b2, voffB);
            PG8_BAR; PG8_WAIT_L(0); PG8_MMA(0, 1, At, B1); PG8_BAR;
            PG8_LDA(At, 0, 1); PG8_STAGE(PG8_SA(0, 0), a2, voffA);
            PG8_BAR; PG8_WAIT_L(0); PG8_MMA(1, 0, At, B0); PG8_BAR; PG8_SCHED;
            PG8_STAGE(PG8_SB(0, 1), b2 + hstep, voffB);
            PG8_WAIT_V(6); PG8_BAR; PG8_MMA(1, 1, At, B1); PG8_BAR;
            PG8_LDB(B0, 1, 0); PG8_SCHED; PG8_LDA(At, 1, 0); PG8_STAGE(PG8_SA(0, 1), a2 + hstep, voffA);
            PG8_WAIT_L(8); PG8_BAR; PG8_WAIT_L(0); PG8_MMA(0, 0, At, B0); PG8_BAR; PG8_SCHED;
            PG8_LDB(B1, 1, 1); PG8_STAGE(PG8_SB(1, 0), b3, voffB);
            PG8_BAR; PG8_WAIT_L(0); PG8_MMA(0, 1, At, B1); PG8_BAR;
            PG8_LDA(At, 1, 1); PG8_STAGE(PG8_SA(1, 0), a3, voffA);
            PG8_BAR; PG8_WAIT_L(0); PG8_MMA(1, 0, At, B0); PG8_BAR; PG8_SCHED;
            PG8_STAGE(PG8_SB(1, 1), b3 + hstep, voffB);
            PG8_WAIT_V(6); PG8_BAR; PG8_MMA(1, 1, At, B1); PG8_BAR;
            }
        }
        PROF_END(10, lds)
        PROF_BEGIN(11)
        if constexpr (ALIGN_EPI) { if (wr == 0) PG8_BAR; }
        { const int et_ = PG8_TID();
          E(acc, cur, wr, wc, et_ & 15, (et_ & 63) >> 4); } if (PROF_ID == 11 && PROF_DRAIN) asm volatile("s_waitcnt vmcnt(0)" ::: "memory");
        PROF_END(11, lds)
        if (!has_next) break;
#pragma unroll
        for (int a = 0; a < 2; ++a)
#pragma unroll
            for (int b = 0; b < 2; ++b)
#pragma unroll
                for (int m = 0; m < 4; ++m)
#pragma unroll
                    for (int n = 0; n < 2; ++n) acc[a][b][m][n] = (f32x4){0.f, 0.f, 0.f, 0.f};
        cur = nxt; cA = nA; cB = nB; ++ui;
        if constexpr (GATHER) cgp = ngp;
        if constexpr (ALIGN_EPI) { if (wr == 1) PG8_BAR; }
    }
    PG8_WAIT_V(0);
    if constexpr (!ALIGN_EPI) { if (wr == 0) PG8_BAR; }
    PG8_BAR;
#undef PG8_SA
#undef PG8_SB
#undef PG8_STAGE
#undef PG8_STAGE2
#undef PG8_GOFF
#undef PG8_STAGE_A
#undef PG8_LDA
#undef PG8_LDB
#undef PG8_MMA
#undef PG8_TID
#undef PG8_WAIT_V
#undef PG8_WAIT_L
#undef PG8_BAR
#undef PG8_SCHED
}

#ifndef EPI_NT
#define EPI_NT 0
#endif
#if EPI_NT == 2
__device__ __forceinline__ void st_wt(u32x4* p, u32x4 w) { asm volatile("global_store_dwordx4 %0, %1, off sc1" :: "v"(p), "v"(w) : "memory"); }
__device__ __forceinline__ void st_wt(u32x2* p, u32x2 w) { asm volatile("global_store_dwordx2 %0, %1, off sc1" :: "v"(p), "v"(w) : "memory"); }
#define EPI_STORE(T, p, w) st_wt((T*)(p), (w))
#elif EPI_NT
#define EPI_STORE(T, p, w) __builtin_nontemporal_store((w), (T*)(p))
#else
#define EPI_STORE(T, p, w) (*(T*)(p) = (w))
#endif
__device__ __forceinline__ void st4bf(bf16_t* p, f32x4 v) { u32x2 w; w.x = cvt_pk_bf16(v[0], v[1]); w.y = cvt_pk_bf16(v[2], v[3]); EPI_STORE(u32x2, p, w); }
__device__ __forceinline__ void st8bf(bf16_t* p, f32x4 a, f32x4 b) { u32x4 w; w.x = cvt_pk_bf16(a[0], a[1]); w.y = cvt_pk_bf16(a[2], a[3]); w.z = cvt_pk_bf16(b[0], b[1]); w.w = cvt_pk_bf16(b[2], b[3]); EPI_STORE(u32x4, p, w); }

struct EpiInProj {
    static constexpr bool PERM = false;
    bf16_t *Q, *Kb, *Vb, *GB, *Z; const float* rope;
    __device__ __forceinline__ void operator()(const f32x4 (&acc)[2][2][4][2], const Unit& u, int wr, int wc, int fr, int fq) const {
        const int lrow0 = wr * 64 + fr, lcol0 = wc * 32 + 4 * fq;
        if (u.kind == 0 && u.pn < 4) {
            const bool isq = u.pn < 2; const float qs = isq ? 0.125f * 1.4426950408889634f : 1.0f;
#pragma unroll
            for (int ai = 0; ai < 2; ++ai) {
                f32x4 csv[4], snv[4];
#pragma unroll
                for (int m = 0; m < 4; ++m) { const int npos = (u.pm * 256 + ai * 128 + m * 16 + lrow0) & (SEQ - 1); const int p = (wc & 1) ? (npos & 63) : (npos >> 6);
                    csv[m] = *(const f32x4*)(rope + p * 32 + 4 * fq); snv[m] = *(const f32x4*)(rope + p * 32 + 16 + 4 * fq); }
                asm volatile("" ::: "memory");
#pragma unroll
                for (int m = 0; m < 4; ++m) {
                    const int row = u.pm * 256 + ai * 128 + m * 16 + lrow0, npos = row & (SEQ - 1), b = row >> 11;
                    const f32x4 cs = csv[m], sn = snv[m];
                    bf16_t* dst = isq ? Q + (size_t)row * 512 + (u.pn & 1) * 256 + lcol0 : Kb + (((size_t)b * 4 + (u.pn & 1) * 2) * SKV + CTX + npos) * 128 + lcol0;
                    const size_t hstride = isq ? 128 : (size_t)SKV * 128;
#pragma unroll
                    for (int bj = 0; bj < 2; ++bj) {
                        const f32x4 lo = acc[ai][bj][m][0], hi = acc[ai][bj][m][1];
                        st4bf(dst + bj * hstride, (lo * cs - hi * sn) * qs); st4bf(dst + bj * hstride + 16, (hi * cs + lo * sn) * qs);
                    }
                }
                asm volatile("" ::: "memory");
            }
        } else if (u.kind == 0 && u.pn >= 8) {
#pragma unroll
            for (int ai = 0; ai < 2; ++ai)
#pragma unroll
                for (int m = 0; m < 4; ++m) {
                    const int row = u.pm * 256 + ai * 128 + m * 16 + lrow0;
                    bf16_t* dst = Z + (size_t)row * 512 + (u.pn - 8) * 128 + lcol0;
#pragma unroll
                    for (int n = 0; n < 2; ++n) st4bf(dst + n * 16, acc[ai][0][m][n] * acc[ai][1][m][n]);
                }
        } else {
#pragma unroll
            for (int ai = 0; ai < 2; ++ai)
#pragma unroll
                for (int m = 0; m < 4; ++m) {
                    const int row = u.pm * 256 + ai * 128 + m * 16 + lrow0;
                    bf16_t* dst; size_t hstride = (size_t)SKV * 128;
                    if (u.kind == 0) { const int npos = row & (SEQ - 1), b = row >> 11;
                        if (u.pn < 6) dst = Vb + (((size_t)b * 4 + (u.pn & 1) * 2) * SKV + CTX + npos) * 128; else { dst = GB + (size_t)row * 512 + (u.pn - 6) * 256; hstride = 128; } }
                    else { const int b = row >> 8, mpos = row & 255;
                        dst = ((u.pn < 2) ? Kb : Vb) + (((size_t)b * 4 + (u.pn & 1) * 2) * SKV + mpos) * 128; }
                    dst += lcol0;
#pragma unroll
                    for (int bj = 0; bj < 2; ++bj)
#pragma unroll
                        for (int n = 0; n < 2; ++n) st4bf(dst + bj * hstride + n * 16, acc[ai][bj][m][n]);
                }
        }
    }
};

template <bool BASE_F32> struct EpiOutProj {
    static constexpr bool PERM = true;
    const void* base; bf16_t* out; const float* g; float* ssq;
    __device__ __forceinline__ void operator()(const f32x4 (&acc)[2][2][4][2], const Unit& u, int wr, int wc, int fr, int fq) const {
        const int lrow0 = wr * 64 + fr, col0 = u.pn * 256 + wc * 32 + 8 * fq, b = u.pm >> 3;
        f32x4 gv[2][2];
#pragma unroll
        for (int bj = 0; bj < 2; ++bj)
#pragma unroll
            for (int n = 0; n < 2; ++n) gv[bj][n] = *(const f32x4*)(g + (size_t)b * MODW + col0 + bj * 128 + n * 4);
        if constexpr (BASE_F32) {
#pragma unroll
            for (int ai = 0; ai < 2; ++ai) { f32x4 bs[4][2][2];
#pragma unroll
                for (int m = 0; m < 4; ++m)
#pragma unroll
                    for (int bj = 0; bj < 2; ++bj)
#pragma unroll
                        for (int n = 0; n < 2; ++n) bs[m][bj][n] = *(const f32x4*)((const float*)base + (size_t)(u.pm * 256 + ai * 128 + m * 16 + lrow0) * DM + col0 + bj * 128 + n * 4);
                asm volatile("" ::: "memory");
#pragma unroll
                for (int m = 0; m < 4; ++m) { const int row = u.pm * 256 + ai * 128 + m * 16 + lrow0; const size_t off = (size_t)row * DM + col0;
#pragma unroll
                    for (int bj = 0; bj < 2; ++bj) { const f32x4 o0 = bs[m][bj][0] + gv[bj][0] * acc[ai][bj][m][0], o1 = bs[m][bj][1] + gv[bj][1] * acc[ai][bj][m][1];
                        st8bf(out + off + bj * 128, o0, o1); }
                }
                asm volatile("" ::: "memory"); }
        } else {
            u32x4 bw[2][4][2];
#pragma unroll
            for (int ai = 0; ai < 2; ++ai)
#pragma unroll
                for (int m = 0; m < 4; ++m)
#pragma unroll
                    for (int bj = 0; bj < 2; ++bj) bw[ai][m][bj] = *(const u32x4*)((const bf16_t*)base + (size_t)(u.pm * 256 + ai * 128 + m * 16 + lrow0) * DM + col0 + bj * 128);
            asm volatile("" ::: "memory");
#pragma unroll
            for (int ai = 0; ai < 2; ++ai)
#pragma unroll
                for (int m = 0; m < 4; ++m) { const int row = u.pm * 256 + ai * 128 + m * 16 + lrow0; const size_t off = (size_t)row * DM + col0;
#pragma unroll
                    for (int bj = 0; bj < 2; ++bj) { const u32x4 w = bw[ai][m][bj];
                        const f32x4 b0 = (f32x4){bflo(w.x), bfhi(w.x), bflo(w.y), bfhi(w.y)}, b1 = (f32x4){bflo(w.z), bfhi(w.z), bflo(w.w), bfhi(w.w)};
                        const f32x4 o0 = b0 + gv[bj][0] * acc[ai][bj][m][0], o1 = b1 + gv[bj][1] * acc[ai][bj][m][1];
                        st8bf(out + off + bj * 128, o0, o1); }
                }
        }
    }
};

struct EpiGateUp {
    static constexpr bool PERM = true;
    bf16_t* ACT;
    __device__ __forceinline__ void operator()(const f32x4 (&acc)[2][2][4][2], const Unit& u, int wr, int wc, int fr, int fq) const {
        const int lrow0 = wr * 64 + fr, col0 = u.pn * 128 + wc * 32 + 8 * fq;
#pragma unroll
        for (int ai = 0; ai < 2; ++ai)
#pragma unroll
            for (int m = 0; m < 4; ++m) {
                const int row = u.pm * 256 + ai * 128 + m * 16 + lrow0; f32x4 r[2];
#pragma unroll
                for (int n = 0; n < 2; ++n) { const f32x4 gt = acc[ai][0][m][n], up = acc[ai][1][m][n];
#pragma unroll
                    for (int i = 0; i < 4; ++i) { const float e = __builtin_amdgcn_exp2f(gt[i] * -1.4426950408889634f); r[n][i] = gt[i] * __builtin_amdgcn_rcpf(1.0f + e) * up[i]; } }
                st8bf(ACT + (size_t)row * DM + col0, r[0], r[1]);
            }
    }
};

struct EpiDown {
    static constexpr bool PERM = true;
    bf16_t* Y; const float* vals;
    __device__ __forceinline__ void operator()(const f32x4 (&acc)[2][2][4][2], const Unit& u, int wr, int wc, int fr, int fq) const {
        const int lrow0 = wr * 64 + fr, col0 = u.pn * 256 + wc * 32 + 8 * fq;
#pragma unroll
        for (int ai = 0; ai < 2; ++ai)
#pragma unroll
            for (int m = 0; m < 4; ++m) {
                const int row = u.pm * 256 + ai * 128 + m * 16 + lrow0; const float v = vals[row];
#pragma unroll
                for (int bj = 0; bj < 2; ++bj) st8bf(Y + (size_t)row * DM + col0 + bj * 128, acc[ai][bj][m][0] * v, acc[ai][bj][m][1] * v);
            }
    }
};

struct EpiGateUp8 {
    static constexpr bool PERM = true;
    unsigned char* ACT8;
    __device__ __forceinline__ void operator()(const f32x4 (&acc)[2][2][4][2], const Unit& u, int wr, int wc, int fr, int fq) const {
        const int lrow0 = wr * 64 + fr, col0 = u.pn * 128 + wc * 32 + 8 * fq;
#pragma unroll
        for (int ai = 0; ai < 2; ++ai)
#pragma unroll
            for (int m = 0; m < 4; ++m) {
                const int row = u.pm * 256 + ai * 128 + m * 16 + lrow0; f32x4 r[2];
#pragma unroll
                for (int n = 0; n < 2; ++n) { const f32x4 gt = acc[ai][0][m][n] * FP8_UNSCALE, up = acc[ai][1][m][n] * (FP8_UNSCALE * FP8_SA);
#pragma unroll
                    for (int i = 0; i < 4; ++i) { const float e = __builtin_amdgcn_exp2f(gt[i] * -1.4426950408889634f); r[n][i] = gt[i] * __builtin_amdgcn_rcpf(1.0f + e) * up[i]; } }
                u32x2 w; w.x = pk4_fp8(r[0]); w.y = pk4_fp8(r[1]); *(u32x2*)(ACT8 + (size_t)row * DM + col0) = w;
            }
    }
};
struct EpiDown8 {
    static constexpr bool PERM = true;
    unsigned char* Y; const float* vals;
    __device__ __forceinline__ void operator()(const f32x4 (&acc)[2][2][4][2], const Unit& u, int wr, int wc, int fr, int fq) const {
        const int lrow0 = wr * 64 + fr, col0 = u.pn * 256 + wc * 32 + 8 * fq;
#pragma unroll
        for (int ai = 0; ai < 2; ++ai)
#pragma unroll
            for (int m = 0; m < 4; ++m) {
                const int row = u.pm * 256 + ai * 128 + m * 16 + lrow0; const float v = vals[row] * (FP8_UNSCALE * FP8_SY);
#pragma unroll
                for (int bj = 0; bj < 2; ++bj) { u32x2 w; w.x = pk4_fp8(acc[ai][bj][m][0] * v); w.y = pk4_fp8(acc[ai][bj][m][1] * v); EPI_STORE(u32x2, Y + (size_t)row * DM + col0 + bj * 128, w); }
            }
    }
};

struct EpiOddIn {
    static constexpr bool PERM = true;
    bf16_t* U; bf16_t* VV; float* ssqv;
    __device__ __forceinline__ void operator()(const f32x4 (&acc)[2][2][4][2], const Unit& u, int wr, int wc, int fr, int fq) const {
        const int lrow0 = wr * 64 + fr; const bool isv = u.pn >= 4; const int pnl = u.pn & 3, col0 = pnl * 256 + wc * 32 + 8 * fq;
        bf16_t* dstb = isv ? VV : U;
#pragma unroll
        for (int ai = 0; ai < 2; ++ai)
#pragma unroll
            for (int m = 0; m < 4; ++m) {
                const int row = u.pm * 256 + ai * 128 + m * 16 + lrow0; float s = 0.f;
#pragma unroll
                for (int bj = 0; bj < 2; ++bj) { const f32x4 v0 = acc[ai][bj][m][0], v1 = acc[ai][bj][m][1];
                    const f32x2 a = gelu_pk((f32x2){v0[0], v0[1]}), b = gelu_pk((f32x2){v0[2], v0[3]}), c = gelu_pk((f32x2){v1[0], v1[1]}), d = gelu_pk((f32x2){v1[2], v1[3]});
                    s += (a.x * a.x + a.y * a.y) + (b.x * b.x + b.y * b.y) + (c.x * c.x + c.y * c.y) + (d.x * d.x + d.y * d.y);
                    st8bf(dstb + (size_t)row * DM + col0 + bj * 128, (f32x4){a.x, a.y, b.x, b.y}, (f32x4){c.x, c.y, d.x, d.y}); }
                if (isv) { s += __shfl_xor(s, 16); s += __shfl_xor(s, 32); if (fq == 0) ssqv[(size_t)(pnl * 4 + wc) * MROWS + row] = s; }
            }
    }
};

constexpr size_t TSTEP = (size_t)256 * DM * 2;
struct SchedSimple {
    const char* A; const char* B; int nM, nN, G, c;
    __device__ __forceinline__ bool next(int i, Unit& u) const {
        const int nwg = nM * nN; const long L = (long)i * G + c; if (L >= nwg) return false;
        const int w = xcd_remap((int)L, nwg); grouped(w, nM, nN, u.pm, u.pn); u.kind = 0; u.A = A + (size_t)u.pm * TSTEP; u.B = B + (size_t)u.pn * TSTEP; return true;
    }
};
struct SchedInProj {
    const char* A; const char* Ac; const char* B; int G, c;
    __device__ __forceinline__ bool next(int i, Unit& u) const {
        constexpr int n0 = 128 * 12, nwg = n0 + 64; const long L = (long)i * G + c; if (L >= nwg) return false;
        const int w = xcd_remap((int)L, nwg);
        if (w < n0) { grouped(w, 128, 12, u.pm, u.pn); u.kind = 0; u.A = A + (size_t)u.pm * TSTEP; u.B = B + (size_t)u.pn * TSTEP; }
        else { const int x = w - n0; u.pm = x >> 2; u.pn = x & 3; u.kind = 1; u.A = Ac + (size_t)u.pm * TSTEP; u.B = B + (size_t)(2 + u.pn) * TSTEP; }
        return true;
    }
};
struct SchedMoe {
    const char* A; const char* B; int nN, G, c;
    __device__ __forceinline__ bool next(int i, Unit& u) const {
        const int nwg = 256 * nN; const long L = (long)i * G + c; if (L >= nwg) return false;
        const int w = xcd_remap((int)L, nwg); grouped(w, 256, nN, u.pm, u.pn); u.kind = 0; u.A = A + (size_t)u.pm * TSTEP; u.B = B + (size_t)((u.pm >> 4) * nN + u.pn) * TSTEP; return true;
    }
};
struct SchedMoeGather {
    const char* A; const char* B; int G, c;
    __device__ __forceinline__ bool next(int i, Unit& u) const {
        constexpr int nN = 8, nwg = 256 * nN; const long L = (long)i * G + c; if (L >= nwg) return false;
        const int w = xcd_remap((int)L, nwg); grouped(w, 256, nN, u.pm, u.pn); u.kind = 0; u.A = A + (size_t)(u.pm & 15) * SEQ * DM * 2; u.B = B + (size_t)((u.pm >> 4) * nN + u.pn) * TSTEP; return true;
    }
};
constexpr size_t TSTEP8 = (size_t)256 * DM;
struct SchedMoe8 {
    const char* A; const char* B; int nN, G, c;
    __device__ __forceinline__ bool next(int i, Unit& u) const {
        const int nwg = 256 * nN; const long L = (long)i * G + c; if (L >= nwg) return false;
        const int w = xcd_remap((int)L, nwg); grouped(w, 256, nN, u.pm, u.pn); u.kind = 0; u.A = A + (size_t)u.pm * TSTEP8; u.B = B + (size_t)((u.pm >> 4) * nN + u.pn) * TSTEP8; return true;
    }
};
struct SchedMoeGather8 {
    const char* A; const char* B; int G, c;
    __device__ __forceinline__ bool next(int i, Unit& u) const {
        constexpr int nN = 8, nwg = 256 * nN; const long L = (long)i * G + c; if (L >= nwg) return false;
        const int w = xcd_remap((int)L, nwg); grouped(w, 256, nN, u.pm, u.pn); u.kind = 0; u.A = A + (size_t)(u.pm & 15) * SEQ * DM; u.B = B + (size_t)((u.pm >> 4) * nN + u.pn) * TSTEP8; return true;
    }
};
}

namespace att {
#ifndef ATT_PRIO
#define ATT_PRIO 0
#endif
#ifndef ATT_PV_FIRST
#define ATT_PV_FIRST 1
#endif
#ifndef ATT_STAGE_IN_M
#define ATT_STAGE_IN_M 3
#endif
constexpr int NW = 8, QBLK = 32, KVBLK = 64, LDQ = 512, LDK = 128;
constexpr float SCALE = 0.125f, THR = 8.f;
constexpr int SHM_V = KVBLK * 128 * 2, SHM_K = KVBLK * 128 * 2, SHM_ATTN = 3 * (SHM_V + SHM_K) + NW * 64 * 4;
#define KSWZ(row, colB) ((row) * 256 + ((colB) ^ (((row) & 7) << 4)))
#define SBAR() __builtin_amdgcn_sched_barrier(0)
__device__ __forceinline__ int crow(int r, int hi) { return (r & 3) + 8 * (r >> 2) + 4 * hi; }
__device__ __forceinline__ unsigned cvtpk(float lo, float hi) { unsigned r; asm volatile("v_cvt_pk_bf16_f32 %0, %1, %2" : "=v"(r) : "v"(lo), "v"(hi)); return r; }

__device__ __forceinline__ void partialSM(f32x16& p0, f32x16& p1, float& m_reg, float& mn, float& alpha) {
  constexpr float C = SCALE * 1.4426950408889634f;
  float pmax = p0[0]; for (int r = 1; r < 16; ++r) pmax = fmaxf(pmax, p0[r]); for (int r = 0; r < 16; ++r) pmax = fmaxf(pmax, p1[r]);
  { auto rr = __builtin_amdgcn_permlane32_swap(__float_as_uint(pmax), __float_as_uint(pmax), false, false);
    pmax = fmaxf(__uint_as_float(rr[0]), __uint_as_float(rr[1])); }
  if (__builtin_expect(__all(pmax - m_reg <= THR / SCALE), 1)) { mn = m_reg; alpha = 1.f; }
  else { mn = fmaxf(m_reg, pmax); alpha = __builtin_amdgcn_exp2f((m_reg - mn) * C); m_reg = mn; }
  float mnC = -mn * C;
  for (int r = 0; r < 16; ++r) p0[r] = fmaf(p0[r], C, mnC); for (int r = 0; r < 16; ++r) p1[r] = fmaf(p1[r], C, mnC);
  for (int r = 0; r < 16; ++r) p0[r] = __builtin_amdgcn_exp2f(p0[r]);
}
__device__ __forceinline__ void finishSM(f32x16& p0, f32x16& p1, float alpha, float& l_reg, bf16x8& pa0, bf16x8& pa1, bf16x8& pa2, bf16x8& pa3) {
  for (int r = 0; r < 16; ++r) p1[r] = __builtin_amdgcn_exp2f(p1[r]);
  float ps = 0; for (int r = 0; r < 16; ++r) ps += p0[r]; for (int r = 0; r < 16; ++r) ps += p1[r];
  { auto rr = __builtin_amdgcn_permlane32_swap(__float_as_uint(ps), __float_as_uint(ps), false, false);
    ps = __uint_as_float(rr[0]) + __uint_as_float(rr[1]); }
  l_reg = l_reg * alpha + ps;
#define PK4(P, BASE, OUT) do { unsigned a0 = cvtpk(P[BASE + 0], P[BASE + 1]), a1 = cvtpk(P[BASE + 2], P[BASE + 3]);   \
    unsigned b0 = cvtpk(P[BASE + 4], P[BASE + 5]), b1 = cvtpk(P[BASE + 6], P[BASE + 7]);                              \
    auto r0 = __builtin_amdgcn_permlane32_swap(a0, b0, false, false); auto r1 = __builtin_amdgcn_permlane32_swap(a1, b1, false, false); \
    u32x4 w = {r0[0], r1[0], r0[1], r1[1]}; OUT = *reinterpret_cast<bf16x8*>(&w); } while (0)
  PK4(p0, 0, pa0); PK4(p0, 8, pa1); PK4(p1, 0, pa2); PK4(p1, 8, pa3);
#undef PK4
}
__device__ __forceinline__ void qkt(f32x16& p0, f32x16& p1, const LAS unsigned char* Ks, const bf16x8* qr, int r32, int hi, int map) {
  p0 = f32x16{}; p1 = f32x16{};
#pragma unroll
  for (int d0 = 0; d0 < 4; ++d0) { const int cb = ((map * 4 + d0) * 16 + hi * 8) * 2;
    bf16x8 b0 = *(const LAS bf16x8*)(Ks + KSWZ(r32, cb));
    bf16x8 b1 = *(const LAS bf16x8*)(Ks + KSWZ(32 + r32, cb));
    p0 = __builtin_amdgcn_mfma_f32_32x32x16_bf16(b0, qr[d0], p0, 0, 0, 0);
    p1 = __builtin_amdgcn_mfma_f32_32x32x16_bf16(b1, qr[d0], p1, 0, 0, 0); }
}
__device__ __forceinline__ int v_st(int k, int c) { const int kk = (k & ~0xC) | ((k & 4) << 1) | ((k & 8) >> 1); return ((kk >> 3) * 4 + (c >> 5)) * 512 + ((kk & 7) * 32 + (c & 31)) * 2; }
__device__ __forceinline__ int v_rd_base(int lane) { return ((lane & 3) << 3) | (((lane >> 2) & 3) << 6) | (((lane >> 4) & 1) << 5) | (((lane >> 5) & 1) << 8); }
constexpr int v_rd_off(int d0, int ks, int half) { return d0 * 512 + ks * 4096 + half * 2048; }
template <int OFF> __device__ __forceinline__ s16x4 tr_read(int vb) {
  s16x4 r; asm volatile("ds_read_b64_tr_b16 %0, %1 offset:%2" : "=&v"(r) : "v"(vb), "i"(OFF) : "memory"); return r;
}
template <int D0> __device__ __forceinline__ void pv_one(f32x16& od, int vb, bf16x8 pa0, bf16x8 pa1, bf16x8 pa2, bf16x8 pa3) {
  const s16x4 l0 = tr_read<v_rd_off(D0, 0, 0)>(vb), h0 = tr_read<v_rd_off(D0, 0, 1)>(vb), l1 = tr_read<v_rd_off(D0, 1, 0)>(vb), h1 = tr_read<v_rd_off(D0, 1, 1)>(vb);
  const s16x4 l2 = tr_read<v_rd_off(D0, 2, 0)>(vb), h2 = tr_read<v_rd_off(D0, 2, 1)>(vb), l3 = tr_read<v_rd_off(D0, 3, 0)>(vb), h3 = tr_read<v_rd_off(D0, 3, 1)>(vb);
  asm volatile("s_waitcnt lgkmcnt(0)" ::: "memory"); SBAR();
#define PK(L, H) (bf16x8){L[0], L[1], L[2], L[3], H[0], H[1], H[2], H[3]}
  od = __builtin_amdgcn_mfma_f32_32x32x16_bf16(pa0, PK(l0, h0), od, 0, 0, 0);
  od = __builtin_amdgcn_mfma_f32_32x32x16_bf16(pa1, PK(l1, h1), od, 0, 0, 0);
  od = __builtin_amdgcn_mfma_f32_32x32x16_bf16(pa2, PK(l2, h2), od, 0, 0, 0);
  od = __builtin_amdgcn_mfma_f32_32x32x16_bf16(pa3, PK(l3, h3), od, 0, 0, 0);
#undef PK
}
__device__ __forceinline__ void pv_d0(f32x16* o, int vb, bf16x8 pa0, bf16x8 pa1, bf16x8 pa2, bf16x8 pa3) {
  pv_one<0>(o[0], vb, pa0, pa1, pa2, pa3); pv_one<1>(o[1], vb, pa0, pa1, pa2, pa3); pv_one<2>(o[2], vb, pa0, pa1, pa2, pa3); pv_one<3>(o[3], vb, pa0, pa1, pa2, pa3);
}

template <int OFF> __device__ __forceinline__ bf16x8 lds_read128(int addr) {
  bf16x8 r; asm volatile("ds_read_b128 %0, %1 offset:%2" : "=&v"(r) : "v"(addr), "i"(OFF) : "memory"); return r;
}
#define LGKM_WAIT(N) asm volatile("s_waitcnt lgkmcnt(" #N ")" ::: "memory")
#define VTR8(D0, L0, H0, L1, H1, L2, H2, L3, H3, vb) do { L0 = tr_read<v_rd_off(D0, 0, 0)>(vb); H0 = tr_read<v_rd_off(D0, 0, 1)>(vb); L1 = tr_read<v_rd_off(D0, 1, 0)>(vb); H1 = tr_read<v_rd_off(D0, 1, 1)>(vb); \
    L2 = tr_read<v_rd_off(D0, 2, 0)>(vb); H2 = tr_read<v_rd_off(D0, 2, 1)>(vb); L3 = tr_read<v_rd_off(D0, 3, 0)>(vb); H3 = tr_read<v_rd_off(D0, 3, 1)>(vb); } while (0)
#define VPK(L, H) (bf16x8){L[0], L[1], L[2], L[3], H[0], H[1], H[2], H[3]}
#define PV4(OD, L0, H0, L1, H1, L2, H2, L3, H3) do { OD = __builtin_amdgcn_mfma_f32_32x32x16_bf16(VPK(L0, H0), pa0, OD, 0, 0, 0); OD = __builtin_amdgcn_mfma_f32_32x32x16_bf16(VPK(L1, H1), pa1, OD, 0, 0, 0); \
    OD = __builtin_amdgcn_mfma_f32_32x32x16_bf16(VPK(L2, H2), pa2, OD, 0, 0, 0); OD = __builtin_amdgcn_mfma_f32_32x32x16_bf16(VPK(L3, H3), pa3, OD, 0, 0, 0); } while (0)
template <bool DO_QK, bool DO_PV>
__device__ __forceinline__ void m_phase(f32x16& p0, f32x16& p1, f32x16 (&o)[4], const bf16x8 (&qr)[4], const int (&kaddr)[4], int kb, int vb, bf16x8 pa0, bf16x8 pa1, bf16x8 pa2, bf16x8 pa3, float negm) {
  bf16x8 kf[4]; s16x4 a0, a1, a2, a3, a4, a5, a6, a7;
  SBAR();
  if (ATT_PRIO == 1) __builtin_amdgcn_s_setprio(1);
  if constexpr (DO_QK) {
#pragma unroll
    for (int d0 = 0; d0 < 2; ++d0) { kf[2 * d0] = lds_read128<0>(kaddr[d0] + kb); kf[2 * d0 + 1] = lds_read128<8192>(kaddr[d0] + kb); }
  }
  if constexpr (DO_PV) VTR8(0, a0, a1, a2, a3, a4, a5, a6, a7, vb);
  if constexpr (DO_QK) {
    if constexpr (DO_PV) LGKM_WAIT(8); else LGKM_WAIT(0);
    SBAR();
    f32x16 ini;
#pragma unroll
    for (int r = 0; r < 16; ++r) ini[r] = negm;
    p0 = __builtin_amdgcn_mfma_f32_32x32x16_bf16(kf[0], qr[0], ini, 0, 0, 0); p1 = __builtin_amdgcn_mfma_f32_32x32x16_bf16(kf[1], qr[0], ini, 0, 0, 0);
    p0 = __builtin_amdgcn_mfma_f32_32x32x16_bf16(kf[2], qr[1], p0, 0, 0, 0); p1 = __builtin_amdgcn_mfma_f32_32x32x16_bf16(kf[3], qr[1], p1, 0, 0, 0);
    SBAR();
#pragma unroll
    for (int d0 = 2; d0 < 4; ++d0) { kf[2 * d0 - 4] = lds_read128<0>(kaddr[d0] + kb); kf[2 * d0 - 3] = lds_read128<8192>(kaddr[d0] + kb); }
    LGKM_WAIT(0); SBAR();
    p0 = __builtin_amdgcn_mfma_f32_32x32x16_bf16(kf[0], qr[2], p0, 0, 0, 0); p1 = __builtin_amdgcn_mfma_f32_32x32x16_bf16(kf[1], qr[2], p1, 0, 0, 0);
    p0 = __builtin_amdgcn_mfma_f32_32x32x16_bf16(kf[2], qr[3], p0, 0, 0, 0); p1 = __builtin_amdgcn_mfma_f32_32x32x16_bf16(kf[3], qr[3], p1, 0, 0, 0);
    SBAR();
  }
  if constexpr (DO_PV) {
    LGKM_WAIT(0); SBAR(); PV4(o[0], a0, a1, a2, a3, a4, a5, a6, a7); SBAR(); VTR8(1, a0, a1, a2, a3, a4, a5, a6, a7, vb);
    LGKM_WAIT(0); SBAR(); PV4(o[1], a0, a1, a2, a3, a4, a5, a6, a7); SBAR(); VTR8(2, a0, a1, a2, a3, a4, a5, a6, a7, vb);
    LGKM_WAIT(0); SBAR(); PV4(o[2], a0, a1, a2, a3, a4, a5, a6, a7); SBAR(); VTR8(3, a0, a1, a2, a3, a4, a5, a6, a7, vb);
    LGKM_WAIT(0); SBAR(); PV4(o[3], a0, a1, a2, a3, a4, a5, a6, a7); SBAR();
  }
  if (ATT_PRIO == 1) __builtin_amdgcn_s_setprio(0);
}

template <bool DO_QK>
__device__ __forceinline__ void m_phase_pvfirst(f32x16& p0, f32x16& p1, f32x16 (&o)[4], const bf16x8 (&qr)[4], const int (&kaddr)[4], int kb, int vb, bf16x8 pa0, bf16x8 pa1, bf16x8 pa2, bf16x8 pa3, float negm,
                                                s16x4 a0, s16x4 a1, s16x4 a2, s16x4 a3, s16x4 a4, s16x4 a5, s16x4 a6, s16x4 a7) {
  bf16x8 kf[4];
  SBAR();
  if constexpr (DO_QK) {
#pragma unroll
    for (int d0 = 0; d0 < 2; ++d0) { kf[2 * d0] = lds_read128<0>(kaddr[d0] + kb); kf[2 * d0 + 1] = lds_read128<8192>(kaddr[d0] + kb); }
    LGKM_WAIT(4);
  } else LGKM_WAIT(0);
  SBAR(); PV4(o[0], a0, a1, a2, a3, a4, a5, a6, a7); SBAR(); VTR8(1, a0, a1, a2, a3, a4, a5, a6, a7, vb);
  if constexpr (DO_QK) {
    LGKM_WAIT(8); SBAR();
    f32x16 ini;
#pragma unroll
    for (int r = 0; r < 16; ++r) ini[r] = negm;
    p0 = __builtin_amdgcn_mfma_f32_32x32x16_bf16(kf[0], qr[0], ini, 0, 0, 0); p1 = __builtin_amdgcn_mfma_f32_32x32x16_bf16(kf[1], qr[0], ini, 0, 0, 0);
    p0 = __builtin_amdgcn_mfma_f32_32x32x16_bf16(kf[2], qr[1], p0, 0, 0, 0); p1 = __builtin_amdgcn_mfma_f32_32x32x16_bf16(kf[3], qr[1], p1, 0, 0, 0);
    SBAR();
#pragma unroll
    for (int d0 = 2; d0 < 4; ++d0) { kf[2 * d0 - 4] = lds_read128<0>(kaddr[d0] + kb); kf[2 * d0 - 3] = lds_read128<8192>(kaddr[d0] + kb); }
    LGKM_WAIT(4);
  } else LGKM_WAIT(0);
  SBAR(); PV4(o[1], a0, a1, a2, a3, a4, a5, a6, a7); SBAR(); VTR8(2, a0, a1, a2, a3, a4, a5, a6, a7, vb);
  if constexpr (DO_QK) {
    LGKM_WAIT(8); SBAR();
    p0 = __builtin_amdgcn_mfma_f32_32x32x16_bf16(kf[0], qr[2], p0, 0, 0, 0); p1 = __builtin_amdgcn_mfma_f32_32x32x16_bf16(kf[1], qr[2], p1, 0, 0, 0);
    p0 = __builtin_amdgcn_mfma_f32_32x32x16_bf16(kf[2], qr[3], p0, 0, 0, 0); p1 = __builtin_amdgcn_mfma_f32_32x32x16_bf16(kf[3], qr[3], p1, 0, 0, 0);
    SBAR();
  }
  LGKM_WAIT(0); SBAR(); PV4(o[2], a0, a1, a2, a3, a4, a5, a6, a7); SBAR(); VTR8(3, a0, a1, a2, a3, a4, a5, a6, a7, vb);
  LGKM_WAIT(0); SBAR(); PV4(o[3], a0, a1, a2, a3, a4, a5, a6, a7); SBAR();
}

constexpr float THR2 = 8.f * 1.4426950408889634f;
__device__ __forceinline__ void softmax_tile(const bool first, f32x16& p0, f32x16& p1, float& m_reg, float& l_reg, f32x16 (&o)[4], LAS float* al_l, int r32, int hi,
                                             bf16x8& pa0, bf16x8& pa1, bf16x8& pa2, bf16x8& pa3) {
  float mxa = fmaxf(fmaxf(p0[0], p0[1]), p0[2]), mxb = fmaxf(fmaxf(p0[3], p0[4]), p0[5]), mxc = fmaxf(fmaxf(p1[0], p1[1]), p1[2]), mxd = fmaxf(fmaxf(p1[3], p1[4]), p1[5]);
  mxa = fmaxf(fmaxf(mxa, p0[6]), p0[7]); mxb = fmaxf(fmaxf(mxb, p0[8]), p0[9]); mxc = fmaxf(fmaxf(mxc, p1[6]), p1[7]); mxd = fmaxf(fmaxf(mxd, p1[8]), p1[9]);
  mxa = fmaxf(fmaxf(mxa, p0[10]), p0[11]); mxb = fmaxf(fmaxf(mxb, p0[12]), p0[13]); mxc = fmaxf(fmaxf(mxc, p1[10]), p1[11]); mxd = fmaxf(fmaxf(mxd, p1[12]), p1[13]);
  mxa = fmaxf(fmaxf(mxa, p0[14]), p0[15]); mxc = fmaxf(fmaxf(mxc, p1[14]), p1[15]);
  float pmax = fmaxf(fmaxf(mxa, mxb), fmaxf(mxc, mxd));
  { auto rr = __builtin_amdgcn_permlane32_swap(__float_as_uint(pmax), __float_as_uint(pmax), false, false);
    pmax = fmaxf(__uint_as_float(rr[0]), __uint_as_float(rr[1])); }
  if (first || !__builtin_expect(__all(pmax <= THR2), 1)) {
    const float dl = first ? pmax : fmaxf(pmax, 0.f); m_reg += dl;
#pragma unroll
    for (int r = 0; r < 16; ++r) { p0[r] -= dl; p1[r] -= dl; }
    const float alpha = first ? 1.0f : __builtin_amdgcn_exp2f(-dl); l_reg *= alpha;
#pragma unroll
    for (int d = 0; d < 4; ++d)
#pragma unroll
      for (int r = 0; r < 16; ++r) o[d][r] *= alpha;
  }
#pragma unroll
  for (int r = 0; r < 16; ++r) { p0[r] = __builtin_amdgcn_exp2f(p0[r]); p1[r] = __builtin_amdgcn_exp2f(p1[r]); }
  float ps0 = p0[0] + p1[0], ps1 = p0[1] + p1[1], ps2 = p0[2] + p1[2], ps3 = p0[3] + p1[3];
#pragma unroll
  for (int r = 4; r < 16; r += 4) { ps0 += p0[r] + p1[r]; ps1 += p0[r + 1] + p1[r + 1]; ps2 += p0[r + 2] + p1[r + 2]; ps3 += p0[r + 3] + p1[r + 3]; }
  float ps = (ps0 + ps1) + (ps2 + ps3);
  { auto rr = __builtin_amdgcn_permlane32_swap(__float_as_uint(ps), __float_as_uint(ps), false, false);
    ps = __uint_as_float(rr[0]) + __uint_as_float(rr[1]); }
  l_reg += ps;
#define PK4(P, BASE, OUT) do { unsigned a0 = cvtpk(P[BASE + 0], P[BASE + 1]), a1 = cvtpk(P[BASE + 2], P[BASE + 3]);   \
    unsigned b0 = cvtpk(P[BASE + 4], P[BASE + 5]), b1 = cvtpk(P[BASE + 6], P[BASE + 7]);                              \
    auto r0 = __builtin_amdgcn_permlane32_swap(a0, b0, false, false); auto r1 = __builtin_amdgcn_permlane32_swap(a1, b1, false, false); \
    u32x4 w = {r0[0], r1[0], r0[1], r1[1]}; OUT = *reinterpret_cast<bf16x8*>(&w); } while (0)
  PK4(p0, 0, pa0); PK4(p0, 8, pa1); PK4(p1, 0, pa2); PK4(p1, 8, pa3);
#undef PK4
}

__device__ __forceinline__ void attn_unit(const bf16_t* Qb, const bf16_t* Kh, const bf16_t* Vh, bf16_t* Ob, float lam, const float* subln, LAS unsigned char* lds, int wave_s) {
  int tid = wave_s * 64 + lane_id_now();
  const int wid = tid >> 6, lane = tid & 63, r32 = lane & 31, hi = lane >> 5, map = wid >> 2, qw = wid & 3;
  const bool lead = __builtin_amdgcn_readfirstlane(wid) < 4;
  constexpr int SLOT = SHM_K + SHM_V;
  LAS float* ws = (LAS float*)(lds + 3 * SLOT) + wid * 64; LAS float* li_l = ws; LAS float* al_l = ws + 32;
  float m_reg = 0.f, l_reg = 0; f32x16 o[4] = {}; bf16x8 qr[4];
  const bf16_t* Qw = Qb + (long)(qw * QBLK + r32) * LDQ + map * 64 + hi * 8;
#pragma unroll
  for (int d0 = 0; d0 < 4; ++d0) qr[d0] = *(const bf16x8*)(Qw + d0 * 16);
  const int sr = tid >> 4, sc = (tid & 15) * 8, vst0 = v_st(sr, sc), kst0 = KSWZ(sr, sc * 2);
  const int vrb = (int)(uintptr_t)lds + SHM_K + v_rd_base(lane);
  int kaddr[4];
#pragma unroll
  for (int d0 = 0; d0 < 4; ++d0) kaddr[d0] = (int)(uintptr_t)lds + r32 * 256 + map * 128 + ((hi * 16 + d0 * 32) ^ ((r32 & 7) << 4));
  bf16x8 vs0, vs1, ks0, ks1;
  const unsigned slo = (unsigned)((sr * LDK + sc) * 2);
#define SLOAD(k0) do { const char* vb_ = (const char*)Vh + (size_t)(k0) * LDK * 2; const char* kb_ = (const char*)Kh + (size_t)(k0) * LDK * 2; \
    vs0 = *(const bf16x8*)(vb_ + slo); vs1 = *(const bf16x8*)(vb_ + (size_t)32 * LDK * 2 + slo); ks0 = *(const bf16x8*)(kb_ + slo); ks1 = *(const bf16x8*)(kb_ + (size_t)32 * LDK * 2 + slo); } while (0)
#define SWRITE(slot) do { LAS unsigned char* sb_ = lds + (slot) * SLOT; *(LAS bf16x8*)(sb_ + SHM_K + vst0) = vs0; *(LAS bf16x8*)(sb_ + SHM_K + vst0 + 8192) = vs1; \
    *(LAS bf16x8*)(sb_ + kst0) = ks0; *(LAS bf16x8*)(sb_ + kst0 + 8192) = ks1; } while (0)
  constexpr int NT = SKV / KVBLK;
  f32x16 p0, p1; bf16x8 pa0, pa1, pa2, pa3;
  PROF_BEGIN(2)
  {
    const char* vb1_ = (const char*)Vh + (size_t)KVBLK * LDK * 2; const char* kb1_ = (const char*)Kh + (size_t)KVBLK * LDK * 2;
    SLOAD(0);
    const bf16x8 wv0 = *(const bf16x8*)(vb1_ + slo), wv1 = *(const bf16x8*)(vb1_ + (size_t)32 * LDK * 2 + slo), wk0 = *(const bf16x8*)(kb1_ + slo), wk1 = *(const bf16x8*)(kb1_ + (size_t)32 * LDK * 2 + slo);
    SWRITE(0);
    vs0 = wv0; vs1 = wv1; ks0 = wk0; ks1 = wk1; SWRITE(1); }
  if (ATT_STAGE_IN_M < 2) SLOAD(2 * KVBLK);
  __syncthreads();
  PROF_END(2, lds)
  if (ATT_PRIO == 3 && !lead) __builtin_amdgcn_s_setprio(1);
  if (!lead) __syncthreads();
  pa0 = pa1 = pa2 = pa3 = bf16x8{};
  m_phase<true, false>(p0, p1, o, qr, kaddr, 0, vrb, pa0, pa1, pa2, pa3, 0.f);
  __syncthreads();
  int s_cur = 0, s_nxt = 1, s_nn = 2;
  for (int t = 0; t < NT; ++t) {
    PROF_BEGIN(3)
    if (ATT_STAGE_IN_M == 3) { if (t + 2 < NT) SLOAD((t + 2) * KVBLK); asm volatile("" ::: "memory"); }
    { PROF_BEGIN(7)
    if (ATT_PRIO == 2) __builtin_amdgcn_s_setprio(1);
    softmax_tile(t == 0, p0, p1, m_reg, l_reg, o, al_l, r32, hi, pa0, pa1, pa2, pa3);
    asm volatile("" :: "v"(pa0), "v"(pa1), "v"(pa2), "v"(pa3), "v"(l_reg));
    if (ATT_PRIO == 2) __builtin_amdgcn_s_setprio(0);
    PROF_END(7, lds) }
    PROF_BEGIN(8)
    if (!ATT_STAGE_IN_M) {
      if (lead) { if (t >= 1 && t + 1 < NT) { SWRITE(s_nxt); if (t + 2 < NT) SLOAD((t + 2) * KVBLK); } }
      else      { if (t + 2 < NT) { SWRITE(s_nn); if (t + 3 < NT) SLOAD((t + 3) * KVBLK); } }
    } else if (ATT_STAGE_IN_M == 2) { if (t + 2 < NT) SLOAD((t + 2) * KVBLK); }
    asm volatile("s_waitcnt lgkmcnt(0)" ::: "memory");
    PROF_END(8, lds)
    PROF_END(3, lds)
    s16x4 fa0, fa1, fa2, fa3, fa4, fa5, fa6, fa7;
    if (ATT_PV_FIRST) VTR8(0, fa0, fa1, fa2, fa3, fa4, fa5, fa6, fa7, vrb + s_cur * SLOT);
    PROF_BEGIN(5)
    __syncthreads();
    PROF_END(5, lds)
    PROF_BEGIN(4)
    if (ATT_STAGE_IN_M == 3) { if (t + 2 < NT) SWRITE(s_nn); asm volatile("" ::: "memory"); }
    if (ATT_PV_FIRST) {
      if (t + 1 < NT) m_phase_pvfirst<true>(p0, p1, o, qr, kaddr, s_nxt * SLOT, vrb + s_cur * SLOT, pa0, pa1, pa2, pa3, -m_reg, fa0, fa1, fa2, fa3, fa4, fa5, fa6, fa7);
      else m_phase_pvfirst<false>(p0, p1, o, qr, kaddr, 0, vrb + s_cur * SLOT, pa0, pa1, pa2, pa3, 0.f, fa0, fa1, fa2, fa3, fa4, fa5, fa6, fa7);
    } else {
      if (t + 1 < NT) m_phase<true, true>(p0, p1, o, qr, kaddr, s_nxt * SLOT, vrb + s_cur * SLOT, pa0, pa1, pa2, pa3, -m_reg);
      else m_phase<false, true>(p0, p1, o, qr, kaddr, 0, vrb + s_cur * SLOT, pa0, pa1, pa2, pa3, 0.f);
    }
    if (ATT_STAGE_IN_M == 1 || ATT_STAGE_IN_M == 2) { __builtin_amdgcn_sched_barrier(0); asm volatile("" ::: "memory"); if (t + 2 < NT) { SWRITE(s_nn); if (ATT_STAGE_IN_M == 1 && t + 3 < NT) SLOAD((t + 3) * KVBLK); } asm volatile("s_waitcnt lgkmcnt(0)" ::: "memory"); __builtin_amdgcn_sched_barrier(0); }
    asm volatile("s_nop 0" :: "v"(o[0]), "v"(o[1]), "v"(o[2]), "v"(o[3]), "v"(p0), "v"(p1));
    PROF_END(4, lds)
    { PROF_BEGIN(5)
    __syncthreads();
    PROF_END(5, lds) }
    { const int x = s_cur; s_cur = s_nxt; s_nxt = s_nn; s_nn = x; }
  }
  if (ATT_PRIO == 3 && !lead) __builtin_amdgcn_s_setprio(0);
  if (lead) __syncthreads();
  PROF_BEGIN(6)
  const float rl = __builtin_amdgcn_rcpf(l_reg);
  __syncthreads();
  LAS float* X = (LAS float*)lds + qw * 4096 + lane;
  if (map == 1) {
#pragma unroll
    for (int d0 = 0; d0 < 4; ++d0)
#pragma unroll
      for (int r = 0; r < 16; ++r) X[(d0 * 16 + r) * 64] = o[d0][r] * rl;
  }
  __syncthreads();
  if (map == 0) {
    float s0 = 0.f, s1 = 0.f, s2 = 0.f, s3 = 0.f;
#pragma unroll
    for (int d0 = 0; d0 < 4; ++d0)
#pragma unroll
      for (int r = 0; r < 16; r += 4) {
        const float e0 = o[d0][r] * rl - lam * X[(d0 * 16 + r) * 64], e1 = o[d0][r + 1] * rl - lam * X[(d0 * 16 + r + 1) * 64], e2 = o[d0][r + 2] * rl - lam * X[(d0 * 16 + r + 2) * 64], e3 = o[d0][r + 3] * rl - lam * X[(d0 * 16 + r + 3) * 64];
        o[d0][r] = e0; o[d0][r + 1] = e1; o[d0][r + 2] = e2; o[d0][r + 3] = e3; s0 += e0 * e0; s1 += e1 * e1; s2 += e2 * e2; s3 += e3 * e3; }
    float ssum = (s0 + s1) + (s2 + s3);
    { auto rr = __builtin_amdgcn_permlane32_swap(__float_as_uint(ssum), __float_as_uint(ssum), false, false); ssum = __uint_as_float(rr[0]) + __uint_as_float(rr[1]); }
    const float sc = __builtin_amdgcn_rsqf(ssum * (1.0f / 128.0f) + NORM_EPS) * 0.8f;
    bf16_t* orow = Ob + (long)(qw * QBLK + r32) * 1024 + hi * 8;
#pragma unroll
    for (int d0 = 0; d0 < 4; ++d0)
#pragma unroll
      for (int pr = 0; pr < 2; ++pr) {
        const f32x4 g0 = *(const f32x4*)(subln + 32 * d0 + 16 * pr + 4 * hi), g1 = *(const f32x4*)(subln + 32 * d0 + 16 * pr + 8 + 4 * hi);
        const int ra = 8 * pr, rb = 8 * pr + 4;
        unsigned ax = cvtpk(o[d0][ra] * sc * g0[0], o[d0][ra + 1] * sc * g0[1]), ay = cvtpk(o[d0][ra + 2] * sc * g0[2], o[d0][ra + 3] * sc * g0[3]);
        unsigned bx = cvtpk(o[d0][rb] * sc * g1[0], o[d0][rb + 1] * sc * g1[1]), by = cvtpk(o[d0][rb + 2] * sc * g1[2], o[d0][rb + 3] * sc * g1[3]);
        { auto rx = __builtin_amdgcn_permlane32_swap(ax, bx, false, false); ax = rx[0]; bx = rx[1]; auto ry = __builtin_amdgcn_permlane32_swap(ay, by, false, false); ay = ry[0]; by = ry[1]; }
        u32x4 w = {ax, ay, bx, by};
        *(u32x4*)(orow + 32 * d0 + 16 * pr) = w; }
  }
  __syncthreads();
  PROF_END(6, lds)
#undef SLOAD
#undef SWRITE
}
}

constexpr int NWAVES = 8;
#ifndef MK_PER_PHASE
#define MK_PER_PHASE 0
#endif
constexpr int N_PHASES = 18;
#ifndef REPMASK
#define REPMASK 0
#endif
#ifndef SUBREP
#define SUBREP 0
#endif
#ifndef GEMM_SKEW
#define GEMM_SKEW 0
#endif
#ifndef GEMM_ALIGN
#define GEMM_ALIGN true
#endif
#ifndef GEMM_ALIGN_GU
#define GEMM_ALIGN_GU GEMM_ALIGN
#endif
#ifndef GEMM_ALIGN_DN
#define GEMM_ALIGN_DN GEMM_ALIGN
#endif
#ifndef CVT_CLASS
#define CVT_CLASS(v) (((v) >> 4) & 3)
#endif
#ifndef MOE_CVT_IN_ATTN
#define MOE_CVT_IN_ATTN 1
#endif
#ifndef PHMASK_FULL
#define PHMASK_FULL 0x3ffff
#endif
#ifndef PHMASK
#define PHMASK 0xfff
#endif

constexpr size_t MiB = 1u << 20;
constexpr size_t WS_CTL = 0, CTL_ZERO_BYTES = 128 * 1024;
constexpr size_t WS_MODP = 1 * MiB;
constexpr size_t WS_MOD = 8 * MiB;
constexpr size_t WS_PROBS = 9 * MiB;
constexpr size_t WS_SLOT = 11 * MiB;
constexpr size_t WS_VALS = 13 * MiB;
constexpr size_t WS_SSQ = 14 * MiB;
constexpr size_t WS_IDX = 13 * MiB + 512 * 1024;
constexpr size_t WS_GPK = 126 * MiB;
constexpr size_t WS_WIN0 = 16 * MiB;
constexpr size_t WS_WIN1 = 22 * MiB;
constexpr size_t WS_WOUT = 26 * MiB;
constexpr size_t WS_WGU = 30 * MiB;
constexpr size_t WS_WD = 158 * MiB;
constexpr size_t WS_H = 222 * MiB;
constexpr size_t WS_HC = 286 * MiB;
constexpr size_t WS_R = 294 * MiB;
constexpr size_t WS_Q = WS_R, WS_K = WS_R + 32 * MiB, WS_V = WS_R + 68 * MiB, WS_GB = WS_R + 104 * MiB, WS_Z = WS_R + 136 * MiB, WS_MIX = WS_R + 168 * MiB;
constexpr size_t WS_XG = WS_R, WS_ACT = WS_R + 128 * MiB, WS_Y = WS_R;
constexpr size_t WS_U = WS_R, WS_VV = WS_R + 64 * MiB, WS_MIX1 = WS_R + 128 * MiB;
constexpr size_t WS_X2 = WS_R + 192 * MiB;
constexpr size_t WS_X3 = WS_WGU;
constexpr size_t WS_END = WS_R + 256 * MiB;
constexpr int CW_BAR = 4096, CW_GRP = 16384;

constexpr int RING_BYTES = 131072, LDSCTL_OFF = RING_BYTES, MISC_OFF = LDSCTL_OFF + 320, LDS_BYTES = 147456;

typedef GAS unsigned gu32;
#define RLX_AGENT __ATOMIC_RELAXED, __HIP_MEMORY_SCOPE_AGENT
#define LDS_WAIT() asm volatile("s_waitcnt lgkmcnt(0)" ::: "memory")
#define VM_WAIT() asm volatile("s_waitcnt vmcnt(0)" ::: "memory")

#define XB_TMO      128
#define XB_XCNT(j)  (256  + 64 * (j))
#define XB_XSUB(j)  (1280 + 64 * (j))
#define XB_XGEN(j)  (2304 + 64 * (j))
#define XB_TOP      3328
#define XB_TOPGEN   3392
#define XCD_BAR_WORDS 3456
#define XB_SPIN_CAP (1u << 20)
__device__ __forceinline__ unsigned xb_ld(unsigned* p)              { return __hip_atomic_load(p, __ATOMIC_RELAXED, __HIP_MEMORY_SCOPE_AGENT); }
__device__ __forceinline__ unsigned xb_add(unsigned* p, unsigned v) { return __hip_atomic_fetch_add(p, v, __ATOMIC_RELAXED, __HIP_MEMORY_SCOPE_AGENT); }
__device__ __forceinline__ unsigned xb_xcc_id() { return (unsigned)__builtin_amdgcn_s_getreg((3 << 11) | 20) & 0xFu; }
#define XB_SPIN(cond, bar) do { unsigned _sp = 0; while (cond) { __builtin_amdgcn_s_sleep(1); \
    if ((++_sp & 255u) == 0u) { if (xb_ld(&(bar)[XB_TMO])) break; if (_sp > XB_SPIN_CAP) { atomicAdd(&(bar)[XB_TMO], 1u); break; } } } } while (0)
struct XcdBarrier { unsigned* bar; unsigned x; volatile LAS unsigned* st; int w; };
__device__ __forceinline__ XcdBarrier xcd_barrier_post(unsigned* bar, volatile LAS unsigned* st, int wave_s) {
    XcdBarrier b; b.bar = bar; b.x = xb_xcc_id(); b.st = st; b.w = wave_s;
    if (wave_s == 0 && lane_id_now() == 0) (void)xb_add(&bar[XB_XCNT(b.x)], 1u);
    return b;
}
__device__ __forceinline__ void xcd_barrier_complete(unsigned* bar, unsigned x, unsigned& nloc, unsigned& nx) {
    const unsigned G = gridDim.x * gridDim.y * gridDim.z;
    unsigned sum, cnt, mine, sp = 0u;
    for (;;) {
        sum = 0u; cnt = 0u; mine = 0u;
#pragma unroll
        for (unsigned j = 0; j < 16; ++j) { const unsigned c = xb_ld(&bar[XB_XCNT(j)]); sum += c; cnt += (c > 0u) ? 1u : 0u; mine = (j == x) ? c : mine; }
        if (sum == G) break;
        __builtin_amdgcn_s_sleep(1);
        if ((++sp & 255u) == 0u) { if (xb_ld(&bar[XB_TMO])) break; if (sp > XB_SPIN_CAP) { atomicAdd(&bar[XB_TMO], 1u); break; } }
    }
    nloc = mine > 0u ? mine : 1u; nx = cnt > 0u ? cnt : 1u;
}
__device__ __forceinline__ void xcd_barrier(const XcdBarrier& b) {
    asm volatile("s_waitcnt vmcnt(0)" ::: "memory");
    __syncthreads();
    if (b.w == 0 && lane_id_now() == 0) {
        unsigned* bar = b.bar;
        __builtin_amdgcn_s_waitcnt(0);
        unsigned nloc = b.st[0], nx = b.st[1];
        if (nloc == 0u) { xcd_barrier_complete(bar, b.x, nloc, nx); b.st[0] = nloc; b.st[1] = nx; }
        const unsigned old = xb_add(&bar[XB_XSUB(b.x)], 1u);
        const unsigned gen = old / nloc;
        if (old + 1u == (gen + 1u) * nloc) {
            __builtin_amdgcn_fence(__ATOMIC_RELEASE, "agent");
            asm volatile("s_waitcnt vmcnt(0)" ::: "memory");
            const unsigned og = xb_add(&bar[XB_TOP], 1u);
            const unsigned tg = og / nx;
            if (og + 1u == (tg + 1u) * nx) xb_add(&bar[XB_TOPGEN], 1u);
            else XB_SPIN(xb_ld(&bar[XB_TOPGEN]) == tg, bar);
            __builtin_amdgcn_fence(__ATOMIC_ACQUIRE, "agent");
            xb_add(&bar[XB_XGEN(b.x)], 1u);
            asm volatile("s_waitcnt vmcnt(0)" ::: "memory");
        } else {
            XB_SPIN(xb_ld(&bar[XB_XGEN(b.x)]) == gen, bar);
            __builtin_amdgcn_fence(__ATOMIC_ACQUIRE, "agent");
            asm volatile("s_waitcnt vmcnt(0)" ::: "memory");
        }
    }
    __syncthreads();
}

__device__ __forceinline__ void group_barrier(unsigned* gw, int use, int wave_s) {
    asm volatile("s_waitcnt vmcnt(0)" ::: "memory");
    __syncthreads();
    if (wave_s == 0 && lane_id_now() == 0) {
        const unsigned x = xb_xcc_id(), nloc = xb_ld(&gw[x]);
        const unsigned old = xb_add(&gw[64 + 32 * use + x], 1u);
        if (old + 1u == nloc) {
            __builtin_amdgcn_fence(__ATOMIC_RELEASE, "agent");
            asm volatile("s_waitcnt vmcnt(0)" ::: "memory");
            (void)xb_add(&gw[32 + 16 * use], nloc);
        }
        unsigned sp = 0u;
        while (xb_ld(&gw[32 + 16 * use]) < 16u) { __builtin_amdgcn_s_sleep(1); if (++sp > XB_SPIN_CAP) break; }
        __builtin_amdgcn_fence(__ATOMIC_ACQUIRE, "agent");
        asm volatile("s_waitcnt vmcnt(0)" ::: "memory");
    }
    __syncthreads();
}

__device__ const float ROPE_TAB[64 * 32] = {
1.000000000e+00f, 1.000000000e+00f, 1.000000000e+00f, 1.000000000e+00f, 1.000000000e+00f, 1.000000000e+00f, 1.000000000e+00f, 1.000000000e+00f, 1.000000000e+00f, 1.000000000e+00f, 1.000000000e+00f, 1.000000000e+00f, 1.000000000e+00f, 1.000000000e+00f, 1.000000000e+00f, 1.000000000e+00f, 0.000000000e+00f, 0.000000000e+00f, 0.000000000e+00f, 0.000000000e+00f, 0.000000000e+00f, 0.000000000e+00f, 0.000000000e+00f, 0.000000000e+00f, 0.000000000e+00f, 0.000000000e+00f, 0.000000000e+00f, 0.000000000e+00f, 0.000000000e+00f, 0.000000000e+00f, 0.000000000e+00f, 0.000000000e+00f,
5.403023059e-01f, 8.460091103e-01f, 9.504152803e-01f, 9.842302345e-01f, 9.950041653e-01f, 9.984192778e-01f, 9.995000417e-01f, 9.998418903e-01f, 9.999500004e-01f, 9.999841887e-01f, 9.999950000e-01f, 9.999984189e-01f, 9.999995000e-01f, 9.999998419e-01f, 9.999999500e-01f, 9.999999842e-01f, 8.414709848e-01f, 5.331684399e-01f, 3.109835929e-01f, 1.768921862e-01f, 9.983341665e-02f, 5.620449921e-02f, 3.161750640e-02f, 1.778185688e-02f, 9.999833334e-03f, 5.623383614e-03f, 3.162272390e-03f, 1.778278473e-03f, 9.999998333e-04f, 5.623412956e-04f, 3.162277607e-04f, 1.778279401e-04f,
-4.161468365e-01f, 4.314628294e-01f, 8.065784099e-01f, 9.374183089e-01f, 9.800665778e-01f, 9.936821085e-01f, 9.980006666e-01f, 9.993676111e-01f, 9.998000067e-01f, 9.999367551e-01f, 9.999800001e-01f, 9.999936755e-01f, 9.999980000e-01f, 9.999993675e-01f, 9.999998000e-01f, 9.999999368e-01f, 9.092974268e-01f, 9.021307150e-01f, 5.911271172e-01f, 3.482052759e-01f, 1.986693308e-01f, 1.122313110e-01f, 6.320339793e-02f, 3.555809079e-02f, 1.999866669e-02f, 1.124658940e-02f, 6.324513157e-03f, 3.556551322e-03f, 1.999998667e-03f, 1.124682413e-03f, 6.324554899e-04f, 3.556558745e-04f,
-9.899924966e-01f, -1.159661415e-01f, 5.827536107e-01f, 8.610406494e-01f, 9.553364891e-01f, 9.858034685e-01f, 9.955033740e-01f, 9.985773125e-01f, 9.995500337e-01f, 9.998577009e-01f, 9.999550003e-01f, 9.999857698e-01f, 9.999955000e-01f, 9.999985770e-01f, 9.999995500e-01f, 9.999998577e-01f, 1.411200081e-01f, 9.932531671e-01f, 8.126488966e-01f, 5.085361344e-01f, 2.955202067e-01f, 1.679033098e-01f, 9.472609133e-02f, 5.332308054e-02f, 2.999550020e-02f, 1.686943954e-02f, 9.486690679e-03f, 5.334812925e-03f, 2.999995500e-03f, 1.687023175e-03f, 9.486831557e-04f, 5.334837977e-04f,
-6.536436209e-01f, -6.276796538e-01f, 3.011374626e-01f, 7.575061717e-01f, 9.210609940e-01f, 9.748082656e-01f, 9.920106610e-01f, 9.974712444e-01f, 9.992001067e-01f, 9.997470285e-01f, 9.999200011e-01f, 9.999747019e-01f, 9.999920000e-01f, 9.999974702e-01f, 9.999992000e-01f, 9.999997470e-01f, -7.568024953e-01f, 7.784717415e-01f, 9.535807405e-01f, 6.528280017e-01f, 3.894183423e-01f, 2.230444916e-01f, 1.261540665e-01f, 7.107120850e-02f, 3.998933419e-02f, 2.249175622e-02f, 1.264877333e-02f, 7.113057657e-03f, 3.999989333e-03f, 2.249363404e-03f, 1.264910727e-03f, 7.113117040e-04f,
2.836621855e-01f, -9.460792693e-01f, -1.034231891e-02f, 6.300803045e-01f, 8.775825619e-01f, 9.607312606e-01f, 9.875260200e-01f, 9.960497564e-01f, 9.987502604e-01f, 9.996047413e-01f, 9.998750026e-01f, 9.999604718e-01f, 9.999875000e-01f, 9.999960472e-01f, 9.999987500e-01f, 9.999996047e-01f, -9.589242747e-01f, 3.239352036e-01f, 9.999465168e-01f, 7.765299800e-01f, 4.794255386e-01f, 2.774805306e-01f, 1.574558982e-01f, 8.879686236e-02f, 4.997916927e-02f, 2.811336166e-02f, 1.581072950e-02f, 8.891279896e-03f, 4.999979167e-03f, 2.811702921e-03f, 1.581138171e-03f, 8.891395879e-04f,
9.601702867e-01f, -9.731037080e-01f, -3.207964584e-01f, 4.827820000e-01f, 8.253356149e-01f, 9.436169571e-01f, 9.820539352e-01f, 9.943132982e-01f, 9.982005399e-01f, 9.994308440e-01f, 9.998200054e-01f, 9.999430795e-01f, 9.999820001e-01f, 9.999943079e-01f, 9.999982000e-01f, 9.999994308e-01f, -2.794154982e-01f, -2.303674747e-01f, 9.471481575e-01f, 8.757405669e-01f, 5.646424734e-01f, 3.310393303e-01f, 1.886002871e-01f, 1.064944369e-01f, 5.996400648e-02f, 3.373407807e-02f, 1.897252756e-02f, 1.066947402e-02f, 5.999964000e-03f, 3.374041549e-03f, 1.897365458e-03f, 1.066967444e-03f,
7.539022543e-01f, -7.004299352e-01f, -5.994373930e-01f, 3.202569776e-01f, 7.648421873e-01f, 9.235194611e-01f, 9.755998784e-01f, 9.922624187e-01f, 9.975510003e-01f, 9.992253420e-01f, 9.997550100e-01f, 9.999225252e-01f, 9.999755001e-01f, 9.999922524e-01f, 9.999975500e-01f, 9.999992252e-01f, 6.569865987e-01f, -7.137211682e-01f, 8.004216463e-01f, 9.473307069e-01f, 6.442176872e-01f, 3.835515676e-01f, 2.195560914e-01f, 1.241583359e-01f, 6.994284734e-02f, 3.935372772e-02f, 2.213413590e-02f, 1.244763440e-02f, 6.999942833e-03f, 3.936379111e-03f, 2.213592554e-03f, 1.244795266e-03f,
-1.455000338e-01f, -2.120365045e-01f, -8.186324573e-01f, 1.476312003e-01f, 6.967067093e-01f, 9.005023096e-01f, 9.681703030e-01f, 9.898977666e-01f, 9.968017063e-01f, 9.989882418e-01f, 9.996800171e-01f, 9.998988088e-01f, 9.999680002e-01f, 9.999898807e-01f, 9.999968000e-01f, 9.999989881e-01f, 9.893582466e-01f, -9.772617463e-01f, 5.743177691e-01f, 9.890424807e-01f, 7.173560909e-01f, 4.348512280e-01f, 2.502923579e-01f, 1.417829736e-01f, 7.991469397e-02f, 4.497213290e-02f, 2.529552289e-02f, 1.422575542e-02f, 7.999914667e-03f, 4.498715427e-03f, 2.529819430e-03f, 1.422623048e-03f,
-9.111302619e-01f, 3.416603061e-01f, -9.566441996e-01f, -2.965079584e-02f, 6.216099683e-01f, 8.746382701e-01f, 9.597726380e-01f, 9.872200896e-01f, 9.959527330e-01f, 9.987195509e-01f, 9.995950273e-01f, 9.998719305e-01f, 9.999595003e-01f, 9.999871928e-01f, 9.999959500e-01f, 9.999987193e-01f, 4.121184852e-01f, -9.398235128e-01f, 2.912591207e-01f, 9.995603185e-01f, 7.833269096e-01f, 4.847761303e-01f, 2.807783529e-01f, 1.593627767e-01f, 8.987854920e-02f, 5.058911594e-02f, 2.845665693e-02f, 1.600383145e-02f, 8.999878500e-03f, 5.061050321e-03f, 2.846046052e-03f, 1.600450786e-03f,
-8.390715291e-01f, 7.901319677e-01f, -9.997860729e-01f, -2.059976198e-01f, 5.403023059e-01f, 8.460091103e-01f, 9.504152803e-01f, 9.842302345e-01f, 9.950041653e-01f, 9.984192778e-01f, 9.995000417e-01f, 9.998418903e-01f, 9.999500004e-01f, 9.999841887e-01f, 9.999950000e-01f, 9.999984189e-01f, -5.440211109e-01f, -6.129367615e-01f, -2.068353153e-02f, 9.785524925e-01f, 8.414709848e-01f, 5.331684399e-01f, 3.109835929e-01f, 1.768921862e-01f, 9.983341665e-02f, 5.620449921e-02f, 3.161750640e-02f, 1.778185688e-02f, 9.999833334e-03f, 5.623383614e-03f, 3.162272390e-03f, 1.778278473e-03f,
4.425697988e-03f, 9.952573799e-01f, -9.437797217e-01f, -3.758473754e-01f, 4.535961214e-01f, 8.147053397e-01f, 9.401075865e-01f, 9.809291466e-01f, 9.939560980e-01f, 9.980874320e-01f, 9.993950610e-01f, 9.998086883e-01f, 9.999395006e-01f, 9.999808683e-01f, 9.999939500e-01f, 9.999980868e-01f, -9.999902066e-01f, -9.727665569e-02f, -3.305750095e-01f, 9.266815798e-01f, 8.912073601e-01f, 5.798751671e-01f, 3.408778753e-01f, 1.943656590e-01f, 1.097783008e-01f, 6.181810515e-02f, 3.477803970e-02f, 1.955982607e-02f, 1.099977817e-02f, 6.185715129e-03f, 3.478498411e-03f, 1.956106104e-03f,
8.438539587e-01f, 8.938616532e-01f, -7.941792645e-01f, -5.338430810e-01f, 3.623577545e-01f, 7.808259235e-01f, 9.288598634e-01f, 9.773178698e-01f, 9.928086359e-01f, 9.977240240e-01f, 9.992800864e-01f, 9.997723246e-01f, 9.999280009e-01f, 9.999772317e-01f, 9.999928000e-01f, 9.999977232e-01f, -5.365729180e-01f, 4.483428876e-01f, -6.076835491e-01f, 8.455835647e-01f, 9.320390860e-01f, 6.247486512e-01f, 3.704313082e-01f, 2.117776696e-01f, 1.197122073e-01f, 6.742975624e-02f, 3.793822522e-02f, 2.133773341e-02f, 1.199971200e-02f, 6.748044688e-03f, 3.794724085e-03f, 2.133933673e-03f,
9.074467815e-01f, 5.171728240e-01f, -5.658204948e-01f, -6.750016262e-01f, 2.674988286e-01f, 7.444779696e-01f, 9.166833580e-01f, 9.733975461e-01f, 9.915618937e-01f, 9.973290652e-01f, 9.991551190e-01f, 9.997327994e-01f, 9.999155012e-01f, 9.999732789e-01f, 9.999915500e-01f, 9.999973279e-01f, 4.201670368e-01f, 8.558809906e-01f, -8.245284517e-01f, 7.378162404e-01f, 9.635581854e-01f, 6.676470271e-01f, 3.996143406e-01f, 2.291227120e-01f, 1.296341426e-01f, 7.303927501e-02f, 4.109803135e-02f, 2.311557328e-02f, 1.299963384e-02f, 7.310372113e-03f, 4.110949379e-03f, 2.311761174e-03f,
1.367372182e-01f, -1.879581181e-02f, -2.813496238e-01f, -7.948709366e-01f, 1.699671429e-01f, 7.057763899e-01f, 9.035902455e-01f, 9.691694153e-01f, 9.902159962e-01f, 9.969025682e-01f, 9.990201601e-01f, 9.996901128e-01f, 9.999020016e-01f, 9.999690098e-01f, 9.999902000e-01f, 9.999969010e-01f, 9.906073557e-01f, 9.998233431e-01f, -9.596053299e-01f, 6.067785379e-01f, 9.854497300e-01f, 7.084346741e-01f, 4.283977921e-01f, 2.463953013e-01f, 1.395431146e-01f, 7.864648408e-02f, 4.425742651e-02f, 2.489334005e-02f, 1.399954267e-02f, 7.872697226e-03f, 4.427174262e-03f, 2.489588602e-03f,
-7.596879129e-01f, -5.489756801e-01f, 3.102253171e-02f, -8.896703905e-01f, 7.073720167e-02f, 6.648435374e-01f, 8.895936181e-01f, 9.646348142e-01f, 9.887710779e-01f, 9.964445465e-01f, 9.988752109e-01f, 9.996442649e-01f, 9.998875021e-01f, 9.999644246e-01f, 9.999887500e-01f, 9.999964424e-01f, 6.502878402e-01f, 8.358383233e-01f, -9.995186854e-01f, 4.566033249e-01f, 9.974949866e-01f, 7.469826442e-01f, 4.567528814e-01f, 2.635899757e-01f, 1.494381325e-01f, 8.425120614e-02f, 4.741637909e-02f, 2.667102809e-02f, 1.499943751e-02f, 8.435019850e-03f, 4.743398702e-03f, 2.667415952e-03f,
-9.576594803e-01f, -9.100810415e-01f, 3.403182001e-01f, -9.564100574e-01f, -2.919952230e-02f, 6.218088190e-01f, 8.747074712e-01f, 9.597951768e-01f, 9.872272834e-01f, 9.959550145e-01f, 9.987202730e-01f, 9.995952558e-01f, 9.998720027e-01f, 9.999595231e-01f, 9.999872000e-01f, 9.999959523e-01f, -2.879033167e-01f, 4.144303293e-01f, -9.403103332e-01f, 2.920270571e-01f, 9.995736030e-01f, 7.831690702e-01f, 4.846512559e-01f, 2.807012978e-01f, 1.593182066e-01f, 8.985326395e-02f, 5.057485751e-02f, 2.844863180e-02f, 1.599931734e-02f, 8.997339806e-03f, 5.059622668e-03f, 2.845243217e-03f,
-2.751633381e-01f, -9.908980244e-01f, 6.158647034e-01f, -9.929849996e-01f, -1.288444943e-01f, 5.768082866e-01f, 8.589466897e-01f, 9.546520336e-01f, 9.855847669e-01f, 9.954339878e-01f, 9.985553480e-01f, 9.995430857e-01f, 9.998555035e-01f, 9.999543054e-01f, 9.999855500e-01f, 9.999954305e-01f, -9.613974919e-01f, -1.346146549e-01f, -7.878519322e-01f, 1.182403929e-01f, 9.916648105e-01f, 8.168795508e-01f, 5.120650195e-01f, 2.977238566e-01f, 1.691823491e-01f, 9.545248036e-02f, 5.373283018e-02f, 3.022614554e-02f, 1.699918118e-02f, 9.559656917e-03f, 5.375846129e-03f, 3.023070392e-03f,
6.603167082e-01f, -7.665364704e-01f, 8.303362493e-01f, -9.982416606e-01f, -2.272020947e-01f, 5.299842069e-01f, 8.423270331e-01f, 9.492070108e-01f, 9.838436928e-01f, 9.948814827e-01f, 9.983804374e-01f, 9.994877548e-01f, 9.998380044e-01f, 9.999487715e-01f, 9.999838000e-01f, 9.999948771e-01f, -7.509872468e-01f, -6.422007782e-01f, -5.572626967e-01f, -5.927551787e-02f, 9.738476309e-01f, 8.480075120e-01f, 5.389667608e-01f, 3.146522694e-01f, 1.790295734e-01f, 1.010486783e-01f, 5.689026552e-02f, 3.200356370e-02f, 1.799902802e-02f, 1.012197101e-02f, 5.692069051e-03f, 3.200897472e-03f,
9.887046182e-01f, -3.060956503e-01f, 9.624638147e-01f, -9.720142477e-01f, -3.232895669e-01f, 4.814846115e-01f, 8.248651197e-01f, 9.434618303e-01f, 9.820042351e-01f, 9.942975168e-01f, 9.981955429e-01f, 9.994292632e-01f, 9.998195054e-01f, 9.999429214e-01f, 9.999819501e-01f, 9.999942921e-01f, 1.498772097e-01f, -9.520007631e-01f, -2.714100320e-01f, -2.349219066e-01f, 9.463000877e-01f, 8.764545447e-01f, 5.653295802e-01f, 3.314811830e-01f, 1.888588950e-01f, 1.066416808e-01f, 6.004713196e-02f, 3.378088066e-02f, 1.899885685e-02f, 1.068428189e-02f, 6.008291404e-03f, 3.378724451e-03f,
4.080820618e-01f, 2.486170528e-01f, 9.991443830e-01f, -9.151299613e-01f, -4.161468365e-01f, 4.314628294e-01f, 8.065784099e-01f, 9.374183089e-01f, 9.800665778e-01f, 9.936821085e-01f, 9.980006666e-01f, 9.993676111e-01f, 9.998000067e-01f, 9.999367551e-01f, 9.999800001e-01f, 9.999936755e-01f, 9.129452507e-01f, -9.686018589e-01f, 4.135821352e-02f, -4.031589686e-01f, 9.092974268e-01f, 9.021307150e-01f, 5.911271172e-01f, 3.482052759e-01f, 1.986693308e-01f, 1.122313110e-01f, 6.320339793e-02f, 3.555809079e-02f, 1.999866669e-02f, 1.124658940e-02f, 6.324513157e-03f, 3.556551322e-03f,
-5.477292602e-01f, 7.267602337e-01f, 9.367403630e-01f, -8.293829050e-01f, -5.048461046e-01f, 3.800770014e-01f, 7.874851889e-01f, 9.310783576e-01f, 9.780309147e-01f, 9.930352774e-01f, 9.977958102e-01f, 9.993027988e-01f, 9.997795081e-01f, 9.999302726e-01f, 9.999779501e-01f, 9.999930272e-01f, 8.366556385e-01f, -6.868912307e-01f, 3.500249882e-01f, -5.586805857e-01f, 8.632093666e-01f, 9.249548492e-01f, 6.163335763e-01f, 3.648192595e-01f, 2.084598998e-01f, 1.178173922e-01f, 6.635903187e-02f, 3.733518848e-02f, 2.099845653e-02f, 1.180889335e-02f, 6.640734277e-03f, 3.734378081e-03f,
-9.999608264e-01f, 9.810745045e-01f, 7.814403262e-01f, -7.174775009e-01f, -5.885011173e-01f, 3.274895812e-01f, 7.676045483e-01f, 9.244439812e-01f, 9.758974493e-01f, 9.923570438e-01f, 9.975809759e-01f, 9.992348264e-01f, 9.997580098e-01f, 9.999234739e-01f, 9.999758001e-01f, 9.999923473e-01f, -8.851309290e-03f, -1.936306189e-01f, 6.239799809e-01f, -6.965816792e-01f, 8.084964038e-01f, 9.448547900e-01f, 6.409237532e-01f, 3.813178801e-01f, 2.182296231e-01f, 1.233997476e-01f, 6.951400222e-02f, 3.911216810e-02f, 2.199822538e-02f, 1.237119357e-02f, 6.956954733e-03f, 3.912204722e-03f,
-5.328330203e-01f, 9.332357037e-01f, 5.486452902e-01f, -5.829431928e-01f, -6.662760213e-01f, 2.738668208e-01f, 7.469563671e-01f, 9.175172776e-01f, 9.736663950e-01f, 9.916474291e-01f, 9.973561658e-01f, 9.991636942e-01f, 9.997355117e-01f, 9.999163589e-01f, 9.999735501e-01f, 9.999916358e-01f, -8.462204042e-01f, 3.592646954e-01f, 8.360552287e-01f, -8.125129131e-01f, 7.457052122e-01f, 9.617676250e-01f, 6.648730598e-01f, 3.976959206e-01f, 2.279775235e-01f, 1.289782009e-01f, 7.266827742e-02f, 4.088902404e-02f, 2.299797222e-02f, 1.293348988e-02f, 7.273174493e-03f, 4.090031240e-03f,
4.241790073e-01f, 5.979773102e-01f, 2.614414084e-01f, -4.300231298e-01f, -7.373937155e-01f, 2.193782457e-01f, 7.255612918e-01f, 9.103004373e-01f, 9.713379749e-01f, 9.909064559e-01f, 9.971213821e-01f, 9.990894023e-01f, 9.997120138e-01f, 9.999089278e-01f, 9.999712001e-01f, 9.999908927e-01f, -9.055783620e-01f, 8.015130295e-01f, 9.652193481e-01f, -9.028178708e-01f, 6.754631806e-01f, 9.756398851e-01f, 6.881575487e-01f, 4.139482019e-01f, 2.377026264e-01f, 1.345525755e-01f, 7.582182595e-02f, 4.266575068e-02f, 2.399769607e-02f, 1.349578209e-02f, 7.589393526e-03f, 4.267857628e-03f,
9.912028119e-01f, 7.855280068e-02f, -5.168947139e-02f, -2.635403389e-01f, -8.011436155e-01f, 1.641961185e-01f, 7.034407157e-01f, 9.027957423e-01f, 9.689124217e-01f, 9.901341476e-01f, 9.968766273e-01f, 9.990119510e-01f, 9.996875163e-01f, 9.999011805e-01f, 9.999687502e-01f, 9.999901179e-01f, -1.323517501e-01f, 9.969099546e-01f, 9.986632058e-01f, -9.646483762e-01f, 5.984721441e-01f, 9.864277139e-01f, 7.107539373e-01f, 4.300695848e-01f, 2.474039593e-01f, 1.401226951e-01f, 7.897461625e-02f, 4.444234239e-02f, 2.499739591e-02f, 1.405807004e-02f, 7.905611800e-03f, 4.445683881e-03f,
6.469193223e-01f, -4.650645402e-01f, -3.596943353e-01f, -8.874560929e-02f, -8.568887534e-01f, 1.084948944e-01f, 6.806167575e-01f, 8.950055657e-01f, 9.663899781e-01f, 9.893305286e-01f, 9.966219036e-01f, 9.989313405e-01f, 9.996620190e-01f, 9.998931169e-01f, 9.999662002e-01f, 9.999893115e-01f, 7.625584505e-01f, 8.852767779e-01f, 9.330701931e-01f, -9.960543242e-01f, 5.155013718e-01f, 9.940970063e-01f, 7.326396313e-01f, 4.460549713e-01f, 2.570805519e-01f, 1.456883837e-01f, 8.212661682e-02f, 4.621879357e-02f, 2.599707077e-02f, 1.462035354e-02f, 8.221829283e-03f, 4.623509993e-03f,
-2.921388087e-01f, -8.654504764e-01f, -6.320285135e-01f, 8.884811520e-02f, -9.040721420e-01f, 5.245066969e-02f, 6.571122393e-01f, 8.869323709e-01f, 9.637708964e-01f, 9.884956243e-01f, 9.963572138e-01f, 9.988475712e-01f, 9.996355221e-01f, 9.998847372e-01f, 9.999635502e-01f, 9.999884735e-01f, 9.563759284e-01f, 5.009944839e-01f, 7.749451323e-01f, -9.960451859e-01f, 4.273798802e-01f, 9.986235163e-01f, 7.537927467e-01f, 4.618993065e-01f, 2.667314367e-01f, 1.512494653e-01f, 8.527779611e-02f, 4.799509859e-02f, 2.699671962e-02f, 1.518263242e-02f, 8.538045944e-03f, 4.801335960e-03f,
-9.626058663e-01f, -9.992934349e-01f, -8.416847784e-01f, 2.636396118e-01f, -9.422223407e-01f, -3.759374883e-03f, 6.329506635e-01f, 8.785787110e-01f, 9.610554383e-01f, 9.876294611e-01f, 9.960825604e-01f, 9.987606432e-01f, 9.996080256e-01f, 9.998760413e-01f, 9.999608003e-01f, 9.999876039e-01f, 2.709057883e-01f, -3.758498280e-02f, 5.399691971e-01f, -9.646212496e-01f, 3.349881502e-01f, 9.999929335e-01f, 7.741921322e-01f, 4.775975802e-01f, 2.763556486e-01f, 1.568057639e-01f, 8.842812263e-02f, 4.977125184e-02f, 2.799634148e-02f, 1.574490650e-02f, 8.854261752e-03f, 4.979161774e-03f,
-7.480575297e-01f, -8.253722231e-01f, -9.678716355e-01f, 4.301160387e-01f, -9.709581651e-01f, -5.995753440e-02f, 6.081561899e-01f, 8.699472273e-01f, 9.582438755e-01f, 9.867320664e-01f, 9.957979462e-01f, 9.986705569e-01f, 9.995795295e-01f, 9.998670292e-01f, 9.999579503e-01f, 9.999867027e-01f, -6.636338842e-01f, -5.645889596e-01f, 2.514448194e-01f, -9.027736113e-01f, 2.392493292e-01f, 9.982009287e-01f, 7.938173900e-01f, 4.931448283e-01f, 2.859522251e-01f, 1.623571039e-01f, 9.157756487e-02f, 5.154724769e-02f, 2.899593534e-02f, 1.630717560e-02f, 9.170476674e-03f, 5.156987431e-03f,
1.542514499e-01f, -3.972514054e-01f, -9.980752051e-01f, 5.830268074e-01f, -9.899924966e-01f, -1.159661415e-01f, 5.827536107e-01f, 8.610406494e-01f, 9.553364891e-01f, 9.858034685e-01f, 9.955033740e-01f, 9.985773125e-01f, 9.995500337e-01f, 9.998577009e-01f, 9.999550003e-01f, 9.999857698e-01f, -9.880316241e-01f, -9.177098239e-01f, -6.201520023e-02f, -8.124529167e-01f, 1.411200081e-01f, 9.932531671e-01f, 8.126488966e-01f, 5.085361344e-01f, 2.955202067e-01f, 1.679033098e-01f, 9.472609133e-02f, 5.332308054e-02f, 2.999550020e-02f, 1.686943954e-02f, 9.486690679e-03f, 5.334812925e-03f,
9.147423578e-01f, 1.532156071e-01f, -9.293002159e-01f, 7.175491840e-01f, -9.991351503e-01f, -1.716081281e-01f, 5.567683265e-01f, 8.518617938e-01f, 9.523335699e-01f, 9.848436969e-01f, 9.951988468e-01f, 9.984809103e-01f, 9.995195385e-01f, 9.998480564e-01f, 9.999519504e-01f, 9.999848053e-01f, -4.040376453e-01f, -9.881927837e-01f, -3.693252072e-01f, -6.965078381e-01f, 4.158066243e-02f, 9.851652909e-01f, 8.306678221e-01f, 5.237666315e-01f, 3.050586364e-01f, 1.734442061e-01f, 9.787367054e-02f, 5.509874477e-02f, 3.099503507e-02f, 1.743169815e-02f, 9.802903735e-03f, 5.512638250e-03f,
8.342233605e-01f, 6.564950042e-01f, -7.683670453e-01f, 8.294403958e-01f, -9.982947758e-01f, -2.267075851e-01f, 5.302263203e-01f, 8.424135629e-01f, 9.492354181e-01f, 9.838527819e-01f, 9.948843676e-01f, 9.983813507e-01f, 9.994880437e-01f, 9.998380958e-01f, 9.999488004e-01f, 9.999838092e-01f, 5.514266812e-01f, -7.543303715e-01f, -6.400094403e-01f, -5.585952289e-01f, -5.837414343e-02f, 9.739628693e-01f, 8.478561489e-01f, 5.388315034e-01f, 3.145665606e-01f, 1.789796176e-01f, 1.010202710e-01f, 5.687423476e-02f, 3.199453895e-02f, 1.799395124e-02f, 1.011911581e-02f, 5.690463401e-03f,
-1.327674722e-02f, 9.575859018e-01f, -5.312353455e-01f, 9.151714465e-01f, -9.874797699e-01f, -2.810903188e-01f, 5.031541321e-01f, 8.326989444e-01f, 9.460423435e-01f, 9.828307548e-01f, 9.945599395e-01f, 9.982786339e-01f, 9.994555494e-01f, 9.998278189e-01f, 9.999455505e-01f, 9.999827814e-01f, 9.999118601e-01f, -2.881479492e-01f, -8.472242960e-01f, -4.030647882e-01f, -1.577456941e-01f, 9.596813183e-01f, 8.641966902e-01f, 5.537259863e-01f, 3.240430284e-01f, 1.845093693e-01f, 1.041658613e-01f, 5.864954490e-02f, 3.299401083e-02f, 1.855619865e-02f, 1.043532687e-02f, 5.868288372e-03f,
-8.485702748e-01f, 9.637577894e-01f, -2.414213342e-01f, 9.720384190e-01f, -9.667981926e-01f, -3.345844009e-01f, 4.755788316e-01f, 8.227210104e-01f, 9.427546655e-01f, 9.817776480e-01f, 9.942255659e-01f, 9.981727603e-01f, 9.994220557e-01f, 9.998172259e-01f, 9.999422006e-01f, 9.999817221e-01f, 5.290826861e-01f, 2.667787912e-01f, -9.704203931e-01f, -2.348218730e-01f, -2.555411020e-01f, 9.423657881e-01f, 8.796731069e-01f, 5.684453703e-01f, 3.334870921e-01f, 1.900332863e-01f, 1.073104099e-01f, 6.042466957e-02f, 3.399344971e-02f, 1.911844019e-02f, 1.075153690e-02f, 6.046113157e-03f,
-9.036922051e-01f, 6.731098380e-01f, 7.233429552e-02f, 9.982477555e-01f, -9.364566873e-01f, -3.870207132e-01f, 4.475279919e-01f, 8.124829160e-01f, 9.393727128e-01f, 9.806934947e-01f, 9.938812501e-01f, 9.980637301e-01f, 9.993875625e-01f, 9.998063167e-01f, 9.999387506e-01f, 9.999806311e-01f, -4.281826695e-01f, 7.395425248e-01f, -9.973804438e-01f, -5.917278607e-02f, -3.507832277e-01f, 9.220710209e-01f, 8.942699237e-01f, 5.829850008e-01f, 3.428978075e-01f, 1.955511940e-01f, 1.104538854e-01f, 6.219960316e-02f, 3.499285460e-02f, 1.968067568e-02f, 1.106774584e-02f, 6.223937751e-03f,
-1.279636896e-01f, 1.751563210e-01f, 3.789165737e-01f, 9.929728260e-01f, -8.967584163e-01f, -4.382334809e-01f, 4.190296615e-01f, 8.019878987e-01f, 9.358968237e-01f, 9.795783292e-01f, 9.935269954e-01f, 9.979515438e-01f, 9.993520700e-01f, 9.997950914e-01f, 9.999352007e-01f, 9.999795085e-01f, -9.917788534e-01f, 9.845406356e-01f, -9.254308349e-01f, 1.183425828e-01f, -4.425204433e-01f, 8.988611774e-01f, 9.079725452e-01f, 5.973402802e-01f, 3.522742333e-01f, 2.010629178e-01f, 1.135962563e-01f, 6.397434006e-02f, 3.599222450e-02f, 2.024290495e-02f, 1.138395368e-02f, 6.401762149e-03f,
7.654140519e-01f, -3.767421515e-01f, 6.479219076e-01f, 9.563799991e-01f, -8.481000317e-01f, -4.880607978e-01f, 3.901123364e-01f, 7.912392773e-01f, 9.323273456e-01f, 9.784321869e-01f, 9.931628054e-01f, 9.978362017e-01f, 9.993155781e-01f, 9.997835499e-01f, 9.999315508e-01f, 9.999783543e-01f, -6.435381334e-01f, 9.263181696e-01f, -7.617067688e-01f, 2.921254821e-01f, -5.298361409e-01f, 8.728096342e-01f, 9.207672697e-01f, 6.115066689e-01f, 3.616154320e-01f, 2.065682834e-01f, 1.167374914e-01f, 6.574887465e-02f, 3.699155841e-02f, 2.080512781e-02f, 1.170016038e-02f, 6.579586343e-03f,
9.550736440e-01f, -8.126109057e-01f, 8.526731891e-01f, 8.896233956e-01f, -7.909677119e-01f, -5.363451377e-01f, 3.608049314e-01f, 7.802404506e-01f, 9.286646356e-01f, 9.772551038e-01f, 9.927886839e-01f, 9.977177042e-01f, 9.992780869e-01f, 9.997716922e-01f, 9.999278009e-01f, 9.999771684e-01f, 2.963685787e-01f, 5.828065854e-01f, -5.224446694e-01f, 4.566948806e-01f, -6.118578909e-01f, 8.439987519e-01f, 9.326413038e-01f, 6.254796874e-01f, 3.709204694e-01f, 2.120671168e-01f, 1.198775590e-01f, 6.752320133e-02f, 3.799085533e-02f, 2.136734410e-02f, 1.201636591e-02f, 6.757410330e-03f,
2.666429324e-01f, -9.982103072e-01f, 9.728653484e-01f, 7.948084874e-01f, -7.259323042e-01f, -5.829338522e-01f, 3.311367516e-01f, 7.689948967e-01f, 9.249090599e-01f, 9.760471174e-01f, 9.924046345e-01f, 9.975960516e-01f, 9.992395964e-01f, 9.997595184e-01f, 9.999239510e-01f, 9.999759510e-01f, 9.637953863e-01f, 5.980119189e-02f, -2.313720250e-01f, 6.068603368e-01f, -6.877661592e-01f, 8.125196145e-01f, 9.435827742e-01f, 6.392549170e-01f, 3.801884151e-01f, 2.175592441e-01f, 1.230164278e-01f, 6.929731449e-02f, 3.899011425e-02f, 2.192955363e-02f, 1.233257024e-02f, 6.935234103e-03f,
-6.669380617e-01f, -8.763791221e-01f, 9.965789963e-01f, 6.749256921e-01f, -6.536436209e-01f, -6.276796538e-01f, 3.011374626e-01f, 7.575061717e-01f, 9.210609940e-01f, 9.748082656e-01f, 9.920106610e-01f, 9.974712444e-01f, 9.992001067e-01f, 9.997470285e-01f, 9.999200011e-01f, 9.999747019e-01f, 7.451131605e-01f, -4.816218791e-01f, 8.264565347e-02f, 7.378857026e-01f, -7.568024953e-01f, 7.784717415e-01f, 9.535807405e-01f, 6.528280017e-01f, 3.894183423e-01f, 2.230444916e-01f, 1.261540665e-01f, 7.107120850e-02f, 3.998933419e-02f, 2.249175622e-02f, 1.264877333e-02f, 7.113057657e-03f,
-9.873392775e-01f, -4.846391354e-01f, 9.214624639e-01f, 5.337560571e-01f, -5.748239465e-01f, -6.704410810e-01f, 2.708370612e-01f, 7.457779085e-01f, 9.171208228e-01f, 9.735385879e-01f, 9.916067674e-01f, 9.973432828e-01f, 9.991596177e-01f, 9.997342223e-01f, 9.999159512e-01f, 9.999734212e-01f, -1.586226688e-01f, -8.747141867e-01f, 3.884674088e-01f, 8.456384993e-01f, -8.182771111e-01f, 7.419627733e-01f, 9.626252055e-01f, 6.661946496e-01f, 3.986093280e-01f, 2.285226858e-01f, 1.292904437e-01f, 7.284487777e-02f, 4.098851413e-02f, 2.305395171e-02f, 1.296497516e-02f, 7.290880986e-03f,
-3.999853150e-01f, 5.636087450e-02f, 7.549650153e-01f, 3.757520063e-01f, -4.902608213e-01f, -7.110829460e-01f, 2.402658454e-01f, 7.338138159e-01f, 9.130889403e-01f, 9.722381242e-01f, 9.911929578e-01f, 9.972121674e-01f, 9.991181296e-01f, 9.997211001e-01f, 9.999118013e-01f, 9.999721088e-01f, -9.165215479e-01f, -9.984104626e-01f, 6.557650689e-01f, 9.267202543e-01f, -8.715757724e-01f, 7.031081310e-01f, 9.707071255e-01f, 6.793506338e-01f, 4.077604531e-01f, 2.339936535e-01f, 1.324255279e-01f, 7.461831668e-02f, 4.198765309e-02f, 2.361613990e-02f, 1.328117570e-02f, 7.468704084e-03f,
5.551133015e-01f, 5.800027620e-01f, 5.135981094e-01f, 2.058969135e-01f, -4.007991721e-01f, -7.494767618e-01f, 2.094543837e-01f, 7.216176770e-01f, 9.089657497e-01f, 9.709069157e-01f, 9.907692362e-01f, 9.970778985e-01f, 9.990756424e-01f, 9.997076617e-01f, 9.999075514e-01f, 9.999707649e-01f, -8.317747426e-01f, -8.146145076e-01f, 8.580308748e-01f, 9.785736871e-01f, -9.161659367e-01f, 6.620306515e-01f, 9.778184193e-01f, 6.922917941e-01f, 4.168708024e-01f, 2.394572216e-01f, 1.355592879e-01f, 7.639151963e-02f, 4.298675006e-02f, 2.417832062e-02f, 1.359737490e-02f, 7.646526947e-03f,
9.998433086e-01f, 9.250143668e-01f, 2.212979668e-01f, 2.954792850e-02f, -3.073328700e-01f, -7.855011484e-01f, 1.784334851e-01f, 7.091933487e-01f, 9.047516632e-01f, 9.695450046e-01f, 9.903356070e-01f, 9.969404766e-01f, 9.990321562e-01f, 9.996939071e-01f, 9.999032016e-01f, 9.999693893e-01f, 1.770192511e-02f, -3.799321270e-01f, 9.752062397e-01f, 9.995633646e-01f, -9.516020739e-01f, 6.188601989e-01f, 9.839519762e-01f, 7.050140383e-01f, 4.259394651e-01f, 2.449132175e-01f, 1.386916923e-01f, 7.816448100e-02f, 4.398580404e-02f, 2.474049370e-02f, 1.391357275e-02f, 7.824349567e-03f,
5.253219888e-01f, 9.851384009e-01f, -9.294817111e-02f, -1.477329843e-01f, -2.107957994e-01f, -8.190422169e-01f, 1.472341679e-01f, 6.965447596e-01f, 9.004471024e-01f, 9.681524338e-01f, 9.898920744e-01f, 9.967999021e-01f, 9.989876708e-01f, 9.996798365e-01f, 9.998987517e-01f, 9.999679821e-01f, 8.509035245e-01f, 1.717624261e-01f, 9.956709484e-01f, 9.890272824e-01f, -9.775301177e-01f, 5.737332542e-01f, 9.891016630e-01f, 7.175133434e-01f, 4.349655341e-01f, 2.503614686e-01f, 1.418227098e-01f, 7.993719520e-02f, 4.498481404e-02f, 2.530265896e-02f, 1.422976920e-02f, 8.002171940e-03f,
-4.321779449e-01f, 7.418577573e-01f, -3.979766910e-01f, -3.203544680e-01f, -1.121525269e-01f, -8.499939289e-01f, 1.158876288e-01f, 6.836759095e-01f, 8.960524975e-01f, 9.667292474e-01f, 9.894386429e-01f, 9.966561754e-01f, 9.989421865e-01f, 9.996654497e-01f, 9.998942019e-01f, 9.999665433e-01f, 9.017883476e-01f, 6.705572816e-01f, 9.173955273e-01f, 9.472977435e-01f, -9.936910036e-01f, 5.267924836e-01f, 9.932623307e-01f, 7.297857568e-01f, 4.439481070e-01f, 2.558018026e-01f, 1.449523091e-01f, 8.170965662e-02f, 4.598377905e-02f, 2.586481621e-02f, 1.454596424e-02f, 8.179994060e-03f,
-9.923354692e-01f, 2.700984415e-01f, -6.635380855e-01f, -4.828721220e-01f, -1.238866346e-02f, -8.782584324e-01f, 8.442521171e-02f, 6.705908678e-01f, 8.915682882e-01f, 9.652754904e-01f, 9.889753170e-01f, 9.965092971e-01f, 9.988957033e-01f, 9.996507468e-01f, 9.998895520e-01f, 9.999650728e-01f, 1.235731227e-01f, 9.628327123e-01f, 7.481425059e-01f, 8.756908780e-01f, -9.999232576e-01f, 4.781862879e-01f, 9.964298187e-01f, 7.418273977e-01f, 4.528862854e-01f, 2.612340474e-01f, 1.480804588e-01f, 8.348185965e-02f, 4.698269808e-02f, 2.642696529e-02f, 1.486215781e-02f, 8.357815921e-03f,
-6.401443395e-01f, -2.848462729e-01f, -8.632967800e-01f, -6.301602158e-01f, 8.749898344e-02f, -9.037463706e-01f, 5.287837645e-02f, 6.572937723e-01f, 8.869949228e-01f, 9.637912089e-01f, 9.885021014e-01f, 9.963592674e-01f, 9.988482212e-01f, 9.996357277e-01f, 9.998848022e-01f, 9.999635708e-01f, -7.682546613e-01f, 9.585732110e-01f, 5.046966116e-01f, 7.764651328e-01f, -9.961646088e-01f, 4.280683329e-01f, 9.986009600e-01f, 7.536344584e-01f, 4.617791755e-01f, 2.666580314e-01f, 1.512071278e-01f, 8.525379868e-02f, 4.798157012e-02f, 2.698910600e-02f, 1.517834990e-02f, 8.535637518e-03f,
3.005925437e-01f, -7.520635254e-01f, -9.774428167e-01f, -7.575733518e-01f, 1.865123694e-01f, -9.263771649e-01f, 2.127866722e-02f, 6.437888276e-01f, 8.823328586e-01f, 9.622764496e-01f, 9.880190008e-01f, 9.962060871e-01f, 9.987997402e-01f, 9.996203926e-01f, 9.998799524e-01f, 9.999620371e-01f, -9.537526528e-01f, 6.590906264e-01f, 2.112002371e-01f, 6.527500415e-01f, -9.824526126e-01f, 3.765970636e-01f, 9.997735835e-01f, 7.652032053e-01f, 4.706258882e-01f, 2.720735828e-01f, 1.543322846e-01f, 8.702546812e-02f, 4.898039419e-02f, 2.755123819e-02f, 1.549454048e-02f, 8.713458845e-03f,
9.649660285e-01f, -9.876589150e-01f, -9.946563971e-01f, -8.610929796e-01f, 2.836621855e-01f, -9.460792693e-01f, -1.034231891e-02f, 6.300803045e-01f, 8.775825619e-01f, 9.607312606e-01f, 9.875260200e-01f, 9.960497564e-01f, 9.987502604e-01f, 9.996047413e-01f, 9.998750026e-01f, 9.999604718e-01f, -2.623748537e-01f, 1.566201379e-01f, -1.032407464e-01f, 5.084475199e-01f, -9.589242747e-01f, 3.239352036e-01f, 9.999465168e-01f, 7.765299800e-01f, 4.794255386e-01f, 2.774805306e-01f, 1.574558982e-01f, 8.879686236e-02f, 4.997916927e-02f, 2.811336166e-02f, 1.581072950e-02f, 8.891279896e-03f,
7.421541968e-01f, -9.190733545e-01f, -9.132304601e-01f, -9.374541386e-01f, 3.779777427e-01f, -9.627903967e-01f, -4.195296357e-02f, 6.161725377e-01f, 8.727445076e-01f, 9.591556907e-01f, 9.870231639e-01f, 9.958902760e-01f, 9.986997819e-01f, 9.995887740e-01f, 9.998699528e-01f, 9.999588749e-01f, 6.702291758e-01f, -3.940864994e-01f, -4.074434030e-01f, 3.481088020e-01f, -9.258146823e-01f, 2.702492405e-01f, 9.991195869e-01f, 7.876112009e-01f, 4.881772469e-01f, 2.828787037e-01f, 1.605779372e-01f, 9.056797580e-02f, 5.097789438e-02f, 2.867547624e-02f, 1.612691694e-02f, 9.069100666e-03f,
-1.629907808e-01f, -5.674299469e-01f, -7.412399703e-01f, -9.842484337e-01f, 4.685166713e-01f, -9.764577158e-01f, -7.352165877e-02f, 6.020699252e-01f, 8.678191797e-01f, 9.575497897e-01f, 9.865104376e-01f, 9.957276462e-01f, 9.986483046e-01f, 9.995724905e-01f, 9.998648030e-01f, 9.999572463e-01f, 9.866275920e-01f, -8.234216753e-01f, -6.712401257e-01f, 1.767908958e-01f, -8.834546557e-01f, 2.157088994e-01f, 9.972936206e-01f, 7.984433638e-01f, 4.968801378e-01f, 2.882679314e-01f, 1.636983704e-01f, 9.233880284e-02f, 5.197656850e-02f, 2.923758175e-02f, 1.644310277e-02f, 9.246921150e-03f,
-9.182827862e-01f, -4.102845452e-02f, -4.957411282e-01f, -9.999999947e-01f, 5.543743362e-01f, -9.870380181e-01f, -1.050168384e-01f, 5.877769265e-01f, 8.628070705e-01f, 9.559136084e-01f, 9.859878462e-01f, 9.955618678e-01f, 9.985958287e-01f, 9.995558910e-01f, 9.998595533e-01f, 9.999555861e-01f, 3.959251502e-01f, -9.991579785e-01f, -8.684703414e-01f, -1.029124367e-04f, -8.322674422e-01f, 1.604866066e-01f, 9.944704438e-01f, 8.090230434e-01f, 5.055333412e-01f, 2.936480433e-01f, 1.668171666e-01f, 9.410933788e-02f, 5.297519065e-02f, 2.979967802e-02f, 1.675928696e-02f, 9.424741341e-03f,
-8.293098329e-01f, 4.980090543e-01f, -2.010799162e-01f, -9.842120249e-01f, 6.346928759e-01f, -9.944978545e-01f, -1.364070100e-01f, 5.732980613e-01f, 8.577086814e-01f, 9.542471985e-01f, 9.854553950e-01f, 9.953929410e-01f, 9.985423543e-01f, 9.995389753e-01f, 9.998542035e-01f, 9.999538943e-01f, -5.587890489e-01f, -8.671718295e-01f, -9.795748401e-01f, -1.769934748e-01f, -7.727644876e-01f, 1.047569444e-01f, 9.906528795e-01f, 8.193468942e-01f, 5.141359917e-01f, 2.990188692e-01f, 1.699342947e-01f, 9.587957531e-02f, 5.397375983e-02f, 3.036176486e-02f, 1.707546947e-02f, 9.602561234e-03f,
2.212675626e-02f, 8.836688484e-01f, 1.135222784e-01f, -9.373824693e-01f, 7.086697743e-01f, -9.988136413e-01f, -1.676607860e-01f, 5.586379081e-01f, 8.525245221e-01f, 9.525506128e-01f, 9.849130892e-01f, 9.952208666e-01f, 9.984878812e-01f, 9.995217436e-01f, 9.998487538e-01f, 9.999521709e-01f, -9.997551734e-01f, -4.681125574e-01f, -9.935354510e-01f, -3.483017460e-01f, -7.055403256e-01f, 4.869609889e-02f, 9.858447448e-01f, 8.294116515e-01f, 5.226872289e-01f, 3.043802394e-01f, 1.730497234e-01f, 9.764950955e-02f, 5.497227503e-02f, 3.092384210e-02f, 1.739165027e-02f, 9.780380823e-03f,
8.532201077e-01f, 9.971747381e-01f, 4.168665323e-01f, -8.609883102e-01f, 7.755658785e-01f, -9.999717342e-01f, -1.987469151e-01f, 5.438011027e-01f, 8.472551110e-01f, 9.508239048e-01f, 9.843609343e-01f, 9.950456450e-01f, 9.984324097e-01f, 9.995041958e-01f, 9.998432041e-01f, 9.999504159e-01f, -5.215510021e-01f, 7.511685313e-02f, -9.089677080e-01f, -5.086247435e-01f, -6.312666379e-01f, -7.518696635e-03f, 9.800508475e-01f, 8.392141328e-01f, 5.311861979e-01f, 3.097319842e-01f, 1.761634216e-01f, 9.941913500e-02f, 5.597073526e-02f, 3.148590956e-02f, 1.770782933e-02f, 9.958200103e-03f,
8.998668270e-01f, 8.035689776e-01f, 6.788703658e-01f, -7.574389836e-01f, 8.347127848e-01f, -9.979684721e-01f, -2.296343139e-01f, 5.287923369e-01f, 8.419009752e-01f, 9.490671292e-01f, 9.837989357e-01f, 9.948672768e-01f, 9.983759398e-01f, 9.994863320e-01f, 9.998375544e-01f, 9.999486292e-01f, 4.361647552e-01f, 5.952116415e-01f, -7.342581470e-01f, -6.529059551e-01f, -5.506855426e-01f, -6.370972221e-02f, 9.732769811e-01f, 8.487512383e-01f, 5.396320487e-01f, 3.150739345e-01f, 1.792753582e-01f, 1.011884461e-01f, 5.696913951e-02f, 3.204796707e-02f, 1.802400663e-02f, 1.013601907e-02f,
1.191801354e-01f, 3.624786135e-01f, 8.735510056e-01f, -6.300003866e-01f, 8.855195169e-01f, -9.928101881e-01f, -2.602920974e-01f, 5.136163566e-01f, 8.364626499e-01f, 9.472803416e-01f, 9.832270992e-01f, 9.946857625e-01f, 9.983184715e-01f, 9.994681520e-01f, 9.998318047e-01f, 9.999468110e-01f, 9.928726481e-01f, 9.319920894e-01f, -4.867326171e-01f, -7.765948190e-01f, -4.646021794e-01f, -1.196993330e-01f, 9.655299188e-01f, 8.580199521e-01f, 5.480239368e-01f, 3.204059213e-01f, 1.823855020e-01f, 1.029574371e-01f, 5.796748680e-02f, 3.261001444e-02f, 1.834018212e-02f, 1.031383771e-02f,
-7.710802230e-01f, -1.902485591e-01f, 9.816020819e-01f, -4.826918728e-01f, 9.274784307e-01f, -9.845131900e-01f, -2.906896106e-01f, 4.982779609e-01f, 8.309406791e-01f, 9.454635984e-01f, 9.826454305e-01f, 9.945011028e-01f, 9.982600048e-01f, 9.994496561e-01f, 9.998259550e-01f, 9.999449611e-01f, 6.367380071e-01f, 9.817359552e-01f, -1.909380864e-01f, -8.757902465e-01f, -3.738766648e-01f, -1.753105211e-01f, 9.568174070e-01f, 8.670173434e-01f, 5.563610229e-01f, 3.257277760e-01f, 1.854938220e-01f, 1.047261026e-01f, 5.896577612e-02f, 3.317205150e-02f, 1.865635577e-02f, 1.049165603e-02f,
-9.524129804e-01f, -6.843826418e-01f, 9.923082299e-01f, -3.201594838e-01f, 9.601702867e-01f, -9.731037080e-01f, -3.207964584e-01f, 4.827820000e-01f, 8.253356149e-01f, 9.436169571e-01f, 9.820539352e-01f, 9.943132982e-01f, 9.982005399e-01f, 9.994308440e-01f, 9.998200054e-01f, 9.999430795e-01f, -3.048106211e-01f, 7.291230346e-01f, 1.237916674e-01f, -9.473636604e-01f, -2.794154982e-01f, -2.303674747e-01f, 9.471481575e-01f, 8.757405669e-01f, 5.646424734e-01f, 3.310393303e-01f, 1.886002871e-01f, 1.064944369e-01f, 5.996400648e-02f, 3.373407807e-02f, 1.897252756e-02f, 1.066947402e-02f,
-2.581016359e-01f, -9.677393408e-01f, 9.046077269e-01f, -1.475294147e-01f, 9.832684384e-01f, -9.586178129e-01f, -3.505825365e-01f, 4.671333740e-01f, 8.196480178e-01f, 9.417404761e-01f, 9.814526195e-01f, 9.941223493e-01f, 9.981400768e-01f, 9.994117159e-01f, 9.998139558e-01f, 9.999411664e-01f, -9.661177700e-01f, 2.519535043e-01f, 4.262450708e-01f, -9.890576686e-01f, -1.821625043e-01f, -2.846961343e-01f, 9.365318388e-01f, 8.841868642e-01f, 5.728674601e-01f, 3.363404163e-01f, 1.917048661e-01f, 1.082624345e-01f, 6.096217687e-02f, 3.429609397e-02f, 1.928869745e-02f, 1.084729167e-02f,
6.735071623e-01f, -9.530499555e-01f, 7.271977827e-01f, 2.975366287e-02f, 9.965420970e-01f, -9.411013007e-01f, -3.800180612e-01f, 4.513370314e-01f, 8.138784567e-01f, 9.398342148e-01f, 9.808414892e-01f, 9.939282566e-01f, 9.980786156e-01f, 9.993922718e-01f, 9.998078062e-01f, 9.999392216e-01f, -7.391806966e-01f, -3.028131145e-01f, 6.864279895e-01f, -9.995572618e-01f, -8.308940282e-02f, -3.381247429e-01f, 9.249790663e-01f, 8.923535645e-01f, 5.810351605e-01f, 3.416308663e-01f, 1.948075281e-01f, 1.100300897e-01f, 6.196028630e-02f, 3.485809903e-02f, 1.960486542e-02f, 1.102510897e-02f,
9.858965816e-01f, -6.448385490e-01f, 4.776720420e-01f, 2.060983239e-01f, 9.998586364e-01f, -9.206095492e-01f, -4.090735996e-01f, 4.353979673e-01f, 8.080275083e-01f, 9.378982333e-01f, 9.802205506e-01f, 9.937310210e-01f, 9.980161563e-01f, 9.993725116e-01f, 9.998015566e-01f, 9.999372453e-01f, 1.673557003e-01f, -7.643188115e-01f, 8.785382293e-01f, -9.785312876e-01f, 1.681390048e-02f, -3.904843889e-01f, 9.125013918e-01f, 9.002380852e-01f, 5.891447579e-01f, 3.469105129e-01f, 1.979082420e-01f, 1.117973969e-01f, 6.295833377e-02f, 3.542009306e-02f, 1.992103142e-02f, 1.120292593e-02f
};

struct Args { const float* in[22]; float* out; unsigned char* ws; int ph_lo, ph_hi; };
struct Frame { LAS unsigned char* lds; int tid, lane, wave, vcu, G, bx; };
#define CAS __attribute__((address_space(4)))
typedef CAS const char* kptr_t;
__device__ __forceinline__ kptr_t kargp() { kptr_t kp = (kptr_t)__builtin_amdgcn_kernarg_segment_ptr(); asm volatile("" : "+s"(kp)); return kp; }
typedef const float* cfp_t; typedef float* fp_t; typedef unsigned char* ucp_t;
__device__ __forceinline__ const float* arg_in(int i) { return *(CAS const cfp_t*)(kargp() + 8 * i); }
__device__ __forceinline__ float* arg_out() { return *(CAS const fp_t*)(kargp() + 176); }
__device__ __forceinline__ unsigned char* arg_ws() { return *(CAS const ucp_t*)(kargp() + 184); }
__device__ __forceinline__ float wave_sum(float v) {
#pragma unroll
    for (int o = 1; o < 64; o <<= 1) v += __shfl_xor(v, o);
    return v;
}
__device__ __forceinline__ float silu_f(float v) { return v * __builtin_amdgcn_rcpf(1.0f + __builtin_amdgcn_exp2f(v * -1.4426950408889634f)); }

constexpr int TP_PITCH = 144;
constexpr int N_TILES = 768 + 512 + 512 + 96 * 256;
struct TileDesc { const float* src; bf16_t* dst; int N, k0, n0, drow0, fp8; };
__device__ __forceinline__ TileDesc p0_decode(int t) {
    TileDesc d; int it, kind = 0; d.fp8 = 0;
    if (t < 768) { d.src = arg_in(8); d.dst = (bf16_t*)(arg_ws() + WS_WIN0); d.N = 3072; it = t; kind = 1; }
    else if (t < 1280) { d.src = arg_in(12); d.dst = (bf16_t*)(arg_ws() + WS_WIN1); d.N = 2048; it = t - 768; }
    else if (t < 1792) { const int x = t - 1280, l = x >> 8; d.src = arg_in(16) + (size_t)l * DM * DM; d.dst = (bf16_t*)(arg_ws() + WS_WOUT) + (size_t)l * DM * DM; d.N = 1024; it = x & 255; }
    else { const int x = t - 1792, mat = x >> 8, which = mat >> 5, le = mat & 31; it = x & 255; d.N = 1024;
        d.src = arg_in(18 + which) + (size_t)le * DM * DM;
        d.fp8 = 1; const int l = le >> 4, e = le & 15;
        if (which == 2) d.dst = (bf16_t*)(arg_ws() + WS_WD + (size_t)l * 32 * MiB + (size_t)e * DM * DM); else { d.dst = (bf16_t*)(arg_ws() + WS_WGU + (size_t)l * 64 * MiB + (size_t)e * 2048 * DM); kind = 2 + which; } }
    const int nb = d.N >> 6, kb = it / nb, nblk = it - kb * nb; d.k0 = kb * 64; d.n0 = nblk * 64;
    int drow0 = d.n0;
    if (kind == 1) { if (d.n0 >= 2560) { const int c = d.n0 - 2560; drow0 = 2048 + (c >> 7) * 256 + 128 + (c & 127); } else if (d.n0 >= 2048) { const int c = d.n0 - 2048; drow0 = 2048 + (c >> 7) * 256 + (c & 127); } }
    else if (kind == 2) drow0 = (d.n0 >> 7) * 256 + (d.n0 & 127);
    else if (kind == 3) drow0 = (d.n0 >> 7) * 256 + 128 + (d.n0 & 127);
    d.drow0 = drow0; return d;
}
__device__ __forceinline__ void p0_tile_load(int t, int lane, f32x4 (&v)[16]) {
    const TileDesc d = p0_decode(t); const int nq = lane >> 2, kq = lane & 3;
    const float* s = d.src + (size_t)(d.k0 + 16 * kq) * d.N + d.n0 + 4 * nq;
#pragma unroll
    for (int i = 0; i < 16; ++i) v[i] = *(const f32x4*)(s + (size_t)i * d.N);
}
__device__ __forceinline__ void p0_tile_store(int t, int lane, const f32x4 (&v)[16], LAS unsigned char* T) {
    const TileDesc d = p0_decode(t); const int nq = lane >> 2, kq = lane & 3;
    if (d.fp8) {
#pragma unroll
        for (int j = 0; j < 4; ++j) { u32x4 w;
            w.x = pk4_fp8((f32x4){v[0][j], v[1][j], v[2][j], v[3][j]} * FP8_SW); w.y = pk4_fp8((f32x4){v[4][j], v[5][j], v[6][j], v[7][j]} * FP8_SW);
            w.z = pk4_fp8((f32x4){v[8][j], v[9][j], v[10][j], v[11][j]} * FP8_SW); w.w = pk4_fp8((f32x4){v[12][j], v[13][j], v[14][j], v[15][j]} * FP8_SW);
            *(LAS u32x4*)(T + (4 * nq + j) * 80 + 16 * kq) = w; }
        LDS_WAIT(); asm volatile("" ::: "memory");
        unsigned char* dp = (unsigned char*)d.dst + (size_t)(d.drow0 + (lane >> 2)) * DM + d.k0 + 16 * (lane & 3);
#pragma unroll
        for (int r = 0; r < 4; ++r) { const u32x4 w = *(const LAS u32x4*)(T + (16 * r + (lane >> 2)) * 80 + 16 * (lane & 3)); *(u32x4*)(dp + (size_t)(16 * r) * DM) = w; }
        LDS_WAIT(); asm volatile("" ::: "memory");
        return;
    }
#pragma unroll
    for (int j = 0; j < 4; ++j) { u32x4 w0, w1;
        w0.x = cvt_pk_bf16(v[0][j], v[1][j]); w0.y = cvt_pk_bf16(v[2][j], v[3][j]); w0.z = cvt_pk_bf16(v[4][j], v[5][j]); w0.w = cvt_pk_bf16(v[6][j], v[7][j]);
        w1.x = cvt_pk_bf16(v[8][j], v[9][j]); w1.y = cvt_pk_bf16(v[10][j], v[11][j]); w1.z = cvt_pk_bf16(v[12][j], v[13][j]); w1.w = cvt_pk_bf16(v[14][j], v[15][j]);
        LAS unsigned char* p = T + (4 * nq + j) * TP_PITCH + 32 * kq; *(LAS u32x4*)p = w0; *(LAS u32x4*)(p + 16) = w1; }
    LDS_WAIT(); asm volatile("" ::: "memory");
    bf16_t* dp = d.dst + (size_t)(d.drow0 + (lane >> 3)) * DM + d.k0 + 8 * (lane & 7);
#pragma unroll
    for (int r = 0; r < 8; ++r) { const u32x4 w = *(const LAS u32x4*)(T + (8 * r + (lane >> 3)) * TP_PITCH + 16 * (lane & 7)); *(u32x4*)(dp + (size_t)(8 * r) * DM) = w; }
    LDS_WAIT(); asm volatile("" ::: "memory");
}
__device__ __forceinline__ void p0_mod_block(Frame& F, int l, int cc, int kq4) {
    LAS float* sl = (LAS float*)F.lds;
    const int kbase = kq4 * 256;
    for (int idx = F.tid; idx < 17 * 256; idx += 512) { const int bb = idx >> 8, k = idx & 255; const float v = (bb < 16) ? arg_in(1)[bb * DM + kbase + k] : arg_in(3)[kbase + k]; sl[k * 20 + bb] = silu_f(v); }
    __syncthreads();
    const int ksub = F.lane >> 3, cq = F.lane & 7, j0 = cc * 256 + F.wave * 32 + 4 * cq;
    f32x4 acc[17];
#pragma unroll
    for (int bb = 0; bb < 17; ++bb) acc[bb] = (f32x4){0.f, 0.f, 0.f, 0.f};
    const float* wl = arg_in(4) + ((size_t)l * DM + kbase) * MODW; const unsigned loff = (unsigned)(ksub * MODW + j0);
#define MOD_LOAD(W, i0) do { _Pragma("unroll") for (int q = 0; q < 8; ++q) W[q] = *(const f32x4*)(wl + (size_t)(8 * ((i0) + q)) * MODW + loff); } while (0)
#define MOD_FMA(W, i0) do { _Pragma("unroll") for (int q = 0; q < 8; ++q) { const int k = 8 * ((i0) + q) + ksub; const f32x4 w = W[q]; \
        const f32x4 s0 = *(const LAS f32x4*)(sl + k * 20), s1 = *(const LAS f32x4*)(sl + k * 20 + 4), s2 = *(const LAS f32x4*)(sl + k * 20 + 8), s3 = *(const LAS f32x4*)(sl + k * 20 + 12); const float s4 = sl[k * 20 + 16]; \
        _Pragma("unroll") for (int z = 0; z < 4; ++z) { acc[z] += s0[z] * w; acc[4 + z] += s1[z] * w; acc[8 + z] += s2[z] * w; acc[12 + z] += s3[z] * w; } \
        acc[16] += s4 * w; __builtin_amdgcn_sched_barrier(0); } } while (0)
    { f32x4 wA[8], wB[8], wC[8], wD[8];
      MOD_LOAD(wA, 0); MOD_LOAD(wB, 8); MOD_LOAD(wC, 16); MOD_LOAD(wD, 24); asm volatile("" ::: "memory");
      MOD_FMA(wA, 0); MOD_FMA(wB, 8); MOD_FMA(wC, 16); MOD_FMA(wD, 24); }
#undef MOD_LOAD
#undef MOD_FMA
#pragma unroll
    for (int bb = 0; bb < 17; ++bb)
#pragma unroll
        for (int q = 0; q < 4; ++q) { float x = acc[bb][q]; x += __shfl_xor(x, 8); x += __shfl_xor(x, 16); x += __shfl_xor(x, 32); acc[bb][q] = x; }
    if (ksub == 0) { float* modp = (float*)(arg_ws() + WS_MODP) + ((size_t)(kq4 * 2 + l) * 17) * MODW + j0;
#pragma unroll
        for (int bb = 0; bb < 17; ++bb) *(f32x4*)(modp + (size_t)bb * MODW) = acc[bb]; }
    __syncthreads();
}
template <class MAP> __device__ __forceinline__ void p0_tiles(Frame& F0, int start, int end, const MAP& tile_of) {
    struct { LAS unsigned char* lds; int lane, wave; } F; { F.lds = F0.lds; F.lane = lane_id_now(); F.wave = F0.wave; }
    LAS unsigned char* T = F.lds + F.wave * (64 * TP_PITCH);
    f32x4 vA[16], vB[16];
    int t = start + F.wave;
    if (t < end) p0_tile_load(tile_of(t), F.lane, vA);
    while (t < end) {
        int t2 = t + NWAVES; if (t2 < end) p0_tile_load(tile_of(t2), F.lane, vB);
        p0_tile_store(tile_of(t), F.lane, vA, T);
        t = t2; if (t >= end) break;
        t2 = t + NWAVES; if (t2 < end) p0_tile_load(tile_of(t2), F.lane, vA);
        p0_tile_store(tile_of(t), F.lane, vB, T);
        t = t2;
    }
}
struct TileIdentity { __device__ __forceinline__ int operator()(int t) const { return t; } };
struct TileMoe { int c;
    __device__ __forceinline__ int operator()(int j) const {
        int l = 0, jj = j; if (j >= 48) { l = 1; jj = j - 48; }
        int mat, it;
        if (jj < 32) { const int g = c * 32 + jj; mat = (g >> 12) * 32 + l * 16 + ((g >> 8) & 15); it = g & 255; }
        else { const int g = c * 16 + (jj - 32); mat = 64 + l * 16 + (g >> 8); it = g & 255; }
        return 1792 + mat * 256 + it; } };
constexpr int N_TILES_DENSE = 768 + 512 + 512;
__device__ __forceinline__ void p0_prologue(Frame& F) {
    if ((F.vcu & 3) != 3) { const int m = (F.vcu >> 2) * 3 + (F.vcu & 3), kq4 = m & 3, lc = m >> 2; p0_mod_block(F, lc / 24, lc % 24, kq4); }
    p0_tiles(F, F.vcu * 7, F.vcu * 7 + 7, TileIdentity{});
}
__device__ __forceinline__ void p_moe_convert(Frame& F) {
    p0_tiles(F, N_TILES_DENSE + F.vcu * 96, N_TILES_DENSE + F.vcu * 96 + 96, TileIdentity{});
    __syncthreads();
}

__device__ __forceinline__ void st_row_bf16(bf16_t* orow, int lane, const f32x4 (&v)[4]) {
#pragma unroll
    for (int j = 0; j < 4; ++j) { u32x2 w; w.x = cvt_pk_bf16(v[j][0], v[j][1]); w.y = cvt_pk_bf16(v[j][2], v[j][3]); *(u32x2*)(orow + 4 * lane + 256 * j) = w; }
}
template <int NR> __device__ __forceinline__ void norm_rows(const float* const (&xr)[NR], bf16_t* const (&orow)[NR], int lane, const f32x4 (&A)[4], const f32x4 (&Bv)[4]) {
    f32x4 v[NR][4];
#pragma unroll
    for (int r = 0; r < NR; ++r)
#pragma unroll
        for (int j = 0; j < 4; ++j) v[r][j] = *(const f32x4*)(xr[r] + 4 * lane + 256 * j);
#pragma unroll
    for (int r = 0; r < NR; ++r) { float ss = 0.f;
#pragma unroll
        for (int j = 0; j < 4; ++j) ss += (v[r][j][0] * v[r][j][0] + v[r][j][1] * v[r][j][1]) + (v[r][j][2] * v[r][j][2] + v[r][j][3] * v[r][j][3]);
        const float rstd = __builtin_amdgcn_rsqf(wave_sum(ss) * (1.0f / DM) + NORM_EPS);
#pragma unroll
        for (int j = 0; j < 4; ++j) v[r][j] = v[r][j] * rstd * A[j] + Bv[j];
        st_row_bf16(orow[r], lane, v[r]); }
}
__device__ __forceinline__ void p1_norm_in(Frame& F) {
    const float* modp = (const float*)(arg_ws() + WS_MODP); const float* bmod = arg_in(5); float* modf = (float*)(arg_ws() + WS_MOD);
    for (int idx = F.vcu * 512 + F.tid; idx < 2 * 17 * MODW; idx += F.G * 512) { const int l = idx / (17 * MODW), r = idx - l * (17 * MODW), j = r % MODW; float s = bmod[l * MODW + j];
#pragma unroll
        for (int q = 0; q < 4; ++q) s += modp[(size_t)(q * 2 + l) * 17 * MODW + r];
        modf[idx] = s; }
    const int b = F.vcu >> 4; const float* n1 = arg_in(6);
    f32x4 A[4], Bv[4];
#define P1_COEF(BB) do { _Pragma("unroll") for (int j = 0; j < 4; ++j) { const int c = 4 * F.lane + 256 * j; f32x4 sh = *(const f32x4*)(bmod + c), sc = *(const f32x4*)(bmod + 1024 + c); \
        _Pragma("unroll") for (int q = 0; q < 4; ++q) { const float* pp = modp + ((size_t)(q * 2) * 17 + (BB)) * MODW; sh += *(const f32x4*)(pp + c); sc += *(const f32x4*)(pp + 1024 + c); } \
        A[j] = *(const f32x4*)(n1 + c) * (1.0f + sc); Bv[j] = sh; } } while (0)
    P1_COEF(b);
    bf16_t* H = (bf16_t*)(arg_ws() + WS_H); const float* X = arg_in(0);
    for (int i = 0; i < 16; i += 4) { const int row = F.vcu * 128 + F.wave + 8 * i;
        const float* const xr[4] = {X + (size_t)row * DM, X + (size_t)(row + 8) * DM, X + (size_t)(row + 16) * DM, X + (size_t)(row + 24) * DM};
        bf16_t* const orow[4] = {H + (size_t)row * DM, H + (size_t)(row + 8) * DM, H + (size_t)(row + 16) * DM, H + (size_t)(row + 24) * DM};
        norm_rows<4>(xr, orow, F.lane, A, Bv); }
    P1_COEF(16);
#undef P1_COEF
    bf16_t* HC = (bf16_t*)(arg_ws() + WS_HC); const float* XC = arg_in(2);
    { const int row = F.vcu * 16 + F.wave;
        const float* const xr[2] = {XC + (size_t)row * DM, XC + (size_t)(row + 8) * DM};
        bf16_t* const orow[2] = {HC + (size_t)row * DM, HC + (size_t)(row + 8) * DM};
        norm_rows<2>(xr, orow, F.lane, A, Bv); }
}

#ifndef RNR
#define RNR 2
#endif
__device__ __forceinline__ void router_finish(const float (&lg)[16], int lane, float* prow) {
    float a8[8], a4[4], a2[2], a1;
    { const bool up = (lane & 32) != 0;
#pragma unroll
      for (int q = 0; q < 8; ++q) { const float keep = up ? lg[q + 8] : lg[q], send = up ? lg[q] : lg[q + 8]; a8[q] = keep + __shfl_xor(send, 32); } }
    { const bool up = (lane & 16) != 0;
#pragma unroll
      for (int q = 0; q < 4; ++q) { const float keep = up ? a8[q + 4] : a8[q], send = up ? a8[q] : a8[q + 4]; a4[q] = keep + __shfl_xor(send, 16); } }
    { const bool up = (lane & 8) != 0;
#pragma unroll
      for (int q = 0; q < 2; ++q) { const float keep = up ? a4[q + 2] : a4[q], send = up ? a4[q] : a4[q + 2]; a2[q] = keep + __shfl_xor(send, 8); } }
    { const bool up = (lane & 4) != 0; const float keep = up ? a2[1] : a2[0], send = up ? a2[0] : a2[1]; a1 = keep + __shfl_xor(send, 4); }
    a1 += __shfl_xor(a1, 2); a1 += __shfl_xor(a1, 1);
    float mx = a1; mx = fmaxf(mx, __shfl_xor(mx, 4)); mx = fmaxf(mx, __shfl_xor(mx, 8)); mx = fmaxf(mx, __shfl_xor(mx, 16)); mx = fmaxf(mx, __shfl_xor(mx, 32));
    const float pe = __builtin_amdgcn_exp2f((a1 - mx) * 1.4426950408889634f);
    float sm = pe; sm += __shfl_xor(sm, 4); sm += __shfl_xor(sm, 8); sm += __shfl_xor(sm, 16); sm += __shfl_xor(sm, 32);
    const int e = ((lane >> 5) & 1) * 8 + ((lane >> 4) & 1) * 4 + ((lane >> 3) & 1) * 2 + ((lane >> 2) & 1);
    if ((lane & 3) == 0) prow[e] = pe / sm;
}
__device__ __forceinline__ void p_router(Frame& F, int l) {
    constexpr int WP = 2064;
    LAS unsigned char* WH = F.lds; LAS unsigned char* WL = F.lds + 16 * WP; LAS float* AC = (LAS float*)(F.lds + 32 * WP); LAS float* BC = AC + DM;
    const float* wsrc = arg_in(17) + (size_t)l * DM * NE;
    for (int idx = F.tid; idx < DM * NE; idx += 512) { const int k = idx >> 4, e = idx & 15; const float w = wsrc[idx]; const unsigned hi = cvt_pk_bf16(w, w) & 0xffffu; const float rem = w - __uint_as_float(hi << 16);
        *(LAS unsigned short*)(WH + e * WP + k * 2) = (unsigned short)hi; *(LAS unsigned short*)(WL + e * WP + k * 2) = (unsigned short)(cvt_pk_bf16(rem, rem) & 0xffffu); }
    const int b = F.vcu >> 4; const float* mod = (const float*)(arg_ws() + WS_MOD) + ((size_t)l * 17 + b) * MODW; const float* n2 = arg_in(7) + l * DM;
    for (int k = F.tid; k < DM; k += 512) { AC[k] = n2[k] * (1.0f + mod[4096 + k]); BC[k] = mod[3072 + k]; }
    __syncthreads();
    const int lane = F.lane, r = lane & 15, kq = lane >> 4, row = F.vcu * 128 + F.wave * 16 + r;
    const bf16_t* xr = (l ? (const bf16_t*)(arg_ws() + WS_X3) : (const bf16_t*)arg_out()) + (size_t)row * DM + kq * 8; unsigned char* hr = (unsigned char*)(arg_ws() + WS_H) + (size_t)row * DM + kq * 8;
    const LAS unsigned char* whp = WH + r * WP + kq * 16; const LAS unsigned char* wlp = WL + r * WP + kq * 16; const LAS float* acp = AC + kq * 8; const LAS float* bcp = BC + kq * 8;
    f32x4 acc = (f32x4){0.f, 0.f, 0.f, 0.f};
    u32x4 xs[32];
#pragma unroll
    for (int q = 0; q < 32; ++q) xs[q] = *(const u32x4*)(xr + 32 * q);
    asm volatile("" ::: "memory");
    float rstd; { f32x2 s0 = {0.f, 0.f}, s1 = {0.f, 0.f}, s2 = {0.f, 0.f}, s3 = {0.f, 0.f};
#pragma unroll
        for (int q = 0; q < 32; ++q) { const f32x2 v0 = {bflo(xs[q].x), bfhi(xs[q].x)}, v1 = {bflo(xs[q].y), bfhi(xs[q].y)}, v2 = {bflo(xs[q].z), bfhi(xs[q].z)}, v3 = {bflo(xs[q].w), bfhi(xs[q].w)};
            s0 += v0 * v0; s1 += v1 * v1; s2 += v2 * v2; s3 += v3 * v3; }
        const f32x2 st = (s0 + s1) + (s2 + s3); float sq = st.x + st.y; sq += __shfl_xor(sq, 16); sq += __shfl_xor(sq, 32);
        rstd = __builtin_amdgcn_rsqf(sq * (1.0f / DM) + NORM_EPS); }
#pragma unroll
    for (int q = 0; q < 32; ++q) asm volatile("" : "+v"(xs[q]));
#define RT_STEP1(X, s) do { \
        const f32x4 a0 = *(const LAS f32x4*)(acp + 32 * (s)), a1 = *(const LAS f32x4*)(acp + 32 * (s) + 4), c0 = *(const LAS f32x4*)(bcp + 32 * (s)), c1 = *(const LAS f32x4*)(bcp + 32 * (s) + 4); \
        const f32x4 x0 = (f32x4){bflo(X.x), bfhi(X.x), bflo(X.y), bfhi(X.y)}, x1 = (f32x4){bflo(X.z), bfhi(X.z), bflo(X.w), bfhi(X.w)}; \
        const f32x4 h0 = x0 * rstd * a0 + c0, h1 = x1 * rstd * a1 + c1; \
        u32x4 hw; hw.x = cvt_pk_bf16(h0[0], h0[1]); hw.y = cvt_pk_bf16(h0[2], h0[3]); hw.z = cvt_pk_bf16(h1[0], h1[1]); hw.w = cvt_pk_bf16(h1[2], h1[3]); \
        { u32x2 h8_; h8_.x = pk4_fp8(h0 * FP8_SA); h8_.y = pk4_fp8(h1 * FP8_SA); *(u32x2*)(hr + 32 * (s)) = h8_; } \
        u32x4 lw; lw.x = cvt_pk_bf16(h0[0] - bflo(hw.x), h0[1] - bfhi(hw.x)); lw.y = cvt_pk_bf16(h0[2] - bflo(hw.y), h0[3] - bfhi(hw.y)); lw.z = cvt_pk_bf16(h1[0] - bflo(hw.z), h1[1] - bfhi(hw.z)); lw.w = cvt_pk_bf16(h1[2] - bflo(hw.w), h1[3] - bfhi(hw.w)); \
        const bf16x8 wh = *(const LAS bf16x8*)(whp + 64 * (s)), wl = *(const LAS bf16x8*)(wlp + 64 * (s)); const bf16x8 ah = *reinterpret_cast<const bf16x8*>(&hw), al = *reinterpret_cast<const bf16x8*>(&lw); \
        acc = __builtin_amdgcn_mfma_f32_16x16x32_bf16(ah, wh, acc, 0, 0, 0); acc = __builtin_amdgcn_mfma_f32_16x16x32_bf16(ah, wl, acc, 0, 0, 0); acc = __builtin_amdgcn_mfma_f32_16x16x32_bf16(al, wh, acc, 0, 0, 0); } while (0)
#pragma unroll
    for (int s = 0; s < 32; ++s) RT_STEP1(xs[s], s);
#undef RT_STEP1
    float* probs = (float*)(arg_ws() + WS_PROBS) + (size_t)(F.vcu * 128 + F.wave * 16 + 4 * kq) * 16 + r;
#pragma unroll
    for (int i = 0; i < 4; ++i) { const float lg = acc[i]; float mx = lg; mx = fmaxf(mx, __shfl_xor(mx, 1)); mx = fmaxf(mx, __shfl_xor(mx, 2)); mx = fmaxf(mx, __shfl_xor(mx, 4)); mx = fmaxf(mx, __shfl_xor(mx, 8));
        const float pe = __builtin_amdgcn_exp2f((lg - mx) * 1.4426950408889634f); float sm = pe; sm += __shfl_xor(sm, 1); sm += __shfl_xor(sm, 2); sm += __shfl_xor(sm, 4); sm += __shfl_xor(sm, 8);
        probs[i * 16] = pe / sm; }
}

__device__ __forceinline__ void p_topk(Frame& F, const int e, const int b) {
    const int pm = e * 16 + b, lane = F.lane;
    LAS unsigned* hist = (LAS unsigned*)F.lds;
    LAS unsigned* wtot = (LAS unsigned*)(F.lds + 4096);
    LAS unsigned* sel = (LAS unsigned*)(F.lds + 4096 + 64);
    LAS int* idxs = (LAS int*)(F.lds + 8192);
    const float* probs = (const float*)(arg_ws() + WS_PROBS) + ((size_t)b * SEQ + 4 * F.tid) * 16 + e;
    unsigned u[4];
#pragma unroll
    for (int q = 0; q < 4; ++q) u[q] = __float_as_uint(probs[q * 16]);
    unsigned prefix = 0, need = CAP;
#pragma unroll 1
    for (int pass = 0; pass < 3; ++pass) {
        const int shift = 20 - 10 * pass;
        hist[F.tid] = 0; hist[F.tid + 512] = 0;
        __syncthreads();
#pragma unroll
        for (int q = 0; q < 4; ++q) if (pass == 0 || (u[q] >> (shift + 10)) == prefix) (void)__hip_atomic_fetch_add(&hist[(u[q] >> shift) & 1023u], 1u, __ATOMIC_RELAXED, __HIP_MEMORY_SCOPE_WORKGROUP);
        __syncthreads();
        if (F.wave == 0) {
            const u32x4 c0 = *(const LAS u32x4*)(hist + 16 * lane), c1 = *(const LAS u32x4*)(hist + 16 * lane + 4), c2 = *(const LAS u32x4*)(hist + 16 * lane + 8), c3 = *(const LAS u32x4*)(hist + 16 * lane + 12);
            const unsigned tot = ((c0.x + c0.y) + (c0.z + c0.w)) + ((c1.x + c1.y) + (c1.z + c1.w)) + ((c2.x + c2.y) + (c2.z + c2.w)) + ((c3.x + c3.y) + (c3.z + c3.w));
            unsigned incl = tot;
#pragma unroll
            for (int d = 1; d < 64; d <<= 1) { const unsigned o = __shfl_down(incl, d); if (lane + d < 64) incl += o; }
            const unsigned above = incl - tot;
            if (above < need && need <= above + tot) {
                unsigned run = above, fb = 0, fr = 0;
#define TK_BIN(k, cv) { if (run < need && need <= run + (cv)) { fb = (unsigned)(k); fr = need - run; } run += (cv); }
                TK_BIN(15, c3.w) TK_BIN(14, c3.z) TK_BIN(13, c3.y) TK_BIN(12, c3.x) TK_BIN(11, c2.w) TK_BIN(10, c2.z) TK_BIN(9, c2.y) TK_BIN(8, c2.x)
                TK_BIN(7, c1.w) TK_BIN(6, c1.z) TK_BIN(5, c1.y) TK_BIN(4, c1.x) TK_BIN(3, c0.w) TK_BIN(2, c0.z) TK_BIN(1, c0.y) TK_BIN(0, c0.x)
#undef TK_BIN
                sel[0] = (prefix << 10) | (16u * lane + fb); sel[1] = fr;
            }
        }
        __syncthreads();
        prefix = sel[0]; need = sel[1];
    }
    unsigned cnt = 0;
#pragma unroll
    for (int q = 0; q < 4; ++q) cnt += (u[q] > prefix ? 1u : 0u) + (u[q] == prefix ? 0x10000u : 0u);
    unsigned inc = cnt;
#pragma unroll
    for (int d = 1; d < 64; d <<= 1) { const unsigned o = __shfl_up(inc, d); if (lane >= d) inc += o; }
    if (lane == 63) wtot[F.wave] = inc;
    __syncthreads();
    unsigned run = inc - cnt;
#pragma unroll
    for (int w = 0; w < 8; ++w) run += (w < F.wave) ? wtot[w] : 0u;
    float* vals = (float*)(arg_ws() + WS_VALS) + (size_t)pm * CAP; int* slotg = (int*)(arg_ws() + WS_SLOT) + ((size_t)b * SEQ + 4 * F.tid) * 16 + e;
#pragma unroll
    for (int q = 0; q < 4; ++q) { const unsigned gtb = run & 0xffffu, eqb = run >> 16; const bool gt = u[q] > prefix, eq = u[q] == prefix, s_ = gt || (eq && eqb < need);
        const int sl = s_ ? (int)(gtb + (eqb < need ? eqb : need)) : -1;
        slotg[q * 16] = sl;
        if (s_) { idxs[sl] = 4 * F.tid + q; vals[sl] = __uint_as_float(u[q]); }
        run += (gt ? 1u : 0u) + (eq ? 0x10000u : 0u); }
    __syncthreads();
    { const int R0 = (F.tid >> 7) * 16 + ((F.tid & 63) >> 2);
      const unsigned a0 = (unsigned)idxs[R0], a1 = (unsigned)idxs[R0 + 64], b0 = (unsigned)idxs[128 + R0], b1 = (unsigned)idxs[192 + R0];
      ((u32x2*)(arg_ws() + WS_GPK))[(size_t)pm * 512 + F.tid] = (u32x2){a0 | (a1 << 16), b0 | (b1 << 16)}; }
}

__device__ __forceinline__ void p_combine(Frame& F, int l, bool fin) {
    const int b = F.vcu >> 4, lane = F.lane; const float* mod = (const float*)(arg_ws() + WS_MOD) + ((size_t)l * 17 + b) * MODW;
    f32x4 G2[2][2], A[2][2], Bv[2][2];
#pragma unroll
    for (int j = 0; j < 2; ++j)
#pragma unroll
        for (int h = 0; h < 2; ++h) { const int c = 8 * lane + 512 * j + 4 * h; G2[j][h] = *(const f32x4*)(mod + 5120 + c) * (1.0f / FP8_SY);
            if (fin) { A[j][h] = *(const f32x4*)(arg_in(21) + c); Bv[j][h] = (f32x4){0.f, 0.f, 0.f, 0.f}; }
            else { const float* mod1 = (const float*)(arg_ws() + WS_MOD) + ((size_t)(l + 1) * 17 + b) * MODW; A[j][h] = *(const f32x4*)(arg_in(6) + (l + 1) * DM + c) * (1.0f + *(const f32x4*)(mod1 + 1024 + c)); Bv[j][h] = *(const f32x4*)(mod1 + c); } }
    const int* slotg = (const int*)(arg_ws() + WS_SLOT); const unsigned char* Y = (const unsigned char*)(arg_ws() + WS_Y); bf16_t* H = (bf16_t*)(arg_ws() + WS_H);
    const bf16_t* XI = fin ? (const bf16_t*)(arg_ws() + WS_X3) : (const bf16_t*)arg_out(); bf16_t* XO = (bf16_t*)(arg_ws() + WS_X2); float* OUT = arg_out();
    for (int i = 0; i < 16; ++i) { const int row = F.vcu * 128 + F.wave + 8 * i; const bf16_t* xr = XI + (size_t)row * DM + 8 * lane;
        f32x4 v[2][2], acc[2][2];
#pragma unroll
        for (int j = 0; j < 2; ++j) { const u32x4 w = *(const u32x4*)(xr + 512 * j); v[j][0] = (f32x4){bflo(w.x), bfhi(w.x), bflo(w.y), bfhi(w.y)}; v[j][1] = (f32x4){bflo(w.z), bfhi(w.z), bflo(w.w), bfhi(w.w)};
            acc[j][0] = (f32x4){0.f, 0.f, 0.f, 0.f}; acc[j][1] = (f32x4){0.f, 0.f, 0.f, 0.f}; }
        const int sl = lane < 16 ? slotg[(size_t)row * 16 + lane] : -1;
#pragma unroll
        for (int e = 0; e < 16; ++e) { const int s = __builtin_amdgcn_readlane(sl, e);
            if (s >= 0) { const unsigned char* yr = Y + ((size_t)(e * 16 + b) * CAP + s) * DM + 8 * lane;
#pragma unroll
                for (int j = 0; j < 2; ++j) { const u32x2 w = *(const u32x2*)(yr + 512 * j);
                    const f32x2 p0 = __builtin_amdgcn_cvt_pk_f32_fp8((int)w.x, false), p1 = __builtin_amdgcn_cvt_pk_f32_fp8((int)w.x, true), p2 = __builtin_amdgcn_cvt_pk_f32_fp8((int)w.y, false), p3 = __builtin_amdgcn_cvt_pk_f32_fp8((int)w.y, true);
                    acc[j][0] += (f32x4){p0.x, p0.y, p1.x, p1.y}; acc[j][1] += (f32x4){p2.x, p2.y, p3.x, p3.y}; } } }
        float ss = 0.f;
#pragma unroll
        for (int j = 0; j < 2; ++j)
#pragma unroll
            for (int h = 0; h < 2; ++h) { v[j][h] = v[j][h] + G2[j][h] * acc[j][h]; ss += (v[j][h][0] * v[j][h][0] + v[j][h][1] * v[j][h][1]) + (v[j][h][2] * v[j][h][2] + v[j][h][3] * v[j][h][3]); }
        const float rstd = __builtin_amdgcn_rsqf(wave_sum(ss) * (1.0f / DM) + NORM_EPS);
        if (!fin) {
#pragma unroll
            for (int j = 0; j < 2; ++j) { u32x4 w; w.x = cvt_pk_bf16(v[j][0][0], v[j][0][1]); w.y = cvt_pk_bf16(v[j][0][2], v[j][0][3]); w.z = cvt_pk_bf16(v[j][1][0], v[j][1][1]); w.w = cvt_pk_bf16(v[j][1][2], v[j][1][3]);
                *(u32x4*)(XO + (size_t)row * DM + 8 * lane + 512 * j) = w; }
#pragma unroll
            for (int j = 0; j < 2; ++j) { const f32x4 h0 = v[j][0] * rstd * A[j][0] + Bv[j][0], h1 = v[j][1] * rstd * A[j][1] + Bv[j][1];
                u32x4 w; w.x = cvt_pk_bf16(h0[0], h0[1]); w.y = cvt_pk_bf16(h0[2], h0[3]); w.z = cvt_pk_bf16(h1[0], h1[1]); w.w = cvt_pk_bf16(h1[2], h1[3]);
                *(u32x4*)(H + (size_t)row * DM + 8 * lane + 512 * j) = w; }
        } else {
#pragma unroll
            for (int j = 0; j < 2; ++j)
#pragma unroll
                for (int h = 0; h < 2; ++h) *(f32x4*)(OUT + (size_t)row * DM + 8 * lane + 512 * j + 4 * h) = v[j][h] * rstd * A[j][h];
        }
    }
}

__device__ __forceinline__ void p_conv(Frame& F) {
    bf16_t* MIX = (bf16_t*)(arg_ws() + WS_MIX);
    const bf16_t* Z = (const bf16_t*)(arg_ws() + WS_Z); const bf16_t* GB = (const bf16_t*)(arg_ws() + WS_GB); const float* cw = arg_in(11);
    int c8 = F.lane * 8; asm volatile("" : "+v"(c8));
    f32x4 w0a = *(const f32x4*)(cw + c8), w0b = *(const f32x4*)(cw + c8 + 4), w1a = *(const f32x4*)(cw + 512 + c8), w1b = *(const f32x4*)(cw + 512 + c8 + 4), w2a = *(const f32x4*)(cw + 1024 + c8), w2b = *(const f32x4*)(cw + 1024 + c8 + 4);
    for (int rep_ = 0; rep_ < 1 + ((SUBREP >> 1) & 1); ++rep_)
#pragma unroll 1
    for (int it = 0; it < 4; ++it) { const int r0 = F.vcu * 128 + F.wave * 16 + it * 4;
        const bool lo_ok = (r0 & (SEQ - 1)) != 0, hi_ok = ((r0 + 4) & (SEQ - 1)) != 0;
        u32x4 z[6], g[4];
#pragma unroll
        for (int k = 0; k < 6; ++k) { int rr = r0 - 1 + k; rr = rr < 0 ? 0 : (rr > MROWS - 1 ? MROWS - 1 : rr); z[k] = *(const u32x4*)(Z + (size_t)rr * 512 + c8); }
#pragma unroll
        for (int k = 0; k < 4; ++k) g[k] = *(const u32x4*)(GB + (size_t)(r0 + k) * 512 + c8);
        if (!lo_ok) z[0] = (u32x4){0u, 0u, 0u, 0u};
        if (!hi_ok) z[5] = (u32x4){0u, 0u, 0u, 0u};
#pragma unroll
        for (int j = 0; j < 4; ++j) { const u32x4 zp = z[j], zc = z[j + 1], zn = z[j + 2], gb = g[j];
            f32x4 ra, rb;
#define CONV2(k, R, W0, W1, W2, i0) R[i0] = bflo(gb[k]) * (W0[i0] * bflo(zp[k]) + W1[i0] * bflo(zc[k]) + W2[i0] * bflo(zn[k])); R[i0 + 1] = bfhi(gb[k]) * (W0[i0 + 1] * bfhi(zp[k]) + W1[i0 + 1] * bfhi(zc[k]) + W2[i0 + 1] * bfhi(zn[k]));
            CONV2(0, ra, w0a, w1a, w2a, 0) CONV2(1, ra, w0a, w1a, w2a, 2) CONV2(2, rb, w0b, w1b, w2b, 0) CONV2(3, rb, w0b, w1b, w2b, 2)
#undef CONV2
            pg8::st8bf(MIX + (size_t)(r0 + j) * 1024 + 512 + c8, ra, rb); } }
}

__device__ __forceinline__ void p_attn_conv(Frame& F) {
    const float* lp = arg_in(9); float s1 = 0.f, s2 = 0.f;
    for (int i = 0; i < 64; ++i) { s1 += lp[i] * lp[64 + i]; s2 += lp[128 + i] * lp[192 + i]; }
    const float lam = __expf(s1) - __expf(s2) + 0.2f;
    const bf16_t* Q = (const bf16_t*)(arg_ws() + WS_Q); const bf16_t* Kb = (const bf16_t*)(arg_ws() + WS_K); const bf16_t* Vb = (const bf16_t*)(arg_ws() + WS_V); bf16_t* MIX = (bf16_t*)(arg_ws() + WS_MIX);
    PROF_BEGIN(1)
    for (int rep_ = 0; rep_ < 1 + (SUBREP & 1); ++rep_)
    for (int i = 0; i < 4; ++i) { const int bh = (F.vcu >> 5) * 8 + i * 2 + ((F.vcu >> 4) & 1), qb = F.vcu & 15, b = bh >> 2, h = bh & 3;
        if (MOE_CVT_IN_ATTN && rep_ == 0 && (CVT_CLASS(F.vcu)) == i) p_moe_convert(F);
        att::attn_unit(Q + ((size_t)b * SEQ + qb * 128) * 512 + h * 128, Kb + (size_t)bh * SKV * 128, Vb + (size_t)bh * SKV * 128,
                       MIX + ((size_t)b * SEQ + qb * 128) * 1024 + h * 128, lam, arg_in(10), F.lds, F.wave); }
    PROF_END(1, F.lds)
}

__device__ __forceinline__ void p_spatial(Frame& F) {
    using namespace att;
    const int tid = F.tid, wid = F.wave, lane = F.lane, r32 = lane & 31, hi = lane >> 5, qw = wid & 3, wh = wid >> 2;
    const int b = F.vcu >> 4, ck = F.vcu & 15, R0 = b * SEQ + ck * 128;
    LAS unsigned char* Vl = F.lds; LAS float* rs = (LAS float*)(F.lds + 131072 + 2048);
    const float* ssqv = (const float*)(arg_ws() + WS_SSQ);
    if (tid < 128) { float s = 0.f; for (int q = 0; q < 16; ++q) s += ssqv[(size_t)q * MROWS + R0 + tid]; rs[tid] = __builtin_amdgcn_rsqf(s * (1.0f / DM) + NORM_EPS); }
    const bf16_t* VV = (const bf16_t*)(arg_ws() + WS_VV); const bf16_t* U = (const bf16_t*)(arg_ws() + WS_U); bf16_t* MIX1 = (bf16_t*)(arg_ws() + WS_MIX1);
    const int sr = tid >> 4, sc = (tid & 15) * 8;
    constexpr int SP = 512;
    const int erow = tid >> 5, ecol = (tid & 31) * 8;
    u32x4 t[8];
    const unsigned vlo = (unsigned)((sr * DM + sc) * 2), ulo = (unsigned)((erow * DM + ecol) * 2);
#define SP_LOAD(g) do { _Pragma("unroll") for (int it = 0; it < 8; ++it) { const int buf = it >> 1, jh = buf >> 1, whh = buf & 1; \
        t[it] = *(const u32x4*)((const char*)VV + ((size_t)(R0 + jh * 64 + 32 * (it & 1)) * DM + (g) * 256 + whh * 128) * 2 + vlo); } } while (0)
    SP_LOAD(0);
    u32x4 uu[8], un[8];
#define UU_LOAD(X, g) do { _Pragma("unroll") for (int it = 0; it < 8; ++it) X[it] = *(const u32x4*)((const char*)U + ((size_t)(R0 + 16 * it) * DM + (g) * 256) * 2 + ulo); } while (0)
    UU_LOAD(uu, 0);
#pragma unroll 1
    for (int g = 0; g < 4; ++g) {
        LAS unsigned char* Vb = Vl + (g & 1) * 65536;
        const float* wsg = arg_in(14) + ((size_t)g * 128 + 32 * qw + r32) * 128;
        f32x4 wf[2][4][2];
#pragma unroll
        for (int jh = 0; jh < 2; ++jh)
#pragma unroll
            for (int ks = 0; ks < 4; ++ks) { const int j = jh * 64 + ks * 16 + hi * 8; wf[jh][ks][0] = *(const f32x4*)(wsg + j); wf[jh][ks][1] = *(const f32x4*)(wsg + j + 4); }
#pragma unroll
        for (int it = 0; it < 8; ++it) { const int buf = it >> 1, k = sr + 32 * (it & 1); *(LAS u32x4*)(Vb + buf * 16384 + v_st(k, sc)) = t[it]; }
        __syncthreads();
        { const int gn = g < 3 ? g + 1 : 3; SP_LOAD(gn); UU_LOAD(un, gn); }
        bf16x8 pa[2][4];
#pragma unroll
        for (int jh = 0; jh < 2; ++jh)
#pragma unroll
            for (int ks = 0; ks < 4; ++ks) { const int j = jh * 64 + ks * 16 + hi * 8; const f32x4 ra = *(const LAS f32x4*)(rs + j), rb = *(const LAS f32x4*)(rs + j + 4);
                const f32x4 xa = wf[jh][ks][0] * ra, xb = wf[jh][ks][1] * rb; u32x4 w; w.x = cvtpk(xa[0], xa[1]); w.y = cvtpk(xa[2], xa[3]); w.z = cvtpk(xb[0], xb[1]); w.w = cvtpk(xb[2], xb[3]); pa[jh][ks] = *reinterpret_cast<bf16x8*>(&w); }
        asm volatile("" ::: "memory");
        f32x16 o[4] = {};
        const int vb0 = (int)(uintptr_t)Vb + v_rd_base(lane);
#pragma unroll
        for (int jh = 0; jh < 2; ++jh) pv_d0(o, vb0 + (jh * 2 + wh) * 16384, pa[jh][0], pa[jh][1], pa[jh][2], pa[jh][3]);
        const float* vn = arg_in(13); const float* bs = arg_in(15) + g * 128 + 32 * qw;
        float bsv[16];
#pragma unroll
        for (int r = 0; r < 16; ++r) bsv[r] = bs[crow(r, hi)];
        __syncthreads();
#pragma unroll
        for (int d0 = 0; d0 < 4; ++d0) { const int colg = wh * 128 + 32 * d0 + r32; const float vnc = vn[g * 256 + colg];
#pragma unroll
            for (int r = 0; r < 16; ++r) { const float sv = o[d0][r] * vnc + bsv[r]; *(LAS unsigned short*)(Vb + (32 * qw + crow(r, hi)) * SP + colg * 2) = (unsigned short)(cvtpk(sv, sv) & 0xffffu); } }
        __syncthreads();
#pragma unroll
        for (int it = 0; it < 8; ++it) { const u32x4 sv = *(const LAS u32x4*)(Vb + (erow + 16 * it) * SP + ecol * 2); const u32x4 u4 = uu[it];
            f32x4 ra, rb; ra[0] = bflo(u4.x) * bflo(sv.x); ra[1] = bfhi(u4.x) * bfhi(sv.x); ra[2] = bflo(u4.y) * bflo(sv.y); ra[3] = bfhi(u4.y) * bfhi(sv.y);
            rb[0] = bflo(u4.z) * bflo(sv.z); rb[1] = bfhi(u4.z) * bfhi(sv.z); rb[2] = bflo(u4.w) * bflo(sv.w); rb[3] = bfhi(u4.w) * bfhi(sv.w);
            pg8::st8bf((bf16_t*)((char*)MIX1 + ((size_t)(R0 + 16 * it) * DM + g * 256) * 2 + ulo), ra, rb); }
#pragma unroll
        for (int it = 0; it < 8; ++it) uu[it] = un[it];
    }
#undef SP_LOAD
#undef UU_LOAD
}

__device__ __forceinline__ void gemm_skew(Frame& F) { if (GEMM_SKEW > 0 && ((F.vcu >> 3) & 1)) { const unsigned long long t0 = __builtin_amdgcn_s_memrealtime(); while (__builtin_amdgcn_s_memrealtime() - t0 < (unsigned long long)GEMM_SKEW) __builtin_amdgcn_s_sleep(8); } }

__global__ void __launch_bounds__(NWAVES * 64, 2) fwd_kernel(Args args) {
    extern __shared__ __attribute__((aligned(16))) unsigned char lds[];
    Frame F;
    const int wave0 = __builtin_amdgcn_readfirstlane((int)(threadIdx.x >> 6));
    F.lds = (LAS unsigned char*)lds; F.wave = wave0; F.lane = lane_id_now(); F.tid = wave0 * 64 + F.lane;
    F.G = gridDim.x; F.bx = blockIdx.x; F.vcu = (F.bx % 8) * (F.G / 8) + F.bx / 8;
    volatile LAS unsigned* MISC = (volatile LAS unsigned*)(F.lds + MISC_OFF);
    for (int u = F.tid; u < (LDS_BYTES - LDSCTL_OFF) / 4; u += NWAVES * 64) ((LAS unsigned*)(F.lds + LDSCTL_OFF))[u] = 0u;
    __syncthreads();
    XcdBarrier bar; bar.bar = (unsigned*)(arg_ws() + WS_CTL) + CW_BAR; bar.x = 0; bar.st = nullptr; bar.w = wave0;
    const int lo = args.ph_lo, hi = args.ph_hi;
    if (hi - lo > 1) bar = xcd_barrier_post((unsigned*)(arg_ws() + WS_CTL) + CW_BAR, MISC + 8, wave0);
    if (wave0 == 0 && F.lane == 0) (void)xb_add((unsigned*)(arg_ws() + WS_CTL) + CW_GRP + (F.vcu >> 4) * 128 + xb_xcc_id(), 1u);
    LAS unsigned char* ring = (LAS unsigned char*)lds;
#define RELAUNDER() do { int w_ = wave0; asm volatile("" : "+s"(w_)); F.wave = w_; F.lane = lane_id_now(); F.tid = w_ * 64 + F.lane; \
        int bx_ = blockIdx.x; asm volatile("" : "+s"(bx_)); F.bx = bx_; F.vcu = (bx_ % 8) * (F.G / 8) + bx_ / 8; } while (0)
#define RUN_PHASE(K, ...) if (lo <= (K) && (K) < hi && ((PHMASK_FULL >> (K)) & 1)) { \
        for (int rep_ph = 0; rep_ph <= (int)((REPMASK >> (K)) & 1); ++rep_ph) { RELAUNDER(); \
            if (PROF_ID != 0 && PROF_PH >= 0) { if (F.tid == 0) *(LAS int*)(F.lds + PROF_LDS_OFF + 128) = (K); __syncthreads(); } \
            { PROF_BEGIN(20) __VA_ARGS__ PROF_END(20, F.lds) } \
            if (rep_ph < (int)((REPMASK >> (K)) & 1) || (K) + 1 < hi) { PROF_BEGIN(30) xcd_barrier(bar); PROF_END(30, F.lds) } } }
#define MOE_PHASES(L, K0) \
      \
    RUN_PHASE((K0) + 0, { p_router(F, (L)); group_barrier((unsigned*)(arg_ws() + WS_CTL) + CW_GRP + (F.vcu >> 4) * 128, (L), F.wave); p_topk(F, F.vcu & 15, F.vcu >> 4); }) \
    RUN_PHASE((K0) + 2, { pg8::SchedMoeGather8 S{(const char*)(arg_ws() + WS_H), (const char*)(arg_ws() + WS_WGU) + (size_t)(L) * 64 * MiB, F.G, F.bx}; \
                  pg8::EpiGateUp8 E{(unsigned char*)(arg_ws() + WS_ACT)}; \
                  pg8::gemm_phase<pg8::EpiGateUp8, pg8::SchedMoeGather8, GEMM_ALIGN_GU, true, true, true>(ring, DM, S, E, F.tid, (const int*)(arg_ws() + WS_GPK)); }) \
    RUN_PHASE((K0) + 3, { pg8::SchedMoe8 S{(const char*)(arg_ws() + WS_ACT), (const char*)(arg_ws() + WS_WD) + (size_t)(L) * 32 * MiB, 4, F.G, F.bx}; \
                  pg8::EpiDown8 E{(unsigned char*)(arg_ws() + WS_Y), (const float*)(arg_ws() + WS_VALS)}; \
                  pg8::gemm_phase<pg8::EpiDown8, pg8::SchedMoe8, GEMM_ALIGN_DN, true, false, true>(ring, DM, S, E, F.tid); }) \
    RUN_PHASE((K0) + 4, { p_combine(F, (L), (L) == 1); })

    RUN_PHASE(0, { p0_prologue(F); })
    RUN_PHASE(1, { p1_norm_in(F); })
    RUN_PHASE(2, { pg8::SchedInProj S{(const char*)(arg_ws() + WS_H), (const char*)(arg_ws() + WS_HC), (const char*)(arg_ws() + WS_WIN0), F.G, F.bx};
                  pg8::EpiInProj E{(bf16_t*)(arg_ws() + WS_Q), (bf16_t*)(arg_ws() + WS_K), (bf16_t*)(arg_ws() + WS_V), (bf16_t*)(arg_ws() + WS_GB), (bf16_t*)(arg_ws() + WS_Z), ROPE_TAB};
                  pg8::gemm_phase<pg8::EpiInProj, pg8::SchedInProj, GEMM_ALIGN, true>(ring, DM, S, E, F.tid); })
    RUN_PHASE(3, { p_conv(F); RELAUNDER(); p_attn_conv(F); })
    RUN_PHASE(4, { pg8::SchedSimple S{(const char*)(arg_ws() + WS_MIX), (const char*)(arg_ws() + WS_WOUT), 128, 4, F.G, F.bx};
                  pg8::EpiOutProj<true> E{(const void*)arg_in(0), (bf16_t*)arg_out(), (const float*)(arg_ws() + WS_MOD) + 2048, (float*)(arg_ws() + WS_SSQ)};
                  pg8::gemm_phase<pg8::EpiOutProj<true>, pg8::SchedSimple, GEMM_ALIGN, true>(ring, DM, S, E, F.tid); })
    MOE_PHASES(0, 5)
    RUN_PHASE(10, { pg8::SchedSimple S{(const char*)(arg_ws() + WS_H), (const char*)(arg_ws() + WS_WIN1), 128, 8, F.G, F.bx};
                  pg8::EpiOddIn E{(bf16_t*)(arg_ws() + WS_U), (bf16_t*)(arg_ws() + WS_VV), (float*)(arg_ws() + WS_SSQ)};
                  pg8::gemm_phase<pg8::EpiOddIn, pg8::SchedSimple, GEMM_ALIGN, true>(ring, DM, S, E, F.tid); })
    RUN_PHASE(11, { p_spatial(F); })
    RUN_PHASE(12, { pg8::SchedSimple S{(const char*)(arg_ws() + WS_MIX1), (const char*)(arg_ws() + WS_WOUT) + (size_t)DM * DM * 2, 128, 4, F.G, F.bx};
                  pg8::EpiOutProj<false> E{(const void*)(arg_ws() + WS_X2), (bf16_t*)(arg_ws() + WS_X3), (const float*)(arg_ws() + WS_MOD) + (size_t)17 * MODW + 2048, (float*)(arg_ws() + WS_SSQ)};
                  pg8::gemm_phase<pg8::EpiOutProj<false>, pg8::SchedSimple, GEMM_ALIGN, true>(ring, DM, S, E, F.tid); })
    MOE_PHASES(1, 13)
#undef MOE_PHASES
#undef RUN_PHASE
#undef RELAUNDER
    if (PROF_ID != 0) { const unsigned long long acc = *(LAS unsigned long long*)(F.lds + PROF_LDS_OFF + wave0 * 8), t0 = __builtin_amdgcn_s_memrealtime();
        while (__builtin_amdgcn_s_memrealtime() - t0 < (unsigned long long)PROF_MULT * acc) __builtin_amdgcn_s_sleep(8); }
}

extern "C" void kernel_launch(void* const* d_in, const int* in_sizes, int n_in, void* d_out, int out_size, void* d_ws, size_t ws_size, hipStream_t stream) {
    static int grid = 0;
    if (grid == 0) {
        if (n_in != 22 || in_sizes[0] != MROWS * DM || out_size != MROWS * DM || ws_size < WS_END) { fprintf(stderr, "kernel_launch: unexpected shapes (n_in %d, in0 %d, out %d, ws %zu < %zu?); nothing launched\n", n_in, n_in > 0 ? in_sizes[0] : -1, out_size, ws_size, (size_t)WS_END); grid = -1; return; }
        int dev = 0, cus = 0;
        if (hipGetDevice(&dev) != hipSuccess || hipDeviceGetAttribute(&cus, hipDeviceAttributeMultiprocessorCount, dev) != hipSuccess) { grid = -1; return; }
        if (hipFuncSetAttribute((const void*)fwd_kernel, hipFuncAttributeMaxDynamicSharedMemorySize, LDS_BYTES) != hipSuccess) { fprintf(stderr, "kernel_launch: hipFuncSetAttribute failed\n"); grid = -1; return; }
        (void)hipGetLastError();
        grid = cus;
        if (grid != 256) { fprintf(stderr, "kernel_launch: built for 256 CUs, device has %d; nothing launched\n", cus); grid = -1; return; }
    }
    if (grid < 0) return;
    (void)hipMemsetAsync((char*)d_ws + WS_CTL, 0, CTL_ZERO_BYTES, stream);
#ifdef EXTRA_MEMSET
    (void)hipMemsetAsync((char*)d_ws + WS_END - 4096, 0, 4096, stream);
#endif
    Args a{};
    for (int i = 0; i < 22; ++i) a.in[i] = (const float*)d_in[i];
    a.out = (float*)d_out; a.ws = (unsigned char*)d_ws;
#if MK_PER_PHASE
    for (int ph = 0; ph < N_PHASES; ++ph) { a.ph_lo = ph; a.ph_hi = ph + 1; hipLaunchKernelGGL(fwd_kernel, dim3(grid), dim3(NWAVES * 64), LDS_BYTES, stream, a); }
#else
    a.ph_lo = 0; a.ph_hi = N_PHASES; hipLaunchKernelGGL(fwd_kernel, dim3(grid), dim3(NWAVES * 64), LDS_BYTES, stream, a);
#endif
}
```
